# Optimizing an MI355X kernel written in HIP

```python
import math
import jax, jax.numpy as jnp
from jax import lax
import numpy as np

D_MODEL = 1024
BATCH = 4
SEQ = 4096
DEPTH = 1

D_MIX = D_MODEL
M_HEADS = 4
M_DH = D_MODEL // 8
M_WIDTH = M_HEADS * M_DH
CONV_W = 4
CHUNK = 64
A_HEADS = 8
A_DH = D_MODEL // 16
A_WIDTH = A_HEADS * A_DH
IDX_HEADS = 8
IDX_DH = 64
TOPK_MAX = 256
Q_BLOCK = 128
P_HEADS = 8
N_KEYS = 128
N_EXPERTS = N_KEYS * N_KEYS
P_DK = 128
P_TOPK = 16
P_TOK_BLOCK = 128
EPS = 1e-6

_COL_SIZES = (M_WIDTH, M_WIDTH, M_WIDTH, M_WIDTH, M_HEADS, M_HEADS,
              A_WIDTH, A_DH, A_DH, IDX_HEADS * IDX_DH, IDX_DH, IDX_HEADS)
D_IN = 4 * M_WIDTH + 2 * M_HEADS + A_WIDTH + 2 * A_DH + IDX_HEADS * IDX_DH + IDX_DH + IDX_HEADS
F_GATE_OFFSET = 4 * M_WIDTH + M_HEADS

kernel_name = "hymba_mlstm_dsa_peer_block"


def _rmsnorm(x, g):
    xf = x.astype(jnp.float32)
    y = xf * lax.rsqrt(jnp.mean(xf * xf, axis=-1, keepdims=True) + EPS)
    return (y * g.astype(jnp.float32)).astype(x.dtype)


def _headnorm(h, g):
    B, T, H, d = h.shape
    return _rmsnorm(h, g.reshape(H, d)).reshape(B, T, H * d)


def _split_cols(z):
    parts, off = [], 0
    for n in _COL_SIZES:
        parts.append(z[..., off:off + n])
        off += n
    return parts


def _causal_conv(x, w):
    T = x.shape[1]
    xp = jnp.pad(x, ((0, 0), (CONV_W - 1, 0), (0, 0)))
    out = xp[:, 0:T] * w[0]
    for j in range(1, CONV_W):
        out = out + xp[:, j:j + T] * w[j]
    return out


def _mlstm(q, k, v, i_pre, f_pre):
    B, T, H, Dk = q.shape
    Dv = v.shape[-1]
    NC = T // CHUNK

    def to_chunks(a):
        a = a.astype(jnp.float32).reshape((B, NC, CHUNK, H) + a.shape[3:])
        return jnp.moveaxis(a, 3, 1)

    q = to_chunks(q) * (Dk ** -0.5)
    k = to_chunks(k)
    v = to_chunks(v)
    ig = to_chunks(i_pre)
    b = jnp.cumsum(jax.nn.log_sigmoid(to_chunks(f_pre)), -1)
    b_last = b[..., -1]

    causal = jnp.tril(jnp.ones((CHUNK, CHUNK), dtype=bool))
    log_d = jnp.where(causal, b[..., :, None] - b[..., None, :] + ig[..., None, :], -jnp.inf)

    a = b_last[..., None] - b + ig
    m_loc = jnp.max(a, axis=-1)
    w_loc = jnp.exp(a - m_loc[..., None])
    kv = jnp.einsum('bhcsd,bhcse->bhcde', k * w_loc[..., None], v)
    ks = jnp.einsum('bhcs,bhcsd->bhcd', w_loc, k)

    def step(carry, inp):
        C, n, m = carry
        bl, ml, kvc, ksc = inp
        m_new = jnp.maximum(bl + m, ml)
        dec = jnp.exp(bl + m - m_new)
        inj = jnp.exp(ml - m_new)
        C_new = dec[..., None, None] * C + inj[..., None, None] * kvc
        n_new = dec[..., None] * n + inj[..., None] * ksc
        return (C_new, n_new, m_new), (C, n, m)

    init = (jnp.zeros((B, H, Dk, Dv), jnp.float32),
            jnp.zeros((B, H, Dk), jnp.float32),
            jnp.zeros((B, H), jnp.float32))
    xs = (jnp.moveaxis(b_last, 2, 0), jnp.moveaxis(m_loc, 2, 0),
          jnp.moveaxis(kv, 2, 0), jnp.moveaxis(ks, 2, 0))
    _, (C0, n0, m0) = lax.scan(step, init, xs)
    C0 = jnp.moveaxis(C0, 0, 2)
    n0 = jnp.moveaxis(n0, 0, 2)
    m0 = jnp.moveaxis(m0, 0, 2)

    m_inter = b + m0[..., None]
    m_t = jnp.maximum(m_inter, jnp.max(log_d, axis=-1))
    w_inter = jnp.exp(m_inter - m_t)
    s = jnp.einsum('bhctd,bhcsd->bhcts', q, k) * jnp.exp(log_d - m_t[..., None])
    num = (jnp.einsum('bhcts,bhcse->bhcte', s, v)
           + w_inter[..., None] * jnp.einsum('bhctd,bhcde->bhcte', q, C0))
    den = jnp.sum(s, axis=-1) + w_inter * jnp.einsum('bhctd,bhcd->bhct', q, n0)
    h = num / jnp.maximum(jnp.abs(den), jnp.exp(-m_t))[..., None]
    return jnp.moveaxis(h, 1, 3).reshape(B, T, H, Dv)


def _dsa(q, k, v, qi, ki, wi):
    B, T, H, dh = q.shape
    n_sel = min(TOPK_MAX, T // 4)
    NB = T // Q_BLOCK
    idx_scale = (IDX_DH ** -0.5) * (IDX_HEADS ** -0.5)
    att_scale = dh ** -0.5
    key_pos = jnp.arange(T)

    def blocks(a):
        return jnp.moveaxis(a.reshape((B, NB, Q_BLOCK) + a.shape[2:]), 1, 0)

    def block(args):
        qb, qib, wib, tb = args
        rel = jax.nn.relu(jnp.einsum('bqhd,bsd->bqhs', qib, ki))
        score = jnp.einsum('bqhs,bqh->bqs', rel, wib).astype(jnp.float32) * idx_scale
        admissible = key_pos[None, :] <= tb[:, None]
        score = jnp.where(admissible[None], score, -jnp.inf)
        _, idx = lax.top_k(score, n_sel)
        kg = jax.vmap(lambda kk, ii: kk[ii])(k, idx)
        vg = jax.vmap(lambda vv, ii: vv[ii])(v, idx)
        s = jnp.einsum('bqhd,bqkd->bqhk', qb, kg).astype(jnp.float32) * att_scale
        ok = idx <= tb[None, :, None]
        s = jnp.where(ok[:, :, None, :], s, -jnp.inf)
        p = jax.nn.softmax(s, axis=-1).astype(vg.dtype)
        return jnp.einsum('bqhk,bqkd->bqhd', p, vg)

    out = lax.map(block, (blocks(q), blocks(qi), blocks(wi), key_pos.reshape(NB, Q_BLOCK)))
    return jnp.moveaxis(out, 0, 1).reshape(B, T, H, dh)


def _peer(h, w_q, sub_keys, u_tab, v_tab):
    B, T, D = h.shape
    n_tok = B * T
    xt = h.reshape(n_tok, D)
    qry = (xt @ w_q).reshape(n_tok, P_HEADS, 2, P_DK // 2)
    s = jnp.einsum('nhpd,hpkd->nhpk', qry, sub_keys).astype(jnp.float32)
    s1, i1 = lax.top_k(s[:, :, 0], P_TOPK)
    s2, i2 = lax.top_k(s[:, :, 1], P_TOPK)
    cand = (s1[..., :, None] + s2[..., None, :]).reshape(n_tok, P_HEADS, P_TOPK * P_TOPK)
    cidx = (i1[..., :, None] * N_KEYS + i2[..., None, :]).reshape(n_tok, P_HEADS, P_TOPK * P_TOPK)
    top, pos = lax.top_k(cand, P_TOPK)
    eidx = jnp.take_along_axis(cidx, pos, axis=-1).reshape(n_tok, P_HEADS * P_TOPK)
    gate = jax.nn.softmax(top, axis=-1).reshape(n_tok, P_HEADS * P_TOPK).astype(h.dtype)
    nb = n_tok // P_TOK_BLOCK

    def block(args):
        xb, eb, gb = args
        a = jnp.einsum('nd,nkd->nk', xb, u_tab[eb])
        return jnp.einsum('nk,nkd->nd', gb * jax.nn.gelu(a, approximate=False), v_tab[eb])

    out = lax.map(block, (xt.reshape(nb, P_TOK_BLOCK, D),
                          eidx.reshape(nb, P_TOK_BLOCK, P_HEADS * P_TOPK),
                          gate.reshape(nb, P_TOK_BLOCK, P_HEADS * P_TOPK)))
    return out.reshape(B, T, D)


def setup_inputs(seed: int = 0) -> dict:
    key = jax.random.key(seed)
    ks = jax.random.split(key, 20)
    f32 = jnp.float32
    D = D_MODEL
    nrm = lambda k, s: jax.random.normal(k, s, f32)
    x = nrm(ks[0], (BATCH, SEQ, D))
    c = nrm(ks[1], (BATCH, D))
    w_ada = nrm(ks[2], (DEPTH, D, 6 * D)) * (0.5 * D ** -0.5)
    b_ada = nrm(ks[3], (DEPTH, 6 * D)) * 0.02
    norm1_g = 1.0 + 0.02 * nrm(ks[4], (DEPTH, D))
    w_in = nrm(ks[5], (DEPTH, D, D_IN)) * D ** -0.5
    f_bias = jnp.linspace(3.0, 6.0, M_HEADS, dtype=f32)
    b_in = (0.02 * nrm(ks[6], (DEPTH, D_IN))).at[:, F_GATE_OFFSET:F_GATE_OFFSET + M_HEADS].add(f_bias)
    conv_qk = nrm(ks[7], (DEPTH, CONV_W, 2 * M_WIDTH)) * CONV_W ** -0.5
    out_norm_m = 1.0 + 0.02 * nrm(ks[8], (DEPTH, M_WIDTH))
    out_norm_a = 1.0 + 0.02 * nrm(ks[9], (DEPTH, A_WIDTH))
    w_out = nrm(ks[10], (DEPTH, D_MIX, D)) * D_MIX ** -0.5
    norm2_g = 1.0 + 0.02 * nrm(ks[11], (DEPTH, D))
    w_peer_q = nrm(ks[12], (DEPTH, D, P_HEADS * P_DK)) * D ** -0.5
    peer_sub_keys = nrm(ks[13], (DEPTH, P_HEADS, 2, N_KEYS, P_DK // 2)) * (P_DK // 2) ** -0.5
    peer_u = nrm(ks[14], (DEPTH, N_EXPERTS, D)) * D ** -0.5
    peer_v = nrm(ks[15], (DEPTH, N_EXPERTS, D)) * P_HEADS ** -0.5
    final_g = 1.0 + 0.02 * nrm(ks[16], (D,))
    return {"x": x, "c": c, "w_ada": w_ada, "b_ada": b_ada, "norm1_g": norm1_g,
            "w_in": w_in, "b_in": b_in, "conv_qk": conv_qk, "out_norm_m": out_norm_m,
            "out_norm_a": out_norm_a, "w_out": w_out, "norm2_g": norm2_g,
            "w_peer_q": w_peer_q, "peer_sub_keys": peer_sub_keys, "peer_u": peer_u,
            "peer_v": peer_v, "final_g": final_g}


def reference(x, c, w_ada, b_ada, norm1_g, w_in, b_in, conv_qk, out_norm_m, out_norm_a,
              w_out, norm2_g, w_peer_q, peer_sub_keys, peer_u, peer_v, final_g):
    B, T, _ = x.shape
    for l in range(DEPTH):
        ada = jax.nn.silu(c) @ w_ada[l] + b_ada[l]
        sh1, sc1, g1, sh2, sc2, g2 = jnp.split(ada, 6, axis=-1)
        h = _rmsnorm(x, norm1_g[l]) * (1.0 + sc1[:, None]) + sh1[:, None]
        z = h @ w_in[l] + b_in[l]
        mq, mk, mv, mo, mi, mf, aq, ak, av, iq, ik, iw = _split_cols(z)
        qk = jax.nn.silu(_causal_conv(jnp.concatenate([mq, mk], axis=-1), conv_qk[l]))
        mq, mk = qk[..., :M_WIDTH], qk[..., M_WIDTH:]
        hm = _mlstm(mq.reshape(B, T, M_HEADS, M_DH), mk.reshape(B, T, M_HEADS, M_DH),
                    mv.reshape(B, T, M_HEADS, M_DH), mi, mf)
        hm = _headnorm(hm, out_norm_m[l]).astype(x.dtype) * jax.nn.sigmoid(mo)
        ha = _dsa(aq.reshape(B, T, A_HEADS, A_DH), ak, av,
                  iq.reshape(B, T, IDX_HEADS, IDX_DH), ik, iw)
        ha = _headnorm(ha, out_norm_a[l]).astype(x.dtype)
        y = jnp.concatenate([hm, ha], axis=-1) @ w_out[l]
        x = x + g1[:, None] * y
        h2 = _rmsnorm(x, norm2_g[l]) * (1.0 + sc2[:, None]) + sh2[:, None]
        x = x + g2[:, None] * _peer(h2, w_peer_q[l], peer_sub_keys[l], peer_u[l], peer_v[l])
    return _rmsnorm(x, final_g)
```

```cpp
#include <hip/hip_runtime.h>
#include <stdint.h>
#define REP_PHASE -1
#define DSA_REP 0
#include <cstdio>

#define LAS __attribute__((address_space(3)))
typedef unsigned short bf16_t;
typedef short bf16x8 __attribute__((ext_vector_type(8)));
typedef float f32x4 __attribute__((ext_vector_type(4)));
typedef float f32x2 __attribute__((ext_vector_type(2)));
typedef float f32x16 __attribute__((ext_vector_type(16)));
typedef unsigned u32x4 __attribute__((ext_vector_type(4)));
typedef unsigned u32x2 __attribute__((ext_vector_type(2)));

constexpr int NTOK = 16384, DM = 1024, SEQ = 4096;
constexpr int NIN_PAD = 3328;
constexpr int LDS_BYTES = 163840 - 64;
constexpr int NTHREADS = 512;

constexpr size_t MiB = 1024 * 1024;
constexpr size_t OFF_CTL = 0;
constexpr size_t CTL_BYTES = 16384;
constexpr size_t OFF_ADA = 64 * 1024;
constexpr size_t OFF_BIAS = 192 * 1024;
constexpr size_t OFF_SK = 256 * 1024;
constexpr size_t OFF_WIN = 512 * 1024;
constexpr size_t OFF_WOUT = 7 * MiB;
constexpr size_t OFF_WPQ = 9 * MiB;
constexpr size_t OFF_ACT = 11 * MiB;
constexpr size_t OFF_MQ = 43 * MiB;
constexpr size_t OFF_MK = 59 * MiB;
constexpr size_t OFF_MV = 75 * MiB;
constexpr size_t OFF_MO = 91 * MiB;
constexpr size_t OFF_AQ = 107 * MiB;
constexpr size_t OFF_IQ = 123 * MiB;
constexpr size_t OFF_AK = 139 * MiB;
constexpr size_t OFF_AV = 141 * MiB;
constexpr size_t OFF_IK = 143 * MiB;
constexpr size_t OFF_GATE = 145 * MiB;
constexpr size_t OFF_KV = 146 * MiB;
constexpr size_t OFF_KS = 178 * MiB;
constexpr size_t OFF_MLOC = 178 * MiB + 512 * 1024;
constexpr size_t OFF_BLAST = OFF_MLOC + 4096;
constexpr size_t OFF_M0 = OFF_BLAST + 4096;
constexpr size_t OFF_UT = 179 * MiB;
constexpr size_t OFF_VT = 195 * MiB;
constexpr size_t WS_END = 211 * MiB;
constexpr size_t OFF_QRY = OFF_MQ;
constexpr size_t OFF_EIDX = OFF_MV;
constexpr size_t OFF_GW = OFF_MV + 8 * MiB;

struct Params {
    const float* x; const float* c; const float* w_ada; const float* b_ada; const float* norm1_g;
    const float* w_in; const float* b_in; const float* conv_qk; const float* out_norm_m; const float* out_norm_a;
    const float* w_out; const float* norm2_g; const float* w_peer_q; const float* sub_keys; const float* peer_u;
    const float* peer_v; const float* final_g;
    float* out; unsigned char* ws;
    int ph_lo, ph_hi;
};

__device__ __forceinline__ int opaque_tid() { int t = threadIdx.x; asm volatile("" : "+v"(t)); return t; }
__device__ __forceinline__ float bf2f(unsigned short b) { return __uint_as_float(((unsigned)b) << 16); }
__device__ __forceinline__ unsigned short f2bf(float f) { unsigned u = __float_as_uint(f); u += 0x7FFFu + ((u >> 16) & 1u); return (unsigned short)(u >> 16); }
__device__ __forceinline__ unsigned pack2(float lo, float hi) { return (unsigned)f2bf(lo) | ((unsigned)f2bf(hi) << 16); }
__device__ __forceinline__ float lo16(unsigned w) { return __uint_as_float(w << 16); }
__device__ __forceinline__ float hi16(unsigned w) { return __uint_as_float(w & 0xffff0000u); }
__device__ __forceinline__ float wave_sum(float v) {
#pragma unroll
    for (int o = 32; o >= 1; o >>= 1) v += __shfl_xor(v, o);
    return v;
}
__device__ __forceinline__ int wave_sum_i32_uniform(int v) {
    v += __builtin_amdgcn_update_dpp(0, v, 0xB1, 0xF, 0xF, true);
    v += __builtin_amdgcn_update_dpp(0, v, 0x4E, 0xF, 0xF, true);
    v += __builtin_amdgcn_update_dpp(0, v, 0x141, 0xF, 0xF, true);
    v += __builtin_amdgcn_update_dpp(0, v, 0x140, 0xF, 0xF, true);
    return __builtin_amdgcn_readlane(v, 0) + __builtin_amdgcn_readlane(v, 16) + __builtin_amdgcn_readlane(v, 32) + __builtin_amdgcn_readlane(v, 48);
}
__device__ __forceinline__ float wave_scan_add(float v, int lane) {
#pragma unroll
    for (int o = 1; o < 64; o <<= 1) { const float t = __shfl_up(v, o); if (lane >= o) v += t; }
    return v;
}
__device__ __forceinline__ float wave_scan_max(float v, int lane) {
#pragma unroll
    for (int o = 1; o < 64; o <<= 1) { const float t = __shfl_up(v, o); if (lane >= o) v = fmaxf(v, t); }
    return v;
}
__device__ __forceinline__ float wave_max(float v) {
#pragma unroll
    for (int o = 32; o >= 1; o >>= 1) v = fmaxf(v, __shfl_xor(v, o));
    return v;
}
#define dppf(v, ctrl) __uint_as_float((unsigned)__builtin_amdgcn_update_dpp(0, (int)__float_as_uint(v), (ctrl), 0xF, 0xF, true))
__device__ __forceinline__ float rlanef(float v, int l) { return __uint_as_float((unsigned)__builtin_amdgcn_readlane((int)__float_as_uint(v), l)); }
__device__ __forceinline__ float wave_sum_dpp(float v) {
    v += dppf(v, 0xB1); v += dppf(v, 0x4E); v += dppf(v, 0x141); v += dppf(v, 0x140);
    return (rlanef(v, 0) + rlanef(v, 16)) + (rlanef(v, 32) + rlanef(v, 48));
}
__device__ __forceinline__ float wave_max_dpp(float v) {
    v = fmaxf(v, dppf(v, 0xB1)); v = fmaxf(v, dppf(v, 0x4E)); v = fmaxf(v, dppf(v, 0x141)); v = fmaxf(v, dppf(v, 0x140));
    return fmaxf(fmaxf(rlanef(v, 0), rlanef(v, 16)), fmaxf(rlanef(v, 32), rlanef(v, 48)));
}
__device__ __forceinline__ float siluf(float x) { return x / (1.f + __expf(-x)); }
__device__ __forceinline__ float sigmoidf_(float x) { return 1.f / (1.f + __expf(-x)); }
__device__ __forceinline__ float logsigmoidf_(float x) { return fminf(x, 0.f) - log1pf(__expf(-fabsf(x))); }

#define XB_TMO      128
#define XB_XCNT(j)  (256  + 64 * (j))
#define XB_XSUB(j)  (1280 + 64 * (j))
#define XB_XGEN(j)  (2304 + 64 * (j))
#define XB_TOP      3328
#define XB_TOPGEN   3392
#define XCD_BAR_WORDS 3456
#define XB_SPIN_CAP (1u << 22)
__device__ __forceinline__ unsigned xb_ld(unsigned* p)              { return __hip_atomic_load(p, __ATOMIC_RELAXED, __HIP_MEMORY_SCOPE_AGENT); }
__device__ __forceinline__ unsigned xb_add(unsigned* p, unsigned v) { return __hip_atomic_fetch_add(p, v, __ATOMIC_RELAXED, __HIP_MEMORY_SCOPE_AGENT); }
__device__ __forceinline__ unsigned xb_xcc_id() { return (unsigned)__builtin_amdgcn_s_getreg((3 << 11) | 20) & 0xFu; }
#define XB_SPIN(cond, bar) do { unsigned _sp = 0; while (cond) { __builtin_amdgcn_s_sleep(1); \
    if ((++_sp & 255u) == 0u) { if (xb_ld(&(bar)[XB_TMO])) break; if (_sp > XB_SPIN_CAP) { atomicAdd(&(bar)[XB_TMO], 1u); break; } } } } while (0)
struct XcdBarrier { unsigned* bar; unsigned x; volatile LAS unsigned* st; };
__device__ __forceinline__ XcdBarrier xcd_barrier_post(unsigned* bar, volatile LAS unsigned* st) {
    XcdBarrier b; b.bar = bar; b.x = xb_xcc_id(); b.st = st;
    if (threadIdx.x == 0) (void)xb_add(&bar[XB_XCNT(b.x)], 1u);
    return b;
}
__device__ __forceinline__ void xcd_barrier_complete(unsigned* bar, unsigned x, unsigned& nloc, unsigned& nx) {
    const unsigned G = gridDim.x * gridDim.y * gridDim.z;
    unsigned sum, cnt, mine, sp = 0u;
    for (;;) {
        sum = 0u; cnt = 0u; mine = 0u;
#pragma unroll
        for (unsigned j = 0; j < 16; ++j) { const unsigned c = xb_ld(&bar[XB_XCNT(j)]); sum += c; cnt += (c > 0u) ? 1u : 0u; mine = (j == x) ? c : mine; }
        if (sum == G) break;
        __builtin_amdgcn_s_sleep(1);
        if ((++sp & 255u) == 0u) { if (xb_ld(&bar[XB_TMO])) break; if (sp > XB_SPIN_CAP) { atomicAdd(&bar[XB_TMO], 1u); break; } }
    }
    nloc = mine > 0u ? mine : 1u; nx = cnt > 0u ? cnt : 1u;
}
__device__ __forceinline__ void xcd_barrier(const XcdBarrier& b) {
    asm volatile("s_waitcnt vmcnt(0)" ::: "memory");
    __syncthreads();
    if (threadIdx.x == 0) {
        unsigned* bar = b.bar;
        __builtin_amdgcn_s_waitcnt(0);
        unsigned nloc = b.st[0], nx = b.st[1];
        if (nloc == 0u) { xcd_barrier_complete(bar, b.x, nloc, nx); b.st[0] = nloc; b.st[1] = nx; }
        const unsigned old = xb_add(&bar[XB_XSUB(b.x)], 1u);
        const unsigned gen = old / nloc;
        if (old + 1u == (gen + 1u) * nloc) {
            __builtin_amdgcn_fence(__ATOMIC_RELEASE, "agent");
            asm volatile("s_waitcnt vmcnt(0)" ::: "memory");
            const unsigned og = xb_add(&bar[XB_TOP], 1u);
            const unsigned tg = og / nx;
            if (og + 1u == (tg + 1u) * nx) xb_add(&bar[XB_TOPGEN], 1u);
            else XB_SPIN(xb_ld(&bar[XB_TOPGEN]) == tg, bar);
            __builtin_amdgcn_fence(__ATOMIC_ACQUIRE, "agent");
            xb_add(&bar[XB_XGEN(b.x)], 1u);
            asm volatile("s_waitcnt vmcnt(0)" ::: "memory");
        } else {
            XB_SPIN(xb_ld(&bar[XB_XGEN(b.x)]) == gen, bar);
            __builtin_amdgcn_fence(__ATOMIC_ACQUIRE, "agent");
            asm volatile("s_waitcnt vmcnt(0)" ::: "memory");
        }
    }
    __syncthreads();
}

#define CNT_ADA  3600
#define CNT_MLA  3664
#define CNT_SCAN 3728
__device__ __forceinline__ void wg_signal(unsigned* ctl, int word) {
    asm volatile("s_waitcnt vmcnt(0)" ::: "memory");
    __syncthreads();
    if (threadIdx.x == 0) {
        __builtin_amdgcn_fence(__ATOMIC_RELEASE, "agent");
        asm volatile("s_waitcnt vmcnt(0)" ::: "memory");
        (void)xb_add(&ctl[word], 1u);
    }
}
__device__ __forceinline__ void wg_wait(unsigned* ctl, int word, unsigned need) {
    if (threadIdx.x == 0) {
        XB_SPIN(xb_ld(&ctl[word]) < need, ctl);
        __builtin_amdgcn_fence(__ATOMIC_ACQUIRE, "agent");
        asm volatile("s_waitcnt vmcnt(0)" ::: "memory");
    }
    __syncthreads();
}

namespace pg8 {
constexpr int BM = 256, BK = 64, HALF = 128, HTB = HALF * BK * 2, STAGE_BYTES = 8 * HTB, NXCD = 8, WGM = 8;
__host__ __device__ __forceinline__ int lds_byte(int r, int c) { const int st = (r >> 4) * 2 + (c >> 5), rr = r & 15, cc = c & 31, ob = rr * 64 + cc * 2; return st * 1024 + (ob ^ (((ob >> 9) & 1) << 5)); }
__host__ __device__ __forceinline__ void stage_rc(int b, int& R, int& C) { const int st = b / 1024, sb = b % 1024, swz = sb ^ (((sb >> 9) & 1) << 5); R = (st >> 1) * 16 + swz / 64; C = (st & 1) * 32 + (swz % 64) / 2; }
__host__ __device__ __forceinline__ int perm32(int rho) { const int n = rho >> 4, i = rho & 15; return 8 * (i >> 2) + 4 * n + (i & 3); }
struct Unit { int pm, pn; };
struct Gemm { const bf16_t* A; const bf16_t* Bt; int M, N, K; };
struct StaticOrder {
    int nM, nN, nwg, G, c;
    __host__ __device__ void init(int M, int N, int G_, int c_) { nM = M / BM; nN = N / BM; nwg = nM * nN; G = G_; c = c_; }
    __host__ __device__ bool next(int i, Unit& u) const {
        const long L = (long)i * G + c; if (L >= nwg) return false;
        int wgid = (int)L; { const int q = nwg / NXCD, r = nwg % NXCD, xcd = wgid % NXCD, off = wgid / NXCD; wgid = (xcd < r ? xcd * (q + 1) : r * (q + 1) + (xcd - r) * q) + off; }
        const int nig = WGM * nN, gid = wgid / nig, fm = gid * WGM, gsz = (nM - fm) < WGM ? (nM - fm) : WGM;
        u.pm = fm + ((wgid % nig) % gsz); u.pn = (wgid % nig) / gsz; return true;
    }
    __device__ __forceinline__ void a_ready(const Unit&) const {}
    __device__ __forceinline__ void done(const Unit&) const {}
};
__device__ __forceinline__ unsigned cvt_pk_bf16(float lo, float hi) { unsigned r; asm volatile("v_cvt_pk_bf16_f32 %0, %1, %2" : "=v"(r) : "v"(lo), "v"(hi)); return r; }

template <class Epi, class Sched>
__device__ __forceinline__ void gemm_phase(LAS unsigned char* lds, const Gemm g, const Sched& S, const Epi& E) {
    const int tid = threadIdx.x, wid = __builtin_amdgcn_readfirstlane(tid >> 6), lane = tid & 63, wr = wid >> 2, wc = wid & 3, fr = lane & 15, fq = lane >> 4;
    const int K = g.K, nt = K / BK;
    unsigned voffA[2], voffB[2];
#pragma unroll
    for (int i = 0; i < 2; ++i) { int R, C; stage_rc(tid * 16 + i * 8192, R, C); const int Rb = Epi::PERM ? ((R & ~31) + perm32(R & 31)) : R;
        voffA[i] = (unsigned)(R * K + C) * 2u; voffB[i] = (unsigned)(Rb * K + C) * 2u; }
    const size_t kstep = (size_t)(BK * 2);
    const size_t hstep = (size_t)HALF * K * 2;
    const size_t tstep = 2 * hstep;
    const unsigned ldsw = (unsigned)wid * 1024u;
    const int aoff = lds_byte(wr * 64 + fr, fq * 8), boff = lds_byte(wc * 32 + fr, fq * 8);
#define PG8_SA(b, h) (((b) * 2 + (h)) * HTB)
#define PG8_SB(b, h) ((4 + (b) * 2 + (h)) * HTB)
#define PG8_STAGE(bufoff, gbase, voff) do { _Pragma("unroll") for (int _i = 0; _i < 2; ++_i) \
        __builtin_amdgcn_global_load_lds((const unsigned*)((const char*)(gbase) + (voff)[_i]), (LAS unsigned*)(lds + (bufoff) + ldsw + _i * 8192), 16, 0, 0); } while (0)
#define PG8_LDA(dst, b, h) do { _Pragma("unroll") for (int m = 0; m < 4; ++m) _Pragma("unroll") for (int k = 0; k < 2; ++k) dst[m][k] = *(const LAS bf16x8*)(lds + PG8_SA(b, h) + aoff + m * 2048 + k * 1024); } while (0)
#define PG8_LDB(dst, b, h) do { _Pragma("unroll") for (int n = 0; n < 2; ++n) _Pragma("unroll") for (int k = 0; k < 2; ++k) dst[n][k] = *(const LAS bf16x8*)(lds + PG8_SB(b, h) + boff + n * 2048 + k * 1024); } while (0)
#define PG8_MMA(ai, bj, At, Bt) do { __builtin_amdgcn_s_setprio(1); _Pragma("unroll") for (int m = 0; m < 4; ++m) _Pragma("unroll") for (int n = 0; n < 2; ++n) _Pragma("unroll") for (int k = 0; k < 2; ++k) \
        acc[ai][bj][m][n] = __builtin_amdgcn_mfma_f32_16x16x32_bf16(Bt[n][k], At[m][k], acc[ai][bj][m][n], 0, 0, 0); __builtin_amdgcn_s_setprio(0); } while (0)
#define PG8_WAIT_V(n) asm volatile("s_waitcnt vmcnt(" #n ")" ::: "memory")
#define PG8_WAIT_L(n) asm volatile("s_waitcnt lgkmcnt(" #n ")" ::: "memory")
#define PG8_BAR __builtin_amdgcn_s_barrier()
#define PG8_SCHED __builtin_amdgcn_sched_barrier(0)
    Unit cur, nxt; int ui = 0;
    if (!S.next(0, cur)) return;
    f32x4 acc[2][2][4][2];
#pragma unroll
    for (int a = 0; a < 2; ++a)
#pragma unroll
        for (int b = 0; b < 2; ++b)
#pragma unroll
            for (int m = 0; m < 4; ++m)
#pragma unroll
                for (int n = 0; n < 2; ++n) acc[a][b][m][n] = (f32x4){0.f, 0.f, 0.f, 0.f};
    bf16x8 At[4][2], B0[2][2], B1[2][2];
    const char* cA = (const char*)g.A + (size_t)cur.pm * tstep; const char* cB = (const char*)g.Bt + (size_t)cur.pn * tstep;
    S.a_ready(cur);
    PG8_STAGE(PG8_SB(0, 0), cB, voffB); PG8_STAGE(PG8_SA(0, 0), cA, voffA); PG8_STAGE(PG8_SB(0, 1), cB + hstep, voffB); PG8_STAGE(PG8_SA(0, 1), cA + hstep, voffA);
    if (wr == 1) PG8_BAR;
    PG8_WAIT_V(4); PG8_BAR;
    PG8_STAGE(PG8_SB(1, 0), cB + kstep, voffB); PG8_STAGE(PG8_SA(1, 0), cA + kstep, voffA); PG8_STAGE(PG8_SB(1, 1), cB + hstep + kstep, voffB);
    PG8_WAIT_V(6); PG8_BAR;
    for (;;) {
        const bool has_next = S.next(ui + 1, nxt);
        const char* nA = has_next ? (const char*)g.A + (size_t)nxt.pm * tstep : cA; const char* nB = has_next ? (const char*)g.Bt + (size_t)nxt.pn * tstep : cB;
        for (int t = 0; t < nt; t += 2) {
            const bool last = (t == nt - 2);
            const char* a1 = cA + (size_t)(t + 1) * kstep;
            const char* a2 = last ? nA : cA + (size_t)(t + 2) * kstep; const char* b2 = last ? nB : cB + (size_t)(t + 2) * kstep;
            const char* a3 = a2 + kstep; const char* b3 = b2 + kstep;
            if (last && has_next) S.a_ready(nxt);
            PG8_LDB(B0, 0, 0); PG8_SCHED; PG8_LDA(At, 0, 0); PG8_STAGE(PG8_SA(1, 1), a1 + hstep, voffA);
            PG8_WAIT_L(8); PG8_BAR; PG8_WAIT_L(0); PG8_MMA(0, 0, At, B0); PG8_BAR; PG8_SCHED;
            PG8_LDB(B1, 0, 1); PG8_STAGE(PG8_SB(0, 0), b2, voffB);
            PG8_BAR; PG8_WAIT_L(0); PG8_MMA(0, 1, At, B1); PG8_BAR;
            PG8_LDA(At, 0, 1); PG8_STAGE(PG8_SA(0, 0), a2, voffA);
            PG8_BAR; PG8_WAIT_L(0); PG8_MMA(1, 0, At, B0); PG8_BAR; PG8_SCHED;
            PG8_STAGE(PG8_SB(0, 1), b2 + hstep, voffB);
            PG8_WAIT_V(6); PG8_BAR; PG8_MMA(1, 1, At, B1); PG8_BAR;
            PG8_LDB(B0, 1, 0); PG8_SCHED; PG8_LDA(At, 1, 0); PG8_STAGE(PG8_SA(0, 1), a2 + hstep, voffA);
            PG8_WAIT_L(8); PG8_BAR; PG8_WAIT_L(0); PG8_MMA(0, 0, At, B0); PG8_BAR; PG8_SCHED;
            PG8_LDB(B1, 1, 1); PG8_STAGE(PG8_SB(1, 0), b3, voffB);
            PG8_BAR; PG8_WAIT_L(0); PG8_MMA(0, 1, At, B1); PG8_BAR;
            PG8_LDA(At, 1, 1); PG8_STAGE(PG8_SA(1, 0), a3, voffA);
            PG8_BAR; PG8_WAIT_L(0); PG8_MMA(1, 0, At, B0); PG8_BAR; PG8_SCHED;
            PG8_STAGE(PG8_SB(1, 1), b3 + hstep, voffB);
            PG8_WAIT_V(6); PG8_BAR; PG8_MMA(1, 1, At, B1); PG8_BAR;
        }
        E(acc, cur, wr, wc, fr, fq); S.done(cur);
        if (!has_next) break;
#pragma unroll
        for (int a = 0; a < 2; ++a)
#pragma unroll
            for (int b = 0; b < 2; ++b)
#pragma unroll
                for (int m = 0; m < 4; ++m)
#pragma unroll
                    for (int n = 0; n < 2; ++n) acc[a][b][m][n] = (f32x4){0.f, 0.f, 0.f, 0.f};
        cur = nxt; cA = nA; cB = nB; ++ui;
    }
    PG8_WAIT_V(0);
    if (wr == 0) PG8_BAR;
    PG8_BAR;
#undef PG8_SA
#undef PG8_SB
#undef PG8_STAGE
#undef PG8_LDA
#undef PG8_LDB
#undef PG8_MMA
#undef PG8_WAIT_V
#undef PG8_WAIT_L
#undef PG8_BAR
#undef PG8_SCHED
}
}

struct EpiInMain {
    static constexpr bool PERM = true;
    unsigned char* ws; const float* bias;
    __device__ __forceinline__ void operator()(const f32x4 (&acc)[2][2][4][2], const pg8::Unit& u, int wr, int wc, int fr, int fq) const {
        const int row0 = u.pm * 256 + wr * 64 + fr;
        const int cl0 = wc * 32 + 8 * fq;
        bf16_t* base = (bf16_t*)(ws + OFF_MQ + (size_t)(u.pn >> 1) * (16 * MiB)) + (u.pn & 1) * 256 + cl0;
        const float* bp = bias + u.pn * 256 + cl0;
#pragma unroll
        for (int bj = 0; bj < 2; ++bj) {
            const f32x4 b0 = *(const f32x4*)(bp + bj * 128), b1 = *(const f32x4*)(bp + bj * 128 + 4);
#pragma unroll
            for (int ai = 0; ai < 2; ++ai)
#pragma unroll
                for (int m = 0; m < 4; ++m) {
                    const f32x4 v0 = acc[ai][bj][m][0] + b0, v1 = acc[ai][bj][m][1] + b1;
                    u32x4 o; o[0] = pg8::cvt_pk_bf16(v0[0], v0[1]); o[1] = pg8::cvt_pk_bf16(v0[2], v0[3]); o[2] = pg8::cvt_pk_bf16(v1[0], v1[1]); o[3] = pg8::cvt_pk_bf16(v1[2], v1[3]);
                    *(u32x4*)(base + (size_t)(row0 + ai * 128 + m * 16) * 512 + bj * 128) = o;
                }
        }
    }
};
struct EpiInTail {
    static constexpr bool PERM = true;
    unsigned char* ws; const float* bias;
    __device__ __forceinline__ void operator()(const f32x4 (&acc)[2][2][4][2], const pg8::Unit& u, int wr, int wc, int fr, int fq) const {
        const int row0 = u.pm * 256 + wr * 64 + fr;
        const int cl0 = wc * 32 + 8 * fq;
#pragma unroll
        for (int bj = 0; bj < 2; ++bj) {
            const int cl = bj * 128 + cl0;
            if (cl >= 208) continue;
            const f32x4 b0 = *(const f32x4*)(bias + cl), b1 = *(const f32x4*)(bias + cl + 4);
            if (cl < 192) {
                bf16_t* dst = (bf16_t*)(ws + OFF_AK + (size_t)(cl >> 6) * (2 * MiB)) + (cl & 63);
#pragma unroll
                for (int ai = 0; ai < 2; ++ai)
#pragma unroll
                    for (int m = 0; m < 4; ++m) {
                        const f32x4 v0 = acc[ai][bj][m][0] + b0, v1 = acc[ai][bj][m][1] + b1;
                        u32x4 o; o[0] = pg8::cvt_pk_bf16(v0[0], v0[1]); o[1] = pg8::cvt_pk_bf16(v0[2], v0[3]); o[2] = pg8::cvt_pk_bf16(v1[0], v1[1]); o[3] = pg8::cvt_pk_bf16(v1[2], v1[3]);
                        *(u32x4*)(dst + (size_t)(row0 + ai * 128 + m * 16) * 64) = o;
                    }
            } else {
                float* dst = (float*)(ws + OFF_GATE) + (cl - 192);
#pragma unroll
                for (int ai = 0; ai < 2; ++ai)
#pragma unroll
                    for (int m = 0; m < 4; ++m) {
                        float* d = dst + (size_t)(row0 + ai * 128 + m * 16) * 16;
                        *(f32x4*)d = acc[ai][bj][m][0] + b0; *(f32x4*)(d + 4) = acc[ai][bj][m][1] + b1;
                    }
            }
        }
    }
};
struct EpiOut {
    static constexpr bool PERM = false;
    const float* x; const float* ada; float* out;
    __device__ __forceinline__ void operator()(const f32x4 (&acc)[2][2][4][2], const pg8::Unit& u, int wr, int wc, int fr, int fq) const {
        const int row0 = u.pm * 256 + wr * 64 + fr, col0 = u.pn * 256 + wc * 32 + 4 * fq;
        const int b = (u.pm * 256) >> 12;
        f32x4 gv[2][2];
#pragma unroll
        for (int bj = 0; bj < 2; ++bj)
#pragma unroll
            for (int n = 0; n < 2; ++n) gv[bj][n] = *(const f32x4*)(ada + b * 6144 + 2048 + col0 + bj * 128 + n * 16);
#pragma unroll
        for (int ai = 0; ai < 2; ++ai)
#pragma unroll
            for (int m = 0; m < 4; ++m) {
                const size_t ro = (size_t)(row0 + ai * 128 + m * 16) * 1024 + col0;
#pragma unroll
                for (int bj = 0; bj < 2; ++bj)
#pragma unroll
                    for (int n = 0; n < 2; ++n) {
                        const f32x4 xv = *(const f32x4*)(x + ro + bj * 128 + n * 16);
                        *(f32x4*)(out + ro + bj * 128 + n * 16) = xv + gv[bj][n] * acc[ai][bj][m][n];
                    }
            }
    }
};
struct EpiQry {
    static constexpr bool PERM = true;
    bf16_t* O;
    __device__ __forceinline__ void operator()(const f32x4 (&acc)[2][2][4][2], const pg8::Unit& u, int wr, int wc, int fr, int fq) const {
        const int row0 = u.pm * 256 + wr * 64 + fr, col0 = u.pn * 256 + wc * 32 + 8 * fq;
#pragma unroll
        for (int ai = 0; ai < 2; ++ai)
#pragma unroll
            for (int m = 0; m < 4; ++m) {
                bf16_t* rowp = O + (size_t)(row0 + ai * 128 + m * 16) * 1024 + col0;
#pragma unroll
                for (int bj = 0; bj < 2; ++bj) {
                    const f32x4 v0 = acc[ai][bj][m][0], v1 = acc[ai][bj][m][1];
                    u32x4 o; o[0] = pg8::cvt_pk_bf16(v0[0], v0[1]); o[1] = pg8::cvt_pk_bf16(v0[2], v0[3]); o[2] = pg8::cvt_pk_bf16(v1[0], v1[1]); o[3] = pg8::cvt_pk_bf16(v1[2], v1[3]);
                    *(u32x4*)(rowp + bj * 128) = o;
                }
            }
    }
};

__device__ __forceinline__ int inperm_src(int n) {
    if (n < 2048) return n;
    if (n < 2560) return 2056 + (n - 2048);
    if (n < 3072) return 2696 + (n - 2560);
    if (n < 3136) return 2568 + (n - 3072);
    if (n < 3200) return 2632 + (n - 3136);
    if (n < 3264) return 3208 + (n - 3200);
    if (n < 3268) return 2048 + (n - 3264);
    if (n < 3272) return 2052 + (n - 3268);
    if (n < 3280) return 3272 + (n - 3272);
    return -1;
}
template <bool PERMUTE>
__device__ __forceinline__ void transpose_tile(const float* src, int ld, bf16_t* dst, int n0, int k0, LAS float* t) {
    const int tid = threadIdx.x;
    for (int i = tid; i < 4096; i += NTHREADS) {
        const int kk = i >> 6, nn = i & 63;
        const int sc = PERMUTE ? inperm_src(n0 + nn) : (n0 + nn);
        t[kk * 65 + nn] = sc >= 0 ? src[(size_t)(k0 + kk) * ld + sc] : 0.f;
    }
    __syncthreads();
    for (int i = tid; i < 2048; i += NTHREADS) {
        const int nn = i >> 5, kp = (i & 31) * 2;
        ((unsigned*)dst)[((size_t)(n0 + nn) * 1024 + k0 + kp) >> 1] = pack2(t[kp * 65 + nn], t[(kp + 1) * 65 + nn]);
    }
    __syncthreads();
}
__device__ __forceinline__ void convert_chunk(const float* src, bf16_t* dst, size_t e0, int n) {
    for (int i = threadIdx.x * 8; i < n; i += NTHREADS * 8) {
        const f32x4 a = *(const f32x4*)(src + e0 + i), b = *(const f32x4*)(src + e0 + i + 4);
        u32x4 o; o[0] = pack2(a[0], a[1]); o[1] = pack2(a[2], a[3]); o[2] = pack2(b[0], b[1]); o[3] = pack2(b[2], b[3]);
        *(u32x4*)(dst + e0 + i) = o;
    }
}
__device__ __forceinline__ unsigned pack4_fp8(float a, float b, float c, float d) {
    a = fminf(fmaxf(a, -448.f), 448.f); b = fminf(fmaxf(b, -448.f), 448.f); c = fminf(fmaxf(c, -448.f), 448.f); d = fminf(fmaxf(d, -448.f), 448.f);
    int w = 0;
    w = __builtin_amdgcn_cvt_pk_fp8_f32(a, b, w, false);
    w = __builtin_amdgcn_cvt_pk_fp8_f32(c, d, w, true);
    return (unsigned)w;
}
__device__ __forceinline__ void convert_chunk_fp8(const float* src, unsigned char* dst, size_t e0, int n, float scale) {
    for (int i = threadIdx.x * 16; i < n; i += NTHREADS * 16) {
        const f32x4 a = *(const f32x4*)(src + e0 + i), b = *(const f32x4*)(src + e0 + i + 4), c = *(const f32x4*)(src + e0 + i + 8), d = *(const f32x4*)(src + e0 + i + 12);
        u32x4 o; o[0] = pack4_fp8(a[0] * scale, a[1] * scale, a[2] * scale, a[3] * scale); o[1] = pack4_fp8(b[0] * scale, b[1] * scale, b[2] * scale, b[3] * scale);
        o[2] = pack4_fp8(c[0] * scale, c[1] * scale, c[2] * scale, c[3] * scale); o[3] = pack4_fp8(d[0] * scale, d[1] * scale, d[2] * scale, d[3] * scale);
        *(u32x4*)(dst + e0 + i) = o;
    }
}
__device__ __forceinline__ unsigned pack8_fp4(const f32x4 a, const f32x4 b, float scale) {
    float v[8] = {a[0] * scale, a[1] * scale, a[2] * scale, a[3] * scale, b[0] * scale, b[1] * scale, b[2] * scale, b[3] * scale};
#pragma unroll
    for (int i = 0; i < 8; ++i) v[i] = fminf(fmaxf(v[i], -6.f), 6.f);
    unsigned w = 0;
    w = __builtin_amdgcn_cvt_scalef32_pk_fp4_f32(w, v[0], v[1], 1.0f, 0);
    w = __builtin_amdgcn_cvt_scalef32_pk_fp4_f32(w, v[2], v[3], 1.0f, 1);
    w = __builtin_amdgcn_cvt_scalef32_pk_fp4_f32(w, v[4], v[5], 1.0f, 2);
    w = __builtin_amdgcn_cvt_scalef32_pk_fp4_f32(w, v[6], v[7], 1.0f, 3);
    return w;
}
__device__ __forceinline__ void convert_chunk_fp4(const float* src, unsigned char* dst, size_t e0, int n, float scale) {
    for (int i = threadIdx.x * 32; i < n; i += NTHREADS * 32) {
        u32x4 o;
#pragma unroll
        for (int k = 0; k < 4; ++k) o[k] = pack8_fp4(*(const f32x4*)(src + e0 + i + 8 * k), *(const f32x4*)(src + e0 + i + 8 * k + 4), scale);
        *(u32x4*)(dst + ((e0 + i) >> 1)) = o;
    }
}
__device__ __forceinline__ void convert_tables(const Params& p, int first, int stride) {
    for (int it = first; it < 1024; it += stride) {
        const int tsel = it >> 9; const size_t e0 = (size_t)(it & 511) * 32768;
        if (tsel) convert_chunk_fp4(p.peer_v, p.ws + OFF_VT, e0, 32768, 5.656854f);
        else convert_chunk_fp8(p.peer_u, p.ws + OFF_UT, e0, 32768, 512.f);
    }
}
__device__ __forceinline__ void phase0(const Params& p, LAS unsigned char* lds) {
    const int tid = threadIdx.x;
    float* ada = (float*)(p.ws + OFF_ADA);
    LAS float* lf = (LAS float*)lds;
    constexpr int N_ADA = 192, N_WIN = 52 * 16, N_WOUT = 256, N_WPQ = 256, N_SK = 4, N_BIAS = 1;
    constexpr int NITEMS = N_ADA + N_WIN + N_WOUT + N_WPQ + N_SK + N_BIAS;
    if (blockIdx.x < N_ADA) {
        {
            const int it = blockIdx.x;
            LAS float* sc = lf; LAS float* red = lf + 4096;
            for (int i = tid; i < 4096; i += NTHREADS) sc[i] = siluf(p.c[i]);
            __syncthreads();
            const int col = tid & 31, kg = tid >> 5, c0 = it * 32;
            float a0 = 0.f, a1 = 0.f, a2 = 0.f, a3 = 0.f;
            const float* w = p.w_ada + c0 + col;
#pragma unroll 8
            for (int j = 0; j < 64; ++j) { const int k = kg + 16 * j; const float wv = w[(size_t)k * 6144];
                a0 += sc[k] * wv; a1 += sc[1024 + k] * wv; a2 += sc[2048 + k] * wv; a3 += sc[3072 + k] * wv; }
            red[(kg * 4 + 0) * 32 + col] = a0; red[(kg * 4 + 1) * 32 + col] = a1; red[(kg * 4 + 2) * 32 + col] = a2; red[(kg * 4 + 3) * 32 + col] = a3;
            __syncthreads();
            if (tid < 128) { const int b = tid >> 5, cc = tid & 31; float s = 0.f;
                for (int g = 0; g < 16; ++g) s += red[(g * 4 + b) * 32 + cc];
                ada[b * 6144 + c0 + cc] = s + p.b_ada[c0 + cc]; }
        }
        wg_signal((unsigned*)(p.ws + OFF_CTL), CNT_ADA);
        __syncthreads();
    }
    for (int item = N_ADA + ((blockIdx.x + gridDim.x - N_ADA) % gridDim.x); item < NITEMS; item += gridDim.x) {
        int it = item;
        it -= N_ADA;
        if (it < N_WIN) { transpose_tile<true>(p.w_in, 3280, (bf16_t*)(p.ws + OFF_WIN), (it >> 4) * 64, (it & 15) * 64, lf); continue; }
        it -= N_WIN;
        if (it < N_WOUT) { transpose_tile<false>(p.w_out, 1024, (bf16_t*)(p.ws + OFF_WOUT), (it >> 4) * 64, (it & 15) * 64, lf); continue; }
        it -= N_WOUT;
        if (it < N_WPQ) { transpose_tile<false>(p.w_peer_q, 1024, (bf16_t*)(p.ws + OFF_WPQ), (it >> 4) * 64, (it & 15) * 64, lf); continue; }
        it -= N_WPQ;

        if (it < N_SK) { convert_chunk(p.sub_keys, (bf16_t*)(p.ws + OFF_SK), (size_t)it * 32768, 32768); continue; }
        it -= N_SK;
        { float* bias = (float*)(p.ws + OFF_BIAS);
          for (int n = tid; n < NIN_PAD; n += NTHREADS) { const int s = inperm_src(n); bias[n] = s >= 0 ? p.b_in[s] : 0.f; } }
    }
}

__device__ __forceinline__ void norm_mod_rows(const float* X, const float* g, const float* ada, int sh_off, int sc_off, bf16_t* out) {
    const int wid = threadIdx.x >> 6, lane = threadIdx.x & 63;
    for (int row = (blockIdx.x * 8 + wid) * 2; row < NTOK; row += gridDim.x * 16) {
        const int b = row >> 12;
        f32x4 v[2][4]; float ss[2] = {0.f, 0.f};
#pragma unroll
        for (int rr = 0; rr < 2; ++rr)
#pragma unroll
            for (int j = 0; j < 4; ++j) v[rr][j] = *(const f32x4*)(X + (size_t)(row + rr) * 1024 + 4 * (lane + 64 * j));
#pragma unroll
        for (int rr = 0; rr < 2; ++rr)
#pragma unroll
            for (int j = 0; j < 4; ++j) ss[rr] += v[rr][j][0] * v[rr][j][0] + v[rr][j][1] * v[rr][j][1] + v[rr][j][2] * v[rr][j][2] + v[rr][j][3] * v[rr][j][3];
        ss[0] = wave_sum(ss[0]); ss[1] = wave_sum(ss[1]);
        const float rstd0 = rsqrtf(ss[0] * (1.f / 1024.f) + 1e-6f), rstd1 = rsqrtf(ss[1] * (1.f / 1024.f) + 1e-6f);
#pragma unroll
        for (int j = 0; j < 4; ++j) {
            const int c = 4 * (lane + 64 * j);
            const f32x4 gg = *(const f32x4*)(g + c), sc = *(const f32x4*)(ada + b * 6144 + sc_off + c), sh = *(const f32x4*)(ada + b * 6144 + sh_off + c);
#pragma unroll
            for (int rr = 0; rr < 2; ++rr) {
                const float rstd = rr ? rstd1 : rstd0;
                float h[4];
#pragma unroll
                for (int i = 0; i < 4; ++i) h[i] = (v[rr][j][i] * rstd * gg[i]) * (1.f + sc[i]) + sh[i];
                u32x2 o; o[0] = pack2(h[0], h[1]); o[1] = pack2(h[2], h[3]);
                *(u32x2*)(out + (size_t)(row + rr) * 1024 + c) = o;
            }
        }
    }
}

__device__ __forceinline__ bf16x8 lds_frag(const LAS bf16_t* base, int row, int stride, int kofs) { return *(const LAS bf16x8*)(base + row * stride + kofs); }

__device__ __forceinline__ void conv_silu8(const bf16_t* src, const float* cw  , int row, int tpos, int col, float scale, float (&o)[8]) {
    float acc[8];
#pragma unroll
    for (int i = 0; i < 8; ++i) acc[i] = 0.f;
#pragma unroll
    for (int j = 0; j < 4; ++j) {
        const int tt = tpos - 3 + j;
        if (tt >= 0) {
            const u32x4 xv = *(const u32x4*)(src + (size_t)(row - 3 + j) * 512 + col);
            const f32x4 w0 = *(const f32x4*)(cw + j * 1024), w1 = *(const f32x4*)(cw + j * 1024 + 4);
            acc[0] += w0[0] * lo16(xv[0]); acc[1] += w0[1] * hi16(xv[0]); acc[2] += w0[2] * lo16(xv[1]); acc[3] += w0[3] * hi16(xv[1]);
            acc[4] += w1[0] * lo16(xv[2]); acc[5] += w1[1] * hi16(xv[2]); acc[6] += w1[2] * lo16(xv[3]); acc[7] += w1[3] * hi16(xv[3]);
        }
    }
#pragma unroll
    for (int i = 0; i < 8; ++i) o[i] = siluf(acc[i]) * scale;
}

__device__ __forceinline__ void mlstm_passA(const Params& p, int task, LAS unsigned char* lds) {
    const int tid = opaque_tid(), wid = tid >> 6, lane = tid & 63;
    const int bh = task >> 6, c = task & 63, b = bh >> 2, h = bh & 3;
    const int row0 = b * SEQ + c * 64;
    const float* gates = (const float*)(p.ws + OFF_GATE);
    const bf16_t* MK = (const bf16_t*)(p.ws + OFF_MK); const bf16_t* MV = (const bf16_t*)(p.ws + OFF_MV);
    LAS bf16_t* KT = (LAS bf16_t*)lds;
    LAS bf16_t* VT = KT + 128 * 72;
    LAS float* sc = (LAS float*)(VT + 128 * 72);
    LAS float* lsg = sc; LAS float* ig = sc + 64; LAS float* wloc = sc + 128; LAS float* misc = sc + 192;
    if (tid < 64) {
        const float f = gates[(size_t)(row0 + tid) * 16 + 4 + h], iv = gates[(size_t)(row0 + tid) * 16 + h];
        const float bc = wave_scan_add(logsigmoidf_(f), lane);
        const float bl = __shfl(bc, 63);
        const float a = bl - bc + iv;
        const float m = wave_max(a);
        lsg[tid] = bc; ig[tid] = iv; wloc[tid] = __expf(a - m);
        if (tid == 0) { misc[0] = m; misc[1] = bl; }
    }
    __syncthreads();
    for (int pc = tid; pc < 1024; pc += NTHREADS) {
        const int s = pc >> 4, dg = pc & 15;
        float kk[8];
        conv_silu8(MK, p.conv_qk + 512 + h * 128 + dg * 8, row0 + s, c * 64 + s, h * 128 + dg * 8, 1.f, kk);
#pragma unroll
        for (int i = 0; i < 8; ++i) KT[(dg * 8 + i) * 72 + s] = f2bf(kk[i]);
        const u32x4 vv = *(const u32x4*)(MV + (size_t)(row0 + s) * 512 + h * 128 + dg * 8);
        const float w = wloc[s];
#pragma unroll
        for (int i = 0; i < 4; ++i) { VT[(dg * 8 + 2 * i) * 72 + s] = f2bf(lo16(vv[i]) * w); VT[(dg * 8 + 2 * i + 1) * 72 + s] = f2bf(hi16(vv[i]) * w); }
    }
    __syncthreads();
    {
        const int r = lane & 15, g = lane >> 4;
        bf16x8 a0 = lds_frag(VT, wid * 16 + r, 72, 8 * g), a1 = lds_frag(VT, wid * 16 + r, 72, 8 * g + 32);
        bf16_t* KV = (bf16_t*)(p.ws + OFF_KV) + (size_t)task * 16384;
#pragma unroll
        for (int dt = 0; dt < 8; ++dt) {
            f32x4 acc = {0.f, 0.f, 0.f, 0.f};
            acc = __builtin_amdgcn_mfma_f32_16x16x32_bf16(a0, lds_frag(KT, dt * 16 + r, 72, 8 * g), acc, 0, 0, 0);
            acc = __builtin_amdgcn_mfma_f32_16x16x32_bf16(a1, lds_frag(KT, dt * 16 + r, 72, 8 * g + 32), acc, 0, 0, 0);
#pragma unroll
            for (int j = 0; j < 4; ++j) KV[(wid * 16 + 4 * g + j) * 128 + dt * 16 + r] = f2bf(acc[j]);
        }
    }
    if (tid < 128) {
        float s = 0.f;
        for (int i = 0; i < 64; ++i) s += wloc[i] * bf2f(KT[tid * 72 + i]);
        ((float*)(p.ws + OFF_KS))[(size_t)task * 128 + tid] = s;
    }
    if (tid == 0) { ((float*)(p.ws + OFF_MLOC))[task] = misc[0]; ((float*)(p.ws + OFF_BLAST))[task] = misc[1]; }
    __syncthreads();
}

__device__ __forceinline__ void mlstm_scan(const Params& p, int item, LAS unsigned char* lds) {
    const int tid = opaque_tid();
    const int bh = item >> 4, blk = item & 15;
    LAS float* dec = (LAS float*)lds; LAS float* inj = dec + 64;
    if (tid == 0) {
        const float* ML = (const float*)(p.ws + OFF_MLOC); const float* BL = (const float*)(p.ws + OFF_BLAST); float* M0 = (float*)(p.ws + OFF_M0);
        float m = 0.f;
        for (int c = 0; c < 64; ++c) {
            const float ml = ML[bh * 64 + c], bl = BL[bh * 64 + c];
            if (blk == 0) M0[bh * 64 + c] = m;
            const float mn = fmaxf(bl + m, ml);
            dec[c] = __expf(bl + m - mn); inj[c] = __expf(ml - mn); m = mn;
        }
    }
    __syncthreads();
    unsigned* KV = (unsigned*)(p.ws + OFF_KV) + (size_t)bh * 64 * 8192 + blk * 512 + tid;
    float s0 = 0.f, s1 = 0.f;
#pragma unroll 8
    for (int c = 0; c < 64; ++c) {
        const unsigned w = KV[(size_t)c * 8192];
        KV[(size_t)c * 8192] = pack2(s0, s1);
        s0 = dec[c] * s0 + inj[c] * lo16(w); s1 = dec[c] * s1 + inj[c] * hi16(w);
    }
    if (blk == 0 && tid < 128) {
        float* KS = (float*)(p.ws + OFF_KS) + (size_t)bh * 64 * 128 + tid;
        float s = 0.f;
        for (int c = 0; c < 64; ++c) { const float k = KS[c * 128]; KS[c * 128] = s; s = dec[c] * s + inj[c] * k; }
    }
    __syncthreads();
}

__device__ __forceinline__ void mlstm_passB(const Params& p, int task, LAS unsigned char* lds) {
    const int tid = opaque_tid(), wid = tid >> 6, lane = tid & 63;
    const int bh = task >> 6, c = task & 63, b = bh >> 2, h = bh & 3;
    const int row0 = b * SEQ + c * 64;
    const float* gates = (const float*)(p.ws + OFF_GATE);
    const bf16_t* MQ = (const bf16_t*)(p.ws + OFF_MQ); const bf16_t* MK = (const bf16_t*)(p.ws + OFF_MK);
    const bf16_t* MV = (const bf16_t*)(p.ws + OFF_MV); const bf16_t* MO = (const bf16_t*)(p.ws + OFF_MO);
    LAS bf16_t* Q = (LAS bf16_t*)lds;
    LAS bf16_t* K = Q + 64 * 136;
    LAS bf16_t* VT = K + 64 * 136;
    LAS bf16_t* C0 = VT + 128 * 72;
    LAS bf16_t* P = C0 + 128 * 136;
    LAS float* sc = (LAS float*)(P + 64 * 72);
    LAS float* bcum = sc; LAS float* ig = sc + 64; LAS float* cs = sc + 128; LAS float* rb = sc + 192; LAS float* wint = sc + 256;
    LAS float* emt = sc + 320; LAS float* rinv = sc + 384; LAS float* qn = sc + 448; LAS float* n0 = sc + 512; LAS float* rowpart = sc + 640;
    LAS float* H = (LAS float*)lds;
    if (tid < 64) {
        const float f = gates[(size_t)(row0 + tid) * 16 + 4 + h], iv = gates[(size_t)(row0 + tid) * 16 + h];
        const float m0 = ((const float*)(p.ws + OFF_M0))[task];
        const float sc_ = wave_scan_add(logsigmoidf_(f), lane);
        const float cst = iv - sc_;
        const float pm = wave_scan_max(cst, lane);
        const float m_intra = sc_ + pm, m_inter = sc_ + m0, mt = fmaxf(m_inter, m_intra);
        bcum[tid] = sc_; ig[tid] = iv; cs[tid] = cst; rb[tid] = sc_ - mt; wint[tid] = __expf(m_inter - mt); emt[tid] = __expf(-mt);
    }
    if (tid >= 64 && tid < 192) n0[tid - 64] = ((const float*)(p.ws + OFF_KS))[(size_t)task * 128 + tid - 64];
    for (int pc = tid; pc < 1024; pc += NTHREADS) {
        const int s = pc >> 4, dg = pc & 15;
        float qq[8], kk[8];
        conv_silu8(MQ, p.conv_qk + h * 128 + dg * 8, row0 + s, c * 64 + s, h * 128 + dg * 8, 0.08838834764831845f, qq);
        conv_silu8(MK, p.conv_qk + 512 + h * 128 + dg * 8, row0 + s, c * 64 + s, h * 128 + dg * 8, 1.f, kk);
        u32x4 qo, ko;
#pragma unroll
        for (int i = 0; i < 4; ++i) { qo[i] = pack2(qq[2 * i], qq[2 * i + 1]); ko[i] = pack2(kk[2 * i], kk[2 * i + 1]); }
        *(LAS u32x4*)(Q + s * 136 + dg * 8) = qo; *(LAS u32x4*)(K + s * 136 + dg * 8) = ko;
        const u32x4 vv = *(const u32x4*)(MV + (size_t)(row0 + s) * 512 + h * 128 + dg * 8);
#pragma unroll
        for (int i = 0; i < 4; ++i) { VT[(dg * 8 + 2 * i) * 72 + s] = (bf16_t)(vv[i] & 0xffffu); VT[(dg * 8 + 2 * i + 1) * 72 + s] = (bf16_t)(vv[i] >> 16); }
    }
    {
        const bf16_t* KV = (const bf16_t*)(p.ws + OFF_KV) + (size_t)task * 16384;
        for (int pc = tid; pc < 2048; pc += NTHREADS) { const int e = pc >> 4, dg = pc & 15;
            *(LAS u32x4*)(C0 + e * 136 + dg * 8) = *(const u32x4*)(KV + e * 128 + dg * 8); }
    }
    __syncthreads();
    const int r = lane & 15, g = lane >> 4;
    {
        const int t = tid >> 3, part = tid & 7; float s = 0.f;
#pragma unroll
        for (int i = 0; i < 16; ++i) s += bf2f(Q[t * 136 + part * 16 + i]) * n0[part * 16 + i];
        s += __shfl_xor(s, 1); s += __shfl_xor(s, 2); s += __shfl_xor(s, 4);
        if (part == 0) qn[t] = s;
    }
    {
        const int rt = wid >> 1;
#pragma unroll
        for (int cc = 0; cc < 2; ++cc) {
            const int ct = 2 * (wid & 1) + cc;
            f32x4 acc = {0.f, 0.f, 0.f, 0.f};
#pragma unroll
            for (int ks = 0; ks < 4; ++ks)
                acc = __builtin_amdgcn_mfma_f32_16x16x32_bf16(lds_frag(Q, rt * 16 + r, 136, 8 * g + 32 * ks), lds_frag(K, ct * 16 + r, 136, 8 * g + 32 * ks), acc, 0, 0, 0);
            const int scol = ct * 16 + r; const float csv = cs[scol];
#pragma unroll
            for (int j = 0; j < 4; ++j) {
                const int t = rt * 16 + 4 * g + j;
                float pv = (scol <= t) ? acc[j] * __expf(rb[t] + csv) : 0.f;
                P[t * 72 + scol] = f2bf(pv);
                pv += __shfl_xor(pv, 1); pv += __shfl_xor(pv, 2); pv += __shfl_xor(pv, 4); pv += __shfl_xor(pv, 8);
                if (r == 0) rowpart[t * 4 + ct] = pv;
            }
        }
    }
    __syncthreads();
    if (tid < 64) {
        const float den = rowpart[tid * 4] + rowpart[tid * 4 + 1] + rowpart[tid * 4 + 2] + rowpart[tid * 4 + 3] + wint[tid] * qn[tid];
        rinv[tid] = 1.f / fmaxf(fabsf(den), emt[tid]);
    }
    f32x4 hacc[4];
    {
        const int rt = wid >> 1;
#pragma unroll
        for (int ee = 0; ee < 4; ++ee) {
            const int et = 4 * (wid & 1) + ee;
            f32x4 a1 = {0.f, 0.f, 0.f, 0.f}, a2 = {0.f, 0.f, 0.f, 0.f};
#pragma unroll
            for (int ks = 0; ks < 2; ++ks)
                a1 = __builtin_amdgcn_mfma_f32_16x16x32_bf16(lds_frag(P, rt * 16 + r, 72, 8 * g + 32 * ks), lds_frag(VT, et * 16 + r, 72, 8 * g + 32 * ks), a1, 0, 0, 0);
#pragma unroll
            for (int ks = 0; ks < 4; ++ks)
                a2 = __builtin_amdgcn_mfma_f32_16x16x32_bf16(lds_frag(Q, rt * 16 + r, 136, 8 * g + 32 * ks), lds_frag(C0, et * 16 + r, 136, 8 * g + 32 * ks), a2, 0, 0, 0);
#pragma unroll
            for (int j = 0; j < 4; ++j) { const int t = rt * 16 + 4 * g + j; hacc[ee][j] = a1[j] + wint[t] * a2[j]; }
        }
    }
    __syncthreads();
    {
        const int rt = wid >> 1;
#pragma unroll
        for (int ee = 0; ee < 4; ++ee) {
            const int et = 4 * (wid & 1) + ee;
#pragma unroll
            for (int j = 0; j < 4; ++j) { const int t = rt * 16 + 4 * g + j; H[t * 132 + et * 16 + r] = hacc[ee][j] * rinv[t]; }
        }
    }
    __syncthreads();
    {
        const int t = tid >> 3, part = tid & 7;
        float hv[16]; float ss = 0.f;
#pragma unroll
        for (int i = 0; i < 16; ++i) { hv[i] = H[t * 132 + part * 16 + i]; ss += hv[i] * hv[i]; }
        ss += __shfl_xor(ss, 1); ss += __shfl_xor(ss, 2); ss += __shfl_xor(ss, 4);
        const float rstd = rsqrtf(ss * (1.f / 128.f) + 1e-6f);
        const int col = h * 128 + part * 16;
        const u32x4 m0v = *(const u32x4*)(MO + (size_t)(row0 + t) * 512 + col), m1v = *(const u32x4*)(MO + (size_t)(row0 + t) * 512 + col + 8);
        float mo[16];
#pragma unroll
        for (int i = 0; i < 4; ++i) { mo[2 * i] = lo16(m0v[i]); mo[2 * i + 1] = hi16(m0v[i]); mo[8 + 2 * i] = lo16(m1v[i]); mo[8 + 2 * i + 1] = hi16(m1v[i]); }
        float o[16];
#pragma unroll
        for (int i = 0; i < 16; ++i) o[i] = (hv[i] * rstd * p.out_norm_m[col + i]) * sigmoidf_(mo[i]);
        u32x4 o0, o1;
#pragma unroll
        for (int i = 0; i < 4; ++i) { o0[i] = pack2(o[2 * i], o[2 * i + 1]); o1[i] = pack2(o[8 + 2 * i], o[8 + 2 * i + 1]); }
        bf16_t* dst = (bf16_t*)(p.ws + OFF_ACT) + (size_t)(row0 + t) * 1024 + col;
        *(u32x4*)dst = o0; *(u32x4*)(dst + 8) = o1;
    }
    __syncthreads();
}

__device__ __forceinline__ unsigned f2sortable(float f) { const unsigned u = __float_as_uint(f); return (u & 0x80000000u) ? ~u : (u | 0x80000000u); }
#define CNT4(c0, c1, c2, c3, a, b, cc, d, thr) asm volatile( \
    "v_cmp_ge_u32 s[40:41], %4, %8\n\tv_cmp_ge_u32 s[42:43], %5, %8\n\tv_cmp_ge_u32 s[44:45], %6, %8\n\tv_cmp_ge_u32 s[46:47], %7, %8\n\t" \
    "v_addc_co_u32 %0, s[48:49], 0, %0, s[40:41]\n\tv_addc_co_u32 %1, s[50:51], 0, %1, s[42:43]\n\tv_addc_co_u32 %2, s[52:53], 0, %2, s[44:45]\n\tv_addc_co_u32 %3, s[54:55], 0, %3, s[46:47]" \
    : "+v"(c0), "+v"(c1), "+v"(c2), "+v"(c3) : "v"(a), "v"(b), "v"(cc), "v"(d), "v"(thr) \
    : "s40", "s41", "s42", "s43", "s44", "s45", "s46", "s47", "s48", "s49", "s50", "s51", "s52", "s53", "s54", "s55")
template <int NR>
__device__ __forceinline__ int count_geN(const unsigned (&u)[NR], unsigned thr) {
    int c0 = 0, c1 = 0, c2 = 0, c3 = 0;
#pragma unroll
    for (int j = 0; j < NR; j += 4) CNT4(c0, c1, c2, c3, u[j], u[j + 1], u[j + 2], u[j + 3], thr);
    return (c0 + c1) + (c2 + c3);
}
template <int NR>
__device__ __forceinline__ void select_topk(const LAS float* srow, LAS int* lq, int t, int n, int lane) {
    unsigned u[NR];
#pragma unroll
    for (int j = 0; j < NR; ++j) { const int key = lane + 64 * j; u[j] = (key <= t) ? ((f2sortable(srow[key]) & 0xFFFFF000u) | (unsigned)(4095 - key)) : 0u; }
    unsigned tau = 1u;
    if (n > 256) {
        tau = 0u;
        for (int bit = 31; bit >= 0; --bit) {
            const unsigned cand = tau | (1u << bit);
            const int cnt = wave_sum_i32_uniform(count_geN<NR>(u, cand));
            if (cnt >= 256) { tau = cand; if (cnt == 256) break; }
        }
    }
    const int c = count_geN<NR>(u, tau);
    int pre = c;
#pragma unroll
    for (int o = 1; o < 64; o <<= 1) { const int v = __shfl_up(pre, o); if (lane >= o) pre += v; }
    int pos = pre - c;
    int keyv = lane;
#pragma unroll
    for (int j = 0; j < NR; ++j) {
        const bool sel = u[j] >= tau;
        const int slot = sel ? pos : (256 + lane);
        lq[slot] = keyv;
        pos += sel ? 1 : 0; keyv += 64;
    }
}
__device__ __forceinline__ void dsa_task(const Params& p, int task, LAS unsigned char* lds) {
    const int tid = opaque_tid(), wid = __builtin_amdgcn_readfirstlane(tid >> 6), lane = tid & 63;
    const int b = task >> 9, qg = task & 511, t0 = qg * 8, rowb = b * SEQ;
    const bf16_t* IQ = (const bf16_t*)(p.ws + OFF_IQ); const bf16_t* IK = (const bf16_t*)(p.ws + OFF_IK);
    const bf16_t* AQ = (const bf16_t*)(p.ws + OFF_AQ); const bf16_t* AK = (const bf16_t*)(p.ws + OFF_AK); const bf16_t* AV = (const bf16_t*)(p.ws + OFF_AV);
    const float* gates = (const float*)(p.ws + OFF_GATE);
    LAS float* scores = (LAS float*)lds;
    LAS int* lists = (LAS int*)(lds + 131072);
    const int ntile = (t0 + 8 + 31) >> 5;
#pragma unroll 1
    for (int rr0 = 0; rr0 < ((DSA_REP & 1) ? 2 : 1); ++rr0)
    {
        const int r = lane & 31, hh = lane >> 5;
        bf16x8 af[2][4]; float wv[2][4][4];
#pragma unroll
        for (int rt = 0; rt < 2; ++rt) {
            const size_t qrow = (size_t)(rowb + t0 + 4 * rt + (r >> 3));
#pragma unroll
            for (int ks = 0; ks < 4; ++ks) af[rt][ks] = *(const bf16x8*)(IQ + qrow * 512 + (r & 7) * 64 + 16 * ks + 8 * hh);
#pragma unroll
            for (int q4 = 0; q4 < 4; ++q4)
#pragma unroll
                for (int h4 = 0; h4 < 4; ++h4) wv[rt][q4][h4] = gates[(size_t)(rowb + t0 + 4 * rt + q4) * 16 + 8 + h4 + 4 * hh] * 0.04419417382415922f;
        }
        bf16x8 bfr[4], bnx[4];
        if (wid < ntile) {
#pragma unroll
            for (int ks = 0; ks < 4; ++ks) bfr[ks] = *(const bf16x8*)(IK + (size_t)(rowb + 32 * wid + r) * 64 + 16 * ks + 8 * hh);
        }
        for (int kt = wid; kt < ntile; kt += 8) {
            if (kt + 8 < ntile) {
#pragma unroll
                for (int ks = 0; ks < 4; ++ks) bnx[ks] = *(const bf16x8*)(IK + (size_t)(rowb + 32 * (kt + 8) + r) * 64 + 16 * ks + 8 * hh);
            }
            const int key = 32 * kt + r;
#pragma unroll
            for (int rt = 0; rt < 2; ++rt) {
                f32x16 acc;
#pragma unroll
                for (int i = 0; i < 16; ++i) acc[i] = 0.f;
#pragma unroll
                for (int ks = 0; ks < 4; ++ks) acc = __builtin_amdgcn_mfma_f32_32x32x16_bf16(af[rt][ks], bfr[ks], acc, 0, 0, 0);
#pragma unroll
                for (int q4 = 0; q4 < 4; ++q4) {
                    float part = 0.f;
#pragma unroll
                    for (int h4 = 0; h4 < 4; ++h4) part += fmaxf(acc[q4 * 4 + h4], 0.f) * wv[rt][q4][h4];
                    part += __shfl_xor(part, 32);
                    const int qq = 4 * rt + q4;
                    if (hh == 0) scores[qq * 4096 + key] = (key <= t0 + qq) ? part : -INFINITY;
                }
            }
#pragma unroll
            for (int ks = 0; ks < 4; ++ks) bfr[ks] = bnx[ks];
        }
    }
    __syncthreads();
    const int qq = wid, t = t0 + qq, n = t + 1;
    const int nsel = n < 256 ? n : 256;
#pragma unroll 1
    for (int rr1 = 0; rr1 < ((DSA_REP & 2) ? 2 : 1); ++rr1)
    {
        const LAS float* srow = scores + qq * 4096; LAS int* lq = lists + qq * 320;
        const int nreg = (t >> 6) + 1;
        if (nreg <= 8) select_topk<8>(srow, lq, t, n, lane);
        else if (nreg <= 16) select_topk<16>(srow, lq, t, n, lane);
        else if (nreg <= 24) select_topk<24>(srow, lq, t, n, lane);
        else if (nreg <= 32) select_topk<32>(srow, lq, t, n, lane);
        else if (nreg <= 40) select_topk<40>(srow, lq, t, n, lane);
        else if (nreg <= 48) select_topk<48>(srow, lq, t, n, lane);
        else if (nreg <= 56) select_topk<56>(srow, lq, t, n, lane);
        else select_topk<64>(srow, lq, t, n, lane);
    }
    asm volatile("s_waitcnt lgkmcnt(0)" ::: "memory");
#pragma unroll 1
    for (int rr2 = 0; rr2 < ((DSA_REP & 4) ? 2 : 1); ++rr2) {
    {
        const int r = lane & 15, g = lane >> 4;
        const size_t qrow = (size_t)(rowb + t);
        bf16x8 bq[2];
#pragma unroll
        for (int ks = 0; ks < 2; ++ks) {
            if (r < 8) bq[ks] = *(const bf16x8*)(AQ + qrow * 512 + r * 64 + 8 * g + 32 * ks);
            else { bq[ks] = (bf16x8){0, 0, 0, 0, 0, 0, 0, 0}; }
        }
        LAS float* Pl = scores + qq * 4096;
#pragma unroll 1
        for (int half = 0; half < 2; ++half) {
            bf16x8 a0[8], a1[8];
#pragma unroll
            for (int i = 0; i < 8; ++i) {
                const int jp = 16 * (half * 8 + i) + r;
                const int key = (jp < nsel) ? lists[qq * 320 + jp] : 0;
                a0[i] = *(const bf16x8*)(AK + (size_t)(rowb + key) * 64 + 8 * g); a1[i] = *(const bf16x8*)(AK + (size_t)(rowb + key) * 64 + 8 * g + 32);
            }
#pragma unroll
            for (int i = 0; i < 8; ++i) {
                const int kt = half * 8 + i;
                f32x4 acc = {0.f, 0.f, 0.f, 0.f};
                acc = __builtin_amdgcn_mfma_f32_16x16x32_bf16(a0[i], bq[0], acc, 0, 0, 0);
                acc = __builtin_amdgcn_mfma_f32_16x16x32_bf16(a1[i], bq[1], acc, 0, 0, 0);
                if (r < 8) {
#pragma unroll
                    for (int j = 0; j < 4; ++j) Pl[(16 * kt + 4 * g + j) * 8 + r] = acc[j] * 0.125f;
                }
            }
        }
        asm volatile("s_waitcnt lgkmcnt(0)" ::: "memory");
        f32x4 pa[4], pb[4];
        float mx[8];
#pragma unroll
        for (int hd = 0; hd < 8; ++hd) mx[hd] = -INFINITY;
#pragma unroll
        for (int i = 0; i < 4; ++i) {
            const int jp = lane + 64 * i;
            pa[i] = *(const LAS f32x4*)(Pl + jp * 8); pb[i] = *(const LAS f32x4*)(Pl + jp * 8 + 4);
            if (jp < nsel) {
#pragma unroll
                for (int hd = 0; hd < 4; ++hd) { mx[hd] = fmaxf(mx[hd], pa[i][hd]); mx[4 + hd] = fmaxf(mx[4 + hd], pb[i][hd]); }
            }
        }
#pragma unroll
        for (int hd = 0; hd < 8; ++hd) mx[hd] = wave_max_dpp(mx[hd]);
        float sm[8];
#pragma unroll
        for (int hd = 0; hd < 8; ++hd) sm[hd] = 0.f;
#pragma unroll
        for (int i = 0; i < 4; ++i) {
            const bool ok = (lane + 64 * i) < nsel;
#pragma unroll
            for (int hd = 0; hd < 4; ++hd) {
                pa[i][hd] = ok ? __expf(pa[i][hd] - mx[hd]) : 0.f; sm[hd] += pa[i][hd];
                pb[i][hd] = ok ? __expf(pb[i][hd] - mx[4 + hd]) : 0.f; sm[4 + hd] += pb[i][hd];
            }
        }
#pragma unroll
        for (int hd = 0; hd < 8; ++hd) sm[hd] = 1.f / wave_sum_dpp(sm[hd]);
        LAS bf16_t* Pt = (LAS bf16_t*)((LAS unsigned char*)Pl + 9216);
#pragma unroll
        for (int i = 0; i < 4; ++i) {
            const int jp = lane + 64 * i;
#pragma unroll
            for (int hd = 0; hd < 4; ++hd) { Pt[hd * 264 + jp] = f2bf(pa[i][hd] * sm[hd]); Pt[(4 + hd) * 264 + jp] = f2bf(pb[i][hd] * sm[4 + hd]); }
        }
    }
    asm volatile("s_waitcnt lgkmcnt(0)" ::: "memory");
    {
        typedef short s16x4 __attribute__((ext_vector_type(4)));
        const int r = lane & 15, g = lane >> 4;
        LAS unsigned char* wb = (LAS unsigned char*)(scores + qq * 4096);
        const LAS bf16_t* Pt = (const LAS bf16_t*)(wb + 9216);
        const int nchunk = (nsel + 31) >> 5;
        const int kl = lane >> 3, dc = lane & 7;
        f32x4 acc[4];
#pragma unroll
        for (int ct = 0; ct < 4; ++ct) acc[ct] = (f32x4){0.f, 0.f, 0.f, 0.f};
        u32x4 vq[4], vn[4];
#pragma unroll
        for (int i = 0; i < 4; ++i) {
            const int jp = kl + 8 * i;
            const int key = (jp < nsel) ? lists[qq * 320 + jp] : 0;
            vq[i] = *(const u32x4*)(AV + (size_t)(rowb + key) * 64 + dc * 8);
        }
#pragma unroll 1
        for (int c = 0; c < nchunk; ++c) {
            LAS unsigned char* vb = wb + (c & 1) * 4608;
#pragma unroll
            for (int i = 0; i < 4; ++i) *(LAS u32x4*)(vb + (kl + 8 * i) * 144 + dc * 16) = vq[i];
            if (c + 1 < nchunk) {
#pragma unroll
                for (int i = 0; i < 4; ++i) {
                    const int jp = 32 * (c + 1) + kl + 8 * i;
                    const int key = (jp < nsel) ? lists[qq * 320 + jp] : 0;
                    vn[i] = *(const u32x4*)(AV + (size_t)(rowb + key) * 64 + dc * 8);
                }
            }
            bf16x8 a = *(const LAS bf16x8*)(Pt + (r & 7) * 264 + 32 * c + 8 * g);
            if (r >= 8) a = (bf16x8){0, 0, 0, 0, 0, 0, 0, 0};
#pragma unroll
            for (int ct = 0; ct < 4; ++ct) {
                LAS unsigned char* ba = vb + (8 * g + (r >> 2)) * 144 + (16 * ct + 4 * (r & 3)) * 2;
                const s16x4 b0 = __builtin_amdgcn_ds_read_tr16_b64_v4i16((LAS s16x4*)ba);
                const s16x4 b1 = __builtin_amdgcn_ds_read_tr16_b64_v4i16((LAS s16x4*)(ba + 4 * 144));
                bf16x8 bb; bb[0] = b0[0]; bb[1] = b0[1]; bb[2] = b0[2]; bb[3] = b0[3]; bb[4] = b1[0]; bb[5] = b1[1]; bb[6] = b1[2]; bb[7] = b1[3];
                acc[ct] = __builtin_amdgcn_mfma_f32_16x16x32_bf16(a, bb, acc[ct], 0, 0, 0);
            }
#pragma unroll
            for (int i = 0; i < 4; ++i) vq[i] = vn[i];
        }
        bf16_t* dst = (bf16_t*)(p.ws + OFF_ACT) + (size_t)(rowb + t) * 1024 + 512;
#pragma unroll
        for (int j = 0; j < 4; ++j) {
            float ss = acc[0][j] * acc[0][j] + acc[1][j] * acc[1][j] + acc[2][j] * acc[2][j] + acc[3][j] * acc[3][j];
            ss += __shfl_xor(ss, 1); ss += __shfl_xor(ss, 2); ss += __shfl_xor(ss, 4); ss += __shfl_xor(ss, 8);
            const float rstd = rsqrtf(ss * (1.f / 64.f) + 1e-6f);
            if (g < 2) {
                const int hd = 4 * g + j;
#pragma unroll
                for (int ct = 0; ct < 4; ++ct) dst[hd * 64 + 16 * ct + r] = f2bf(acc[ct][j] * rstd * p.out_norm_a[hd * 64 + 16 * ct + r]);
            }
        }
    }
    }
    __syncthreads();
}

__device__ __forceinline__ float sortable2f(unsigned s) { return __uint_as_float((s & 0x80000000u) ? (s ^ 0x80000000u) : ~s); }
#define CE_DESC(x, y) do { const unsigned mx_ = max(x, y), mn_ = min(x, y); (x) = mx_; (y) = mn_; } while (0)
template <int BASE, int N>
__device__ __forceinline__ void bitonic_sort16_desc(unsigned (&a)[N]) {
#pragma unroll
    for (int k = 2; k <= 16; k <<= 1) {
#pragma unroll
        for (int j = k >> 1; j > 0; j >>= 1) {
#pragma unroll
            for (int i = 0; i < 16; ++i) {
                const int l = i ^ j;
                if (l > i) {
                    if ((i & k) == 0) CE_DESC(a[BASE + i], a[BASE + l]);
                    else CE_DESC(a[BASE + l], a[BASE + i]);
                }
            }
        }
    }
}
template <int BASE, int N>
__device__ __forceinline__ void bitonic_merge16_desc(unsigned (&a)[N]) {
#pragma unroll
    for (int j = 8; j > 0; j >>= 1) {
#pragma unroll
        for (int i = 0; i < 16; ++i) { const int l = i ^ j; if (l > i) CE_DESC(a[BASE + i], a[BASE + l]); }
    }
}
template <int BA, int BB, int N>
__device__ __forceinline__ void top16_merge(unsigned (&a)[N]) {
#pragma unroll
    for (int i = 0; i < 16; ++i) a[BA + i] = max(a[BA + i], a[BB + 15 - i]);
    bitonic_merge16_desc<BA, N>(a);
}
__device__ __forceinline__ void top16_of_64(unsigned (&a)[64]) {
    bitonic_sort16_desc<0, 64>(a); bitonic_sort16_desc<16, 64>(a); bitonic_sort16_desc<32, 64>(a); bitonic_sort16_desc<48, 64>(a);
    top16_merge<0, 16, 64>(a); top16_merge<32, 48, 64>(a); top16_merge<0, 32, 64>(a);
}
__device__ __forceinline__ void peer_route(const Params& p, int task, LAS unsigned char* lds) {
    const int tid = opaque_tid(), wid = __builtin_amdgcn_readfirstlane(tid >> 6), lane = tid & 63;
    const int n0 = task * 32, head = wid;
    const int r = lane & 31, hh = lane >> 5;
    const bf16_t* QRY = (const bf16_t*)(p.ws + OFF_QRY); const bf16_t* SK = (const bf16_t*)(p.ws + OFF_SK);
    LAS unsigned* tkl = (LAS unsigned*)lds + wid * (32 * 64);
#pragma unroll 1
    for (int p2 = 0; p2 < 2; ++p2) {
        const int grp = head * 2 + p2;
        bf16x8 bq[4];
#pragma unroll
        for (int ks = 0; ks < 4; ++ks) bq[ks] = *(const bf16x8*)(QRY + (size_t)(n0 + r) * 1024 + grp * 64 + 16 * ks + 8 * hh);
        unsigned key[64];
#pragma unroll
        for (int kt = 0; kt < 4; ++kt) {
            f32x16 acc;
#pragma unroll
            for (int i = 0; i < 16; ++i) acc[i] = 0.f;
#pragma unroll
            for (int ks = 0; ks < 4; ++ks) {
                const bf16x8 a = *(const bf16x8*)(SK + (size_t)(grp * 128 + 32 * kt + r) * 64 + 16 * ks + 8 * hh);
                acc = __builtin_amdgcn_mfma_f32_32x32x16_bf16(a, bq[ks], acc, 0, 0, 0);
            }
#pragma unroll
            for (int reg = 0; reg < 16; ++reg) {
                const int idx = 32 * kt + (reg & 3) + 8 * (reg >> 2) + 4 * hh;
                key[kt * 16 + reg] = (f2sortable(acc[reg]) & ~0x7Fu) | (unsigned)(127 - idx);
            }
        }
        top16_of_64(key);
        unsigned mg[16];
#pragma unroll
        for (int i = 0; i < 16; ++i) mg[i] = max(key[i], (unsigned)__shfl_xor((int)key[15 - i], 32));
        bitonic_merge16_desc<0, 16>(mg);
#pragma unroll
        for (int k = 0; k < 16; ++k) tkl[(p2 * 16 + k) * 64 + lane] = mg[k];
    }
    float v1[16], v2[16];
#pragma unroll
    for (int k = 0; k < 16; ++k) { v1[k] = sortable2f(tkl[k * 64 + lane] & ~0x7Fu); v2[k] = sortable2f(tkl[(16 + k) * 64 + lane] & ~0x7Fu); }
    unsigned ck[64];
    {
        int ci = 0;
#pragma unroll
        for (int a = 0; a < 16; ++a) {
#pragma unroll
            for (int bb = 0; bb < 16 / (a + 1); ++bb) { ck[ci] = (f2sortable(v1[a] + v2[bb]) & ~0xFFu) | (unsigned)(255 - (16 * a + bb)); ++ci; }
        }
#pragma unroll
        for (int i = 50; i < 64; ++i) ck[i] = 0u;
    }
    top16_of_64(ck);
    float tv[16]; int te[16];
    float sum = 0.f;
#pragma unroll
    for (int k = 0; k < 16; ++k) {
        const int flat = 255 - (int)(ck[k] & 0xFFu);
        const int i1 = 127 - (int)(tkl[(flat >> 4) * 64 + lane] & 0x7Fu), i2 = 127 - (int)(tkl[(16 + (flat & 15)) * 64 + lane] & 0x7Fu);
        te[k] = i1 * 128 + i2;
        tv[k] = __expf(sortable2f(ck[k] & ~0xFFu) - sortable2f(ck[0] & ~0xFFu)); sum += tv[k];
    }
    const float inv = 1.f / sum;
    if (hh == 0) {
        int* EI = (int*)(p.ws + OFF_EIDX) + (size_t)(n0 + r) * 128 + head * 16;
#pragma unroll
        for (int q = 0; q < 4; ++q) { u32x4 o; o[0] = te[4 * q]; o[1] = te[4 * q + 1]; o[2] = te[4 * q + 2]; o[3] = te[4 * q + 3]; *(u32x4*)(EI + 4 * q) = o; }
    } else {
        float* GW = (float*)(p.ws + OFF_GW) + (size_t)(n0 + r) * 128 + head * 16;
#pragma unroll
        for (int q = 0; q < 4; ++q) { f32x4 o; o[0] = tv[4 * q] * inv; o[1] = tv[4 * q + 1] * inv; o[2] = tv[4 * q + 2] * inv; o[3] = tv[4 * q + 3] * inv; *(f32x4*)(GW + 4 * q) = o; }
    }
}

__device__ __forceinline__ float gelu_exact(float a) { return 0.5f * a * (1.f + erff(a * 0.70710678118654752440f)); }
__device__ __forceinline__ void dec16_fp8(const u32x4 w, float (&f)[16]) {
#pragma unroll
    for (int i = 0; i < 4; ++i) {
        const f32x2 lo = __builtin_amdgcn_cvt_pk_f32_fp8((int)w[i], false), hi = __builtin_amdgcn_cvt_pk_f32_fp8((int)w[i], true);
        f[4 * i] = lo[0]; f[4 * i + 1] = lo[1]; f[4 * i + 2] = hi[0]; f[4 * i + 3] = hi[1];
    }
}
__device__ __forceinline__ void peer_experts(const Params& p, bool do_store) {
    const int wid = threadIdx.x >> 6, lane = threadIdx.x & 63;
    const bf16_t* H2 = (const bf16_t*)(p.ws + OFF_ACT); const unsigned char* UT = p.ws + OFF_UT; const unsigned char* VT = p.ws + OFF_VT;
    const int* EI = (const int*)(p.ws + OFF_EIDX); const float* GW = (const float*)(p.ws + OFF_GW); const float* ada = (const float*)(p.ws + OFF_ADA);
    const int d0 = 16 * lane;
    for (int tok = blockIdx.x * 8 + wid; tok < NTOK; tok += gridDim.x * 8) {
        __syncthreads();
        const int b = tok >> 12;
        float hx[16];
        {
            const u32x4 h0 = *(const u32x4*)(H2 + (size_t)tok * 1024 + d0), h1 = *(const u32x4*)(H2 + (size_t)tok * 1024 + d0 + 8);
#pragma unroll
            for (int i = 0; i < 4; ++i) { hx[2 * i] = lo16(h0[i]); hx[2 * i + 1] = hi16(h0[i]); hx[8 + 2 * i] = lo16(h1[i]); hx[8 + 2 * i + 1] = hi16(h1[i]); }
        }
        float acc[16];
#pragma unroll
        for (int i = 0; i < 16; ++i) acc[i] = 0.f;
        int k_lo = EI[(size_t)tok * 128 + lane], k_hi = EI[(size_t)tok * 128 + 64 + lane];
        float g_lo = GW[(size_t)tok * 128 + lane], g_hi = GW[(size_t)tok * 128 + 64 + lane];
        {
#pragma unroll
            for (int size = 2; size <= 128; size <<= 1) {
#pragma unroll
                for (int stride = size >> 1; stride >= 1; stride >>= 1) {
                    if (stride == 64) {
                        const bool sw = k_hi < k_lo;
                        const int ta = sw ? k_hi : k_lo, tb = sw ? k_lo : k_hi; const float ga = sw ? g_hi : g_lo, gb = sw ? g_lo : g_hi;
                        k_lo = ta; k_hi = tb; g_lo = ga; g_hi = gb;
                    } else {
                        const int p_lo = __shfl_xor(k_lo, stride), p_hi = __shfl_xor(k_hi, stride);
                        const float q_lo = __shfl_xor(g_lo, stride), q_hi = __shfl_xor(g_hi, stride);
                        const bool lower = (lane & stride) == 0;
                        const bool asc_lo = (size >= 64) ? true : ((lane & size) == 0);
                        const bool asc_hi = (size == 128) ? true : ((size == 64) ? false : ((lane & size) == 0));
                        const bool min_lo = (lower == asc_lo), min_hi = (lower == asc_hi);
                        const bool take_lo = min_lo ? (p_lo < k_lo) : (p_lo > k_lo);
                        const bool take_hi = min_hi ? (p_hi < k_hi) : (p_hi > k_hi);
                        k_lo = take_lo ? p_lo : k_lo; g_lo = take_lo ? q_lo : g_lo;
                        k_hi = take_hi ? p_hi : k_hi; g_hi = take_hi ? q_hi : g_hi;
                    }
                }
            }
        }
        for (int k0 = 0; k0 < 128; k0 += 8) {
            if ((k0 & 31) == 0 && k0) __syncthreads();
            u32x4 uu[8]; u32x2 vv[8]; float gg[8];
#pragma unroll
            for (int q = 0; q < 8; ++q) {
                const int e_ = __builtin_amdgcn_readlane(k0 < 64 ? k_lo : k_hi, (k0 + q) & 63);
                gg[q] = __uint_as_float((unsigned)__builtin_amdgcn_readlane((int)__float_as_uint(k0 < 64 ? g_lo : g_hi), (k0 + q) & 63));
                uu[q] = *(const u32x4*)(UT + (size_t)e_ * 1024 + d0); vv[q] = *(const u32x2*)(VT + (size_t)e_ * 512 + 8 * lane);
            }
            float sv[8];
#pragma unroll
            for (int q = 0; q < 8; ++q) { float f[16]; dec16_fp8(uu[q], f); float s_ = 0.f;
#pragma unroll
                for (int i = 0; i < 16; ++i) s_ += f[i] * hx[i];
                sv[q] = s_; }
            float t4[4];
#pragma unroll
            for (int i = 0; i < 4; ++i) { const u32x2 r_ = __builtin_amdgcn_permlane32_swap(__float_as_uint(sv[i]), __float_as_uint(sv[i + 4]), false, false); t4[i] = __uint_as_float(r_[0]) + __uint_as_float(r_[1]); }
            float w2[2];
#pragma unroll
            for (int i = 0; i < 2; ++i) { const u32x2 r_ = __builtin_amdgcn_permlane16_swap(__float_as_uint(t4[i]), __float_as_uint(t4[i + 2]), false, false); w2[i] = __uint_as_float(r_[0]) + __uint_as_float(r_[1]); }
#pragma unroll
            for (int i = 0; i < 2; ++i) {
                w2[i] += __uint_as_float((unsigned)__builtin_amdgcn_update_dpp(0, (int)__float_as_uint(w2[i]), 0xB1, 0xF, 0xF, true));
                w2[i] += __uint_as_float((unsigned)__builtin_amdgcn_update_dpp(0, (int)__float_as_uint(w2[i]), 0x4E, 0xF, 0xF, true));
                w2[i] += __uint_as_float((unsigned)__builtin_amdgcn_update_dpp(0, (int)__float_as_uint(w2[i]), 0x141, 0xF, 0xF, true));
                w2[i] += __uint_as_float((unsigned)__builtin_amdgcn_update_dpp(0, (int)__float_as_uint(w2[i]), 0x140, 0xF, 0xF, true)); }
            float mine = 0.f, gmine = 0.f;
#pragma unroll
            for (int q = 0; q < 8; ++q) {
                const float tq = __uint_as_float((unsigned)__builtin_amdgcn_readlane((int)__float_as_uint(w2[q & 1]), 16 * (((q >> 1) & 1) + 2 * (q >> 2))));
                mine = ((lane & 7) == q) ? tq : mine; gmine = ((lane & 7) == q) ? gg[q] : gmine; }
            const float cmine = gmine * gelu_exact(mine * (1.f / 512.f)) * (1.f / 5.656854f);
#pragma unroll
            for (int q = 0; q < 8; ++q) {
                const float coef = __uint_as_float((unsigned)__builtin_amdgcn_readlane((int)__float_as_uint(cmine), q));
                float f[16];
#pragma unroll
                for (int w = 0; w < 2; ++w) {
                    const f32x2 f0 = __builtin_amdgcn_cvt_scalef32_pk_f32_fp4(vv[q][w], 1.0f, 0), f1 = __builtin_amdgcn_cvt_scalef32_pk_f32_fp4(vv[q][w], 1.0f, 1);
                    const f32x2 f2 = __builtin_amdgcn_cvt_scalef32_pk_f32_fp4(vv[q][w], 1.0f, 2), f3 = __builtin_amdgcn_cvt_scalef32_pk_f32_fp4(vv[q][w], 1.0f, 3);
                    f[8 * w] = f0[0]; f[8 * w + 1] = f0[1]; f[8 * w + 2] = f1[0]; f[8 * w + 3] = f1[1]; f[8 * w + 4] = f2[0]; f[8 * w + 5] = f2[1]; f[8 * w + 6] = f3[0]; f[8 * w + 7] = f3[1];
                }
#pragma unroll
                for (int i = 0; i < 16; ++i) acc[i] += coef * f[i]; }
        }
        float* orow = p.out + (size_t)tok * 1024 + d0;
        float xo[16]; float ss = 0.f;
#pragma unroll
        for (int q = 0; q < 4; ++q) {
            const f32x4 xv = *(const f32x4*)(orow + 4 * q), gv = *(const f32x4*)(ada + b * 6144 + 5120 + d0 + 4 * q);
#pragma unroll
            for (int i = 0; i < 4; ++i) { const float v = xv[i] + gv[i] * acc[q * 4 + i]; xo[q * 4 + i] = v; ss += v * v; }
        }
        ss = wave_sum(ss);
        const float rstd = rsqrtf(ss * (1.f / 1024.f) + 1e-6f);
#pragma unroll
        for (int q = 0; q < 4; ++q) {
            const f32x4 fg = *(const f32x4*)(p.final_g + d0 + 4 * q);
            f32x4 ov;
#pragma unroll
            for (int i = 0; i < 4; ++i) ov[i] = xo[q * 4 + i] * rstd * fg[i];
            if (do_store) *(f32x4*)(orow + 4 * q) = ov;
        }
    }
}

enum { PH_PREP = 0, PH_GEMM_IN, PH_MIX, PH_GEMM_OUT, PH_H2, PH_GEMM_Q, PH_ROUTE, PH_EXPERT, PH_COUNT };

typedef const __attribute__((address_space(4))) Params* KParams;
__device__ __forceinline__ const Params& kparams() {
    auto q = __builtin_amdgcn_kernarg_segment_ptr();
    asm volatile("" : "+s"(q));
    return *(const Params*)q;
}
#ifndef PHMASK
#define PHMASK 0xFFFF
#endif
#ifndef REP_PHASE
#define REP_PHASE -1
#endif
#define PHASE_BEGIN(idx) if (((PHMASK >> (idx)) & 1) && ph_lo <= (idx) && (idx) < ph_hi) { for (int rep = 0; rep < ((idx) == REP_PHASE ? 2 : 1); ++rep) { if ((idx) != ph_lo || rep) xcd_barrier(bar); const Params& p = kparams(); const int G = gridDim.x; (void)G; const bool last_rep = (rep == ((idx) == REP_PHASE ? 1 : 0)); (void)last_rep;
#define PHASE_END } }

__global__ void __launch_bounds__(NTHREADS, 2) hymba_fwd(Params p_) {
    extern __shared__ __attribute__((aligned(16))) unsigned char smem_raw[];
    LAS unsigned char* lds = (LAS unsigned char*)smem_raw;
    volatile LAS unsigned* xbw = (volatile LAS unsigned*)(lds + LDS_BYTES - 16);
    if (threadIdx.x == 0) { xbw[0] = 0u; xbw[1] = 0u; xbw[2] = 0u; xbw[3] = 0u; }
    __syncthreads();
    XcdBarrier bar = xcd_barrier_post((unsigned*)(p_.ws + OFF_CTL), xbw);
    const int ph_lo = p_.ph_lo, ph_hi = p_.ph_hi;

    PHASE_BEGIN(PH_PREP)
        phase0(p, lds);
        wg_wait((unsigned*)(p.ws + OFF_CTL), CNT_ADA, 192u);
        norm_mod_rows(p.x, p.norm1_g, (const float*)(p.ws + OFF_ADA), 0, 1024, (bf16_t*)(p.ws + OFF_ACT));
    PHASE_END
    PHASE_BEGIN(PH_GEMM_IN)
        {   pg8::StaticOrder S; S.init(NTOK, 3072, G, blockIdx.x);
            EpiInMain E; E.ws = p.ws; E.bias = (const float*)(p.ws + OFF_BIAS);
            pg8::gemm_phase(lds, pg8::Gemm{(const bf16_t*)(p.ws + OFF_ACT), (const bf16_t*)(p.ws + OFF_WIN), NTOK, 3072, 1024}, S, E); }
        {   pg8::StaticOrder S; S.init(NTOK, 256, G, blockIdx.x);
            EpiInTail E; E.ws = p.ws; E.bias = (const float*)(p.ws + OFF_BIAS) + 3072;
            pg8::gemm_phase(lds, pg8::Gemm{(const bf16_t*)(p.ws + OFF_ACT), (const bf16_t*)(p.ws + OFF_WIN) + (size_t)3072 * 1024, NTOK, 256, 1024}, S, E); }
        if (G > 64) { if ((int)blockIdx.x >= 64) convert_tables(p, (int)blockIdx.x - 64, G - 64); }
        else convert_tables(p, (int)blockIdx.x, G);
    PHASE_END
    PHASE_BEGIN(PH_MIX)
        unsigned* ctl = (unsigned*)(p.ws + OFF_CTL);
        for (int t = blockIdx.x; t < 1024; t += G) mlstm_passA(p, t, lds);
        wg_signal(ctl, CNT_MLA);
        __syncthreads();
        for (int t = blockIdx.x; t < 2048; t += G) {
            const int rnd = t >> 8, w = t & 255; const int bsel = rnd >> 1; const int qgs = (rnd & 1) ? w : (511 - w);
            dsa_task(p, (bsel << 9) | qgs, lds); }
        wg_wait(ctl, CNT_MLA, (unsigned)G);
        for (int t = blockIdx.x; t < 256; t += G) mlstm_scan(p, t, lds);
        wg_signal(ctl, CNT_SCAN);
        wg_wait(ctl, CNT_SCAN, (unsigned)G);
        for (int t = blockIdx.x; t < 1024; t += G) mlstm_passB(p, t, lds);
    PHASE_END
    PHASE_BEGIN(PH_GEMM_OUT)
        {   pg8::StaticOrder S; S.init(NTOK, 1024, G, blockIdx.x);
            EpiOut E; E.x = p.x; E.ada = (const float*)(p.ws + OFF_ADA); E.out = p.out;
            pg8::gemm_phase(lds, pg8::Gemm{(const bf16_t*)(p.ws + OFF_ACT), (const bf16_t*)(p.ws + OFF_WOUT), NTOK, 1024, 1024}, S, E); }
    PHASE_END
    PHASE_BEGIN(PH_H2) norm_mod_rows(p.out, p.norm2_g, (const float*)(p.ws + OFF_ADA), 3072, 4096, (bf16_t*)(p.ws + OFF_ACT)); PHASE_END
    PHASE_BEGIN(PH_GEMM_Q)
        {   pg8::StaticOrder S; S.init(NTOK, 1024, G, blockIdx.x);
            EpiQry E; E.O = (bf16_t*)(p.ws + OFF_QRY);
            pg8::gemm_phase(lds, pg8::Gemm{(const bf16_t*)(p.ws + OFF_ACT), (const bf16_t*)(p.ws + OFF_WPQ), NTOK, 1024, 1024}, S, E); }
    PHASE_END
    PHASE_BEGIN(PH_ROUTE) for (int t = blockIdx.x; t < 512; t += G) peer_route(p, t, lds); PHASE_END
    PHASE_BEGIN(PH_EXPERT) peer_experts(p, last_rep); PHASE_END
}

extern "C" void kernel_launch(void* const* d_in, const int* in_sizes, int n_in, void* d_out, int out_size, void* d_ws, size_t ws_size, hipStream_t stream) {
    static int grid = 0;
    if (grid == 0) {
        int dev = 0, cus = 0, per_cu = 0;
        if (hipGetDevice(&dev) != hipSuccess || hipDeviceGetAttribute(&cus, hipDeviceAttributeMultiprocessorCount, dev) != hipSuccess) { fprintf(stderr, "kernel_launch: device query failed\n"); grid = -1; return; }
        if (hipFuncSetAttribute((const void*)hymba_fwd, hipFuncAttributeMaxDynamicSharedMemorySize, LDS_BYTES) != hipSuccess) { fprintf(stderr, "kernel_launch: hipFuncSetAttribute failed\n"); grid = -1; return; }
        if (hipOccupancyMaxActiveBlocksPerMultiprocessor(&per_cu, (const void*)hymba_fwd, NTHREADS, LDS_BYTES) != hipSuccess || per_cu < 1) { fprintf(stderr, "kernel_launch: occupancy query says %d blocks/CU\n", per_cu); }
        (void)hipGetLastError();
        grid = cus;
        if (ws_size < WS_END || n_in != 17) { fprintf(stderr, "kernel_launch: unexpected sizes (ws %zu, n_in %d)\n", ws_size, n_in); grid = -1; return; }
    }
    if (grid < 0) return;
    (void)hipMemsetAsync((char*)d_ws + OFF_CTL, 0, CTL_BYTES, stream);
    Params p{};
    p.x = (const float*)d_in[0]; p.c = (const float*)d_in[1]; p.w_ada = (const float*)d_in[2]; p.b_ada = (const float*)d_in[3]; p.norm1_g = (const float*)d_in[4];
    p.w_in = (const float*)d_in[5]; p.b_in = (const float*)d_in[6]; p.conv_qk = (const float*)d_in[7]; p.out_norm_m = (const float*)d_in[8]; p.out_norm_a = (const float*)d_in[9];
    p.w_out = (const float*)d_in[10]; p.norm2_g = (const float*)d_in[11]; p.w_peer_q = (const float*)d_in[12]; p.sub_keys = (const float*)d_in[13]; p.peer_u = (const float*)d_in[14];
    p.peer_v = (const float*)d_in[15]; p.final_g = (const float*)d_in[16];
    p.out = (float*)d_out; p.ws = (unsigned char*)d_ws; p.ph_lo = 0; p.ph_hi = PH_COUNT;
    void* args[] = {&p};
    hipError_t e = hipLaunchCooperativeKernel((const void*)hymba_fwd, dim3(grid), dim3(NTHREADS), args, LDS_BYTES, stream);
    if (e != hipSuccess) fprintf(stderr, "kernel_launch: cooperative launch failed: %s (grid %d)\n", hipGetErrorString(e), grid);
}
```

```cpp
#include <hip/hip_runtime.h>
#include <stdint.h>
#define REP_PHASE -1
#define DSA_REP 0
#include <cstdio>

#define LAS __attribute__((address_space(3)))
typedef unsigned short bf16_t;
typedef short bf16x8 __attribute__((ext_vector_type(8)));
typedef float f32x4 __attribute__((ext_vector_type(4)));
typedef float f32x2 __attribute__((ext_vector_type(2)));
typedef float f32x16 __attribute__((ext_vector_type(16)));
typedef unsigned u32x4 __attribute__((ext_vector_type(4)));
typedef unsigned u32x2 __attribute__((ext_vector_type(2)));

constexpr int NTOK = 16384, DM = 1024, SEQ = 4096;
constexpr int NIN_PAD = 3328;
constexpr int LDS_BYTES = 163840 - 64;
constexpr int NTHREADS = 512;

constexpr size_t MiB = 1024 * 1024;
constexpr size_t OFF_CTL = 0;
constexpr size_t CTL_BYTES = 16384;
constexpr size_t OFF_ADA = 64 * 1024;
constexpr size_t OFF_BIAS = 192 * 1024;
constexpr size_t OFF_SK = 256 * 1024;
constexpr size_t OFF_WIN = 512 * 1024;
constexpr size_t OFF_WOUT = 7 * MiB;
constexpr size_t OFF_WPQ = 9 * MiB;
constexpr size_t OFF_ACT = 11 * MiB;
constexpr size_t OFF_MQ = 43 * MiB;
constexpr size_t OFF_MK = 59 * MiB;
constexpr size_t OFF_MV = 75 * MiB;
constexpr size_t OFF_MO = 91 * MiB;
constexpr size_t OFF_AQ = 107 * MiB;
constexpr size_t OFF_IQ = 123 * MiB;
constexpr size_t OFF_AK = 139 * MiB;
constexpr size_t OFF_AV = 141 * MiB;
constexpr size_t OFF_IK = 143 * MiB;
constexpr size_t OFF_GATE = 145 * MiB;
constexpr size_t OFF_KV = 146 * MiB;
constexpr size_t OFF_KS = 178 * MiB;
constexpr size_t OFF_MLOC = 178 * MiB + 512 * 1024;
constexpr size_t OFF_BLAST = OFF_MLOC + 4096;
constexpr size_t OFF_M0 = OFF_BLAST + 4096;
constexpr size_t OFF_UT = 179 * MiB;
constexpr size_t OFF_VT = 195 * MiB;
constexpr size_t WS_END = 211 * MiB;
constexpr float PEER_SU = 812.8f;
constexpr float PEER_SV = 8.443f;
constexpr float PEER_SC = 2048.f;
constexpr size_t OFF_QRY = OFF_MQ;
constexpr size_t OFF_EIDX = OFF_MV;
constexpr size_t OFF_GW = OFF_MV + 8 * MiB;

struct Params {
    const float* x; const float* c; const float* w_ada; const float* b_ada; const float* norm1_g;
    const float* w_in; const float* b_in; const float* conv_qk; const float* out_norm_m; const float* out_norm_a;
    const float* w_out; const float* norm2_g; const float* w_peer_q; const float* sub_keys; const float* peer_u;
    const float* peer_v; const float* final_g;
    float* out; unsigned char* ws;
    int ph_lo, ph_hi;
};

__device__ __forceinline__ int opaque_tid() { int t = threadIdx.x; asm volatile("" : "+v"(t)); return t; }
__device__ __forceinline__ float bf2f(unsigned short b) { return __uint_as_float(((unsigned)b) << 16); }
__device__ __forceinline__ unsigned short f2bf(float f) { unsigned u = __float_as_uint(f); u += 0x7FFFu + ((u >> 16) & 1u); return (unsigned short)(u >> 16); }
__device__ __forceinline__ unsigned pack2(float lo, float hi) { return (unsigned)f2bf(lo) | ((unsigned)f2bf(hi) << 16); }
__device__ __forceinline__ float lo16(unsigned w) { return __uint_as_float(w << 16); }
__device__ __forceinline__ float hi16(unsigned w) { return __uint_as_float(w & 0xffff0000u); }
__device__ __forceinline__ float wave_sum(float v) {
#pragma unroll
    for (int o = 32; o >= 1; o >>= 1) v += __shfl_xor(v, o);
    return v;
}
__device__ __forceinline__ int wave_sum_i32_uniform(int v) {
    v += __builtin_amdgcn_update_dpp(0, v, 0xB1, 0xF, 0xF, true);
    v += __builtin_amdgcn_update_dpp(0, v, 0x4E, 0xF, 0xF, true);
    v += __builtin_amdgcn_update_dpp(0, v, 0x141, 0xF, 0xF, true);
    v += __builtin_amdgcn_update_dpp(0, v, 0x140, 0xF, 0xF, true);
    return __builtin_amdgcn_readlane(v, 0) + __builtin_amdgcn_readlane(v, 16) + __builtin_amdgcn_readlane(v, 32) + __builtin_amdgcn_readlane(v, 48);
}
__device__ __forceinline__ float wave_scan_add(float v, int lane) {
#pragma unroll
    for (int o = 1; o < 64; o <<= 1) { const float t = __shfl_up(v, o); if (lane >= o) v += t; }
    return v;
}
__device__ __forceinline__ float wave_scan_max(float v, int lane) {
#pragma unroll
    for (int o = 1; o < 64; o <<= 1) { const float t = __shfl_up(v, o); if (lane >= o) v = fmaxf(v, t); }
    return v;
}
__device__ __forceinline__ float wave_max(float v) {
#pragma unroll
    for (int o = 32; o >= 1; o >>= 1) v = fmaxf(v, __shfl_xor(v, o));
    return v;
}
#define dppf(v, ctrl) __uint_as_float((unsigned)__builtin_amdgcn_update_dpp(0, (int)__float_as_uint(v), (ctrl), 0xF, 0xF, true))
__device__ __forceinline__ float rlanef(float v, int l) { return __uint_as_float((unsigned)__builtin_amdgcn_readlane((int)__float_as_uint(v), l)); }
__device__ __forceinline__ float wave_sum_dpp(float v) {
    v += dppf(v, 0xB1); v += dppf(v, 0x4E); v += dppf(v, 0x141); v += dppf(v, 0x140);
    return (rlanef(v, 0) + rlanef(v, 16)) + (rlanef(v, 32) + rlanef(v, 48));
}
__device__ __forceinline__ float wave_max_dpp(float v) {
    v = fmaxf(v, dppf(v, 0xB1)); v = fmaxf(v, dppf(v, 0x4E)); v = fmaxf(v, dppf(v, 0x141)); v = fmaxf(v, dppf(v, 0x140));
    return fmaxf(fmaxf(rlanef(v, 0), rlanef(v, 16)), fmaxf(rlanef(v, 32), rlanef(v, 48)));
}
__device__ __forceinline__ float siluf(float x) { return x / (1.f + __expf(-x)); }
__device__ __forceinline__ float sigmoidf_(float x) { return 1.f / (1.f + __expf(-x)); }
__device__ __forceinline__ float logsigmoidf_(float x) { return fminf(x, 0.f) - log1pf(__expf(-fabsf(x))); }

#define XB_TMO      128
#define XB_XCNT(j)  (256  + 64 * (j))
#define XB_XSUB(j)  (1280 + 64 * (j))
#define XB_XGEN(j)  (2304 + 64 * (j))
#define XB_TOP      3328
#define XB_TOPGEN   3392
#define XCD_BAR_WORDS 3456
#define XB_SPIN_CAP (1u << 22)
__device__ __forceinline__ unsigned xb_ld(unsigned* p)              { return __hip_atomic_load(p, __ATOMIC_RELAXED, __HIP_MEMORY_SCOPE_AGENT); }
__device__ __forceinline__ unsigned xb_add(unsigned* p, unsigned v) { return __hip_atomic_fetch_add(p, v, __ATOMIC_RELAXED, __HIP_MEMORY_SCOPE_AGENT); }
__device__ __forceinline__ unsigned xb_xcc_id() { return (unsigned)__builtin_amdgcn_s_getreg((3 << 11) | 20) & 0xFu; }
#define XB_SPIN(cond, bar) do { unsigned _sp = 0; while (cond) { __builtin_amdgcn_s_sleep(1); \
    if ((++_sp & 255u) == 0u) { if (xb_ld(&(bar)[XB_TMO])) break; if (_sp > XB_SPIN_CAP) { atomicAdd(&(bar)[XB_TMO], 1u); break; } } } } while (0)
struct XcdBarrier { unsigned* bar; unsigned x; volatile LAS unsigned* st; };
__device__ __forceinline__ XcdBarrier xcd_barrier_post(unsigned* bar, volatile LAS unsigned* st) {
    XcdBarrier b; b.bar = bar; b.x = xb_xcc_id(); b.st = st;
    if (threadIdx.x == 0) (void)xb_add(&bar[XB_XCNT(b.x)], 1u);
    return b;
}
__device__ __forceinline__ void xcd_barrier_complete(unsigned* bar, unsigned x, unsigned& nloc, unsigned& nx) {
    const unsigned G = gridDim.x * gridDim.y * gridDim.z;
    unsigned sum, cnt, mine, sp = 0u;
    for (;;) {
        sum = 0u; cnt = 0u; mine = 0u;
#pragma unroll
        for (unsigned j = 0; j < 16; ++j) { const unsigned c = xb_ld(&bar[XB_XCNT(j)]); sum += c; cnt += (c > 0u) ? 1u : 0u; mine = (j == x) ? c : mine; }
        if (sum == G) break;
        __builtin_amdgcn_s_sleep(1);
        if ((++sp & 255u) == 0u) { if (xb_ld(&bar[XB_TMO])) break; if (sp > XB_SPIN_CAP) { atomicAdd(&bar[XB_TMO], 1u); break; } }
    }
    nloc = mine > 0u ? mine : 1u; nx = cnt > 0u ? cnt : 1u;
}
__device__ __forceinline__ void xcd_barrier(const XcdBarrier& b) {
    asm volatile("s_waitcnt vmcnt(0)" ::: "memory");
    __syncthreads();
    if (threadIdx.x == 0) {
        unsigned* bar = b.bar;
        __builtin_amdgcn_s_waitcnt(0);
        unsigned nloc = b.st[0], nx = b.st[1];
        if (nloc == 0u) { xcd_barrier_complete(bar, b.x, nloc, nx); b.st[0] = nloc; b.st[1] = nx; }
        const unsigned old = xb_add(&bar[XB_XSUB(b.x)], 1u);
        const unsigned gen = old / nloc;
        if (old + 1u == (gen + 1u) * nloc) {
            __builtin_amdgcn_fence(__ATOMIC_RELEASE, "agent");
            asm volatile("s_waitcnt vmcnt(0)" ::: "memory");
            const unsigned og = xb_add(&bar[XB_TOP], 1u);
            const unsigned tg = og / nx;
            if (og + 1u == (tg + 1u) * nx) xb_add(&bar[XB_TOPGEN], 1u);
            else XB_SPIN(xb_ld(&bar[XB_TOPGEN]) == tg, bar);
            __builtin_amdgcn_fence(__ATOMIC_ACQUIRE, "agent");
            xb_add(&bar[XB_XGEN(b.x)], 1u);
            asm volatile("s_waitcnt vmcnt(0)" ::: "memory");
        } else {
            XB_SPIN(xb_ld(&bar[XB_XGEN(b.x)]) == gen, bar);
            __builtin_amdgcn_fence(__ATOMIC_ACQUIRE, "agent");
            asm volatile("s_waitcnt vmcnt(0)" ::: "memory");
        }
    }
    __syncthreads();
}

#define CNT_ADA  3600
#define CNT_MLA  3664
#define CNT_SCAN 3728
__device__ __forceinline__ void wg_signal(unsigned* ctl, int word) {
    asm volatile("s_waitcnt vmcnt(0)" ::: "memory");
    __syncthreads();
    if (threadIdx.x == 0) {
        __builtin_amdgcn_fence(__ATOMIC_RELEASE, "agent");
        asm volatile("s_waitcnt vmcnt(0)" ::: "memory");
        (void)xb_add(&ctl[word], 1u);
    }
}
__device__ __forceinline__ void wg_wait(unsigned* ctl, int word, unsigned need) {
    if (threadIdx.x == 0) {
        XB_SPIN(xb_ld(&ctl[word]) < need, ctl);
        __builtin_amdgcn_fence(__ATOMIC_ACQUIRE, "agent");
        asm volatile("s_waitcnt vmcnt(0)" ::: "memory");
    }
    __syncthreads();
}

namespace pg8 {
constexpr int BM = 256, BK = 64, HALF = 128, HTB = HALF * BK * 2, STAGE_BYTES = 8 * HTB, NXCD = 8, WGM = 8;
__host__ __device__ __forceinline__ int lds_byte(int r, int c) { const int st = (r >> 4) * 2 + (c >> 5), rr = r & 15, cc = c & 31, ob = rr * 64 + cc * 2; return st * 1024 + (ob ^ (((ob >> 9) & 1) << 5)); }
__host__ __device__ __forceinline__ void stage_rc(int b, int& R, int& C) { const int st = b / 1024, sb = b % 1024, swz = sb ^ (((sb >> 9) & 1) << 5); R = (st >> 1) * 16 + swz / 64; C = (st & 1) * 32 + (swz % 64) / 2; }
__host__ __device__ __forceinline__ int perm32(int rho) { const int n = rho >> 4, i = rho & 15; return 8 * (i >> 2) + 4 * n + (i & 3); }
struct Unit { int pm, pn; };
struct Gemm { const bf16_t* A; const bf16_t* Bt; int M, N, K; };
struct StaticOrder {
    int nM, nN, nwg, G, c;
    __host__ __device__ void init(int M, int N, int G_, int c_) { nM = M / BM; nN = N / BM; nwg = nM * nN; G = G_; c = c_; }
    __host__ __device__ bool next(int i, Unit& u) const {
        const long L = (long)i * G + c; if (L >= nwg) return false;
        int wgid = (int)L; { const int q = nwg / NXCD, r = nwg % NXCD, xcd = wgid % NXCD, off = wgid / NXCD; wgid = (xcd < r ? xcd * (q + 1) : r * (q + 1) + (xcd - r) * q) + off; }
        const int nig = WGM * nN, gid = wgid / nig, fm = gid * WGM, gsz = (nM - fm) < WGM ? (nM - fm) : WGM;
        u.pm = fm + ((wgid % nig) % gsz); u.pn = (wgid % nig) / gsz; return true;
    }
    __device__ __forceinline__ void a_ready(const Unit&) const {}
    __device__ __forceinline__ void done(const Unit&) const {}
};
__device__ __forceinline__ unsigned cvt_pk_bf16(float lo, float hi) { unsigned r; asm volatile("v_cvt_pk_bf16_f32 %0, %1, %2" : "=v"(r) : "v"(lo), "v"(hi)); return r; }

template <class Epi, class Sched>
__device__ __forceinline__ void gemm_phase(LAS unsigned char* lds, const Gemm g, const Sched& S, const Epi& E) {
    const int tid = threadIdx.x, wid = __builtin_amdgcn_readfirstlane(tid >> 6), lane = tid & 63, wr = wid >> 2, wc = wid & 3, fr = lane & 15, fq = lane >> 4;
    const int K = g.K, nt = K / BK;
    unsigned voffA[2], voffB[2];
#pragma unroll
    for (int i = 0; i < 2; ++i) { int R, C; stage_rc(tid * 16 + i * 8192, R, C); const int Rb = Epi::PERM ? ((R & ~31) + perm32(R & 31)) : R;
        voffA[i] = (unsigned)(R * K + C) * 2u; voffB[i] = (unsigned)(Rb * K + C) * 2u; }
    const size_t kstep = (size_t)(BK * 2);
    const size_t hstep = (size_t)HALF * K * 2;
    const size_t tstep = 2 * hstep;
    const unsigned ldsw = (unsigned)wid * 1024u;
    const int aoff = lds_byte(wr * 64 + fr, fq * 8), boff = lds_byte(wc * 32 + fr, fq * 8);
#define PG8_SA(b, h) (((b) * 2 + (h)) * HTB)
#define PG8_SB(b, h) ((4 + (b) * 2 + (h)) * HTB)
#define PG8_STAGE(bufoff, gbase, voff) do { _Pragma("unroll") for (int _i = 0; _i < 2; ++_i) \
        __builtin_amdgcn_global_load_lds((const unsigned*)((const char*)(gbase) + (voff)[_i]), (LAS unsigned*)(lds + (bufoff) + ldsw + _i * 8192), 16, 0, 0); } while (0)
#define PG8_LDA(dst, b, h) do { _Pragma("unroll") for (int m = 0; m < 4; ++m) _Pragma("unroll") for (int k = 0; k < 2; ++k) dst[m][k] = *(const LAS bf16x8*)(lds + PG8_SA(b, h) + aoff + m * 2048 + k * 1024); } while (0)
#define PG8_LDB(dst, b, h) do { _Pragma("unroll") for (int n = 0; n < 2; ++n) _Pragma("unroll") for (int k = 0; k < 2; ++k) dst[n][k] = *(const LAS bf16x8*)(lds + PG8_SB(b, h) + boff + n * 2048 + k * 1024); } while (0)
#define PG8_MMA(ai, bj, At, Bt) do { __builtin_amdgcn_s_setprio(1); _Pragma("unroll") for (int m = 0; m < 4; ++m) _Pragma("unroll") for (int n = 0; n < 2; ++n) _Pragma("unroll") for (int k = 0; k < 2; ++k) \
        acc[ai][bj][m][n] = __builtin_amdgcn_mfma_f32_16x16x32_bf16(Bt[n][k], At[m][k], acc[ai][bj][m][n], 0, 0, 0); __builtin_amdgcn_s_setprio(0); } while (0)
#define PG8_WAIT_V(n) asm volatile("s_waitcnt vmcnt(" #n ")" ::: "memory")
#define PG8_WAIT_L(n) asm volatile("s_waitcnt lgkmcnt(" #n ")" ::: "memory")
#define PG8_BAR __builtin_amdgcn_s_barrier()
#define PG8_SCHED __builtin_amdgcn_sched_barrier(0)
    Unit cur, nxt; int ui = 0;
    if (!S.next(0, cur)) return;
    f32x4 acc[2][2][4][2];
#pragma unroll
    for (int a = 0; a < 2; ++a)
#pragma unroll
        for (int b = 0; b < 2; ++b)
#pragma unroll
            for (int m = 0; m < 4; ++m)
#pragma unroll
                for (int n = 0; n < 2; ++n) acc[a][b][m][n] = (f32x4){0.f, 0.f, 0.f, 0.f};
    bf16x8 At[4][2], B0[2][2], B1[2][2];
    const char* cA = (const char*)g.A + (size_t)cur.pm * tstep; const char* cB = (const char*)g.Bt + (size_t)cur.pn * tstep;
    S.a_ready(cur);
    PG8_STAGE(PG8_SB(0, 0), cB, voffB); PG8_STAGE(PG8_SA(0, 0), cA, voffA); PG8_STAGE(PG8_SB(0, 1), cB + hstep, voffB); PG8_STAGE(PG8_SA(0, 1), cA + hstep, voffA);
    if (wr == 1) PG8_BAR;
    PG8_WAIT_V(4); PG8_BAR;
    PG8_STAGE(PG8_SB(1, 0), cB + kstep, voffB); PG8_STAGE(PG8_SA(1, 0), cA + kstep, voffA); PG8_STAGE(PG8_SB(1, 1), cB + hstep + kstep, voffB);
    PG8_WAIT_V(6); PG8_BAR;
    for (;;) {
        const bool has_next = S.next(ui + 1, nxt);
        const char* nA = has_next ? (const char*)g.A + (size_t)nxt.pm * tstep : cA; const char* nB = has_next ? (const char*)g.Bt + (size_t)nxt.pn * tstep : cB;
        for (int t = 0; t < nt; t += 2) {
            const bool last = (t == nt - 2);
            const char* a1 = cA + (size_t)(t + 1) * kstep;
            const char* a2 = last ? nA : cA + (size_t)(t + 2) * kstep; const char* b2 = last ? nB : cB + (size_t)(t + 2) * kstep;
            const char* a3 = a2 + kstep; const char* b3 = b2 + kstep;
            if (last && has_next) S.a_ready(nxt);
            PG8_LDB(B0, 0, 0); PG8_SCHED; PG8_LDA(At, 0, 0); PG8_STAGE(PG8_SA(1, 1), a1 + hstep, voffA);
            PG8_WAIT_L(8); PG8_BAR; PG8_WAIT_L(0); PG8_MMA(0, 0, At, B0); PG8_BAR; PG8_SCHED;
            PG8_LDB(B1, 0, 1); PG8_STAGE(PG8_SB(0, 0), b2, voffB);
            PG8_BAR; PG8_WAIT_L(0); PG8_MMA(0, 1, At, B1); PG8_BAR;
            PG8_LDA(At, 0, 1); PG8_STAGE(PG8_SA(0, 0), a2, voffA);
            PG8_BAR; PG8_WAIT_L(0); PG8_MMA(1, 0, At, B0); PG8_BAR; PG8_SCHED;
            PG8_STAGE(PG8_SB(0, 1), b2 + hstep, voffB);
            PG8_WAIT_V(6); PG8_BAR; PG8_MMA(1, 1, At, B1); PG8_BAR;
            PG8_LDB(B0, 1, 0); PG8_SCHED; PG8_LDA(At, 1, 0); PG8_STAGE(PG8_SA(0, 1), a2 + hstep, voffA);
            PG8_WAIT_L(8); PG8_BAR; PG8_WAIT_L(0); PG8_MMA(0, 0, At, B0); PG8_BAR; PG8_SCHED;
            PG8_LDB(B1, 1, 1); PG8_STAGE(PG8_SB(1, 0), b3, voffB);
            PG8_BAR; PG8_WAIT_L(0); PG8_MMA(0, 1, At, B1); PG8_BAR;
            PG8_LDA(At, 1, 1); PG8_STAGE(PG8_SA(1, 0), a3, voffA);
            PG8_BAR; PG8_WAIT_L(0); PG8_MMA(1, 0, At, B0); PG8_BAR; PG8_SCHED;
            PG8_STAGE(PG8_SB(1, 1), b3 + hstep, voffB);
            PG8_WAIT_V(6); PG8_BAR; PG8_MMA(1, 1, At, B1); PG8_BAR;
        }
        E(acc, cur, wr, wc, fr, fq); S.done(cur);
        if (!has_next) break;
#pragma unroll
        for (int a = 0; a < 2; ++a)
#pragma unroll
            for (int b = 0; b < 2; ++b)
#pragma unroll
                for (int m = 0; m < 4; ++m)
#pragma unroll
                    for (int n = 0; n < 2; ++n) acc[a][b][m][n] = (f32x4){0.f, 0.f, 0.f, 0.f};
        cur = nxt; cA = nA; cB = nB; ++ui;
    }
    PG8_WAIT_V(0);
    if (wr == 0) PG8_BAR;
    PG8_BAR;
#undef PG8_SA
#undef PG8_SB
#undef PG8_STAGE
#undef PG8_LDA
#undef PG8_LDB
#undef PG8_MMA
#undef PG8_WAIT_V
#undef PG8_WAIT_L
#undef PG8_BAR
#undef PG8_SCHED
}
}

struct EpiInMain {
    static constexpr bool PERM = true;
    unsigned char* ws; const float* bias;
    __device__ __forceinline__ void operator()(const f32x4 (&acc)[2][2][4][2], const pg8::Unit& u, int wr, int wc, int fr, int fq) const {
        const int row0 = u.pm * 256 + wr * 64 + fr;
        const int cl0 = wc * 32 + 8 * fq;
        bf16_t* base = (bf16_t*)(ws + OFF_MQ + (size_t)(u.pn >> 1) * (16 * MiB)) + (u.pn & 1) * 256 + cl0;
        const float* bp = bias + u.pn * 256 + cl0;
#pragma unroll
        for (int bj = 0; bj < 2; ++bj) {
            const f32x4 b0 = *(const f32x4*)(bp + bj * 128), b1 = *(const f32x4*)(bp + bj * 128 + 4);
#pragma unroll
            for (int ai = 0; ai < 2; ++ai)
#pragma unroll
                for (int m = 0; m < 4; ++m) {
                    const f32x4 v0 = acc[ai][bj][m][0] + b0, v1 = acc[ai][bj][m][1] + b1;
                    u32x4 o; o[0] = pg8::cvt_pk_bf16(v0[0], v0[1]); o[1] = pg8::cvt_pk_bf16(v0[2], v0[3]); o[2] = pg8::cvt_pk_bf16(v1[0], v1[1]); o[3] = pg8::cvt_pk_bf16(v1[2], v1[3]);
                    *(u32x4*)(base + (size_t)(row0 + ai * 128 + m * 16) * 512 + bj * 128) = o;
                }
        }
    }
};
struct EpiInTail {
    static constexpr bool PERM = true;
    unsigned char* ws; const float* bias;
    __device__ __forceinline__ void operator()(const f32x4 (&acc)[2][2][4][2], const pg8::Unit& u, int wr, int wc, int fr, int fq) const {
        const int row0 = u.pm * 256 + wr * 64 + fr;
        const int cl0 = wc * 32 + 8 * fq;
#pragma unroll
        for (int bj = 0; bj < 2; ++bj) {
            const int cl = bj * 128 + cl0;
            if (cl >= 208) continue;
            const f32x4 b0 = *(const f32x4*)(bias + cl), b1 = *(const f32x4*)(bias + cl + 4);
            if (cl < 192) {
                bf16_t* dst = (bf16_t*)(ws + OFF_AK + (size_t)(cl >> 6) * (2 * MiB)) + (cl & 63);
#pragma unroll
                for (int ai = 0; ai < 2; ++ai)
#pragma unroll
                    for (int m = 0; m < 4; ++m) {
                        const f32x4 v0 = acc[ai][bj][m][0] + b0, v1 = acc[ai][bj][m][1] + b1;
                        u32x4 o; o[0] = pg8::cvt_pk_bf16(v0[0], v0[1]); o[1] = pg8::cvt_pk_bf16(v0[2], v0[3]); o[2] = pg8::cvt_pk_bf16(v1[0], v1[1]); o[3] = pg8::cvt_pk_bf16(v1[2], v1[3]);
                        *(u32x4*)(dst + (size_t)(row0 + ai * 128 + m * 16) * 64) = o;
                    }
            } else {
                float* dst = (float*)(ws + OFF_GATE) + (cl - 192);
#pragma unroll
                for (int ai = 0; ai < 2; ++ai)
#pragma unroll
                    for (int m = 0; m < 4; ++m) {
                        float* d = dst + (size_t)(row0 + ai * 128 + m * 16) * 16;
                        *(f32x4*)d = acc[ai][bj][m][0] + b0; *(f32x4*)(d + 4) = acc[ai][bj][m][1] + b1;
                    }
            }
        }
    }
};
struct EpiOut {
    static constexpr bool PERM = false;
    const float* x; const float* ada; float* out;
    __device__ __forceinline__ void operator()(const f32x4 (&acc)[2][2][4][2], const pg8::Unit& u, int wr, int wc, int fr, int fq) const {
        const int row0 = u.pm * 256 + wr * 64 + fr, col0 = u.pn * 256 + wc * 32 + 4 * fq;
        const int b = (u.pm * 256) >> 12;
        f32x4 gv[2][2];
#pragma unroll
        for (int bj = 0; bj < 2; ++bj)
#pragma unroll
            for (int n = 0; n < 2; ++n) gv[bj][n] = *(const f32x4*)(ada + b * 6144 + 2048 + col0 + bj * 128 + n * 16);
#pragma unroll
        for (int ai = 0; ai < 2; ++ai)
#pragma unroll
            for (int m = 0; m < 4; ++m) {
                const size_t ro = (size_t)(row0 + ai * 128 + m * 16) * 1024 + col0;
#pragma unroll
                for (int bj = 0; bj < 2; ++bj)
#pragma unroll
                    for (int n = 0; n < 2; ++n) {
                        const f32x4 xv = *(const f32x4*)(x + ro + bj * 128 + n * 16);
                        *(f32x4*)(out + ro + bj * 128 + n * 16) = xv + gv[bj][n] * acc[ai][bj][m][n];
                    }
            }
    }
};
struct EpiQry {
    static constexpr bool PERM = true;
    bf16_t* O;
    __device__ __forceinline__ void operator()(const f32x4 (&acc)[2][2][4][2], const pg8::Unit& u, int wr, int wc, int fr, int fq) const {
        const int row0 = u.pm * 256 + wr * 64 + fr, col0 = u.pn * 256 + wc * 32 + 8 * fq;
#pragma unroll
        for (int ai = 0; ai < 2; ++ai)
#pragma unroll
            for (int m = 0; m < 4; ++m) {
                bf16_t* rowp = O + (size_t)(row0 + ai * 128 + m * 16) * 1024 + col0;
#pragma unroll
                for (int bj = 0; bj < 2; ++bj) {
                    const f32x4 v0 = acc[ai][bj][m][0], v1 = acc[ai][bj][m][1];
                    u32x4 o; o[0] = pg8::cvt_pk_bf16(v0[0], v0[1]); o[1] = pg8::cvt_pk_bf16(v0[2], v0[3]); o[2] = pg8::cvt_pk_bf16(v1[0], v1[1]); o[3] = pg8::cvt_pk_bf16(v1[2], v1[3]);
                    *(u32x4*)(rowp + bj * 128) = o;
                }
            }
    }
};

__device__ __forceinline__ int inperm_src(int n) {
    if (n < 2048) return n;
    if (n < 2560) return 2056 + (n - 2048);
    if (n < 3072) return 2696 + (n - 2560);
    if (n < 3136) return 2568 + (n - 3072);
    if (n < 3200) return 2632 + (n - 3136);
    if (n < 3264) return 3208 + (n - 3200);
    if (n < 3268) return 2048 + (n - 3264);
    if (n < 3272) return 2052 + (n - 3268);
    if (n < 3280) return 3272 + (n - 3272);
    return -1;
}
template <bool PERMUTE>
__device__ __forceinline__ void transpose_tile(const float* src, int ld, bf16_t* dst, int n0, int k0, LAS float* t) {
    const int tid = threadIdx.x;
    for (int i = tid; i < 4096; i += NTHREADS) {
        const int kk = i >> 6, nn = i & 63;
        const int sc = PERMUTE ? inperm_src(n0 + nn) : (n0 + nn);
        t[kk * 65 + nn] = sc >= 0 ? src[(size_t)(k0 + kk) * ld + sc] : 0.f;
    }
    __syncthreads();
    for (int i = tid; i < 2048; i += NTHREADS) {
        const int nn = i >> 5, kp = (i & 31) * 2;
        ((unsigned*)dst)[((size_t)(n0 + nn) * 1024 + k0 + kp) >> 1] = pack2(t[kp * 65 + nn], t[(kp + 1) * 65 + nn]);
    }
    __syncthreads();
}
__device__ __forceinline__ void convert_chunk(const float* src, bf16_t* dst, size_t e0, int n) {
    for (int i = threadIdx.x * 8; i < n; i += NTHREADS * 8) {
        const f32x4 a = *(const f32x4*)(src + e0 + i), b = *(const f32x4*)(src + e0 + i + 4);
        u32x4 o; o[0] = pack2(a[0], a[1]); o[1] = pack2(a[2], a[3]); o[2] = pack2(b[0], b[1]); o[3] = pack2(b[2], b[3]);
        *(u32x4*)(dst + e0 + i) = o;
    }
}
__device__ __forceinline__ unsigned pack4_fp8(float a, float b, float c, float d) {
    a = fminf(fmaxf(a, -448.f), 448.f); b = fminf(fmaxf(b, -448.f), 448.f); c = fminf(fmaxf(c, -448.f), 448.f); d = fminf(fmaxf(d, -448.f), 448.f);
    int w = 0;
    w = __builtin_amdgcn_cvt_pk_fp8_f32(a, b, w, false);
    w = __builtin_amdgcn_cvt_pk_fp8_f32(c, d, w, true);
    return (unsigned)w;
}
__device__ __forceinline__ void convert_chunk_fp8(const float* src, unsigned char* dst, size_t e0, int n, float scale) {
    for (int i = threadIdx.x * 16; i < n; i += NTHREADS * 16) {
        const f32x4 a = *(const f32x4*)(src + e0 + i), b = *(const f32x4*)(src + e0 + i + 4), c = *(const f32x4*)(src + e0 + i + 8), d = *(const f32x4*)(src + e0 + i + 12);
        u32x4 o; o[0] = pack4_fp8(a[0] * scale, a[1] * scale, a[2] * scale, a[3] * scale); o[1] = pack4_fp8(b[0] * scale, b[1] * scale, b[2] * scale, b[3] * scale);
        o[2] = pack4_fp8(c[0] * scale, c[1] * scale, c[2] * scale, c[3] * scale); o[3] = pack4_fp8(d[0] * scale, d[1] * scale, d[2] * scale, d[3] * scale);
        *(u32x4*)(dst + e0 + i) = o;
    }
}
__device__ __forceinline__ unsigned pack8_fp4(const f32x4 a, const f32x4 b, float scale) {
    float v[8] = {a[0] * scale, a[1] * scale, a[2] * scale, a[3] * scale, b[0] * scale, b[1] * scale, b[2] * scale, b[3] * scale};
#pragma unroll
    for (int i = 0; i < 8; ++i) v[i] = fminf(fmaxf(v[i], -6.f), 6.f);
    unsigned w = 0;
    w = __builtin_amdgcn_cvt_scalef32_pk_fp4_f32(w, v[0], v[1], 1.0f, 0);
    w = __builtin_amdgcn_cvt_scalef32_pk_fp4_f32(w, v[2], v[3], 1.0f, 1);
    w = __builtin_amdgcn_cvt_scalef32_pk_fp4_f32(w, v[4], v[5], 1.0f, 2);
    w = __builtin_amdgcn_cvt_scalef32_pk_fp4_f32(w, v[6], v[7], 1.0f, 3);
    return w;
}
__device__ __forceinline__ void convert_chunk_fp4(const float* src, unsigned char* dst, size_t e0, int n, float scale) {
    for (int i = threadIdx.x * 32; i < n; i += NTHREADS * 32) {
        u32x4 o;
#pragma unroll
        for (int k = 0; k < 4; ++k) o[k] = pack8_fp4(*(const f32x4*)(src + e0 + i + 8 * k), *(const f32x4*)(src + e0 + i + 8 * k + 4), scale);
        *(u32x4*)(dst + ((e0 + i) >> 1)) = o;
    }
}
__device__ __forceinline__ unsigned pack4_i8(float a, float b, float c, float d, float scale) {
    const int ia = (int)fminf(fmaxf(rintf(a * scale), -127.f), 127.f), ib = (int)fminf(fmaxf(rintf(b * scale), -127.f), 127.f);
    const int ic = (int)fminf(fmaxf(rintf(c * scale), -127.f), 127.f), id = (int)fminf(fmaxf(rintf(d * scale), -127.f), 127.f);
    return (unsigned)(ia & 0xFF) | ((unsigned)(ib & 0xFF) << 8) | ((unsigned)(ic & 0xFF) << 16) | ((unsigned)(id & 0xFF) << 24);
}
__device__ __forceinline__ void convert_chunk_i8(const float* src, unsigned char* dst, size_t e0, int n, float scale) {
    for (int i = threadIdx.x * 16; i < n; i += NTHREADS * 16) {
        const f32x4 a = *(const f32x4*)(src + e0 + i), b = *(const f32x4*)(src + e0 + i + 4), c = *(const f32x4*)(src + e0 + i + 8), d = *(const f32x4*)(src + e0 + i + 12);
        u32x4 o; o[0] = pack4_i8(a[0], a[1], a[2], a[3], scale); o[1] = pack4_i8(b[0], b[1], b[2], b[3], scale); o[2] = pack4_i8(c[0], c[1], c[2], c[3], scale); o[3] = pack4_i8(d[0], d[1], d[2], d[3], scale);
        *(u32x4*)(dst + e0 + i) = o;
    }
}
__device__ __forceinline__ unsigned pack8_i4(const f32x4 a, const f32x4 b, float scale) {
    unsigned w = 0;
#pragma unroll
    for (int k = 0; k < 4; ++k) {
        const int qa = (int)fminf(fmaxf(rintf(a[k] * scale), -7.f), 7.f) + 8, qb = (int)fminf(fmaxf(rintf(b[k] * scale), -7.f), 7.f) + 8;
        w |= (unsigned)qa << (4 * k); w |= (unsigned)qb << (4 * (k + 4));
    }
    return w;
}
__device__ __forceinline__ void convert_chunk_i4(const float* src, unsigned char* dst, size_t e0, int n, float scale) {
    for (int i = threadIdx.x * 32; i < n; i += NTHREADS * 32) {
        u32x4 o;
#pragma unroll
        for (int k = 0; k < 4; ++k) o[k] = pack8_i4(*(const f32x4*)(src + e0 + i + 8 * k), *(const f32x4*)(src + e0 + i + 8 * k + 4), scale);
        *(u32x4*)(dst + ((e0 + i) >> 1)) = o;
    }
}
__device__ __forceinline__ void convert_tables(const Params& p, int first, int stride) {
    for (int it = first; it < 1024; it += stride) {
        const int tsel = it >> 9; const size_t e0 = (size_t)(it & 511) * 32768;
        if (tsel) convert_chunk_i4(p.peer_v, p.ws + OFF_VT, e0, 32768, PEER_SV); else convert_chunk_i8(p.peer_u, p.ws + OFF_UT, e0, 32768, PEER_SU);
    }
}
__device__ __forceinline__ void phase0(const Params& p, LAS unsigned char* lds) {
    const int tid = threadIdx.x;
    float* ada = (float*)(p.ws + OFF_ADA);
    LAS float* lf = (LAS float*)lds;
    constexpr int N_ADA = 192, N_WIN = 52 * 16, N_WOUT = 256, N_WPQ = 256, N_SK = 4, N_BIAS = 1;
    constexpr int NITEMS = N_ADA + N_WIN + N_WOUT + N_WPQ + N_SK + N_BIAS;
    if (blockIdx.x < N_ADA) {
        {
            const int it = blockIdx.x;
            LAS float* sc = lf; LAS float* red = lf + 4096;
            for (int i = tid; i < 4096; i += NTHREADS) sc[i] = siluf(p.c[i]);
            __syncthreads();
            const int col = tid & 31, kg = tid >> 5, c0 = it * 32;
            float a0 = 0.f, a1 = 0.f, a2 = 0.f, a3 = 0.f;
            const float* w = p.w_ada + c0 + col;
#pragma unroll 8
            for (int j = 0; j < 64; ++j) { const int k = kg + 16 * j; const float wv = w[(size_t)k * 6144];
                a0 += sc[k] * wv; a1 += sc[1024 + k] * wv; a2 += sc[2048 + k] * wv; a3 += sc[3072 + k] * wv; }
            red[(kg * 4 + 0) * 32 + col] = a0; red[(kg * 4 + 1) * 32 + col] = a1; red[(kg * 4 + 2) * 32 + col] = a2; red[(kg * 4 + 3) * 32 + col] = a3;
            __syncthreads();
            if (tid < 128) { const int b = tid >> 5, cc = tid & 31; float s = 0.f;
                for (int g = 0; g < 16; ++g) s += red[(g * 4 + b) * 32 + cc];
                ada[b * 6144 + c0 + cc] = s + p.b_ada[c0 + cc]; }
        }
        wg_signal((unsigned*)(p.ws + OFF_CTL), CNT_ADA);
        __syncthreads();
    }
    for (int item = N_ADA + ((blockIdx.x + gridDim.x - N_ADA) % gridDim.x); item < NITEMS; item += gridDim.x) {
        int it = item;
        it -= N_ADA;
        if (it < N_WIN) { transpose_tile<true>(p.w_in, 3280, (bf16_t*)(p.ws + OFF_WIN), (it >> 4) * 64, (it & 15) * 64, lf); continue; }
        it -= N_WIN;
        if (it < N_WOUT) { transpose_tile<false>(p.w_out, 1024, (bf16_t*)(p.ws + OFF_WOUT), (it >> 4) * 64, (it & 15) * 64, lf); continue; }
        it -= N_WOUT;
        if (it < N_WPQ) { transpose_tile<false>(p.w_peer_q, 1024, (bf16_t*)(p.ws + OFF_WPQ), (it >> 4) * 64, (it & 15) * 64, lf); continue; }
        it -= N_WPQ;

        if (it < N_SK) { convert_chunk(p.sub_keys, (bf16_t*)(p.ws + OFF_SK), (size_t)it * 32768, 32768); continue; }
        it -= N_SK;
        { float* bias = (float*)(p.ws + OFF_BIAS);
          for (int n = tid; n < NIN_PAD; n += NTHREADS) { const int s = inperm_src(n); bias[n] = s >= 0 ? p.b_in[s] : 0.f; } }
    }
}

__device__ __forceinline__ void norm_mod_rows(const float* X, const float* g, const float* ada, int sh_off, int sc_off, bf16_t* out) {
    const int wid = threadIdx.x >> 6, lane = threadIdx.x & 63;
    for (int row = (blockIdx.x * 8 + wid) * 2; row < NTOK; row += gridDim.x * 16) {
        const int b = row >> 12;
        f32x4 v[2][4]; float ss[2] = {0.f, 0.f};
#pragma unroll
        for (int rr = 0; rr < 2; ++rr)
#pragma unroll
            for (int j = 0; j < 4; ++j) v[rr][j] = *(const f32x4*)(X + (size_t)(row + rr) * 1024 + 4 * (lane + 64 * j));
#pragma unroll
        for (int rr = 0; rr < 2; ++rr)
#pragma unroll
            for (int j = 0; j < 4; ++j) ss[rr] += v[rr][j][0] * v[rr][j][0] + v[rr][j][1] * v[rr][j][1] + v[rr][j][2] * v[rr][j][2] + v[rr][j][3] * v[rr][j][3];
        ss[0] = wave_sum(ss[0]); ss[1] = wave_sum(ss[1]);
        const float rstd0 = rsqrtf(ss[0] * (1.f / 1024.f) + 1e-6f), rstd1 = rsqrtf(ss[1] * (1.f / 1024.f) + 1e-6f);
#pragma unroll
        for (int j = 0; j < 4; ++j) {
            const int c = 4 * (lane + 64 * j);
            const f32x4 gg = *(const f32x4*)(g + c), sc = *(const f32x4*)(ada + b * 6144 + sc_off + c), sh = *(const f32x4*)(ada + b * 6144 + sh_off + c);
#pragma unroll
            for (int rr = 0; rr < 2; ++rr) {
                const float rstd = rr ? rstd1 : rstd0;
                float h[4];
#pragma unroll
                for (int i = 0; i < 4; ++i) h[i] = (v[rr][j][i] * rstd * gg[i]) * (1.f + sc[i]) + sh[i];
                u32x2 o; o[0] = pack2(h[0], h[1]); o[1] = pack2(h[2], h[3]);
                *(u32x2*)(out + (size_t)(row + rr) * 1024 + c) = o;
            }
        }
    }
}

__device__ __forceinline__ bf16x8 lds_frag(const LAS bf16_t* base, int row, int stride, int kofs) { return *(const LAS bf16x8*)(base + row * stride + kofs); }

__device__ __forceinline__ void conv_silu8(const bf16_t* src, const float* cw  , int row, int tpos, int col, float scale, float (&o)[8]) {
    float acc[8];
#pragma unroll
    for (int i = 0; i < 8; ++i) acc[i] = 0.f;
#pragma unroll
    for (int j = 0; j < 4; ++j) {
        const int tt = tpos - 3 + j;
        if (tt >= 0) {
            const u32x4 xv = *(const u32x4*)(src + (size_t)(row - 3 + j) * 512 + col);
            const f32x4 w0 = *(const f32x4*)(cw + j * 1024), w1 = *(const f32x4*)(cw + j * 1024 + 4);
            acc[0] += w0[0] * lo16(xv[0]); acc[1] += w0[1] * hi16(xv[0]); acc[2] += w0[2] * lo16(xv[1]); acc[3] += w0[3] * hi16(xv[1]);
            acc[4] += w1[0] * lo16(xv[2]); acc[5] += w1[1] * hi16(xv[2]); acc[6] += w1[2] * lo16(xv[3]); acc[7] += w1[3] * hi16(xv[3]);
        }
    }
#pragma unroll
    for (int i = 0; i < 8; ++i) o[i] = siluf(acc[i]) * scale;
}

__device__ __forceinline__ void mlstm_passA(const Params& p, int task, LAS unsigned char* lds) {
    const int tid = opaque_tid(), wid = tid >> 6, lane = tid & 63;
    const int bh = task >> 6, c = task & 63, b = bh >> 2, h = bh & 3;
    const int row0 = b * SEQ + c * 64;
    const float* gates = (const float*)(p.ws + OFF_GATE);
    const bf16_t* MK = (const bf16_t*)(p.ws + OFF_MK); const bf16_t* MV = (const bf16_t*)(p.ws + OFF_MV);
    LAS bf16_t* KT = (LAS bf16_t*)lds;
    LAS bf16_t* VT = KT + 128 * 72;
    LAS float* sc = (LAS float*)(VT + 128 * 72);
    LAS float* lsg = sc; LAS float* ig = sc + 64; LAS float* wloc = sc + 128; LAS float* misc = sc + 192;
    if (tid < 64) {
        const float f = gates[(size_t)(row0 + tid) * 16 + 4 + h], iv = gates[(size_t)(row0 + tid) * 16 + h];
        const float bc = wave_scan_add(logsigmoidf_(f), lane);
        const float bl = __shfl(bc, 63);
        const float a = bl - bc + iv;
        const float m = wave_max(a);
        lsg[tid] = bc; ig[tid] = iv; wloc[tid] = __expf(a - m);
        if (tid == 0) { misc[0] = m; misc[1] = bl; }
    }
    __syncthreads();
    for (int pc = tid; pc < 1024; pc += NTHREADS) {
        const int s = pc >> 4, dg = pc & 15;
        float kk[8];
        conv_silu8(MK, p.conv_qk + 512 + h * 128 + dg * 8, row0 + s, c * 64 + s, h * 128 + dg * 8, 1.f, kk);
#pragma unroll
        for (int i = 0; i < 8; ++i) KT[(dg * 8 + i) * 72 + s] = f2bf(kk[i]);
        const u32x4 vv = *(const u32x4*)(MV + (size_t)(row0 + s) * 512 + h * 128 + dg * 8);
        const float w = wloc[s];
#pragma unroll
        for (int i = 0; i < 4; ++i) { VT[(dg * 8 + 2 * i) * 72 + s] = f2bf(lo16(vv[i]) * w); VT[(dg * 8 + 2 * i + 1) * 72 + s] = f2bf(hi16(vv[i]) * w); }
    }
    __syncthreads();
    {
        const int r = lane & 15, g = lane >> 4;
        bf16x8 a0 = lds_frag(VT, wid * 16 + r, 72, 8 * g), a1 = lds_frag(VT, wid * 16 + r, 72, 8 * g + 32);
        bf16_t* KV = (bf16_t*)(p.ws + OFF_KV) + (size_t)task * 16384;
#pragma unroll
        for (int dt = 0; dt < 8; ++dt) {
            f32x4 acc = {0.f, 0.f, 0.f, 0.f};
            acc = __builtin_amdgcn_mfma_f32_16x16x32_bf16(a0, lds_frag(KT, dt * 16 + r, 72, 8 * g), acc, 0, 0, 0);
            acc = __builtin_amdgcn_mfma_f32_16x16x32_bf16(a1, lds_frag(KT, dt * 16 + r, 72, 8 * g + 32), acc, 0, 0, 0);
#pragma unroll
            for (int j = 0; j < 4; ++j) KV[(wid * 16 + 4 * g + j) * 128 + dt * 16 + r] = f2bf(acc[j]);
        }
    }
    if (tid < 128) {
        float s = 0.f;
        for (int i = 0; i < 64; ++i) s += wloc[i] * bf2f(KT[tid * 72 + i]);
        ((float*)(p.ws + OFF_KS))[(size_t)task * 128 + tid] = s;
    }
    if (tid == 0) { ((float*)(p.ws + OFF_MLOC))[task] = misc[0]; ((float*)(p.ws + OFF_BLAST))[task] = misc[1]; }
    __syncthreads();
}

__device__ __forceinline__ void mlstm_scan(const Params& p, int item, LAS unsigned char* lds) {
    const int tid = opaque_tid();
    const int bh = item >> 4, blk = item & 15;
    LAS float* dec = (LAS float*)lds; LAS float* inj = dec + 64;
    if (tid == 0) {
        const float* ML = (const float*)(p.ws + OFF_MLOC); const float* BL = (const float*)(p.ws + OFF_BLAST); float* M0 = (float*)(p.ws + OFF_M0);
        float m = 0.f;
        for (int c = 0; c < 64; ++c) {
            const float ml = ML[bh * 64 + c], bl = BL[bh * 64 + c];
            if (blk == 0) M0[bh * 64 + c] = m;
            const float mn = fmaxf(bl + m, ml);
            dec[c] = __expf(bl + m - mn); inj[c] = __expf(ml - mn); m = mn;
        }
    }
    __syncthreads();
    unsigned* KV = (unsigned*)(p.ws + OFF_KV) + (size_t)bh * 64 * 8192 + blk * 512 + tid;
    float s0 = 0.f, s1 = 0.f;
#pragma unroll 8
    for (int c = 0; c < 64; ++c) {
        const unsigned w = KV[(size_t)c * 8192];
        KV[(size_t)c * 8192] = pack2(s0, s1);
        s0 = dec[c] * s0 + inj[c] * lo16(w); s1 = dec[c] * s1 + inj[c] * hi16(w);
    }
    if (blk == 0 && tid < 128) {
        float* KS = (float*)(p.ws + OFF_KS) + (size_t)bh * 64 * 128 + tid;
        float s = 0.f;
        for (int c = 0; c < 64; ++c) { const float k = KS[c * 128]; KS[c * 128] = s; s = dec[c] * s + inj[c] * k; }
    }
    __syncthreads();
}

__device__ __forceinline__ void mlstm_passB(const Params& p, int task, LAS unsigned char* lds) {
    const int tid = opaque_tid(), wid = tid >> 6, lane = tid & 63;
    const int bh = task >> 6, c = task & 63, b = bh >> 2, h = bh & 3;
    const int row0 = b * SEQ + c * 64;
    const float* gates = (const float*)(p.ws + OFF_GATE);
    const bf16_t* MQ = (const bf16_t*)(p.ws + OFF_MQ); const bf16_t* MK = (const bf16_t*)(p.ws + OFF_MK);
    const bf16_t* MV = (const bf16_t*)(p.ws + OFF_MV); const bf16_t* MO = (const bf16_t*)(p.ws + OFF_MO);
    LAS bf16_t* Q = (LAS bf16_t*)lds;
    LAS bf16_t* K = Q + 64 * 136;
    LAS bf16_t* VT = K + 64 * 136;
    LAS bf16_t* C0 = VT + 128 * 72;
    LAS bf16_t* P = C0 + 128 * 136;
    LAS float* sc = (LAS float*)(P + 64 * 72);
    LAS float* bcum = sc; LAS float* ig = sc + 64; LAS float* cs = sc + 128; LAS float* rb = sc + 192; LAS float* wint = sc + 256;
    LAS float* emt = sc + 320; LAS float* rinv = sc + 384; LAS float* qn = sc + 448; LAS float* n0 = sc + 512; LAS float* rowpart = sc + 640;
    LAS float* H = (LAS float*)lds;
    if (tid < 64) {
        const float f = gates[(size_t)(row0 + tid) * 16 + 4 + h], iv = gates[(size_t)(row0 + tid) * 16 + h];
        const float m0 = ((const float*)(p.ws + OFF_M0))[task];
        const float sc_ = wave_scan_add(logsigmoidf_(f), lane);
        const float cst = iv - sc_;
        const float pm = wave_scan_max(cst, lane);
        const float m_intra = sc_ + pm, m_inter = sc_ + m0, mt = fmaxf(m_inter, m_intra);
        bcum[tid] = sc_; ig[tid] = iv; cs[tid] = cst; rb[tid] = sc_ - mt; wint[tid] = __expf(m_inter - mt); emt[tid] = __expf(-mt);
    }
    if (tid >= 64 && tid < 192) n0[tid - 64] = ((const float*)(p.ws + OFF_KS))[(size_t)task * 128 + tid - 64];
    for (int pc = tid; pc < 1024; pc += NTHREADS) {
        const int s = pc >> 4, dg = pc & 15;
        float qq[8], kk[8];
        conv_silu8(MQ, p.conv_qk + h * 128 + dg * 8, row0 + s, c * 64 + s, h * 128 + dg * 8, 0.08838834764831845f, qq);
        conv_silu8(MK, p.conv_qk + 512 + h * 128 + dg * 8, row0 + s, c * 64 + s, h * 128 + dg * 8, 1.f, kk);
        u32x4 qo, ko;
#pragma unroll
        for (int i = 0; i < 4; ++i) { qo[i] = pack2(qq[2 * i], qq[2 * i + 1]); ko[i] = pack2(kk[2 * i], kk[2 * i + 1]); }
        *(LAS u32x4*)(Q + s * 136 + dg * 8) = qo; *(LAS u32x4*)(K + s * 136 + dg * 8) = ko;
        const u32x4 vv = *(const u32x4*)(MV + (size_t)(row0 + s) * 512 + h * 128 + dg * 8);
#pragma unroll
        for (int i = 0; i < 4; ++i) { VT[(dg * 8 + 2 * i) * 72 + s] = (bf16_t)(vv[i] & 0xffffu); VT[(dg * 8 + 2 * i + 1) * 72 + s] = (bf16_t)(vv[i] >> 16); }
    }
    {
        const bf16_t* KV = (const bf16_t*)(p.ws + OFF_KV) + (size_t)task * 16384;
        for (int pc = tid; pc < 2048; pc += NTHREADS) { const int e = pc >> 4, dg = pc & 15;
            *(LAS u32x4*)(C0 + e * 136 + dg * 8) = *(const u32x4*)(KV + e * 128 + dg * 8); }
    }
    __syncthreads();
    const int r = lane & 15, g = lane >> 4;
    {
        const int t = tid >> 3, part = tid & 7; float s = 0.f;
#pragma unroll
        for (int i = 0; i < 16; ++i) s += bf2f(Q[t * 136 + part * 16 + i]) * n0[part * 16 + i];
        s += __shfl_xor(s, 1); s += __shfl_xor(s, 2); s += __shfl_xor(s, 4);
        if (part == 0) qn[t] = s;
    }
    {
        const int rt = wid >> 1;
#pragma unroll
        for (int cc = 0; cc < 2; ++cc) {
            const int ct = 2 * (wid & 1) + cc;
            f32x4 acc = {0.f, 0.f, 0.f, 0.f};
#pragma unroll
            for (int ks = 0; ks < 4; ++ks)
                acc = __builtin_amdgcn_mfma_f32_16x16x32_bf16(lds_frag(Q, rt * 16 + r, 136, 8 * g + 32 * ks), lds_frag(K, ct * 16 + r, 136, 8 * g + 32 * ks), acc, 0, 0, 0);
            const int scol = ct * 16 + r; const float csv = cs[scol];
#pragma unroll
            for (int j = 0; j < 4; ++j) {
                const int t = rt * 16 + 4 * g + j;
                float pv = (scol <= t) ? acc[j] * __expf(rb[t] + csv) : 0.f;
                P[t * 72 + scol] = f2bf(pv);
                pv += __shfl_xor(pv, 1); pv += __shfl_xor(pv, 2); pv += __shfl_xor(pv, 4); pv += __shfl_xor(pv, 8);
                if (r == 0) rowpart[t * 4 + ct] = pv;
            }
        }
    }
    __syncthreads();
    if (tid < 64) {
        const float den = rowpart[tid * 4] + rowpart[tid * 4 + 1] + rowpart[tid * 4 + 2] + rowpart[tid * 4 + 3] + wint[tid] * qn[tid];
        rinv[tid] = 1.f / fmaxf(fabsf(den), emt[tid]);
    }
    f32x4 hacc[4];
    {
        const int rt = wid >> 1;
#pragma unroll
        for (int ee = 0; ee < 4; ++ee) {
            const int et = 4 * (wid & 1) + ee;
            f32x4 a1 = {0.f, 0.f, 0.f, 0.f}, a2 = {0.f, 0.f, 0.f, 0.f};
#pragma unroll
            for (int ks = 0; ks < 2; ++ks)
                a1 = __builtin_amdgcn_mfma_f32_16x16x32_bf16(lds_frag(P, rt * 16 + r, 72, 8 * g + 32 * ks), lds_frag(VT, et * 16 + r, 72, 8 * g + 32 * ks), a1, 0, 0, 0);
#pragma unroll
            for (int ks = 0; ks < 4; ++ks)
                a2 = __builtin_amdgcn_mfma_f32_16x16x32_bf16(lds_frag(Q, rt * 16 + r, 136, 8 * g + 32 * ks), lds_frag(C0, et * 16 + r, 136, 8 * g + 32 * ks), a2, 0, 0, 0);
#pragma unroll
            for (int j = 0; j < 4; ++j) { const int t = rt * 16 + 4 * g + j; hacc[ee][j] = a1[j] + wint[t] * a2[j]; }
        }
    }
    __syncthreads();
    {
        const int rt = wid >> 1;
#pragma unroll
        for (int ee = 0; ee < 4; ++ee) {
            const int et = 4 * (wid & 1) + ee;
#pragma unroll
            for (int j = 0; j < 4; ++j) { const int t = rt * 16 + 4 * g + j; H[t * 132 + et * 16 + r] = hacc[ee][j] * rinv[t]; }
        }
    }
    __syncthreads();
    {
        const int t = tid >> 3, part = tid & 7;
        float hv[16]; float ss = 0.f;
#pragma unroll
        for (int i = 0; i < 16; ++i) { hv[i] = H[t * 132 + part * 16 + i]; ss += hv[i] * hv[i]; }
        ss += __shfl_xor(ss, 1); ss += __shfl_xor(ss, 2); ss += __shfl_xor(ss, 4);
        const float rstd = rsqrtf(ss * (1.f / 128.f) + 1e-6f);
        const int col = h * 128 + part * 16;
        const u32x4 m0v = *(const u32x4*)(MO + (size_t)(row0 + t) * 512 + col), m1v = *(const u32x4*)(MO + (size_t)(row0 + t) * 512 + col + 8);
        float mo[16];
#pragma unroll
        for (int i = 0; i < 4; ++i) { mo[2 * i] = lo16(m0v[i]); mo[2 * i + 1] = hi16(m0v[i]); mo[8 + 2 * i] = lo16(m1v[i]); mo[8 + 2 * i + 1] = hi16(m1v[i]); }
        float o[16];
#pragma unroll
        for (int i = 0; i < 16; ++i) o[i] = (hv[i] * rstd * p.out_norm_m[col + i]) * sigmoidf_(mo[i]);
        u32x4 o0, o1;
#pragma unroll
        for (int i = 0; i < 4; ++i) { o0[i] = pack2(o[2 * i], o[2 * i + 1]); o1[i] = pack2(o[8 + 2 * i], o[8 + 2 * i + 1]); }
        bf16_t* dst = (bf16_t*)(p.ws + OFF_ACT) + (size_t)(row0 + t) * 1024 + col;
        *(u32x4*)dst = o0; *(u32x4*)(dst + 8) = o1;
    }
    __syncthreads();
}

__device__ __forceinline__ unsigned f2sortable(float f) { const unsigned u = __float_as_uint(f); return (u & 0x80000000u) ? ~u : (u | 0x80000000u); }
#define CNT4(c0, c1, c2, c3, a, b, cc, d, thr) asm volatile( \
    "v_cmp_ge_u32 s[40:41], %4, %8\n\tv_cmp_ge_u32 s[42:43], %5, %8\n\tv_cmp_ge_u32 s[44:45], %6, %8\n\tv_cmp_ge_u32 s[46:47], %7, %8\n\t" \
    "v_addc_co_u32 %0, s[48:49], 0, %0, s[40:41]\n\tv_addc_co_u32 %1, s[50:51], 0, %1, s[42:43]\n\tv_addc_co_u32 %2, s[52:53], 0, %2, s[44:45]\n\tv_addc_co_u32 %3, s[54:55], 0, %3, s[46:47]" \
    : "+v"(c0), "+v"(c1), "+v"(c2), "+v"(c3) : "v"(a), "v"(b), "v"(cc), "v"(d), "v"(thr) \
    : "s40", "s41", "s42", "s43", "s44", "s45", "s46", "s47", "s48", "s49", "s50", "s51", "s52", "s53", "s54", "s55")
template <int NR>
__device__ __forceinline__ int count_geN(const unsigned (&u)[NR], unsigned thr) {
    int c0 = 0, c1 = 0, c2 = 0, c3 = 0;
#pragma unroll
    for (int j = 0; j < NR; j += 4) CNT4(c0, c1, c2, c3, u[j], u[j + 1], u[j + 2], u[j + 3], thr);
    return (c0 + c1) + (c2 + c3);
}
template <int NR>
__device__ __forceinline__ void select_topk(const LAS float* srow, LAS int* lq, int t, int n, int lane) {
    unsigned u[NR];
#pragma unroll
    for (int j = 0; j < NR; ++j) { const int key = lane + 64 * j; u[j] = (key <= t) ? ((f2sortable(srow[key]) & 0xFFFFF000u) | (unsigned)(4095 - key)) : 0u; }
    unsigned tau = 1u;
    if (n > 256) {
        tau = 0u;
        for (int bit = 31; bit >= 0; --bit) {
            const unsigned cand = tau | (1u << bit);
            const int cnt = wave_sum_i32_uniform(count_geN<NR>(u, cand));
            if (cnt >= 256) { tau = cand; if (cnt == 256) break; }
        }
    }
    const int c = count_geN<NR>(u, tau);
    int pre = c;
#pragma unroll
    for (int o = 1; o < 64; o <<= 1) { const int v = __shfl_up(pre, o); if (lane >= o) pre += v; }
    int pos = pre - c;
    int keyv = lane;
#pragma unroll
    for (int j = 0; j < NR; ++j) {
        const bool sel = u[j] >= tau;
        const int slot = sel ? pos : (256 + lane);
        lq[slot] = keyv;
        pos += sel ? 1 : 0; keyv += 64;
    }
}
__device__ __forceinline__ void dsa_task(const Params& p, int task, LAS unsigned char* lds) {
    const int tid = opaque_tid(), wid = __builtin_amdgcn_readfirstlane(tid >> 6), lane = tid & 63;
    const int b = task >> 9, qg = task & 511, t0 = qg * 8, rowb = b * SEQ;
    const bf16_t* IQ = (const bf16_t*)(p.ws + OFF_IQ); const bf16_t* IK = (const bf16_t*)(p.ws + OFF_IK);
    const bf16_t* AQ = (const bf16_t*)(p.ws + OFF_AQ); const bf16_t* AK = (const bf16_t*)(p.ws + OFF_AK); const bf16_t* AV = (const bf16_t*)(p.ws + OFF_AV);
    const float* gates = (const float*)(p.ws + OFF_GATE);
    LAS float* scores = (LAS float*)lds;
    LAS int* lists = (LAS int*)(lds + 131072);
    const int ntile = (t0 + 8 + 31) >> 5;
#pragma unroll 1
    for (int rr0 = 0; rr0 < ((DSA_REP & 1) ? 2 : 1); ++rr0)
    {
        const int r = lane & 31, hh = lane >> 5;
        bf16x8 af[2][4]; float wv[2][4][4];
#pragma unroll
        for (int rt = 0; rt < 2; ++rt) {
            const size_t qrow = (size_t)(rowb + t0 + 4 * rt + (r >> 3));
#pragma unroll
            for (int ks = 0; ks < 4; ++ks) af[rt][ks] = *(const bf16x8*)(IQ + qrow * 512 + (r & 7) * 64 + 16 * ks + 8 * hh);
#pragma unroll
            for (int q4 = 0; q4 < 4; ++q4)
#pragma unroll
                for (int h4 = 0; h4 < 4; ++h4) wv[rt][q4][h4] = gates[(size_t)(rowb + t0 + 4 * rt + q4) * 16 + 8 + h4 + 4 * hh] * 0.04419417382415922f;
        }
        bf16x8 bfr[4], bnx[4];
        if (wid < ntile) {
#pragma unroll
            for (int ks = 0; ks < 4; ++ks) bfr[ks] = *(const bf16x8*)(IK + (size_t)(rowb + 32 * wid + r) * 64 + 16 * ks + 8 * hh);
        }
        for (int kt = wid; kt < ntile; kt += 8) {
            if (kt + 8 < ntile) {
#pragma unroll
                for (int ks = 0; ks < 4; ++ks) bnx[ks] = *(const bf16x8*)(IK + (size_t)(rowb + 32 * (kt + 8) + r) * 64 + 16 * ks + 8 * hh);
            }
            const int key = 32 * kt + r;
#pragma unroll
            for (int rt = 0; rt < 2; ++rt) {
                f32x16 acc;
#pragma unroll
                for (int i = 0; i < 16; ++i) acc[i] = 0.f;
#pragma unroll
                for (int ks = 0; ks < 4; ++ks) acc = __builtin_amdgcn_mfma_f32_32x32x16_bf16(af[rt][ks], bfr[ks], acc, 0, 0, 0);
#pragma unroll
                for (int q4 = 0; q4 < 4; ++q4) {
                    float part = 0.f;
#pragma unroll
                    for (int h4 = 0; h4 < 4; ++h4) part += fmaxf(acc[q4 * 4 + h4], 0.f) * wv[rt][q4][h4];
                    part += __shfl_xor(part, 32);
                    const int qq = 4 * rt + q4;
                    if (hh == 0) scores[qq * 4096 + key] = (key <= t0 + qq) ? part : -INFINITY;
                }
            }
#pragma unroll
            for (int ks = 0; ks < 4; ++ks) bfr[ks] = bnx[ks];
        }
    }
    __syncthreads();
    const int qq = wid, t = t0 + qq, n = t + 1;
    const int nsel = n < 256 ? n : 256;
#pragma unroll 1
    for (int rr1 = 0; rr1 < ((DSA_REP & 2) ? 2 : 1); ++rr1)
    {
        const LAS float* srow = scores + qq * 4096; LAS int* lq = lists + qq * 320;
        const int nreg = (t >> 6) + 1;
        if (nreg <= 8) select_topk<8>(srow, lq, t, n, lane);
        else if (nreg <= 16) select_topk<16>(srow, lq, t, n, lane);
        else if (nreg <= 24) select_topk<24>(srow, lq, t, n, lane);
        else if (nreg <= 32) select_topk<32>(srow, lq, t, n, lane);
        else if (nreg <= 40) select_topk<40>(srow, lq, t, n, lane);
        else if (nreg <= 48) select_topk<48>(srow, lq, t, n, lane);
        else if (nreg <= 56) select_topk<56>(srow, lq, t, n, lane);
        else select_topk<64>(srow, lq, t, n, lane);
    }
    asm volatile("s_waitcnt lgkmcnt(0)" ::: "memory");
#pragma unroll 1
    for (int rr2 = 0; rr2 < ((DSA_REP & 4) ? 2 : 1); ++rr2) {
    {
        const int r = lane & 15, g = lane >> 4;
        const size_t qrow = (size_t)(rowb + t);
        bf16x8 bq[2];
#pragma unroll
        for (int ks = 0; ks < 2; ++ks) {
            if (r < 8) bq[ks] = *(const bf16x8*)(AQ + qrow * 512 + r * 64 + 8 * g + 32 * ks);
            else { bq[ks] = (bf16x8){0, 0, 0, 0, 0, 0, 0, 0}; }
        }
        LAS float* Pl = scores + qq * 4096;
#pragma unroll 1
        for (int half = 0; half < 2; ++half) {
            bf16x8 a0[8], a1[8];
#pragma unroll
            for (int i = 0; i < 8; ++i) {
                const int jp = 16 * (half * 8 + i) + r;
                const int key = (jp < nsel) ? lists[qq * 320 + jp] : 0;
                a0[i] = *(const bf16x8*)(AK + (size_t)(rowb + key) * 64 + 8 * g); a1[i] = *(const bf16x8*)(AK + (size_t)(rowb + key) * 64 + 8 * g + 32);
            }
#pragma unroll
            for (int i = 0; i < 8; ++i) {
                const int kt = half * 8 + i;
                f32x4 acc = {0.f, 0.f, 0.f, 0.f};
                acc = __builtin_amdgcn_mfma_f32_16x16x32_bf16(a0[i], bq[0], acc, 0, 0, 0);
                acc = __builtin_amdgcn_mfma_f32_16x16x32_bf16(a1[i], bq[1], acc, 0, 0, 0);
                if (r < 8) {
#pragma unroll
                    for (int j = 0; j < 4; ++j) Pl[(16 * kt + 4 * g + j) * 8 + r] = acc[j] * 0.125f;
                }
            }
        }
        asm volatile("s_waitcnt lgkmcnt(0)" ::: "memory");
        f32x4 pa[4], pb[4];
        float mx[8];
#pragma unroll
        for (int hd = 0; hd < 8; ++hd) mx[hd] = -INFINITY;
#pragma unroll
        for (int i = 0; i < 4; ++i) {
            const int jp = lane + 64 * i;
            pa[i] = *(const LAS f32x4*)(Pl + jp * 8); pb[i] = *(const LAS f32x4*)(Pl + jp * 8 + 4);
            if (jp < nsel) {
#pragma unroll
                for (int hd = 0; hd < 4; ++hd) { mx[hd] = fmaxf(mx[hd], pa[i][hd]); mx[4 + hd] = fmaxf(mx[4 + hd], pb[i][hd]); }
            }
        }
#pragma unroll
        for (int hd = 0; hd < 8; ++hd) mx[hd] = wave_max_dpp(mx[hd]);
        float sm[8];
#pragma unroll
        for (int hd = 0; hd < 8; ++hd) sm[hd] = 0.f;
#pragma unroll
        for (int i = 0; i < 4; ++i) {
            const bool ok = (lane + 64 * i) < nsel;
#pragma unroll
            for (int hd = 0; hd < 4; ++hd) {
                pa[i][hd] = ok ? __expf(pa[i][hd] - mx[hd]) : 0.f; sm[hd] += pa[i][hd];
                pb[i][hd] = ok ? __expf(pb[i][hd] - mx[4 + hd]) : 0.f; sm[4 + hd] += pb[i][hd];
            }
        }
#pragma unroll
        for (int hd = 0; hd < 8; ++hd) sm[hd] = 1.f / wave_sum_dpp(sm[hd]);
        LAS bf16_t* Pt = (LAS bf16_t*)((LAS unsigned char*)Pl + 9216);
#pragma unroll
        for (int i = 0; i < 4; ++i) {
            const int jp = lane + 64 * i;
#pragma unroll
            for (int hd = 0; hd < 4; ++hd) { Pt[hd * 264 + jp] = f2bf(pa[i][hd] * sm[hd]); Pt[(4 + hd) * 264 + jp] = f2bf(pb[i][hd] * sm[4 + hd]); }
        }
    }
    asm volatile("s_waitcnt lgkmcnt(0)" ::: "memory");
    {
        typedef short s16x4 __attribute__((ext_vector_type(4)));
        const int r = lane & 15, g = lane >> 4;
        LAS unsigned char* wb = (LAS unsigned char*)(scores + qq * 4096);
        const LAS bf16_t* Pt = (const LAS bf16_t*)(wb + 9216);
        const int nchunk = (nsel + 31) >> 5;
        const int kl = lane >> 3, dc = lane & 7;
        f32x4 acc[4];
#pragma unroll
        for (int ct = 0; ct < 4; ++ct) acc[ct] = (f32x4){0.f, 0.f, 0.f, 0.f};
        u32x4 vq[4], vn[4];
#pragma unroll
        for (int i = 0; i < 4; ++i) {
            const int jp = kl + 8 * i;
            const int key = (jp < nsel) ? lists[qq * 320 + jp] : 0;
            vq[i] = *(const u32x4*)(AV + (size_t)(rowb + key) * 64 + dc * 8);
        }
#pragma unroll 1
        for (int c = 0; c < nchunk; ++c) {
            LAS unsigned char* vb = wb + (c & 1) * 4608;
#pragma unroll
            for (int i = 0; i < 4; ++i) *(LAS u32x4*)(vb + (kl + 8 * i) * 144 + dc * 16) = vq[i];
            if (c + 1 < nchunk) {
#pragma unroll
                for (int i = 0; i < 4; ++i) {
                    const int jp = 32 * (c + 1) + kl + 8 * i;
                    const int key = (jp < nsel) ? lists[qq * 320 + jp] : 0;
                    vn[i] = *(const u32x4*)(AV + (size_t)(rowb + key) * 64 + dc * 8);
                }
            }
            bf16x8 a = *(const LAS bf16x8*)(Pt + (r & 7) * 264 + 32 * c + 8 * g);
            if (r >= 8) a = (bf16x8){0, 0, 0, 0, 0, 0, 0, 0};
#pragma unroll
            for (int ct = 0; ct < 4; ++ct) {
                LAS unsigned char* ba = vb + (8 * g + (r >> 2)) * 144 + (16 * ct + 4 * (r & 3)) * 2;
                const s16x4 b0 = __builtin_amdgcn_ds_read_tr16_b64_v4i16((LAS s16x4*)ba);
                const s16x4 b1 = __builtin_amdgcn_ds_read_tr16_b64_v4i16((LAS s16x4*)(ba + 4 * 144));
                bf16x8 bb; bb[0] = b0[0]; bb[1] = b0[1]; bb[2] = b0[2]; bb[3] = b0[3]; bb[4] = b1[0]; bb[5] = b1[1]; bb[6] = b1[2]; bb[7] = b1[3];
                acc[ct] = __builtin_amdgcn_mfma_f32_16x16x32_bf16(a, bb, acc[ct], 0, 0, 0);
            }
#pragma unroll
            for (int i = 0; i < 4; ++i) vq[i] = vn[i];
        }
        bf16_t* dst = (bf16_t*)(p.ws + OFF_ACT) + (size_t)(rowb + t) * 1024 + 512;
#pragma unroll
        for (int j = 0; j < 4; ++j) {
            float ss = acc[0][j] * acc[0][j] + acc[1][j] * acc[1][j] + acc[2][j] * acc[2][j] + acc[3][j] * acc[3][j];
            ss += __shfl_xor(ss, 1); ss += __shfl_xor(ss, 2); ss += __shfl_xor(ss, 4); ss += __shfl_xor(ss, 8);
            const float rstd = rsqrtf(ss * (1.f / 64.f) + 1e-6f);
            if (g < 2) {
                const int hd = 4 * g + j;
#pragma unroll
                for (int ct = 0; ct < 4; ++ct) dst[hd * 64 + 16 * ct + r] = f2bf(acc[ct][j] * rstd * p.out_norm_a[hd * 64 + 16 * ct + r]);
            }
        }
    }
    }
    __syncthreads();
}

__device__ __forceinline__ float sortable2f(unsigned s) { return __uint_as_float((s & 0x80000000u) ? (s ^ 0x80000000u) : ~s); }
#define CE_DESC(x, y) do { const unsigned mx_ = max(x, y), mn_ = min(x, y); (x) = mx_; (y) = mn_; } while (0)
template <int BASE, int N>
__device__ __forceinline__ void bitonic_sort16_desc(unsigned (&a)[N]) {
#pragma unroll
    for (int k = 2; k <= 16; k <<= 1) {
#pragma unroll
        for (int j = k >> 1; j > 0; j >>= 1) {
#pragma unroll
            for (int i = 0; i < 16; ++i) {
                const int l = i ^ j;
                if (l > i) {
                    if ((i & k) == 0) CE_DESC(a[BASE + i], a[BASE + l]);
                    else CE_DESC(a[BASE + l], a[BASE + i]);
                }
            }
        }
    }
}
template <int BASE, int N>
__device__ __forceinline__ void bitonic_merge16_desc(unsigned (&a)[N]) {
#pragma unroll
    for (int j = 8; j > 0; j >>= 1) {
#pragma unroll
        for (int i = 0; i < 16; ++i) { const int l = i ^ j; if (l > i) CE_DESC(a[BASE + i], a[BASE + l]); }
    }
}
template <int BA, int BB, int N>
__device__ __forceinline__ void top16_merge(unsigned (&a)[N]) {
#pragma unroll
    for (int i = 0; i < 16; ++i) a[BA + i] = max(a[BA + i], a[BB + 15 - i]);
    bitonic_merge16_desc<BA, N>(a);
}
__device__ __forceinline__ void top16_of_64(unsigned (&a)[64]) {
    bitonic_sort16_desc<0, 64>(a); bitonic_sort16_desc<16, 64>(a); bitonic_sort16_desc<32, 64>(a); bitonic_sort16_desc<48, 64>(a);
    top16_merge<0, 16, 64>(a); top16_merge<32, 48, 64>(a); top16_merge<0, 32, 64>(a);
}
__device__ __forceinline__ void peer_route(const Params& p, int task, LAS unsigned char* lds) {
    const int tid = opaque_tid(), wid = __builtin_amdgcn_readfirstlane(tid >> 6), lane = tid & 63;
    const int n0 = task * 32, head = wid;
    const int r = lane & 31, hh = lane >> 5;
    const bf16_t* QRY = (const bf16_t*)(p.ws + OFF_QRY); const bf16_t* SK = (const bf16_t*)(p.ws + OFF_SK);
    LAS unsigned* tkl = (LAS unsigned*)lds + wid * (32 * 64);
#pragma unroll 1
    for (int p2 = 0; p2 < 2; ++p2) {
        const int grp = head * 2 + p2;
        bf16x8 bq[4];
#pragma unroll
        for (int ks = 0; ks < 4; ++ks) bq[ks] = *(const bf16x8*)(QRY + (size_t)(n0 + r) * 1024 + grp * 64 + 16 * ks + 8 * hh);
        unsigned key[64];
#pragma unroll
        for (int kt = 0; kt < 4; ++kt) {
            f32x16 acc;
#pragma unroll
            for (int i = 0; i < 16; ++i) acc[i] = 0.f;
#pragma unroll
            for (int ks = 0; ks < 4; ++ks) {
                const bf16x8 a = *(const bf16x8*)(SK + (size_t)(grp * 128 + 32 * kt + r) * 64 + 16 * ks + 8 * hh);
                acc = __builtin_amdgcn_mfma_f32_32x32x16_bf16(a, bq[ks], acc, 0, 0, 0);
            }
#pragma unroll
            for (int reg = 0; reg < 16; ++reg) {
                const int idx = 32 * kt + (reg & 3) + 8 * (reg >> 2) + 4 * hh;
                key[kt * 16 + reg] = (f2sortable(acc[reg]) & ~0x7Fu) | (unsigned)(127 - idx);
            }
        }
        top16_of_64(key);
        unsigned mg[16];
#pragma unroll
        for (int i = 0; i < 16; ++i) mg[i] = max(key[i], (unsigned)__shfl_xor((int)key[15 - i], 32));
        bitonic_merge16_desc<0, 16>(mg);
#pragma unroll
        for (int k = 0; k < 16; ++k) tkl[(p2 * 16 + k) * 64 + lane] = mg[k];
    }
    float v1[16], v2[16];
#pragma unroll
    for (int k = 0; k < 16; ++k) { v1[k] = sortable2f(tkl[k * 64 + lane] & ~0x7Fu); v2[k] = sortable2f(tkl[(16 + k) * 64 + lane] & ~0x7Fu); }
    unsigned ck[64];
    {
        int ci = 0;
#pragma unroll
        for (int a = 0; a < 16; ++a) {
#pragma unroll
            for (int bb = 0; bb < 16 / (a + 1); ++bb) { ck[ci] = (f2sortable(v1[a] + v2[bb]) & ~0xFFu) | (unsigned)(255 - (16 * a + bb)); ++ci; }
        }
#pragma unroll
        for (int i = 50; i < 64; ++i) ck[i] = 0u;
    }
    top16_of_64(ck);
    float tv[16]; int te[16];
    float sum = 0.f;
#pragma unroll
    for (int k = 0; k < 16; ++k) {
        const int flat = 255 - (int)(ck[k] & 0xFFu);
        const int i1 = 127 - (int)(tkl[(flat >> 4) * 64 + lane] & 0x7Fu), i2 = 127 - (int)(tkl[(16 + (flat & 15)) * 64 + lane] & 0x7Fu);
        te[k] = i1 * 128 + i2;
        tv[k] = __expf(sortable2f(ck[k] & ~0xFFu) - sortable2f(ck[0] & ~0xFFu)); sum += tv[k];
    }
    const float inv = 1.f / sum;
    if (hh == 0) {
        int* EI = (int*)(p.ws + OFF_EIDX) + (size_t)(n0 + r) * 128 + head * 16;
#pragma unroll
        for (int q = 0; q < 4; ++q) { u32x4 o; o[0] = te[4 * q]; o[1] = te[4 * q + 1]; o[2] = te[4 * q + 2]; o[3] = te[4 * q + 3]; *(u32x4*)(EI + 4 * q) = o; }
    } else {
        float* GW = (float*)(p.ws + OFF_GW) + (size_t)(n0 + r) * 128 + head * 16;
#pragma unroll
        for (int q = 0; q < 4; ++q) { f32x4 o; o[0] = tv[4 * q] * inv; o[1] = tv[4 * q + 1] * inv; o[2] = tv[4 * q + 2] * inv; o[3] = tv[4 * q + 3] * inv; *(f32x4*)(GW + 4 * q) = o; }
    }
}

__device__ __forceinline__ float gelu_exact(float a) { return 0.5f * a * (1.f + erff(a * 0.70710678118654752440f)); }
__device__ __forceinline__ float gelu_as(float v) {
    const float av = fabsf(v), t = __builtin_amdgcn_rcpf(av * 0.2316418882f + 1.0f);
    float q = t * 0.5307027145f + (-0.7265760135f); q = q * t + 0.7107068705f; q = q * t + (-0.142248368f); q = q * t + 0.127414796f; q = q * t;
    const float e = __builtin_amdgcn_exp2f((v * v) * (-0.72134752044f));
    const float m = v * (q * e), rr = v - m;
    return v < 0.f ? m : rr;
}
__device__ __forceinline__ void dec16_fp8(const u32x4 w, float (&f)[16]) {
#pragma unroll
    for (int i = 0; i < 4; ++i) {
        const f32x2 lo = __builtin_amdgcn_cvt_pk_f32_fp8((int)w[i], false), hi = __builtin_amdgcn_cvt_pk_f32_fp8((int)w[i], true);
        f[4 * i] = lo[0]; f[4 * i + 1] = lo[1]; f[4 * i + 2] = hi[0]; f[4 * i + 3] = hi[1];
    }
}
__device__ __forceinline__ void sort_pairs128(int& k_lo, int& k_hi, float& g_lo, float& g_hi, int lane) {
#pragma unroll
    for (int size = 2; size <= 128; size <<= 1) {
#pragma unroll
        for (int stride = size >> 1; stride >= 1; stride >>= 1) {
            if (stride == 64) {
                const bool sw = k_hi < k_lo;
                const int ta = sw ? k_hi : k_lo, tb = sw ? k_lo : k_hi; const float ga = sw ? g_hi : g_lo, gb = sw ? g_lo : g_hi;
                k_lo = ta; k_hi = tb; g_lo = ga; g_hi = gb;
            } else {
                const int p_lo = __shfl_xor(k_lo, stride), p_hi = __shfl_xor(k_hi, stride);
                const float q_lo = __shfl_xor(g_lo, stride), q_hi = __shfl_xor(g_hi, stride);
                const bool lower = (lane & stride) == 0;
                const bool asc_lo = (size >= 64) ? true : ((lane & size) == 0);
                const bool asc_hi = (size == 128) ? true : ((size == 64) ? false : ((lane & size) == 0));
                const bool min_lo = (lower == asc_lo), min_hi = (lower == asc_hi);
                const bool take_lo = min_lo ? (p_lo < k_lo) : (p_lo > k_lo);
                const bool take_hi = min_hi ? (p_hi < k_hi) : (p_hi > k_hi);
                k_lo = take_lo ? p_lo : k_lo; g_lo = take_lo ? q_lo : g_lo;
                k_hi = take_hi ? p_hi : k_hi; g_hi = take_hi ? q_hi : g_hi;
            }
        }
    }
}
__device__ __forceinline__ void peer_finish_row(const Params& p, const float* ada, int tok, int d0, const float (&acc)[16], bool do_store) {
    const int b = tok >> 12;
    float* orow = p.out + (size_t)tok * 1024 + d0;
    float xo[16]; float ss = 0.f;
#pragma unroll
    for (int q = 0; q < 4; ++q) {
        const f32x4 xv = *(const f32x4*)(orow + 4 * q), gv = *(const f32x4*)(ada + b * 6144 + 5120 + d0 + 4 * q);
#pragma unroll
        for (int i = 0; i < 4; ++i) { const float v = xv[i] + gv[i] * acc[q * 4 + i]; xo[q * 4 + i] = v; ss += v * v; }
    }
    ss = wave_sum(ss);
    const float rstd = rsqrtf(ss * (1.f / 1024.f) + 1e-6f);
#pragma unroll
    for (int q = 0; q < 4; ++q) {
        const f32x4 fg = *(const f32x4*)(p.final_g + d0 + 4 * q);
        f32x4 ov;
#pragma unroll
        for (int i = 0; i < 4; ++i) ov[i] = xo[q * 4 + i] * rstd * fg[i];
        if (do_store) *(f32x4*)(orow + 4 * q) = ov;
    }
}
struct PeTok { unsigned hq[4]; float ascale; int acc_hi[16], acc_lo[16]; int csum_hi, csum_lo; int k_lo, k_hi; float g_lo, g_hi; };
__device__ __forceinline__ void pe_tok_init(PeTok& t, const bf16_t* H2, const int* EI, const float* GW, int tok, int d0, int lane) {
    const u32x4 h0 = *(const u32x4*)(H2 + (size_t)tok * 1024 + d0), h1 = *(const u32x4*)(H2 + (size_t)tok * 1024 + d0 + 8);
    float hx[16];
#pragma unroll
    for (int i = 0; i < 4; ++i) { hx[2 * i] = lo16(h0[i]); hx[2 * i + 1] = hi16(h0[i]); hx[8 + 2 * i] = lo16(h1[i]); hx[8 + 2 * i + 1] = hi16(h1[i]); }
    float am = 0.f;
#pragma unroll
    for (int i = 0; i < 16; ++i) am = fmaxf(am, fabsf(hx[i]));
    am = fmaxf(wave_max_dpp(am), 1e-20f);
    const float hs = 127.f / am;
#pragma unroll
    for (int i = 0; i < 4; ++i) t.hq[i] = pack4_i8(hx[4 * i], hx[4 * i + 1], hx[4 * i + 2], hx[4 * i + 3], hs);
    t.ascale = am * (1.f / (127.f * PEER_SU));
#pragma unroll
    for (int i = 0; i < 16; ++i) { t.acc_hi[i] = 0; t.acc_lo[i] = 0; }
    t.csum_hi = 0; t.csum_lo = 0;
    t.k_lo = EI[(size_t)tok * 128 + lane]; t.k_hi = EI[(size_t)tok * 128 + 64 + lane];
    t.g_lo = GW[(size_t)tok * 128 + lane]; t.g_hi = GW[(size_t)tok * 128 + 64 + lane];
    sort_pairs128(t.k_lo, t.k_hi, t.g_lo, t.g_hi, lane);
}
__device__ __forceinline__ void pe_tok_result(const PeTok& t, float (&acc)[16]) {
    const int coff = 8 * (t.csum_hi * 128 + t.csum_lo);
#pragma unroll
    for (int i = 0; i < 4; ++i)
#pragma unroll
        for (int j = 0; j < 4; ++j) acc[8 * (i >> 1) + 2 * j + (i & 1)] = (float)(t.acc_hi[4 * i + j] * 128 + t.acc_lo[4 * i + j] - coff) * (1.f / (PEER_SC * PEER_SV));
}
__device__ __forceinline__ void pe_vgroup(PeTok& t, const u32x2 (&vv)[8], int base, int c0, int c1, int c2, int c3) {
    const int chi = ((c0 >> 7) & 0xFF) | (((c1 >> 7) & 0xFF) << 8) | (((c2 >> 7) & 0xFF) << 16) | (((c3 >> 7) & 0xFF) << 24);
    const int clo = (c0 & 127) | ((c1 & 127) << 8) | ((c2 & 127) << 16) | ((c3 & 127) << 24);
    t.csum_hi += (c0 >> 7) + (c1 >> 7) + (c2 >> 7) + (c3 >> 7); t.csum_lo += (c0 & 127) + (c1 & 127) + (c2 & 127) + (c3 & 127);
#pragma unroll
    for (int i = 0; i < 4; ++i) {
        const unsigned w0 = (vv[base][i >> 1] >> (4 * (i & 1))) & 0x0F0F0F0Fu, w1 = (vv[base + 1][i >> 1] >> (4 * (i & 1))) & 0x0F0F0F0Fu;
        const unsigned w2_ = (vv[base + 2][i >> 1] >> (4 * (i & 1))) & 0x0F0F0F0Fu, w3 = (vv[base + 3][i >> 1] >> (4 * (i & 1))) & 0x0F0F0F0Fu;
        const unsigned a0 = __builtin_amdgcn_perm(w1, w0, 0x05010400u), a1 = __builtin_amdgcn_perm(w1, w0, 0x07030602u);
        const unsigned b0 = __builtin_amdgcn_perm(w3, w2_, 0x05010400u), b1 = __builtin_amdgcn_perm(w3, w2_, 0x07030602u);
        const unsigned tt0 = __builtin_amdgcn_perm(b0, a0, 0x05040100u), tt1 = __builtin_amdgcn_perm(b0, a0, 0x07060302u);
        const unsigned tt2 = __builtin_amdgcn_perm(b1, a1, 0x05040100u), tt3 = __builtin_amdgcn_perm(b1, a1, 0x07060302u);
        t.acc_hi[4 * i + 0] = __builtin_amdgcn_sdot4((int)tt0, chi, t.acc_hi[4 * i + 0], false); t.acc_lo[4 * i + 0] = __builtin_amdgcn_sdot4((int)tt0, clo, t.acc_lo[4 * i + 0], false);
        t.acc_hi[4 * i + 1] = __builtin_amdgcn_sdot4((int)tt1, chi, t.acc_hi[4 * i + 1], false); t.acc_lo[4 * i + 1] = __builtin_amdgcn_sdot4((int)tt1, clo, t.acc_lo[4 * i + 1], false);
        t.acc_hi[4 * i + 2] = __builtin_amdgcn_sdot4((int)tt2, chi, t.acc_hi[4 * i + 2], false); t.acc_lo[4 * i + 2] = __builtin_amdgcn_sdot4((int)tt2, clo, t.acc_lo[4 * i + 2], false);
        t.acc_hi[4 * i + 3] = __builtin_amdgcn_sdot4((int)tt3, chi, t.acc_hi[4 * i + 3], false); t.acc_lo[4 * i + 3] = __builtin_amdgcn_sdot4((int)tt3, clo, t.acc_lo[4 * i + 3], false);
    }
}
__device__ __forceinline__ void peer_experts(const Params& p, bool do_store) {
    const int wid = threadIdx.x >> 6, lane = threadIdx.x & 63;
    const bf16_t* H2 = (const bf16_t*)(p.ws + OFF_ACT); const unsigned char* UT = p.ws + OFF_UT; const unsigned char* VT = p.ws + OFF_VT;
    const int* EI = (const int*)(p.ws + OFF_EIDX); const float* GW = (const float*)(p.ws + OFF_GW); const float* ada = (const float*)(p.ws + OFF_ADA);
    const int d0 = 16 * lane;
    const int stride = gridDim.x * 8;
    for (int tok0 = blockIdx.x * 8 + wid; tok0 < NTOK; tok0 += 2 * stride) {
        __syncthreads();
        const bool hasB = (tok0 + stride) < NTOK;
        const int tokA = tok0, tokB = hasB ? tok0 + stride : tok0;
        PeTok A, B;
        pe_tok_init(A, H2, EI, GW, tokA, d0, lane);
        pe_tok_init(B, H2, EI, GW, tokB, d0, lane);
        u32x4 uX[8], uY[8]; u32x2 vX[8], vY[8]; float gX[8], gY[8];
#define PE_ISSUE(UU, VV, GG, K0) do { _Pragma("unroll") for (int q = 0; q < 4; ++q) { \
            const unsigned ea_ = (unsigned)__builtin_amdgcn_readlane((K0) < 64 ? A.k_lo : A.k_hi, ((K0) + q) & 63), eb_ = (unsigned)__builtin_amdgcn_readlane((K0) < 64 ? B.k_lo : B.k_hi, ((K0) + q) & 63); \
            GG[q] = rlanef((K0) < 64 ? A.g_lo : A.g_hi, ((K0) + q) & 63); GG[4 + q] = rlanef((K0) < 64 ? B.g_lo : B.g_hi, ((K0) + q) & 63); \
            UU[q] = *(const u32x4*)(UT + (size_t)(ea_ * 1024u) + (unsigned)d0); VV[q] = *(const u32x2*)(VT + (size_t)(ea_ * 512u) + 8u * (unsigned)lane); \
            UU[4 + q] = *(const u32x4*)(UT + (size_t)(eb_ * 1024u) + (unsigned)d0); VV[4 + q] = *(const u32x2*)(VT + (size_t)(eb_ * 512u) + 8u * (unsigned)lane); } } while (0)
#define PE_COMPUTE(UU, VV, GG) do { \
            float sv[8]; \
            _Pragma("unroll") for (int q = 0; q < 8; ++q) { int d_ = 0; \
                _Pragma("unroll") for (int i = 0; i < 4; ++i) d_ = __builtin_amdgcn_sdot4((int)UU[q][i], (int)(q < 4 ? A.hq[i] : B.hq[i]), d_, false); \
                sv[q] = (float)d_ * (q < 4 ? A.ascale : B.ascale); } \
            float t4[4]; \
            _Pragma("unroll") for (int i = 0; i < 4; ++i) { const u32x2 r_ = __builtin_amdgcn_permlane32_swap(__float_as_uint(sv[i]), __float_as_uint(sv[i + 4]), false, false); t4[i] = __uint_as_float(r_[0]) + __uint_as_float(r_[1]); } \
            float w2[2]; \
            _Pragma("unroll") for (int i = 0; i < 2; ++i) { const u32x2 r_ = __builtin_amdgcn_permlane16_swap(__float_as_uint(t4[i]), __float_as_uint(t4[i + 2]), false, false); w2[i] = __uint_as_float(r_[0]) + __uint_as_float(r_[1]); } \
            _Pragma("unroll") for (int i = 0; i < 2; ++i) { w2[i] += dppf(w2[i], 0xB1); w2[i] += dppf(w2[i], 0x4E); w2[i] += dppf(w2[i], 0x141); w2[i] += dppf(w2[i], 0x140); } \
            float mine = 0.f, gmine = 0.f; \
            _Pragma("unroll") for (int q = 0; q < 8; ++q) { \
                const float tq = rlanef(w2[q & 1], 16 * (((q >> 1) & 1) + 2 * (q >> 2))); \
                mine = ((lane & 7) == q) ? tq : mine; gmine = ((lane & 7) == q) ? GG[q] : gmine; } \
            const float cmine = gmine * gelu_as(mine); \
            const int cqm = (int)fminf(fmaxf(rintf(cmine * PEER_SC), -16383.f), 16383.f);        \
            pe_vgroup(A, VV, 0, __builtin_amdgcn_readlane(cqm, 0), __builtin_amdgcn_readlane(cqm, 1), __builtin_amdgcn_readlane(cqm, 2), __builtin_amdgcn_readlane(cqm, 3)); \
            pe_vgroup(B, VV, 4, __builtin_amdgcn_readlane(cqm, 4), __builtin_amdgcn_readlane(cqm, 5), __builtin_amdgcn_readlane(cqm, 6), __builtin_amdgcn_readlane(cqm, 7)); } while (0)
        PE_ISSUE(uX, vX, gX, 0);
#pragma unroll 1
        for (int k0 = 0; k0 < 128; k0 += 8) {
            if ((k0 & 31) == 0 && k0) __syncthreads();
            PE_ISSUE(uY, vY, gY, k0 + 4);
            PE_COMPUTE(uX, vX, gX);
            if (k0 + 8 < 128) PE_ISSUE(uX, vX, gX, k0 + 8);
            PE_COMPUTE(uY, vY, gY);
        }
#undef PE_ISSUE
#undef PE_COMPUTE
        float acc[16];
        pe_tok_result(A, acc); peer_finish_row(p, ada, tokA, d0, acc, do_store);
        pe_tok_result(B, acc); peer_finish_row(p, ada, tokB, d0, acc, do_store && hasB);
    }
}

enum { PH_PREP = 0, PH_GEMM_IN, PH_MIX, PH_GEMM_OUT, PH_H2, PH_GEMM_Q, PH_ROUTE, PH_EXPERT, PH_COUNT };

typedef const __attribute__((address_space(4))) Params* KParams;
__device__ __forceinline__ const Params& kparams() {
    auto q = __builtin_amdgcn_kernarg_segment_ptr();
    asm volatile("" : "+s"(q));
    return *(const Params*)q;
}
#ifndef PHMASK
#define PHMASK 0xFFFF
#endif
#ifndef REP_PHASE
#define REP_PHASE -1
#endif
#define PHASE_BEGIN(idx) if (((PHMASK >> (idx)) & 1) && ph_lo <= (idx) && (idx) < ph_hi) { for (int rep = 0; rep < ((idx) == REP_PHASE ? 2 : 1); ++rep) { if ((idx) != ph_lo || rep) xcd_barrier(bar); const Params& p = kparams(); const int G = gridDim.x; (void)G; const bool last_rep = (rep == ((idx) == REP_PHASE ? 1 : 0)); (void)last_rep;
#define PHASE_END } }

__global__ void __launch_bounds__(NTHREADS, 2) hymba_fwd(Params p_) {
    extern __shared__ __attribute__((aligned(16))) unsigned char smem_raw[];
    LAS unsigned char* lds = (LAS unsigned char*)smem_raw;
    volatile LAS unsigned* xbw = (volatile LAS unsigned*)(lds + LDS_BYTES - 16);
    if (threadIdx.x == 0) { xbw[0] = 0u; xbw[1] = 0u; xbw[2] = 0u; xbw[3] = 0u; }
    __syncthreads();
    XcdBarrier bar = xcd_barrier_post((unsigned*)(p_.ws + OFF_CTL), xbw);
    const int ph_lo = p_.ph_lo, ph_hi = p_.ph_hi;

    PHASE_BEGIN(PH_PREP)
        phase0(p, lds);
        wg_wait((unsigned*)(p.ws + OFF_CTL), CNT_ADA, 192u);
        norm_mod_rows(p.x, p.norm1_g, (const float*)(p.ws + OFF_ADA), 0, 1024, (bf16_t*)(p.ws + OFF_ACT));
    PHASE_END
    PHASE_BEGIN(PH_GEMM_IN)
        {   pg8::StaticOrder S; S.init(NTOK, 3072, G, blockIdx.x);
            EpiInMain E; E.ws = p.ws; E.bias = (const float*)(p.ws + OFF_BIAS);
            pg8::gemm_phase(lds, pg8::Gemm{(const bf16_t*)(p.ws + OFF_ACT), (const bf16_t*)(p.ws + OFF_WIN), NTOK, 3072, 1024}, S, E); }
        {   pg8::StaticOrder S; S.init(NTOK, 256, G, blockIdx.x);
            EpiInTail E; E.ws = p.ws; E.bias = (const float*)(p.ws + OFF_BIAS) + 3072;
            pg8::gemm_phase(lds, pg8::Gemm{(const bf16_t*)(p.ws + OFF_ACT), (const bf16_t*)(p.ws + OFF_WIN) + (size_t)3072 * 1024, NTOK, 256, 1024}, S, E); }
        if (G > 64) { if ((int)blockIdx.x >= 64) convert_tables(p, (int)blockIdx.x - 64, G - 64); }
        else convert_tables(p, (int)blockIdx.x, G);
    PHASE_END
    PHASE_BEGIN(PH_MIX)
        unsigned* ctl = (unsigned*)(p.ws + OFF_CTL);
        for (int t = blockIdx.x; t < 1024; t += G) mlstm_passA(p, t, lds);
        wg_signal(ctl, CNT_MLA);
        __syncthreads();
        for (int t = blockIdx.x; t < 2048; t += G) {
            const int rnd = t >> 8, w = t & 255; const int bsel = rnd >> 1; const int qgs = (rnd & 1) ? w : (511 - w);
            dsa_task(p, (bsel << 9) | qgs, lds); }
        wg_wait(ctl, CNT_MLA, (unsigned)G);
        for (int t = blockIdx.x; t < 256; t += G) mlstm_scan(p, t, lds);
        wg_signal(ctl, CNT_SCAN);
        wg_wait(ctl, CNT_SCAN, (unsigned)G);
        for (int t = blockIdx.x; t < 1024; t += G) mlstm_passB(p, t, lds);
    PHASE_END
    PHASE_BEGIN(PH_GEMM_OUT)
        {   pg8::StaticOrder S; S.init(NTOK, 1024, G, blockIdx.x);
            EpiOut E; E.x = p.x; E.ada = (const float*)(p.ws + OFF_ADA); E.out = p.out;
            pg8::gemm_phase(lds, pg8::Gemm{(const bf16_t*)(p.ws + OFF_ACT), (const bf16_t*)(p.ws + OFF_WOUT), NTOK, 1024, 1024}, S, E); }
    PHASE_END
    PHASE_BEGIN(PH_H2) norm_mod_rows(p.out, p.norm2_g, (const float*)(p.ws + OFF_ADA), 3072, 4096, (bf16_t*)(p.ws + OFF_ACT)); PHASE_END
    PHASE_BEGIN(PH_GEMM_Q)
        {   pg8::StaticOrder S; S.init(NTOK, 1024, G, blockIdx.x);
            EpiQry E; E.O = (bf16_t*)(p.ws + OFF_QRY);
            pg8::gemm_phase(lds, pg8::Gemm{(const bf16_t*)(p.ws + OFF_ACT), (const bf16_t*)(p.ws + OFF_WPQ), NTOK, 1024, 1024}, S, E); }
    PHASE_END
    PHASE_BEGIN(PH_ROUTE) for (int t = blockIdx.x; t < 512; t += G) peer_route(p, t, lds); PHASE_END
    PHASE_BEGIN(PH_EXPERT) peer_experts(p, last_rep); PHASE_END
}

extern "C" void kernel_launch(void* const* d_in, const int* in_sizes, int n_in, void* d_out, int out_size, void* d_ws, size_t ws_size, hipStream_t stream) {
    static int grid = 0;
    if (grid == 0) {
        int dev = 0, cus = 0, per_cu = 0;
        if (hipGetDevice(&dev) != hipSuccess || hipDeviceGetAttribute(&cus, hipDeviceAttributeMultiprocessorCount, dev) != hipSuccess) { fprintf(stderr, "kernel_launch: device query failed\n"); grid = -1; return; }
        if (hipFuncSetAttribute((const void*)hymba_fwd, hipFuncAttributeMaxDynamicSharedMemorySize, LDS_BYTES) != hipSuccess) { fprintf(stderr, "kernel_launch: hipFuncSetAttribute failed\n"); grid = -1; return; }
        if (hipOccupancyMaxActiveBlocksPerMultiprocessor(&per_cu, (const void*)hymba_fwd, NTHREADS, LDS_BYTES) != hipSuccess || per_cu < 1) { fprintf(stderr, "kernel_launch: occupancy query says %d blocks/CU\n", per_cu); }
        (void)hipGetLastError();
        grid = cus;
        if (ws_size < WS_END || n_in != 17) { fprintf(stderr, "kernel_launch: unexpected sizes (ws %zu, n_in %d)\n", ws_size, n_in); grid = -1; return; }
    }
    if (grid < 0) return;
    (void)hipMemsetAsync((char*)d_ws + OFF_CTL, 0, CTL_BYTES, stream);
    Params p{};
    p.x = (const float*)d_in[0]; p.c = (const float*)d_in[1]; p.w_ada = (const float*)d_in[2]; p.b_ada = (const float*)d_in[3]; p.norm1_g = (const float*)d_in[4];
    p.w_in = (const float*)d_in[5]; p.b_in = (const float*)d_in[6]; p.conv_qk = (const float*)d_in[7]; p.out_norm_m = (const float*)d_in[8]; p.out_norm_a = (const float*)d_in[9];
    p.w_out = (const float*)d_in[10]; p.norm2_g = (const float*)d_in[11]; p.w_peer_q = (const float*)d_in[12]; p.sub_keys = (const float*)d_in[13]; p.peer_u = (const float*)d_in[14];
    p.peer_v = (const float*)d_in[15]; p.final_g = (const float*)d_in[16];
    p.out = (float*)d_out; p.ws = (unsigned char*)d_ws; p.ph_lo = 0; p.ph_hi = PH_COUNT;
    void* args[] = {&p};
    hipError_t e = hipLaunchCooperativeKernel((const void*)hymba_fwd, dim3(grid), dim3(NTHREADS), args, LDS_BYTES, stream);
    if (e != hipSuccess) fprintf(stderr, "kernel_launch: cooperative launch failed: %s (grid %d)\n", hipGetErrorString(e), grid);
}
```

```cpp
#include <hip/hip_runtime.h>
#include <stdint.h>
#define REP_PHASE -1
#define DSA_REP 0
#include <cstdio>

#define LAS __attribute__((address_space(3)))
typedef unsigned short bf16_t;
typedef short bf16x8 __attribute__((ext_vector_type(8)));
typedef float f32x4 __attribute__((ext_vector_type(4)));
typedef float f32x2 __attribute__((ext_vector_type(2)));
typedef float f32x16 __attribute__((ext_vector_type(16)));
typedef unsigned u32x4 __attribute__((ext_vector_type(4)));
typedef unsigned u32x2 __attribute__((ext_vector_type(2)));

constexpr int NTOK = 16384, DM = 1024, SEQ = 4096;
constexpr int NIN_PAD = 3328;
constexpr int LDS_BYTES = 163840 - 64;
constexpr int NTHREADS = 512;

constexpr size_t MiB = 1024 * 1024;
constexpr size_t OFF_CTL = 0;
constexpr size_t CTL_BYTES = 16384;
constexpr size_t OFF_ADA = 64 * 1024;
constexpr size_t OFF_BIAS = 192 * 1024;
constexpr size_t OFF_SK = 256 * 1024;
constexpr size_t OFF_WIN = 512 * 1024;
constexpr size_t OFF_WOUT = 7 * MiB;
constexpr size_t OFF_WPQ = 9 * MiB;
constexpr size_t OFF_ACT = 11 * MiB;
constexpr size_t OFF_MQ = 43 * MiB;
constexpr size_t OFF_MK = 59 * MiB;
constexpr size_t OFF_MV = 75 * MiB;
constexpr size_t OFF_MO = 91 * MiB;
constexpr size_t OFF_AQ = 107 * MiB;
constexpr size_t OFF_IQ = 123 * MiB;
constexpr size_t OFF_AK = 139 * MiB;
constexpr size_t OFF_AV = 141 * MiB;
constexpr size_t OFF_IK = 143 * MiB;
constexpr size_t OFF_GATE = 145 * MiB;
constexpr size_t OFF_KV = 146 * MiB;
constexpr size_t OFF_KS = 178 * MiB;
constexpr size_t OFF_MLOC = 178 * MiB + 512 * 1024;
constexpr size_t OFF_BLAST = OFF_MLOC + 4096;
constexpr size_t OFF_M0 = OFF_BLAST + 4096;
constexpr size_t OFF_UT = 179 * MiB;
constexpr size_t OFF_VT = 195 * MiB;
constexpr size_t WS_END = 211 * MiB;
constexpr float PEER_SU = 812.8f;
constexpr float PEER_SV = 8.443f;
constexpr float PEER_SC = 2048.f;
constexpr size_t OFF_QRY = OFF_MQ;
constexpr size_t OFF_EIDX = OFF_MV;
constexpr size_t OFF_GW = OFF_MV + 8 * MiB;

struct Params {
    const float* x; const float* c; const float* w_ada; const float* b_ada; const float* norm1_g;
    const float* w_in; const float* b_in; const float* conv_qk; const float* out_norm_m; const float* out_norm_a;
    const float* w_out; const float* norm2_g; const float* w_peer_q; const float* sub_keys; const float* peer_u;
    const float* peer_v; const float* final_g;
    float* out; unsigned char* ws;
    int ph_lo, ph_hi;
};

__device__ __forceinline__ int opaque_tid() { int t = threadIdx.x; asm volatile("" : "+v"(t)); return t; }
__device__ __forceinline__ float bf2f(unsigned short b) { return __uint_as_float(((unsigned)b) << 16); }
__device__ __forceinline__ unsigned pack2(float lo, float hi) { unsigned r; asm("v_cvt_pk_bf16_f32 %0, %1, %2" : "=v"(r) : "v"(lo), "v"(hi)); return r; }
__device__ __forceinline__ unsigned short f2bf(float f) { return (unsigned short)(pack2(f, 0.f) & 0xffffu); }
__device__ __forceinline__ unsigned short f2bf_sw(float f) { unsigned u = __float_as_uint(f); u += 0x7FFFu + ((u >> 16) & 1u); return (unsigned short)(u >> 16); }
__device__ __forceinline__ float lo16(unsigned w) { return __uint_as_float(w << 16); }
__device__ __forceinline__ float hi16(unsigned w) { return __uint_as_float(w & 0xffff0000u); }
__device__ __forceinline__ float wave_sum(float v) {
#pragma unroll
    for (int o = 32; o >= 1; o >>= 1) v += __shfl_xor(v, o);
    return v;
}
__device__ __forceinline__ int wave_sum_i32_uniform(int v) {
    v += __builtin_amdgcn_update_dpp(0, v, 0xB1, 0xF, 0xF, true);
    v += __builtin_amdgcn_update_dpp(0, v, 0x4E, 0xF, 0xF, true);
    v += __builtin_amdgcn_update_dpp(0, v, 0x141, 0xF, 0xF, true);
    v += __builtin_amdgcn_update_dpp(0, v, 0x140, 0xF, 0xF, true);
    return __builtin_amdgcn_readlane(v, 0) + __builtin_amdgcn_readlane(v, 16) + __builtin_amdgcn_readlane(v, 32) + __builtin_amdgcn_readlane(v, 48);
}
__device__ __forceinline__ float wave_scan_add(float v, int lane) {
#pragma unroll
    for (int o = 1; o < 64; o <<= 1) { const float t = __shfl_up(v, o); if (lane >= o) v += t; }
    return v;
}
__device__ __forceinline__ float wave_scan_max(float v, int lane) {
#pragma unroll
    for (int o = 1; o < 64; o <<= 1) { const float t = __shfl_up(v, o); if (lane >= o) v = fmaxf(v, t); }
    return v;
}
__device__ __forceinline__ float wave_max(float v) {
#pragma unroll
    for (int o = 32; o >= 1; o >>= 1) v = fmaxf(v, __shfl_xor(v, o));
    return v;
}
#define dppf(v, ctrl) __uint_as_float((unsigned)__builtin_amdgcn_update_dpp(0, (int)__float_as_uint(v), (ctrl), 0xF, 0xF, true))
__device__ __forceinline__ float rlanef(float v, int l) { return __uint_as_float((unsigned)__builtin_amdgcn_readlane((int)__float_as_uint(v), l)); }
__device__ __forceinline__ float wave_sum_dpp(float v) {
    v += dppf(v, 0xB1); v += dppf(v, 0x4E); v += dppf(v, 0x141); v += dppf(v, 0x140);
    return (rlanef(v, 0) + rlanef(v, 16)) + (rlanef(v, 32) + rlanef(v, 48));
}
__device__ __forceinline__ float wave_max_dpp(float v) {
    v = fmaxf(v, dppf(v, 0xB1)); v = fmaxf(v, dppf(v, 0x4E)); v = fmaxf(v, dppf(v, 0x141)); v = fmaxf(v, dppf(v, 0x140));
    return fmaxf(fmaxf(rlanef(v, 0), rlanef(v, 16)), fmaxf(rlanef(v, 32), rlanef(v, 48)));
}
__device__ __forceinline__ float siluf(float x) { return x / (1.f + __expf(-x)); }
__device__ __forceinline__ float sigmoidf_(float x) { return 1.f / (1.f + __expf(-x)); }
__device__ __forceinline__ float logsigmoidf_(float x) { return fminf(x, 0.f) - log1pf(__expf(-fabsf(x))); }

#define XB_TMO      128
#define XB_XCNT(j)  (256  + 64 * (j))
#define XB_XSUB(j)  (1280 + 64 * (j))
#define XB_XGEN(j)  (2304 + 64 * (j))
#define XB_TOP      3328
#define XB_TOPGEN   3392
#define XCD_BAR_WORDS 3456
#define XB_SPIN_CAP (1u << 22)
__device__ __forceinline__ unsigned xb_ld(unsigned* p)              { return __hip_atomic_load(p, __ATOMIC_RELAXED, __HIP_MEMORY_SCOPE_AGENT); }
__device__ __forceinline__ unsigned xb_add(unsigned* p, unsigned v) { return __hip_atomic_fetch_add(p, v, __ATOMIC_RELAXED, __HIP_MEMORY_SCOPE_AGENT); }
__device__ __forceinline__ unsigned xb_xcc_id() { return (unsigned)__builtin_amdgcn_s_getreg((3 << 11) | 20) & 0xFu; }
#define XB_SPIN(cond, bar) do { unsigned _sp = 0; while (cond) { __builtin_amdgcn_s_sleep(1); \
    if ((++_sp & 255u) == 0u) { if (xb_ld(&(bar)[XB_TMO])) break; if (_sp > XB_SPIN_CAP) { atomicAdd(&(bar)[XB_TMO], 1u); break; } } } } while (0)
struct XcdBarrier { unsigned* bar; unsigned x; volatile LAS unsigned* st; };
__device__ __forceinline__ XcdBarrier xcd_barrier_post(unsigned* bar, volatile LAS unsigned* st) {
    XcdBarrier b; b.bar = bar; b.x = xb_xcc_id(); b.st = st;
    if (threadIdx.x == 0) (void)xb_add(&bar[XB_XCNT(b.x)], 1u);
    return b;
}
__device__ __forceinline__ void xcd_barrier_complete(unsigned* bar, unsigned x, unsigned& nloc, unsigned& nx) {
    const unsigned G = gridDim.x * gridDim.y * gridDim.z;
    unsigned sum, cnt, mine, sp = 0u;
    for (;;) {
        sum = 0u; cnt = 0u; mine = 0u;
#pragma unroll
        for (unsigned j = 0; j < 16; ++j) { const unsigned c = xb_ld(&bar[XB_XCNT(j)]); sum += c; cnt += (c > 0u) ? 1u : 0u; mine = (j == x) ? c : mine; }
        if (sum == G) break;
        __builtin_amdgcn_s_sleep(1);
        if ((++sp & 255u) == 0u) { if (xb_ld(&bar[XB_TMO])) break; if (sp > XB_SPIN_CAP) { atomicAdd(&bar[XB_TMO], 1u); break; } }
    }
    nloc = mine > 0u ? mine : 1u; nx = cnt > 0u ? cnt : 1u;
}
__device__ __forceinline__ void xcd_barrier(const XcdBarrier& b) {
    asm volatile("s_waitcnt vmcnt(0)" ::: "memory");
    __syncthreads();
    if (threadIdx.x == 0) {
        unsigned* bar = b.bar;
        __builtin_amdgcn_s_waitcnt(0);
        unsigned nloc = b.st[0], nx = b.st[1];
        if (nloc == 0u) { xcd_barrier_complete(bar, b.x, nloc, nx); b.st[0] = nloc; b.st[1] = nx; }
        const unsigned old = xb_add(&bar[XB_XSUB(b.x)], 1u);
        const unsigned gen = old / nloc;
        if (old + 1u == (gen + 1u) * nloc) {
            __builtin_amdgcn_fence(__ATOMIC_RELEASE, "agent");
            asm volatile("s_waitcnt vmcnt(0)" ::: "memory");
            const unsigned og = xb_add(&bar[XB_TOP], 1u);
            const unsigned tg = og / nx;
            if (og + 1u == (tg + 1u) * nx) xb_add(&bar[XB_TOPGEN], 1u);
            else XB_SPIN(xb_ld(&bar[XB_TOPGEN]) == tg, bar);
            __builtin_amdgcn_fence(__ATOMIC_ACQUIRE, "agent");
            xb_add(&bar[XB_XGEN(b.x)], 1u);
            asm volatile("s_waitcnt vmcnt(0)" ::: "memory");
        } else {
            XB_SPIN(xb_ld(&bar[XB_XGEN(b.x)]) == gen, bar);
            __builtin_amdgcn_fence(__ATOMIC_ACQUIRE, "agent");
            asm volatile("s_waitcnt vmcnt(0)" ::: "memory");
        }
    }
    __syncthreads();
}

#define CNT_ADA  3600
#define CNT_MLA  3664
#define CNT_SCAN 3728
__device__ __forceinline__ void wg_signal(unsigned* ctl, int word) {
    asm volatile("s_waitcnt vmcnt(0)" ::: "memory");
    __syncthreads();
    if (threadIdx.x == 0) {
        __builtin_amdgcn_fence(__ATOMIC_RELEASE, "agent");
        asm volatile("s_waitcnt vmcnt(0)" ::: "memory");
        (void)xb_add(&ctl[word], 1u);
    }
}
__device__ __forceinline__ void wg_wait(unsigned* ctl, int word, unsigned need) {
    if (threadIdx.x == 0) {
        XB_SPIN(xb_ld(&ctl[word]) < need, ctl);
        __builtin_amdgcn_fence(__ATOMIC_ACQUIRE, "agent");
        asm volatile("s_waitcnt vmcnt(0)" ::: "memory");
    }
    __syncthreads();
}

namespace pg8 {
constexpr int BM = 256, BK = 64, HALF = 128, HTB = HALF * BK * 2, STAGE_BYTES = 8 * HTB, NXCD = 8, WGM = 8;
__host__ __device__ __forceinline__ int lds_byte(int r, int c) { const int st = (r >> 4) * 2 + (c >> 5), rr = r & 15, cc = c & 31, ob = rr * 64 + cc * 2; return st * 1024 + (ob ^ (((ob >> 9) & 1) << 5)); }
__host__ __device__ __forceinline__ void stage_rc(int b, int& R, int& C) { const int st = b / 1024, sb = b % 1024, swz = sb ^ (((sb >> 9) & 1) << 5); R = (st >> 1) * 16 + swz / 64; C = (st & 1) * 32 + (swz % 64) / 2; }
__host__ __device__ __forceinline__ int perm32(int rho) { const int n = rho >> 4, i = rho & 15; return 8 * (i >> 2) + 4 * n + (i & 3); }
struct Unit { int pm, pn; };
struct Gemm { const bf16_t* A; const bf16_t* Bt; int M, N, K; };
struct StaticOrder {
    int nM, nN, nwg, G, c;
    __host__ __device__ void init(int M, int N, int G_, int c_) { nM = M / BM; nN = N / BM; nwg = nM * nN; G = G_; c = c_; }
    __host__ __device__ bool next(int i, Unit& u) const {
        const long L = (long)i * G + c; if (L >= nwg) return false;
        int wgid = (int)L; { const int q = nwg / NXCD, r = nwg % NXCD, xcd = wgid % NXCD, off = wgid / NXCD; wgid = (xcd < r ? xcd * (q + 1) : r * (q + 1) + (xcd - r) * q) + off; }
        const int nig = WGM * nN, gid = wgid / nig, fm = gid * WGM, gsz = (nM - fm) < WGM ? (nM - fm) : WGM;
        u.pm = fm + ((wgid % nig) % gsz); u.pn = (wgid % nig) / gsz; return true;
    }
    __device__ __forceinline__ void a_ready(const Unit&) const {}
    __device__ __forceinline__ void done(const Unit&) const {}
};
__device__ __forceinline__ unsigned cvt_pk_bf16(float lo, float hi) { unsigned r; asm volatile("v_cvt_pk_bf16_f32 %0, %1, %2" : "=v"(r) : "v"(lo), "v"(hi)); return r; }

template <class Epi, class Sched>
__device__ __forceinline__ void gemm_phase(LAS unsigned char* lds, const Gemm g, const Sched& S, const Epi& E) {
    const int tid = threadIdx.x, wid = __builtin_amdgcn_readfirstlane(tid >> 6), lane = tid & 63, wr = wid >> 2, wc = wid & 3, fr = lane & 15, fq = lane >> 4;
    const int K = g.K, nt = K / BK;
    unsigned voffA[2], voffB[2];
#pragma unroll
    for (int i = 0; i < 2; ++i) { int R, C; stage_rc(tid * 16 + i * 8192, R, C); const int Rb = Epi::PERM ? ((R & ~31) + perm32(R & 31)) : R;
        voffA[i] = (unsigned)(R * K + C) * 2u; voffB[i] = (unsigned)(Rb * K + C) * 2u; }
    const size_t kstep = (size_t)(BK * 2);
    const size_t hstep = (size_t)HALF * K * 2;
    const size_t tstep = 2 * hstep;
    const unsigned ldsw = (unsigned)wid * 1024u;
    const int aoff = lds_byte(wr * 64 + fr, fq * 8), boff = lds_byte(wc * 32 + fr, fq * 8);
#define PG8_SA(b, h) (((b) * 2 + (h)) * HTB)
#define PG8_SB(b, h) ((4 + (b) * 2 + (h)) * HTB)
#define PG8_STAGE(bufoff, gbase, voff) do { _Pragma("unroll") for (int _i = 0; _i < 2; ++_i) \
        __builtin_amdgcn_global_load_lds((const unsigned*)((const char*)(gbase) + (voff)[_i]), (LAS unsigned*)(lds + (bufoff) + ldsw + _i * 8192), 16, 0, 0); } while (0)
#define PG8_LDA(dst, b, h) do { _Pragma("unroll") for (int m = 0; m < 4; ++m) _Pragma("unroll") for (int k = 0; k < 2; ++k) dst[m][k] = *(const LAS bf16x8*)(lds + PG8_SA(b, h) + aoff + m * 2048 + k * 1024); } while (0)
#define PG8_LDB(dst, b, h) do { _Pragma("unroll") for (int n = 0; n < 2; ++n) _Pragma("unroll") for (int k = 0; k < 2; ++k) dst[n][k] = *(const LAS bf16x8*)(lds + PG8_SB(b, h) + boff + n * 2048 + k * 1024); } while (0)
#define PG8_MMA(ai, bj, At, Bt) do { __builtin_amdgcn_s_setprio(1); _Pragma("unroll") for (int m = 0; m < 4; ++m) _Pragma("unroll") for (int n = 0; n < 2; ++n) _Pragma("unroll") for (int k = 0; k < 2; ++k) \
        acc[ai][bj][m][n] = __builtin_amdgcn_mfma_f32_16x16x32_bf16(Bt[n][k], At[m][k], acc[ai][bj][m][n], 0, 0, 0); __builtin_amdgcn_s_setprio(0); } while (0)
#define PG8_WAIT_V(n) asm volatile("s_waitcnt vmcnt(" #n ")" ::: "memory")
#define PG8_WAIT_L(n) asm volatile("s_waitcnt lgkmcnt(" #n ")" ::: "memory")
#define PG8_BAR __builtin_amdgcn_s_barrier()
#define PG8_SCHED __builtin_amdgcn_sched_barrier(0)
    Unit cur, nxt; int ui = 0;
    if (!S.next(0, cur)) return;
    f32x4 acc[2][2][4][2];
#pragma unroll
    for (int a = 0; a < 2; ++a)
#pragma unroll
        for (int b = 0; b < 2; ++b)
#pragma unroll
            for (int m = 0; m < 4; ++m)
#pragma unroll
                for (int n = 0; n < 2; ++n) acc[a][b][m][n] = (f32x4){0.f, 0.f, 0.f, 0.f};
    bf16x8 At[4][2], B0[2][2], B1[2][2];
    const char* cA = (const char*)g.A + (size_t)cur.pm * tstep; const char* cB = (const char*)g.Bt + (size_t)cur.pn * tstep;
    S.a_ready(cur);
    PG8_STAGE(PG8_SB(0, 0), cB, voffB); PG8_STAGE(PG8_SA(0, 0), cA, voffA); PG8_STAGE(PG8_SB(0, 1), cB + hstep, voffB); PG8_STAGE(PG8_SA(0, 1), cA + hstep, voffA);
    if (wr == 1) PG8_BAR;
    PG8_WAIT_V(4); PG8_BAR;
    PG8_STAGE(PG8_SB(1, 0), cB + kstep, voffB); PG8_STAGE(PG8_SA(1, 0), cA + kstep, voffA); PG8_STAGE(PG8_SB(1, 1), cB + hstep + kstep, voffB);
    PG8_WAIT_V(6); PG8_BAR;
    for (;;) {
        const bool has_next = S.next(ui + 1, nxt);
        const char* nA = has_next ? (const char*)g.A + (size_t)nxt.pm * tstep : cA; const char* nB = has_next ? (const char*)g.Bt + (size_t)nxt.pn * tstep : cB;
        for (int t = 0; t < nt; t += 2) {
            const bool last = (t == nt - 2);
            const char* a1 = cA + (size_t)(t + 1) * kstep;
            const char* a2 = last ? nA : cA + (size_t)(t + 2) * kstep; const char* b2 = last ? nB : cB + (size_t)(t + 2) * kstep;
            const char* a3 = a2 + kstep; const char* b3 = b2 + kstep;
            if (last && has_next) S.a_ready(nxt);
            PG8_LDB(B0, 0, 0); PG8_SCHED; PG8_LDA(At, 0, 0); PG8_STAGE(PG8_SA(1, 1), a1 + hstep, voffA);
            PG8_WAIT_L(8); PG8_BAR; PG8_WAIT_L(0); PG8_MMA(0, 0, At, B0); PG8_BAR; PG8_SCHED;
            PG8_LDB(B1, 0, 1); PG8_STAGE(PG8_SB(0, 0), b2, voffB);
            PG8_BAR; PG8_WAIT_L(0); PG8_MMA(0, 1, At, B1); PG8_BAR;
            PG8_LDA(At, 0, 1); PG8_STAGE(PG8_SA(0, 0), a2, voffA);
            PG8_BAR; PG8_WAIT_L(0); PG8_MMA(1, 0, At, B0); PG8_BAR; PG8_SCHED;
            PG8_STAGE(PG8_SB(0, 1), b2 + hstep, voffB);
            PG8_WAIT_V(6); PG8_BAR; PG8_MMA(1, 1, At, B1); PG8_BAR;
            PG8_LDB(B0, 1, 0); PG8_SCHED; PG8_LDA(At, 1, 0); PG8_STAGE(PG8_SA(0, 1), a2 + hstep, voffA);
            PG8_WAIT_L(8); PG8_BAR; PG8_WAIT_L(0); PG8_MMA(0, 0, At, B0); PG8_BAR; PG8_SCHED;
            PG8_LDB(B1, 1, 1); PG8_STAGE(PG8_SB(1, 0), b3, voffB);
            PG8_BAR; PG8_WAIT_L(0); PG8_MMA(0, 1, At, B1); PG8_BAR;
            PG8_LDA(At, 1, 1); PG8_STAGE(PG8_SA(1, 0), a3, voffA);
            PG8_BAR; PG8_WAIT_L(0); PG8_MMA(1, 0, At, B0); PG8_BAR; PG8_SCHED;
            PG8_STAGE(PG8_SB(1, 1), b3 + hstep, voffB);
            PG8_WAIT_V(6); PG8_BAR; PG8_MMA(1, 1, At, B1); PG8_BAR;
        }
        asm volatile("s_nop 15\n\ts_nop 15" ::: "memory");
        E(acc, cur, wr, wc, fr, fq); S.done(cur);
        if (!has_next) break;
#pragma unroll
        for (int a = 0; a < 2; ++a)
#pragma unroll
            for (int b = 0; b < 2; ++b)
#pragma unroll
                for (int m = 0; m < 4; ++m)
#pragma unroll
                    for (int n = 0; n < 2; ++n) acc[a][b][m][n] = (f32x4){0.f, 0.f, 0.f, 0.f};
        cur = nxt; cA = nA; cB = nB; ++ui;
    }
    PG8_WAIT_V(0);
    if (wr == 0) PG8_BAR;
    PG8_BAR;
#undef PG8_SA
#undef PG8_SB
#undef PG8_STAGE
#undef PG8_LDA
#undef PG8_LDB
#undef PG8_MMA
#undef PG8_WAIT_V
#undef PG8_WAIT_L
#undef PG8_BAR
#undef PG8_SCHED
}
}

struct EpiInMain {
    static constexpr bool PERM = true;
    unsigned char* ws; const float* bias;
    __device__ __forceinline__ void operator()(const f32x4 (&acc)[2][2][4][2], const pg8::Unit& u, int wr, int wc, int fr, int fq) const {
        const int row0 = u.pm * 256 + wr * 64 + fr;
        const int cl0 = wc * 32 + 8 * fq;
        bf16_t* base = (bf16_t*)(ws + OFF_MQ + (size_t)(u.pn >> 1) * (16 * MiB)) + (u.pn & 1) * 256 + cl0;
        const float* bp = bias + u.pn * 256 + cl0;
#pragma unroll
        for (int bj = 0; bj < 2; ++bj) {
            const f32x4 b0 = *(const f32x4*)(bp + bj * 128), b1 = *(const f32x4*)(bp + bj * 128 + 4);
#pragma unroll
            for (int ai = 0; ai < 2; ++ai)
#pragma unroll
                for (int m = 0; m < 4; ++m) {
                    const f32x4 v0 = acc[ai][bj][m][0] + b0, v1 = acc[ai][bj][m][1] + b1;
                    u32x4 o; o[0] = pg8::cvt_pk_bf16(v0[0], v0[1]); o[1] = pg8::cvt_pk_bf16(v0[2], v0[3]); o[2] = pg8::cvt_pk_bf16(v1[0], v1[1]); o[3] = pg8::cvt_pk_bf16(v1[2], v1[3]);
                    *(u32x4*)(base + (size_t)(row0 + ai * 128 + m * 16) * 512 + bj * 128) = o;
                }
        }
    }
};
struct EpiInTail {
    static constexpr bool PERM = true;
    unsigned char* ws; const float* bias;
    __device__ __forceinline__ void operator()(const f32x4 (&acc)[2][2][4][2], const pg8::Unit& u, int wr, int wc, int fr, int fq) const {
        const int row0 = u.pm * 256 + wr * 64 + fr;
        const int cl0 = wc * 32 + 8 * fq;
#pragma unroll
        for (int bj = 0; bj < 2; ++bj) {
            const int cl = bj * 128 + cl0;
            if (cl >= 208) continue;
            const f32x4 b0 = *(const f32x4*)(bias + cl), b1 = *(const f32x4*)(bias + cl + 4);
            if (cl < 192) {
                bf16_t* dst = (bf16_t*)(ws + OFF_AK + (size_t)(cl >> 6) * (2 * MiB)) + (cl & 63);
#pragma unroll
                for (int ai = 0; ai < 2; ++ai)
#pragma unroll
                    for (int m = 0; m < 4; ++m) {
                        const f32x4 v0 = acc[ai][bj][m][0] + b0, v1 = acc[ai][bj][m][1] + b1;
                        u32x4 o; o[0] = pg8::cvt_pk_bf16(v0[0], v0[1]); o[1] = pg8::cvt_pk_bf16(v0[2], v0[3]); o[2] = pg8::cvt_pk_bf16(v1[0], v1[1]); o[3] = pg8::cvt_pk_bf16(v1[2], v1[3]);
                        *(u32x4*)(dst + (size_t)(row0 + ai * 128 + m * 16) * 64) = o;
                    }
            } else {
                float* dst = (float*)(ws + OFF_GATE) + (cl - 192);
#pragma unroll
                for (int ai = 0; ai < 2; ++ai)
#pragma unroll
                    for (int m = 0; m < 4; ++m) {
                        float* d = dst + (size_t)(row0 + ai * 128 + m * 16) * 16;
                        *(f32x4*)d = acc[ai][bj][m][0] + b0; *(f32x4*)(d + 4) = acc[ai][bj][m][1] + b1;
                    }
            }
        }
    }
};
struct EpiOut {
    static constexpr bool PERM = false;
    const float* x; const float* ada; float* out;
    __device__ __forceinline__ void operator()(const f32x4 (&acc)[2][2][4][2], const pg8::Unit& u, int wr, int wc, int fr, int fq) const {
        const int row0 = u.pm * 256 + wr * 64 + fr, col0 = u.pn * 256 + wc * 32 + 4 * fq;
        const int b = (u.pm * 256) >> 12;
        f32x4 gv[2][2];
#pragma unroll
        for (int bj = 0; bj < 2; ++bj)
#pragma unroll
            for (int n = 0; n < 2; ++n) gv[bj][n] = *(const f32x4*)(ada + b * 6144 + 2048 + col0 + bj * 128 + n * 16);
#pragma unroll
        for (int ai = 0; ai < 2; ++ai)
#pragma unroll
            for (int m = 0; m < 4; ++m) {
                const size_t ro = (size_t)(row0 + ai * 128 + m * 16) * 1024 + col0;
#pragma unroll
                for (int bj = 0; bj < 2; ++bj)
#pragma unroll
                    for (int n = 0; n < 2; ++n) {
                        const f32x4 xv = *(const f32x4*)(x + ro + bj * 128 + n * 16);
                        *(f32x4*)(out + ro + bj * 128 + n * 16) = xv + gv[bj][n] * acc[ai][bj][m][n];
                    }
            }
    }
};
struct EpiQry {
    static constexpr bool PERM = true;
    bf16_t* O;
    __device__ __forceinline__ void operator()(const f32x4 (&acc)[2][2][4][2], const pg8::Unit& u, int wr, int wc, int fr, int fq) const {
        const int row0 = u.pm * 256 + wr * 64 + fr, col0 = u.pn * 256 + wc * 32 + 8 * fq;
#pragma unroll
        for (int ai = 0; ai < 2; ++ai)
#pragma unroll
            for (int m = 0; m < 4; ++m) {
                bf16_t* rowp = O + (size_t)(row0 + ai * 128 + m * 16) * 1024 + col0;
#pragma unroll
                for (int bj = 0; bj < 2; ++bj) {
                    const f32x4 v0 = acc[ai][bj][m][0], v1 = acc[ai][bj][m][1];
                    u32x4 o; o[0] = pg8::cvt_pk_bf16(v0[0], v0[1]); o[1] = pg8::cvt_pk_bf16(v0[2], v0[3]); o[2] = pg8::cvt_pk_bf16(v1[0], v1[1]); o[3] = pg8::cvt_pk_bf16(v1[2], v1[3]);
                    *(u32x4*)(rowp + bj * 128) = o;
                }
            }
    }
};

__device__ __forceinline__ int inperm_src(int n) {
    if (n < 2048) return n;
    if (n < 2560) return 2056 + (n - 2048);
    if (n < 3072) return 2696 + (n - 2560);
    if (n < 3136) return 2568 + (n - 3072);
    if (n < 3200) return 2632 + (n - 3136);
    if (n < 3264) return 3208 + (n - 3200);
    if (n < 3268) return 2048 + (n - 3264);
    if (n < 3272) return 2052 + (n - 3268);
    if (n < 3280) return 3272 + (n - 3272);
    return -1;
}
template <bool PERMUTE>
__device__ __forceinline__ void transpose_tile(const float* src, int ld, bf16_t* dst, int n0, int k0, LAS float* t) {
    const int tid = threadIdx.x;
    for (int i = tid; i < 4096; i += NTHREADS) {
        const int kk = i >> 6, nn = i & 63;
        const int sc = PERMUTE ? inperm_src(n0 + nn) : (n0 + nn);
        t[kk * 65 + nn] = sc >= 0 ? src[(size_t)(k0 + kk) * ld + sc] : 0.f;
    }
    __syncthreads();
    for (int i = tid; i < 2048; i += NTHREADS) {
        const int nn = i >> 5, kp = (i & 31) * 2;
        ((unsigned*)dst)[((size_t)(n0 + nn) * 1024 + k0 + kp) >> 1] = pack2(t[kp * 65 + nn], t[(kp + 1) * 65 + nn]);
    }
    __syncthreads();
}
__device__ __forceinline__ void convert_chunk(const float* src, bf16_t* dst, size_t e0, int n) {
    for (int i = threadIdx.x * 8; i < n; i += NTHREADS * 8) {
        const f32x4 a = *(const f32x4*)(src + e0 + i), b = *(const f32x4*)(src + e0 + i + 4);
        u32x4 o; o[0] = pack2(a[0], a[1]); o[1] = pack2(a[2], a[3]); o[2] = pack2(b[0], b[1]); o[3] = pack2(b[2], b[3]);
        *(u32x4*)(dst + e0 + i) = o;
    }
}
__device__ __forceinline__ unsigned pack4_fp8(float a, float b, float c, float d) {
    a = fminf(fmaxf(a, -448.f), 448.f); b = fminf(fmaxf(b, -448.f), 448.f); c = fminf(fmaxf(c, -448.f), 448.f); d = fminf(fmaxf(d, -448.f), 448.f);
    int w = 0;
    w = __builtin_amdgcn_cvt_pk_fp8_f32(a, b, w, false);
    w = __builtin_amdgcn_cvt_pk_fp8_f32(c, d, w, true);
    return (unsigned)w;
}
__device__ __forceinline__ void convert_chunk_fp8(const float* src, unsigned char* dst, size_t e0, int n, float scale) {
    for (int i = threadIdx.x * 16; i < n; i += NTHREADS * 16) {
        const f32x4 a = *(const f32x4*)(src + e0 + i), b = *(const f32x4*)(src + e0 + i + 4), c = *(const f32x4*)(src + e0 + i + 8), d = *(const f32x4*)(src + e0 + i + 12);
        u32x4 o; o[0] = pack4_fp8(a[0] * scale, a[1] * scale, a[2] * scale, a[3] * scale); o[1] = pack4_fp8(b[0] * scale, b[1] * scale, b[2] * scale, b[3] * scale);
        o[2] = pack4_fp8(c[0] * scale, c[1] * scale, c[2] * scale, c[3] * scale); o[3] = pack4_fp8(d[0] * scale, d[1] * scale, d[2] * scale, d[3] * scale);
        *(u32x4*)(dst + e0 + i) = o;
    }
}
__device__ __forceinline__ unsigned pack8_fp4(const f32x4 a, const f32x4 b, float scale) {
    float v[8] = {a[0] * scale, a[1] * scale, a[2] * scale, a[3] * scale, b[0] * scale, b[1] * scale, b[2] * scale, b[3] * scale};
#pragma unroll
    for (int i = 0; i < 8; ++i) v[i] = fminf(fmaxf(v[i], -6.f), 6.f);
    unsigned w = 0;
    w = __builtin_amdgcn_cvt_scalef32_pk_fp4_f32(w, v[0], v[1], 1.0f, 0);
    w = __builtin_amdgcn_cvt_scalef32_pk_fp4_f32(w, v[2], v[3], 1.0f, 1);
    w = __builtin_amdgcn_cvt_scalef32_pk_fp4_f32(w, v[4], v[5], 1.0f, 2);
    w = __builtin_amdgcn_cvt_scalef32_pk_fp4_f32(w, v[6], v[7], 1.0f, 3);
    return w;
}
__device__ __forceinline__ void convert_chunk_fp4(const float* src, unsigned char* dst, size_t e0, int n, float scale) {
    for (int i = threadIdx.x * 32; i < n; i += NTHREADS * 32) {
        u32x4 o;
#pragma unroll
        for (int k = 0; k < 4; ++k) o[k] = pack8_fp4(*(const f32x4*)(src + e0 + i + 8 * k), *(const f32x4*)(src + e0 + i + 8 * k + 4), scale);
        *(u32x4*)(dst + ((e0 + i) >> 1)) = o;
    }
}
__device__ __forceinline__ unsigned pack4_i8(float a, float b, float c, float d, float scale) {
    const int ia = (int)fminf(fmaxf(rintf(a * scale), -127.f), 127.f), ib = (int)fminf(fmaxf(rintf(b * scale), -127.f), 127.f);
    const int ic = (int)fminf(fmaxf(rintf(c * scale), -127.f), 127.f), id = (int)fminf(fmaxf(rintf(d * scale), -127.f), 127.f);
    return (unsigned)(ia & 0xFF) | ((unsigned)(ib & 0xFF) << 8) | ((unsigned)(ic & 0xFF) << 16) | ((unsigned)(id & 0xFF) << 24);
}
__device__ __forceinline__ void convert_chunk_i8(const float* src, unsigned char* dst, size_t e0, int n, float scale) {
    for (int i = threadIdx.x * 16; i < n; i += NTHREADS * 16) {
        const f32x4 a = *(const f32x4*)(src + e0 + i), b = *(const f32x4*)(src + e0 + i + 4), c = *(const f32x4*)(src + e0 + i + 8), d = *(const f32x4*)(src + e0 + i + 12);
        u32x4 o; o[0] = pack4_i8(a[0], a[1], a[2], a[3], scale); o[1] = pack4_i8(b[0], b[1], b[2], b[3], scale); o[2] = pack4_i8(c[0], c[1], c[2], c[3], scale); o[3] = pack4_i8(d[0], d[1], d[2], d[3], scale);
        *(u32x4*)(dst + e0 + i) = o;
    }
}
__device__ __forceinline__ unsigned pack8_i4(const f32x4 a, const f32x4 b, float scale) {
    unsigned w = 0;
#pragma unroll
    for (int k = 0; k < 4; ++k) {
        const int qa = (int)fminf(fmaxf(rintf(a[k] * scale), -7.f), 7.f) + 8, qb = (int)fminf(fmaxf(rintf(b[k] * scale), -7.f), 7.f) + 8;
        w |= (unsigned)qa << (4 * k); w |= (unsigned)qb << (4 * (k + 4));
    }
    return w;
}
__device__ __forceinline__ void convert_chunk_i4(const float* src, unsigned char* dst, size_t e0, int n, float scale) {
    for (int i = threadIdx.x * 32; i < n; i += NTHREADS * 32) {
        u32x4 o;
#pragma unroll
        for (int k = 0; k < 4; ++k) o[k] = pack8_i4(*(const f32x4*)(src + e0 + i + 8 * k), *(const f32x4*)(src + e0 + i + 8 * k + 4), scale);
        *(u32x4*)(dst + ((e0 + i) >> 1)) = o;
    }
}
__device__ __forceinline__ void convert_tables(const Params& p, int first, int stride) {
    for (int it = first; it < 1024; it += stride) {
        const int tsel = it >> 9; const size_t e0 = (size_t)(it & 511) * 32768;
        if (tsel) convert_chunk_i4(p.peer_v, p.ws + OFF_VT, e0, 32768, PEER_SV); else convert_chunk_i8(p.peer_u, p.ws + OFF_UT, e0, 32768, PEER_SU);
    }
}
__device__ __forceinline__ void phase0(const Params& p, LAS unsigned char* lds) {
    const int tid = threadIdx.x;
    float* ada = (float*)(p.ws + OFF_ADA);
    LAS float* lf = (LAS float*)lds;
    constexpr int N_ADA = 192, N_WIN = 52 * 16, N_WOUT = 256, N_WPQ = 256, N_SK = 4, N_BIAS = 1;
    constexpr int NITEMS = N_ADA + N_WIN + N_WOUT + N_WPQ + N_SK + N_BIAS;
    if (blockIdx.x < N_ADA) {
        {
            const int it = blockIdx.x;
            LAS float* sc = lf; LAS float* red = lf + 4096;
            for (int i = tid; i < 4096; i += NTHREADS) sc[i] = siluf(p.c[i]);
            __syncthreads();
            const int col = tid & 31, kg = tid >> 5, c0 = it * 32;
            float a0 = 0.f, a1 = 0.f, a2 = 0.f, a3 = 0.f;
            const float* w = p.w_ada + c0 + col;
#pragma unroll 8
            for (int j = 0; j < 64; ++j) { const int k = kg + 16 * j; const float wv = w[(size_t)k * 6144];
                a0 += sc[k] * wv; a1 += sc[1024 + k] * wv; a2 += sc[2048 + k] * wv; a3 += sc[3072 + k] * wv; }
            red[(kg * 4 + 0) * 32 + col] = a0; red[(kg * 4 + 1) * 32 + col] = a1; red[(kg * 4 + 2) * 32 + col] = a2; red[(kg * 4 + 3) * 32 + col] = a3;
            __syncthreads();
            if (tid < 128) { const int b = tid >> 5, cc = tid & 31; float s = 0.f;
                for (int g = 0; g < 16; ++g) s += red[(g * 4 + b) * 32 + cc];
                ada[b * 6144 + c0 + cc] = s + p.b_ada[c0 + cc]; }
        }
        wg_signal((unsigned*)(p.ws + OFF_CTL), CNT_ADA);
        __syncthreads();
    }
    for (int item = N_ADA + ((blockIdx.x + gridDim.x - N_ADA) % gridDim.x); item < NITEMS; item += gridDim.x) {
        int it = item;
        it -= N_ADA;
        if (it < N_WIN) { transpose_tile<true>(p.w_in, 3280, (bf16_t*)(p.ws + OFF_WIN), (it >> 4) * 64, (it & 15) * 64, lf); continue; }
        it -= N_WIN;
        if (it < N_WOUT) { transpose_tile<false>(p.w_out, 1024, (bf16_t*)(p.ws + OFF_WOUT), (it >> 4) * 64, (it & 15) * 64, lf); continue; }
        it -= N_WOUT;
        if (it < N_WPQ) { transpose_tile<false>(p.w_peer_q, 1024, (bf16_t*)(p.ws + OFF_WPQ), (it >> 4) * 64, (it & 15) * 64, lf); continue; }
        it -= N_WPQ;

        if (it < N_SK) { convert_chunk(p.sub_keys, (bf16_t*)(p.ws + OFF_SK), (size_t)it * 32768, 32768); continue; }
        it -= N_SK;
        { float* bias = (float*)(p.ws + OFF_BIAS);
          for (int n = tid; n < NIN_PAD; n += NTHREADS) { const int s = inperm_src(n); bias[n] = s >= 0 ? p.b_in[s] : 0.f; } }
    }
}

__device__ __forceinline__ void norm_mod_rows(const float* X, const float* g, const float* ada, int sh_off, int sc_off, bf16_t* out) {
    const int wid = threadIdx.x >> 6, lane = threadIdx.x & 63;
    for (int row = (blockIdx.x * 8 + wid) * 2; row < NTOK; row += gridDim.x * 16) {
        const int b = row >> 12;
        f32x4 v[2][4]; float ss[2] = {0.f, 0.f};
#pragma unroll
        for (int rr = 0; rr < 2; ++rr)
#pragma unroll
            for (int j = 0; j < 4; ++j) v[rr][j] = *(const f32x4*)(X + (size_t)(row + rr) * 1024 + 4 * (lane + 64 * j));
#pragma unroll
        for (int rr = 0; rr < 2; ++rr)
#pragma unroll
            for (int j = 0; j < 4; ++j) ss[rr] += v[rr][j][0] * v[rr][j][0] + v[rr][j][1] * v[rr][j][1] + v[rr][j][2] * v[rr][j][2] + v[rr][j][3] * v[rr][j][3];
        ss[0] = wave_sum(ss[0]); ss[1] = wave_sum(ss[1]);
        const float rstd0 = rsqrtf(ss[0] * (1.f / 1024.f) + 1e-6f), rstd1 = rsqrtf(ss[1] * (1.f / 1024.f) + 1e-6f);
#pragma unroll
        for (int j = 0; j < 4; ++j) {
            const int c = 4 * (lane + 64 * j);
            const f32x4 gg = *(const f32x4*)(g + c), sc = *(const f32x4*)(ada + b * 6144 + sc_off + c), sh = *(const f32x4*)(ada + b * 6144 + sh_off + c);
#pragma unroll
            for (int rr = 0; rr < 2; ++rr) {
                const float rstd = rr ? rstd1 : rstd0;
                float h[4];
#pragma unroll
                for (int i = 0; i < 4; ++i) h[i] = (v[rr][j][i] * rstd * gg[i]) * (1.f + sc[i]) + sh[i];
                u32x2 o; o[0] = pack2(h[0], h[1]); o[1] = pack2(h[2], h[3]);
                *(u32x2*)(out + (size_t)(row + rr) * 1024 + c) = o;
            }
        }
    }
}

__device__ __forceinline__ bf16x8 lds_frag(const LAS bf16_t* base, int row, int stride, int kofs) { return *(const LAS bf16x8*)(base + row * stride + kofs); }

__device__ __forceinline__ void conv_silu8(const bf16_t* src, const float* cw  , int row, int tpos, int col, float scale, float (&o)[8]) {
    float acc[8];
#pragma unroll
    for (int i = 0; i < 8; ++i) acc[i] = 0.f;
#pragma unroll
    for (int j = 0; j < 4; ++j) {
        const int tt = tpos - 3 + j;
        if (tt >= 0) {
            const u32x4 xv = *(const u32x4*)(src + (size_t)(row - 3 + j) * 512 + col);
            const f32x4 w0 = *(const f32x4*)(cw + j * 1024), w1 = *(const f32x4*)(cw + j * 1024 + 4);
            acc[0] += w0[0] * lo16(xv[0]); acc[1] += w0[1] * hi16(xv[0]); acc[2] += w0[2] * lo16(xv[1]); acc[3] += w0[3] * hi16(xv[1]);
            acc[4] += w1[0] * lo16(xv[2]); acc[5] += w1[1] * hi16(xv[2]); acc[6] += w1[2] * lo16(xv[3]); acc[7] += w1[3] * hi16(xv[3]);
        }
    }
#pragma unroll
    for (int i = 0; i < 8; ++i) o[i] = siluf(acc[i]) * scale;
}

__device__ __forceinline__ void mlstm_passA(const Params& p, int task, LAS unsigned char* lds) {
    const int tid = opaque_tid(), wid = tid >> 6, lane = tid & 63;
    const int bh = task >> 6, c = task & 63, b = bh >> 2, h = bh & 3;
    const int row0 = b * SEQ + c * 64;
    const float* gates = (const float*)(p.ws + OFF_GATE);
    const bf16_t* MK = (const bf16_t*)(p.ws + OFF_MK); const bf16_t* MV = (const bf16_t*)(p.ws + OFF_MV);
    LAS bf16_t* KT = (LAS bf16_t*)lds;
    LAS bf16_t* VT = KT + 128 * 72;
    LAS float* sc = (LAS float*)(VT + 128 * 72);
    LAS float* lsg = sc; LAS float* ig = sc + 64; LAS float* wloc = sc + 128; LAS float* misc = sc + 192;
    if (tid < 64) {
        const float f = gates[(size_t)(row0 + tid) * 16 + 4 + h], iv = gates[(size_t)(row0 + tid) * 16 + h];
        const float bc = wave_scan_add(logsigmoidf_(f), lane);
        const float bl = __shfl(bc, 63);
        const float a = bl - bc + iv;
        const float m = wave_max(a);
        lsg[tid] = bc; ig[tid] = iv; wloc[tid] = __expf(a - m);
        if (tid == 0) { misc[0] = m; misc[1] = bl; }
    }
    __syncthreads();
    for (int pc = tid; pc < 1024; pc += NTHREADS) {
        const int s = pc >> 4, dg = pc & 15;
        float kk[8];
        conv_silu8(MK, p.conv_qk + 512 + h * 128 + dg * 8, row0 + s, c * 64 + s, h * 128 + dg * 8, 1.f, kk);
#pragma unroll
        for (int i = 0; i < 8; ++i) KT[(dg * 8 + i) * 72 + s] = f2bf(kk[i]);
        const u32x4 vv = *(const u32x4*)(MV + (size_t)(row0 + s) * 512 + h * 128 + dg * 8);
        const float w = wloc[s];
#pragma unroll
        for (int i = 0; i < 4; ++i) { VT[(dg * 8 + 2 * i) * 72 + s] = f2bf(lo16(vv[i]) * w); VT[(dg * 8 + 2 * i + 1) * 72 + s] = f2bf(hi16(vv[i]) * w); }
    }
    __syncthreads();
    {
        const int r = lane & 15, g = lane >> 4;
        bf16x8 a0 = lds_frag(VT, wid * 16 + r, 72, 8 * g), a1 = lds_frag(VT, wid * 16 + r, 72, 8 * g + 32);
        bf16_t* KV = (bf16_t*)(p.ws + OFF_KV) + (size_t)task * 16384;
#pragma unroll
        for (int dt = 0; dt < 8; ++dt) {
            f32x4 acc = {0.f, 0.f, 0.f, 0.f};
            acc = __builtin_amdgcn_mfma_f32_16x16x32_bf16(a0, lds_frag(KT, dt * 16 + r, 72, 8 * g), acc, 0, 0, 0);
            acc = __builtin_amdgcn_mfma_f32_16x16x32_bf16(a1, lds_frag(KT, dt * 16 + r, 72, 8 * g + 32), acc, 0, 0, 0);
#pragma unroll
            for (int j = 0; j < 4; ++j) KV[(wid * 16 + 4 * g + j) * 128 + dt * 16 + r] = f2bf_sw(acc[j]);
        }
    }
    if (tid < 128) {
        float s = 0.f;
        for (int i = 0; i < 64; ++i) s += wloc[i] * bf2f(KT[tid * 72 + i]);
        ((float*)(p.ws + OFF_KS))[(size_t)task * 128 + tid] = s;
    }
    if (tid == 0) { ((float*)(p.ws + OFF_MLOC))[task] = misc[0]; ((float*)(p.ws + OFF_BLAST))[task] = misc[1]; }
    __syncthreads();
}

__device__ __forceinline__ void mlstm_scan(const Params& p, int item, LAS unsigned char* lds) {
    const int tid = opaque_tid();
    const int bh = item >> 4, blk = item & 15;
    LAS float* dec = (LAS float*)lds; LAS float* inj = dec + 64;
    if (tid == 0) {
        const float* ML = (const float*)(p.ws + OFF_MLOC); const float* BL = (const float*)(p.ws + OFF_BLAST); float* M0 = (float*)(p.ws + OFF_M0);
        float m = 0.f;
        for (int c = 0; c < 64; ++c) {
            const float ml = ML[bh * 64 + c], bl = BL[bh * 64 + c];
            if (blk == 0) M0[bh * 64 + c] = m;
            const float mn = fmaxf(bl + m, ml);
            dec[c] = __expf(bl + m - mn); inj[c] = __expf(ml - mn); m = mn;
        }
    }
    __syncthreads();
    unsigned* KV = (unsigned*)(p.ws + OFF_KV) + (size_t)bh * 64 * 8192 + blk * 512 + tid;
    float s0 = 0.f, s1 = 0.f;
#pragma unroll 8
    for (int c = 0; c < 64; ++c) {
        const unsigned w = KV[(size_t)c * 8192];
        KV[(size_t)c * 8192] = pack2(s0, s1);
        s0 = dec[c] * s0 + inj[c] * lo16(w); s1 = dec[c] * s1 + inj[c] * hi16(w);
    }
    if (blk == 0 && tid < 128) {
        float* KS = (float*)(p.ws + OFF_KS) + (size_t)bh * 64 * 128 + tid;
        float s = 0.f;
        for (int c = 0; c < 64; ++c) { const float k = KS[c * 128]; KS[c * 128] = s; s = dec[c] * s + inj[c] * k; }
    }
    __syncthreads();
}

__device__ __forceinline__ void mlstm_passB(const Params& p, int task, LAS unsigned char* lds) {
    const int tid = opaque_tid(), wid = tid >> 6, lane = tid & 63;
    const int bh = task >> 6, c = task & 63, b = bh >> 2, h = bh & 3;
    const int row0 = b * SEQ + c * 64;
    const float* gates = (const float*)(p.ws + OFF_GATE);
    const bf16_t* MQ = (const bf16_t*)(p.ws + OFF_MQ); const bf16_t* MK = (const bf16_t*)(p.ws + OFF_MK);
    const bf16_t* MV = (const bf16_t*)(p.ws + OFF_MV); const bf16_t* MO = (const bf16_t*)(p.ws + OFF_MO);
    LAS bf16_t* Q = (LAS bf16_t*)lds;
    LAS bf16_t* K = Q + 64 * 136;
    LAS bf16_t* VT = K + 64 * 136;
    LAS bf16_t* C0 = VT + 128 * 72;
    LAS bf16_t* P = C0 + 128 * 136;
    LAS float* sc = (LAS float*)(P + 64 * 72);
    LAS float* bcum = sc; LAS float* ig = sc + 64; LAS float* cs = sc + 128; LAS float* rb = sc + 192; LAS float* wint = sc + 256;
    LAS float* emt = sc + 320; LAS float* rinv = sc + 384; LAS float* qn = sc + 448; LAS float* n0 = sc + 512; LAS float* rowpart = sc + 640;
    LAS float* H = (LAS float*)lds;
    if (tid < 64) {
        const float f = gates[(size_t)(row0 + tid) * 16 + 4 + h], iv = gates[(size_t)(row0 + tid) * 16 + h];
        const float m0 = ((const float*)(p.ws + OFF_M0))[task];
        const float sc_ = wave_scan_add(logsigmoidf_(f), lane);
        const float cst = iv - sc_;
        const float pm = wave_scan_max(cst, lane);
        const float m_intra = sc_ + pm, m_inter = sc_ + m0, mt = fmaxf(m_inter, m_intra);
        bcum[tid] = sc_; ig[tid] = iv; cs[tid] = cst; rb[tid] = sc_ - mt; wint[tid] = __expf(m_inter - mt); emt[tid] = __expf(-mt);
    }
    if (tid >= 64 && tid < 192) n0[tid - 64] = ((const float*)(p.ws + OFF_KS))[(size_t)task * 128 + tid - 64];
    for (int pc = tid; pc < 1024; pc += NTHREADS) {
        const int s = pc >> 4, dg = pc & 15;
        float qq[8], kk[8];
        conv_silu8(MQ, p.conv_qk + h * 128 + dg * 8, row0 + s, c * 64 + s, h * 128 + dg * 8, 0.08838834764831845f, qq);
        conv_silu8(MK, p.conv_qk + 512 + h * 128 + dg * 8, row0 + s, c * 64 + s, h * 128 + dg * 8, 1.f, kk);
        u32x4 qo, ko;
#pragma unroll
        for (int i = 0; i < 4; ++i) { qo[i] = pack2(qq[2 * i], qq[2 * i + 1]); ko[i] = pack2(kk[2 * i], kk[2 * i + 1]); }
        *(LAS u32x4*)(Q + s * 136 + dg * 8) = qo; *(LAS u32x4*)(K + s * 136 + dg * 8) = ko;
        const u32x4 vv = *(const u32x4*)(MV + (size_t)(row0 + s) * 512 + h * 128 + dg * 8);
#pragma unroll
        for (int i = 0; i < 4; ++i) { VT[(dg * 8 + 2 * i) * 72 + s] = (bf16_t)(vv[i] & 0xffffu); VT[(dg * 8 + 2 * i + 1) * 72 + s] = (bf16_t)(vv[i] >> 16); }
    }
    {
        const bf16_t* KV = (const bf16_t*)(p.ws + OFF_KV) + (size_t)task * 16384;
        for (int pc = tid; pc < 2048; pc += NTHREADS) { const int e = pc >> 4, dg = pc & 15;
            *(LAS u32x4*)(C0 + e * 136 + dg * 8) = *(const u32x4*)(KV + e * 128 + dg * 8); }
    }
    __syncthreads();
    const int r = lane & 15, g = lane >> 4;
    {
        const int t = tid >> 3, part = tid & 7; float s = 0.f;
#pragma unroll
        for (int i = 0; i < 16; ++i) s += bf2f(Q[t * 136 + part * 16 + i]) * n0[part * 16 + i];
        s += __shfl_xor(s, 1); s += __shfl_xor(s, 2); s += __shfl_xor(s, 4);
        if (part == 0) qn[t] = s;
    }
    {
        const int rt = wid >> 1;
#pragma unroll
        for (int cc = 0; cc < 2; ++cc) {
            const int ct = 2 * (wid & 1) + cc;
            f32x4 acc = {0.f, 0.f, 0.f, 0.f};
#pragma unroll
            for (int ks = 0; ks < 4; ++ks)
                acc = __builtin_amdgcn_mfma_f32_16x16x32_bf16(lds_frag(Q, rt * 16 + r, 136, 8 * g + 32 * ks), lds_frag(K, ct * 16 + r, 136, 8 * g + 32 * ks), acc, 0, 0, 0);
            const int scol = ct * 16 + r; const float csv = cs[scol];
#pragma unroll
            for (int j = 0; j < 4; ++j) {
                const int t = rt * 16 + 4 * g + j;
                float pv = (scol <= t) ? acc[j] * __expf(rb[t] + csv) : 0.f;
                P[t * 72 + scol] = f2bf(pv);
                pv += __shfl_xor(pv, 1); pv += __shfl_xor(pv, 2); pv += __shfl_xor(pv, 4); pv += __shfl_xor(pv, 8);
                if (r == 0) rowpart[t * 4 + ct] = pv;
            }
        }
    }
    __syncthreads();
    if (tid < 64) {
        const float den = rowpart[tid * 4] + rowpart[tid * 4 + 1] + rowpart[tid * 4 + 2] + rowpart[tid * 4 + 3] + wint[tid] * qn[tid];
        rinv[tid] = 1.f / fmaxf(fabsf(den), emt[tid]);
    }
    f32x4 hacc[4];
    {
        const int rt = wid >> 1;
#pragma unroll
        for (int ee = 0; ee < 4; ++ee) {
            const int et = 4 * (wid & 1) + ee;
            f32x4 a1 = {0.f, 0.f, 0.f, 0.f}, a2 = {0.f, 0.f, 0.f, 0.f};
#pragma unroll
            for (int ks = 0; ks < 2; ++ks)
                a1 = __builtin_amdgcn_mfma_f32_16x16x32_bf16(lds_frag(P, rt * 16 + r, 72, 8 * g + 32 * ks), lds_frag(VT, et * 16 + r, 72, 8 * g + 32 * ks), a1, 0, 0, 0);
#pragma unroll
            for (int ks = 0; ks < 4; ++ks)
                a2 = __builtin_amdgcn_mfma_f32_16x16x32_bf16(lds_frag(Q, rt * 16 + r, 136, 8 * g + 32 * ks), lds_frag(C0, et * 16 + r, 136, 8 * g + 32 * ks), a2, 0, 0, 0);
#pragma unroll
            for (int j = 0; j < 4; ++j) { const int t = rt * 16 + 4 * g + j; hacc[ee][j] = a1[j] + wint[t] * a2[j]; }
        }
    }
    __syncthreads();
    {
        const int rt = wid >> 1;
#pragma unroll
        for (int ee = 0; ee < 4; ++ee) {
            const int et = 4 * (wid & 1) + ee;
#pragma unroll
            for (int j = 0; j < 4; ++j) { const int t = rt * 16 + 4 * g + j; H[t * 132 + et * 16 + r] = hacc[ee][j] * rinv[t]; }
        }
    }
    __syncthreads();
    {
        const int t = tid >> 3, part = tid & 7;
        float hv[16]; float ss = 0.f;
#pragma unroll
        for (int i = 0; i < 16; ++i) { hv[i] = H[t * 132 + part * 16 + i]; ss += hv[i] * hv[i]; }
        ss += __shfl_xor(ss, 1); ss += __shfl_xor(ss, 2); ss += __shfl_xor(ss, 4);
        const float rstd = rsqrtf(ss * (1.f / 128.f) + 1e-6f);
        const int col = h * 128 + part * 16;
        const u32x4 m0v = *(const u32x4*)(MO + (size_t)(row0 + t) * 512 + col), m1v = *(const u32x4*)(MO + (size_t)(row0 + t) * 512 + col + 8);
        float mo[16];
#pragma unroll
        for (int i = 0; i < 4; ++i) { mo[2 * i] = lo16(m0v[i]); mo[2 * i + 1] = hi16(m0v[i]); mo[8 + 2 * i] = lo16(m1v[i]); mo[8 + 2 * i + 1] = hi16(m1v[i]); }
        float o[16];
#pragma unroll
        for (int i = 0; i < 16; ++i) o[i] = (hv[i] * rstd * p.out_norm_m[col + i]) * sigmoidf_(mo[i]);
        u32x4 o0, o1;
#pragma unroll
        for (int i = 0; i < 4; ++i) { o0[i] = pack2(o[2 * i], o[2 * i + 1]); o1[i] = pack2(o[8 + 2 * i], o[8 + 2 * i + 1]); }
        bf16_t* dst = (bf16_t*)(p.ws + OFF_ACT) + (size_t)(row0 + t) * 1024 + col;
        *(u32x4*)dst = o0; *(u32x4*)(dst + 8) = o1;
    }
    __syncthreads();
}

__device__ __forceinline__ unsigned f2sortable(float f) { const unsigned u = __float_as_uint(f); return (u & 0x80000000u) ? ~u : (u | 0x80000000u); }
#define CNT4(c0, c1, c2, c3, a, b, cc, d, thr) asm volatile( \
    "v_cmp_ge_u32 s[40:41], %4, %8\n\tv_cmp_ge_u32 s[42:43], %5, %8\n\tv_cmp_ge_u32 s[44:45], %6, %8\n\tv_cmp_ge_u32 s[46:47], %7, %8\n\t" \
    "v_addc_co_u32 %0, s[48:49], 0, %0, s[40:41]\n\tv_addc_co_u32 %1, s[50:51], 0, %1, s[42:43]\n\tv_addc_co_u32 %2, s[52:53], 0, %2, s[44:45]\n\tv_addc_co_u32 %3, s[54:55], 0, %3, s[46:47]" \
    : "+v"(c0), "+v"(c1), "+v"(c2), "+v"(c3) : "v"(a), "v"(b), "v"(cc), "v"(d), "v"(thr) \
    : "s40", "s41", "s42", "s43", "s44", "s45", "s46", "s47", "s48", "s49", "s50", "s51", "s52", "s53", "s54", "s55")
template <int NR>
__device__ __forceinline__ int count_geN(const unsigned (&u)[NR], unsigned thr) {
    int c0 = 0, c1 = 0, c2 = 0, c3 = 0;
#pragma unroll
    for (int j = 0; j < NR; j += 4) CNT4(c0, c1, c2, c3, u[j], u[j + 1], u[j + 2], u[j + 3], thr);
    return (c0 + c1) + (c2 + c3);
}
template <int NR>
__device__ __forceinline__ void select_topk(const LAS float* srow, LAS int* lq, int t, int n, int lane) {
    unsigned u[NR];
#pragma unroll
    for (int j = 0; j < NR; ++j) { const int key = lane + 64 * j; u[j] = (key <= t) ? ((f2sortable(srow[key]) & 0xFFFFF000u) | (unsigned)(4095 - key)) : 0u; }
    unsigned tau = 1u;
    if (n > 256) {
        tau = 0u;
        for (int bit = 31; bit >= 0; --bit) {
            const unsigned cand = tau | (1u << bit);
            const int cnt = wave_sum_i32_uniform(count_geN<NR>(u, cand));
            if (cnt >= 256) { tau = cand; if (cnt == 256) break; }
        }
    }
    const int c = count_geN<NR>(u, tau);
    int pre = c;
#pragma unroll
    for (int o = 1; o < 64; o <<= 1) { const int v = __shfl_up(pre, o); if (lane >= o) pre += v; }
    int pos = pre - c;
    int keyv = lane;
#pragma unroll
    for (int j = 0; j < NR; ++j) {
        const bool sel = u[j] >= tau;
        const int slot = sel ? pos : (256 + lane);
        lq[slot] = keyv;
        pos += sel ? 1 : 0; keyv += 64;
    }
}
__device__ __forceinline__ void dsa_task(const Params& p, int task, LAS unsigned char* lds) {
    const int tid = opaque_tid(), wid = __builtin_amdgcn_readfirstlane(tid >> 6), lane = tid & 63;
    const int b = task >> 9, qg = task & 511, t0 = qg * 8, rowb = b * SEQ;
    const bf16_t* IQ = (const bf16_t*)(p.ws + OFF_IQ); const bf16_t* IK = (const bf16_t*)(p.ws + OFF_IK);
    const bf16_t* AQ = (const bf16_t*)(p.ws + OFF_AQ); const bf16_t* AK = (const bf16_t*)(p.ws + OFF_AK); const bf16_t* AV = (const bf16_t*)(p.ws + OFF_AV);
    const float* gates = (const float*)(p.ws + OFF_GATE);
    LAS float* scores = (LAS float*)lds;
    LAS int* lists = (LAS int*)(lds + 131072);
    const int ntile = (t0 + 8 + 31) >> 5;
#pragma unroll 1
    for (int rr0 = 0; rr0 < ((DSA_REP & 1) ? 2 : 1); ++rr0)
    {
        const int r = lane & 31, hh = lane >> 5;
        bf16x8 af[2][4]; float wv[2][4][4];
#pragma unroll
        for (int rt = 0; rt < 2; ++rt) {
            const size_t qrow = (size_t)(rowb + t0 + 4 * rt + (r >> 3));
#pragma unroll
            for (int ks = 0; ks < 4; ++ks) af[rt][ks] = *(const bf16x8*)(IQ + qrow * 512 + (r & 7) * 64 + 16 * ks + 8 * hh);
#pragma unroll
            for (int q4 = 0; q4 < 4; ++q4)
#pragma unroll
                for (int h4 = 0; h4 < 4; ++h4) wv[rt][q4][h4] = gates[(size_t)(rowb + t0 + 4 * rt + q4) * 16 + 8 + h4 + 4 * hh] * 0.04419417382415922f;
        }
        bf16x8 bfr[4], bnx[4];
        if (wid < ntile) {
#pragma unroll
            for (int ks = 0; ks < 4; ++ks) bfr[ks] = *(const bf16x8*)(IK + (size_t)(rowb + 32 * wid + r) * 64 + 16 * ks + 8 * hh);
        }
        for (int kt = wid; kt < ntile; kt += 8) {
            if (kt + 8 < ntile) {
#pragma unroll
                for (int ks = 0; ks < 4; ++ks) bnx[ks] = *(const bf16x8*)(IK + (size_t)(rowb + 32 * (kt + 8) + r) * 64 + 16 * ks + 8 * hh);
            }
            const int key = 32 * kt + r;
#pragma unroll
            for (int rt = 0; rt < 2; ++rt) {
                f32x16 acc;
#pragma unroll
                for (int i = 0; i < 16; ++i) acc[i] = 0.f;
#pragma unroll
                for (int ks = 0; ks < 4; ++ks) acc = __builtin_amdgcn_mfma_f32_32x32x16_bf16(af[rt][ks], bfr[ks], acc, 0, 0, 0);
#pragma unroll
                for (int q4 = 0; q4 < 4; ++q4) {
                    float part = 0.f;
#pragma unroll
                    for (int h4 = 0; h4 < 4; ++h4) part += fmaxf(acc[q4 * 4 + h4], 0.f) * wv[rt][q4][h4];
                    part += __shfl_xor(part, 32);
                    const int qq = 4 * rt + q4;
                    if (hh == 0) scores[qq * 4096 + key] = (key <= t0 + qq) ? part : -INFINITY;
                }
            }
#pragma unroll
            for (int ks = 0; ks < 4; ++ks) bfr[ks] = bnx[ks];
        }
    }
    __syncthreads();
    const int qq = wid, t = t0 + qq, n = t + 1;
    const int nsel = n < 256 ? n : 256;
#pragma unroll 1
    for (int rr1 = 0; rr1 < ((DSA_REP & 2) ? 2 : 1); ++rr1)
    {
        const LAS float* srow = scores + qq * 4096; LAS int* lq = lists + qq * 320;
        const int nreg = (t >> 6) + 1;
        if (nreg <= 8) select_topk<8>(srow, lq, t, n, lane);
        else if (nreg <= 16) select_topk<16>(srow, lq, t, n, lane);
        else if (nreg <= 24) select_topk<24>(srow, lq, t, n, lane);
        else if (nreg <= 32) select_topk<32>(srow, lq, t, n, lane);
        else if (nreg <= 40) select_topk<40>(srow, lq, t, n, lane);
        else if (nreg <= 48) select_topk<48>(srow, lq, t, n, lane);
        else if (nreg <= 56) select_topk<56>(srow, lq, t, n, lane);
        else select_topk<64>(srow, lq, t, n, lane);
    }
    asm volatile("s_waitcnt lgkmcnt(0)" ::: "memory");
#pragma unroll 1
    for (int rr2 = 0; rr2 < ((DSA_REP & 4) ? 2 : 1); ++rr2) {
    {
        const int r = lane & 15, g = lane >> 4;
        const size_t qrow = (size_t)(rowb + t);
        bf16x8 bq[2];
#pragma unroll
        for (int ks = 0; ks < 2; ++ks) {
            if (r < 8) bq[ks] = *(const bf16x8*)(AQ + qrow * 512 + r * 64 + 8 * g + 32 * ks);
            else { bq[ks] = (bf16x8){0, 0, 0, 0, 0, 0, 0, 0}; }
        }
        LAS float* Pl = scores + qq * 4096;
#pragma unroll 1
        for (int half = 0; half < 2; ++half) {
            bf16x8 a0[8], a1[8];
#pragma unroll
            for (int i = 0; i < 8; ++i) {
                const int jp = 16 * (half * 8 + i) + r;
                const int key = (jp < nsel) ? lists[qq * 320 + jp] : 0;
                a0[i] = *(const bf16x8*)(AK + (size_t)(rowb + key) * 64 + 8 * g); a1[i] = *(const bf16x8*)(AK + (size_t)(rowb + key) * 64 + 8 * g + 32);
            }
#pragma unroll
            for (int i = 0; i < 8; ++i) {
                const int kt = half * 8 + i;
                f32x4 acc = {0.f, 0.f, 0.f, 0.f};
                acc = __builtin_amdgcn_mfma_f32_16x16x32_bf16(a0[i], bq[0], acc, 0, 0, 0);
                acc = __builtin_amdgcn_mfma_f32_16x16x32_bf16(a1[i], bq[1], acc, 0, 0, 0);
                if (r < 8) {
#pragma unroll
                    for (int j = 0; j < 4; ++j) Pl[(16 * kt + 4 * g + j) * 8 + r] = acc[j] * 0.125f;
                }
            }
        }
        asm volatile("s_waitcnt lgkmcnt(0)" ::: "memory");
        f32x4 pa[4], pb[4];
        float mx[8];
#pragma unroll
        for (int hd = 0; hd < 8; ++hd) mx[hd] = -INFINITY;
#pragma unroll
        for (int i = 0; i < 4; ++i) {
            const int jp = lane + 64 * i;
            pa[i] = *(const LAS f32x4*)(Pl + jp * 8); pb[i] = *(const LAS f32x4*)(Pl + jp * 8 + 4);
            if (jp < nsel) {
#pragma unroll
                for (int hd = 0; hd < 4; ++hd) { mx[hd] = fmaxf(mx[hd], pa[i][hd]); mx[4 + hd] = fmaxf(mx[4 + hd], pb[i][hd]); }
            }
        }
#pragma unroll
        for (int hd = 0; hd < 8; ++hd) mx[hd] = wave_max_dpp(mx[hd]);
        float sm[8];
#pragma unroll
        for (int hd = 0; hd < 8; ++hd) sm[hd] = 0.f;
#pragma unroll
        for (int i = 0; i < 4; ++i) {
            const bool ok = (lane + 64 * i) < nsel;
#pragma unroll
            for (int hd = 0; hd < 4; ++hd) {
                pa[i][hd] = ok ? __expf(pa[i][hd] - mx[hd]) : 0.f; sm[hd] += pa[i][hd];
                pb[i][hd] = ok ? __expf(pb[i][hd] - mx[4 + hd]) : 0.f; sm[4 + hd] += pb[i][hd];
            }
        }
#pragma unroll
        for (int hd = 0; hd < 8; ++hd) sm[hd] = 1.f / wave_sum_dpp(sm[hd]);
        LAS bf16_t* Pt = (LAS bf16_t*)((LAS unsigned char*)Pl + 9216);
#pragma unroll
        for (int i = 0; i < 4; ++i) {
            const int jp = lane + 64 * i;
#pragma unroll
            for (int hd = 0; hd < 4; ++hd) { Pt[hd * 264 + jp] = f2bf(pa[i][hd] * sm[hd]); Pt[(4 + hd) * 264 + jp] = f2bf(pb[i][hd] * sm[4 + hd]); }
        }
    }
    asm volatile("s_waitcnt lgkmcnt(0)" ::: "memory");
    {
        typedef short s16x4 __attribute__((ext_vector_type(4)));
        const int r = lane & 15, g = lane >> 4;
        LAS unsigned char* wb = (LAS unsigned char*)(scores + qq * 4096);
        const LAS bf16_t* Pt = (const LAS bf16_t*)(wb + 9216);
        const int nchunk = (nsel + 31) >> 5;
        const int kl = lane >> 3, dc = lane & 7;
        f32x4 acc[4];
#pragma unroll
        for (int ct = 0; ct < 4; ++ct) acc[ct] = (f32x4){0.f, 0.f, 0.f, 0.f};
        u32x4 vq[4], vn[4];
#pragma unroll
        for (int i = 0; i < 4; ++i) {
            const int jp = kl + 8 * i;
            const int key = (jp < nsel) ? lists[qq * 320 + jp] : 0;
            vq[i] = *(const u32x4*)(AV + (size_t)(rowb + key) * 64 + dc * 8);
        }
#pragma unroll 1
        for (int c = 0; c < nchunk; ++c) {
            LAS unsigned char* vb = wb + (c & 1) * 4608;
#pragma unroll
            for (int i = 0; i < 4; ++i) *(LAS u32x4*)(vb + (kl + 8 * i) * 144 + dc * 16) = vq[i];
            if (c + 1 < nchunk) {
#pragma unroll
                for (int i = 0; i < 4; ++i) {
                    const int jp = 32 * (c + 1) + kl + 8 * i;
                    const int key = (jp < nsel) ? lists[qq * 320 + jp] : 0;
                    vn[i] = *(const u32x4*)(AV + (size_t)(rowb + key) * 64 + dc * 8);
                }
            }
            bf16x8 a = *(const LAS bf16x8*)(Pt + (r & 7) * 264 + 32 * c + 8 * g);
            if (r >= 8) a = (bf16x8){0, 0, 0, 0, 0, 0, 0, 0};
#pragma unroll
            for (int ct = 0; ct < 4; ++ct) {
                LAS unsigned char* ba = vb + (8 * g + (r >> 2)) * 144 + (16 * ct + 4 * (r & 3)) * 2;
                const s16x4 b0 = __builtin_amdgcn_ds_read_tr16_b64_v4i16((LAS s16x4*)ba);
                const s16x4 b1 = __builtin_amdgcn_ds_read_tr16_b64_v4i16((LAS s16x4*)(ba + 4 * 144));
                bf16x8 bb; bb[0] = b0[0]; bb[1] = b0[1]; bb[2] = b0[2]; bb[3] = b0[3]; bb[4] = b1[0]; bb[5] = b1[1]; bb[6] = b1[2]; bb[7] = b1[3];
                acc[ct] = __builtin_amdgcn_mfma_f32_16x16x32_bf16(a, bb, acc[ct], 0, 0, 0);
            }
#pragma unroll
            for (int i = 0; i < 4; ++i) vq[i] = vn[i];
        }
        bf16_t* dst = (bf16_t*)(p.ws + OFF_ACT) + (size_t)(rowb + t) * 1024 + 512;
#pragma unroll
        for (int j = 0; j < 4; ++j) {
            float ss = acc[0][j] * acc[0][j] + acc[1][j] * acc[1][j] + acc[2][j] * acc[2][j] + acc[3][j] * acc[3][j];
            ss += __shfl_xor(ss, 1); ss += __shfl_xor(ss, 2); ss += __shfl_xor(ss, 4); ss += __shfl_xor(ss, 8);
            const float rstd = rsqrtf(ss * (1.f / 64.f) + 1e-6f);
            if (g < 2) {
                const int hd = 4 * g + j;
#pragma unroll
                for (int ct = 0; ct < 4; ++ct) dst[hd * 64 + 16 * ct + r] = f2bf(acc[ct][j] * rstd * p.out_norm_a[hd * 64 + 16 * ct + r]);
            }
        }
    }
    }
    __syncthreads();
}

__device__ __forceinline__ float sortable2f(unsigned s) { return __uint_as_float((s & 0x80000000u) ? (s ^ 0x80000000u) : ~s); }
#define CE_DESC(x, y) do { const unsigned mx_ = max(x, y), mn_ = min(x, y); (x) = mx_; (y) = mn_; } while (0)
template <int BASE, int N>
__device__ __forceinline__ void bitonic_sort16_desc(unsigned (&a)[N]) {
#pragma unroll
    for (int k = 2; k <= 16; k <<= 1) {
#pragma unroll
        for (int j = k >> 1; j > 0; j >>= 1) {
#pragma unroll
            for (int i = 0; i < 16; ++i) {
                const int l = i ^ j;
                if (l > i) {
                    if ((i & k) == 0) CE_DESC(a[BASE + i], a[BASE + l]);
                    else CE_DESC(a[BASE + l], a[BASE + i]);
                }
            }
        }
    }
}
template <int BASE, int N>
__device__ __forceinline__ void bitonic_merge16_desc(unsigned (&a)[N]) {
#pragma unroll
    for (int j = 8; j > 0; j >>= 1) {
#pragma unroll
        for (int i = 0; i < 16; ++i) { const int l = i ^ j; if (l > i) CE_DESC(a[BASE + i], a[BASE + l]); }
    }
}
template <int BA, int BB, int N>
__device__ __forceinline__ void top16_merge(unsigned (&a)[N]) {
#pragma unroll
    for (int i = 0; i < 16; ++i) a[BA + i] = max(a[BA + i], a[BB + 15 - i]);
    bitonic_merge16_desc<BA, N>(a);
}
__device__ __forceinline__ void top16_of_64(unsigned (&a)[64]) {
    bitonic_sort16_desc<0, 64>(a); bitonic_sort16_desc<16, 64>(a); bitonic_sort16_desc<32, 64>(a); bitonic_sort16_desc<48, 64>(a);
    top16_merge<0, 16, 64>(a); top16_merge<32, 48, 64>(a); top16_merge<0, 32, 64>(a);
}
__device__ __forceinline__ void peer_route(const Params& p, int task, LAS unsigned char* lds) {
    const int tid = opaque_tid(), wid = __builtin_amdgcn_readfirstlane(tid >> 6), lane = tid & 63;
    const int n0 = task * 32, head = wid;
    const int r = lane & 31, hh = lane >> 5;
    const bf16_t* QRY = (const bf16_t*)(p.ws + OFF_QRY); const bf16_t* SK = (const bf16_t*)(p.ws + OFF_SK);
    LAS unsigned* tkl = (LAS unsigned*)lds + wid * (32 * 64);
#pragma unroll 1
    for (int p2 = 0; p2 < 2; ++p2) {
        const int grp = head * 2 + p2;
        bf16x8 bq[4];
#pragma unroll
        for (int ks = 0; ks < 4; ++ks) bq[ks] = *(const bf16x8*)(QRY + (size_t)(n0 + r) * 1024 + grp * 64 + 16 * ks + 8 * hh);
        unsigned key[64];
#pragma unroll
        for (int kt = 0; kt < 4; ++kt) {
            f32x16 acc;
#pragma unroll
            for (int i = 0; i < 16; ++i) acc[i] = 0.f;
#pragma unroll
            for (int ks = 0; ks < 4; ++ks) {
                const bf16x8 a = *(const bf16x8*)(SK + (size_t)(grp * 128 + 32 * kt + r) * 64 + 16 * ks + 8 * hh);
                acc = __builtin_amdgcn_mfma_f32_32x32x16_bf16(a, bq[ks], acc, 0, 0, 0);
            }
#pragma unroll
            for (int reg = 0; reg < 16; ++reg) {
                const int idx = 32 * kt + (reg & 3) + 8 * (reg >> 2) + 4 * hh;
                key[kt * 16 + reg] = (f2sortable(acc[reg]) & ~0x7Fu) | (unsigned)(127 - idx);
            }
        }
        top16_of_64(key);
        unsigned mg[16];
#pragma unroll
        for (int i = 0; i < 16; ++i) mg[i] = max(key[i], (unsigned)__shfl_xor((int)key[15 - i], 32));
        bitonic_merge16_desc<0, 16>(mg);
#pragma unroll
        for (int k = 0; k < 16; ++k) tkl[(p2 * 16 + k) * 64 + lane] = mg[k];
    }
    float v1[16], v2[16];
#pragma unroll
    for (int k = 0; k < 16; ++k) { v1[k] = sortable2f(tkl[k * 64 + lane] & ~0x7Fu); v2[k] = sortable2f(tkl[(16 + k) * 64 + lane] & ~0x7Fu); }
    unsigned ck[64];
    {
        int ci = 0;
#pragma unroll
        for (int a = 0; a < 16; ++a) {
#pragma unroll
            for (int bb = 0; bb < 16 / (a + 1); ++bb) { ck[ci] = (f2sortable(v1[a] + v2[bb]) & ~0xFFu) | (unsigned)(255 - (16 * a + bb)); ++ci; }
        }
#pragma unroll
        for (int i = 50; i < 64; ++i) ck[i] = 0u;
    }
    top16_of_64(ck);
    float tv[16]; int te[16];
    float sum = 0.f;
#pragma unroll
    for (int k = 0; k < 16; ++k) {
        const int flat = 255 - (int)(ck[k] & 0xFFu);
        const int i1 = 127 - (int)(tkl[(flat >> 4) * 64 + lane] & 0x7Fu), i2 = 127 - (int)(tkl[(16 + (flat & 15)) * 64 + lane] & 0x7Fu);
        te[k] = i1 * 128 + i2;
        tv[k] = __expf(sortable2f(ck[k] & ~0xFFu) - sortable2f(ck[0] & ~0xFFu)); sum += tv[k];
    }
    const float inv = 1.f / sum;
    if (hh == 0) {
        int* EI = (int*)(p.ws + OFF_EIDX) + (size_t)(n0 + r) * 128 + head * 16;
#pragma unroll
        for (int q = 0; q < 4; ++q) { u32x4 o; o[0] = te[4 * q]; o[1] = te[4 * q + 1]; o[2] = te[4 * q + 2]; o[3] = te[4 * q + 3]; *(u32x4*)(EI + 4 * q) = o; }
    } else {
        float* GW = (float*)(p.ws + OFF_GW) + (size_t)(n0 + r) * 128 + head * 16;
#pragma unroll
        for (int q = 0; q < 4; ++q) { f32x4 o; o[0] = tv[4 * q] * inv; o[1] = tv[4 * q + 1] * inv; o[2] = tv[4 * q + 2] * inv; o[3] = tv[4 * q + 3] * inv; *(f32x4*)(GW + 4 * q) = o; }
    }
}

__device__ __forceinline__ float gelu_exact(float a) { return 0.5f * a * (1.f + erff(a * 0.70710678118654752440f)); }
__device__ __forceinline__ float gelu_as(float v) {
    const float av = fabsf(v), t = __builtin_amdgcn_rcpf(av * 0.2316418882f + 1.0f);
    float q = t * 0.5307027145f + (-0.7265760135f); q = q * t + 0.7107068705f; q = q * t + (-0.142248368f); q = q * t + 0.127414796f; q = q * t;
    const float e = __builtin_amdgcn_exp2f((v * v) * (-0.72134752044f));
    const float m = v * (q * e), rr = v - m;
    return v < 0.f ? m : rr;
}
__device__ __forceinline__ void dec16_fp8(const u32x4 w, float (&f)[16]) {
#pragma unroll
    for (int i = 0; i < 4; ++i) {
        const f32x2 lo = __builtin_amdgcn_cvt_pk_f32_fp8((int)w[i], false), hi = __builtin_amdgcn_cvt_pk_f32_fp8((int)w[i], true);
        f[4 * i] = lo[0]; f[4 * i + 1] = lo[1]; f[4 * i + 2] = hi[0]; f[4 * i + 3] = hi[1];
    }
}
__device__ __forceinline__ void sort_pairs128(int& k_lo, int& k_hi, float& g_lo, float& g_hi, int lane) {
#pragma unroll
    for (int size = 2; size <= 128; size <<= 1) {
#pragma unroll
        for (int stride = size >> 1; stride >= 1; stride >>= 1) {
            if (stride == 64) {
                const bool sw = k_hi < k_lo;
                const int ta = sw ? k_hi : k_lo, tb = sw ? k_lo : k_hi; const float ga = sw ? g_hi : g_lo, gb = sw ? g_lo : g_hi;
                k_lo = ta; k_hi = tb; g_lo = ga; g_hi = gb;
            } else {
                const int p_lo = __shfl_xor(k_lo, stride), p_hi = __shfl_xor(k_hi, stride);
                const float q_lo = __shfl_xor(g_lo, stride), q_hi = __shfl_xor(g_hi, stride);
                const bool lower = (lane & stride) == 0;
                const bool asc_lo = (size >= 64) ? true : ((lane & size) == 0);
                const bool asc_hi = (size == 128) ? true : ((size == 64) ? false : ((lane & size) == 0));
                const bool min_lo = (lower == asc_lo), min_hi = (lower == asc_hi);
                const bool take_lo = min_lo ? (p_lo < k_lo) : (p_lo > k_lo);
                const bool take_hi = min_hi ? (p_hi < k_hi) : (p_hi > k_hi);
                k_lo = take_lo ? p_lo : k_lo; g_lo = take_lo ? q_lo : g_lo;
                k_hi = take_hi ? p_hi : k_hi; g_hi = take_hi ? q_hi : g_hi;
            }
        }
    }
}
__device__ __forceinline__ void peer_finish_row(const Params& p, const float* ada, int tok, int d0, const float (&acc)[16], bool do_store) {
    const int b = tok >> 12;
    float* orow = p.out + (size_t)tok * 1024 + d0;
    float xo[16]; float ss = 0.f;
#pragma unroll
    for (int q = 0; q < 4; ++q) {
        const f32x4 xv = *(const f32x4*)(orow + 4 * q), gv = *(const f32x4*)(ada + b * 6144 + 5120 + d0 + 4 * q);
#pragma unroll
        for (int i = 0; i < 4; ++i) { const float v = xv[i] + gv[i] * acc[q * 4 + i]; xo[q * 4 + i] = v; ss += v * v; }
    }
    ss = wave_sum(ss);
    const float rstd = rsqrtf(ss * (1.f / 1024.f) + 1e-6f);
#pragma unroll
    for (int q = 0; q < 4; ++q) {
        const f32x4 fg = *(const f32x4*)(p.final_g + d0 + 4 * q);
        f32x4 ov;
#pragma unroll
        for (int i = 0; i < 4; ++i) ov[i] = xo[q * 4 + i] * rstd * fg[i];
        if (do_store) *(f32x4*)(orow + 4 * q) = ov;
    }
}
struct PeTok { unsigned hq[4]; float ascale; int acc_hi[16], acc_lo[16]; int csum_hi, csum_lo; int k_lo, k_hi; float g_lo, g_hi; };
__device__ __forceinline__ void pe_tok_init(PeTok& t, const bf16_t* H2, const int* EI, const float* GW, int tok, int d0, int lane) {
    const u32x4 h0 = *(const u32x4*)(H2 + (size_t)tok * 1024 + d0), h1 = *(const u32x4*)(H2 + (size_t)tok * 1024 + d0 + 8);
    float hx[16];
#pragma unroll
    for (int i = 0; i < 4; ++i) { hx[2 * i] = lo16(h0[i]); hx[2 * i + 1] = hi16(h0[i]); hx[8 + 2 * i] = lo16(h1[i]); hx[8 + 2 * i + 1] = hi16(h1[i]); }
    float am = 0.f;
#pragma unroll
    for (int i = 0; i < 16; ++i) am = fmaxf(am, fabsf(hx[i]));
    am = fmaxf(wave_max_dpp(am), 1e-20f);
    const float hs = 127.f / am;
#pragma unroll
    for (int i = 0; i < 4; ++i) t.hq[i] = pack4_i8(hx[4 * i], hx[4 * i + 1], hx[4 * i + 2], hx[4 * i + 3], hs);
    t.ascale = am * (1.f / (127.f * PEER_SU));
#pragma unroll
    for (int i = 0; i < 16; ++i) { t.acc_hi[i] = 0; t.acc_lo[i] = 0; }
    t.csum_hi = 0; t.csum_lo = 0;
    t.k_lo = EI[(size_t)tok * 128 + lane]; t.k_hi = EI[(size_t)tok * 128 + 64 + lane];
    t.g_lo = GW[(size_t)tok * 128 + lane]; t.g_hi = GW[(size_t)tok * 128 + 64 + lane];
    sort_pairs128(t.k_lo, t.k_hi, t.g_lo, t.g_hi, lane);
}
__device__ __forceinline__ void pe_tok_result(const PeTok& t, float (&acc)[16]) {
    const int coff = 8 * (t.csum_hi * 128 + t.csum_lo);
#pragma unroll
    for (int i = 0; i < 4; ++i)
#pragma unroll
        for (int j = 0; j < 4; ++j) acc[8 * (i >> 1) + 2 * j + (i & 1)] = (float)(t.acc_hi[4 * i + j] * 128 + t.acc_lo[4 * i + j] - coff) * (1.f / (PEER_SC * PEER_SV));
}
__device__ __forceinline__ void pe_vgroup(PeTok& t, const u32x2 (&vv)[8], int base, int c0, int c1, int c2, int c3) {
    const int chi = ((c0 >> 7) & 0xFF) | (((c1 >> 7) & 0xFF) << 8) | (((c2 >> 7) & 0xFF) << 16) | (((c3 >> 7) & 0xFF) << 24);
    const int clo = (c0 & 127) | ((c1 & 127) << 8) | ((c2 & 127) << 16) | ((c3 & 127) << 24);
    t.csum_hi += (c0 >> 7) + (c1 >> 7) + (c2 >> 7) + (c3 >> 7); t.csum_lo += (c0 & 127) + (c1 & 127) + (c2 & 127) + (c3 & 127);
#pragma unroll
    for (int i = 0; i < 4; ++i) {
        const unsigned w0 = (vv[base][i >> 1] >> (4 * (i & 1))) & 0x0F0F0F0Fu, w1 = (vv[base + 1][i >> 1] >> (4 * (i & 1))) & 0x0F0F0F0Fu;
        const unsigned w2_ = (vv[base + 2][i >> 1] >> (4 * (i & 1))) & 0x0F0F0F0Fu, w3 = (vv[base + 3][i >> 1] >> (4 * (i & 1))) & 0x0F0F0F0Fu;
        const unsigned a0 = __builtin_amdgcn_perm(w1, w0, 0x05010400u), a1 = __builtin_amdgcn_perm(w1, w0, 0x07030602u);
        const unsigned b0 = __builtin_amdgcn_perm(w3, w2_, 0x05010400u), b1 = __builtin_amdgcn_perm(w3, w2_, 0x07030602u);
        const unsigned tt0 = __builtin_amdgcn_perm(b0, a0, 0x05040100u), tt1 = __builtin_amdgcn_perm(b0, a0, 0x07060302u);
        const unsigned tt2 = __builtin_amdgcn_perm(b1, a1, 0x05040100u), tt3 = __builtin_amdgcn_perm(b1, a1, 0x07060302u);
        t.acc_hi[4 * i + 0] = __builtin_amdgcn_sdot4((int)tt0, chi, t.acc_hi[4 * i + 0], false); t.acc_lo[4 * i + 0] = __builtin_amdgcn_sdot4((int)tt0, clo, t.acc_lo[4 * i + 0], false);
        t.acc_hi[4 * i + 1] = __builtin_amdgcn_sdot4((int)tt1, chi, t.acc_hi[4 * i + 1], false); t.acc_lo[4 * i + 1] = __builtin_amdgcn_sdot4((int)tt1, clo, t.acc_lo[4 * i + 1], false);
        t.acc_hi[4 * i + 2] = __builtin_amdgcn_sdot4((int)tt2, chi, t.acc_hi[4 * i + 2], false); t.acc_lo[4 * i + 2] = __builtin_amdgcn_sdot4((int)tt2, clo, t.acc_lo[4 * i + 2], false);
        t.acc_hi[4 * i + 3] = __builtin_amdgcn_sdot4((int)tt3, chi, t.acc_hi[4 * i + 3], false); t.acc_lo[4 * i + 3] = __builtin_amdgcn_sdot4((int)tt3, clo, t.acc_lo[4 * i + 3], false);
    }
}
__device__ __forceinline__ void peer_experts(const Params& p, bool do_store) {
    const int wid = threadIdx.x >> 6, lane = threadIdx.x & 63;
    const bf16_t* H2 = (const bf16_t*)(p.ws + OFF_ACT); const unsigned char* UT = p.ws + OFF_UT; const unsigned char* VT = p.ws + OFF_VT;
    const int* EI = (const int*)(p.ws + OFF_EIDX); const float* GW = (const float*)(p.ws + OFF_GW); const float* ada = (const float*)(p.ws + OFF_ADA);
    const int d0 = 16 * lane;
    const int stride = gridDim.x * 8;
    for (int tok0 = blockIdx.x * 8 + wid; tok0 < NTOK; tok0 += 2 * stride) {
        __syncthreads();
        const bool hasB = (tok0 + stride) < NTOK;
        const int tokA = tok0, tokB = hasB ? tok0 + stride : tok0;
        PeTok A, B;
        pe_tok_init(A, H2, EI, GW, tokA, d0, lane);
        pe_tok_init(B, H2, EI, GW, tokB, d0, lane);
        u32x4 uX[8], uY[8]; u32x2 vX[8], vY[8]; float gX[8], gY[8];
#define PE_ISSUE(UU, VV, GG, K0) do { _Pragma("unroll") for (int q = 0; q < 4; ++q) { \
            const unsigned ea_ = (unsigned)__builtin_amdgcn_readlane((K0) < 64 ? A.k_lo : A.k_hi, ((K0) + q) & 63), eb_ = (unsigned)__builtin_amdgcn_readlane((K0) < 64 ? B.k_lo : B.k_hi, ((K0) + q) & 63); \
            GG[q] = rlanef((K0) < 64 ? A.g_lo : A.g_hi, ((K0) + q) & 63); GG[4 + q] = rlanef((K0) < 64 ? B.g_lo : B.g_hi, ((K0) + q) & 63); \
            UU[q] = *(const u32x4*)(UT + (size_t)(ea_ * 1024u) + (unsigned)d0); VV[q] = *(const u32x2*)(VT + (size_t)(ea_ * 512u) + 8u * (unsigned)lane); \
            UU[4 + q] = *(const u32x4*)(UT + (size_t)(eb_ * 1024u) + (unsigned)d0); VV[4 + q] = *(const u32x2*)(VT + (size_t)(eb_ * 512u) + 8u * (unsigned)lane); } } while (0)
#define PE_COMPUTE(UU, VV, GG) do { \
            float sv[8]; \
            _Pragma("unroll") for (int q = 0; q < 8; ++q) { int d_ = 0; \
                _Pragma("unroll") for (int i = 0; i < 4; ++i) d_ = __builtin_amdgcn_sdot4((int)UU[q][i], (int)(q < 4 ? A.hq[i] : B.hq[i]), d_, false); \
                sv[q] = (float)d_ * (q < 4 ? A.ascale : B.ascale); } \
            float t4[4]; \
            _Pragma("unroll") for (int i = 0; i < 4; ++i) { const u32x2 r_ = __builtin_amdgcn_permlane32_swap(__float_as_uint(sv[i]), __float_as_uint(sv[i + 4]), false, false); t4[i] = __uint_as_float(r_[0]) + __uint_as_float(r_[1]); } \
            float w2[2]; \
            _Pragma("unroll") for (int i = 0; i < 2; ++i) { const u32x2 r_ = __builtin_amdgcn_permlane16_swap(__float_as_uint(t4[i]), __float_as_uint(t4[i + 2]), false, false); w2[i] = __uint_as_float(r_[0]) + __uint_as_float(r_[1]); } \
            _Pragma("unroll") for (int i = 0; i < 2; ++i) { w2[i] += dppf(w2[i], 0xB1); w2[i] += dppf(w2[i], 0x4E); w2[i] += dppf(w2[i], 0x141); w2[i] += dppf(w2[i], 0x140); } \
            float mine = 0.f, gmine = 0.f; \
            _Pragma("unroll") for (int q = 0; q < 8; ++q) { \
                const float tq = rlanef(w2[q & 1], 16 * (((q >> 1) & 1) + 2 * (q >> 2))); \
                mine = ((lane & 7) == q) ? tq : mine; gmine = ((lane & 7) == q) ? GG[q] : gmine; } \
            const float cmine = gmine * gelu_as(mine); \
            const int cqm = (int)fminf(fmaxf(rintf(cmine * PEER_SC), -16383.f), 16383.f);        \
            pe_vgroup(A, VV, 0, __builtin_amdgcn_readlane(cqm, 0), __builtin_amdgcn_readlane(cqm, 1), __builtin_amdgcn_readlane(cqm, 2), __builtin_amdgcn_readlane(cqm, 3)); \
            pe_vgroup(B, VV, 4, __builtin_amdgcn_readlane(cqm, 4), __builtin_amdgcn_readlane(cqm, 5), __builtin_amdgcn_readlane(cqm, 6), __builtin_amdgcn_readlane(cqm, 7)); } while (0)
        PE_ISSUE(uX, vX, gX, 0);
#pragma unroll 1
        for (int k0 = 0; k0 < 128; k0 += 8) {
            if ((k0 & 63) == 0 && k0) __syncthreads();
            PE_ISSUE(uY, vY, gY, k0 + 4);
            PE_COMPUTE(uX, vX, gX);
            if (k0 + 8 < 128) PE_ISSUE(uX, vX, gX, k0 + 8);
            PE_COMPUTE(uY, vY, gY);
        }
#undef PE_ISSUE
#undef PE_COMPUTE
        float acc[16];
        pe_tok_result(A, acc); peer_finish_row(p, ada, tokA, d0, acc, do_store);
        pe_tok_result(B, acc); peer_finish_row(p, ada, tokB, d0, acc, do_store && hasB);
    }
}

enum { PH_PREP = 0, PH_GEMM_IN, PH_MIX, PH_GEMM_OUT, PH_H2, PH_GEMM_Q, PH_ROUTE, PH_EXPERT, PH_COUNT };

typedef const __attribute__((address_space(4))) Params* KParams;
__device__ __forceinline__ const Params& kparams() {
    auto q = __builtin_amdgcn_kernarg_segment_ptr();
    asm volatile("" : "+s"(q));
    return *(const Params*)q;
}
#ifndef PHMASK
#define PHMASK 0xFFFF
#endif
#ifndef REP_PHASE
#define REP_PHASE -1
#endif
#define PHASE_BEGIN(idx) if (((PHMASK >> (idx)) & 1) && ph_lo <= (idx) && (idx) < ph_hi) { for (int rep = 0; rep < ((idx) == REP_PHASE ? 2 : 1); ++rep) { if ((idx) != ph_lo || rep) xcd_barrier(bar); const Params& p = kparams(); const int G = gridDim.x; (void)G; const bool last_rep = (rep == ((idx) == REP_PHASE ? 1 : 0)); (void)last_rep;
#define PHASE_END } }

__global__ void __launch_bounds__(NTHREADS, 2) hymba_fwd(Params p_) {
    extern __shared__ __attribute__((aligned(16))) unsigned char smem_raw[];
    LAS unsigned char* lds = (LAS unsigned char*)smem_raw;
    volatile LAS unsigned* xbw = (volatile LAS unsigned*)(lds + LDS_BYTES - 16);
    if (threadIdx.x == 0) { xbw[0] = 0u; xbw[1] = 0u; xbw[2] = 0u; xbw[3] = 0u; }
    __syncthreads();
    XcdBarrier bar = xcd_barrier_post((unsigned*)(p_.ws + OFF_CTL), xbw);
    const int ph_lo = p_.ph_lo, ph_hi = p_.ph_hi;

    PHASE_BEGIN(PH_PREP)
        phase0(p, lds);
        wg_wait((unsigned*)(p.ws + OFF_CTL), CNT_ADA, 192u);
        norm_mod_rows(p.x, p.norm1_g, (const float*)(p.ws + OFF_ADA), 0, 1024, (bf16_t*)(p.ws + OFF_ACT));
    PHASE_END
    PHASE_BEGIN(PH_GEMM_IN)
        {   pg8::StaticOrder S; S.init(NTOK, 3072, G, blockIdx.x);
            EpiInMain E; E.ws = p.ws; E.bias = (const float*)(p.ws + OFF_BIAS);
            pg8::gemm_phase(lds, pg8::Gemm{(const bf16_t*)(p.ws + OFF_ACT), (const bf16_t*)(p.ws + OFF_WIN), NTOK, 3072, 1024}, S, E); }
        {   pg8::StaticOrder S; S.init(NTOK, 256, G, blockIdx.x);
            EpiInTail E; E.ws = p.ws; E.bias = (const float*)(p.ws + OFF_BIAS) + 3072;
            pg8::gemm_phase(lds, pg8::Gemm{(const bf16_t*)(p.ws + OFF_ACT), (const bf16_t*)(p.ws + OFF_WIN) + (size_t)3072 * 1024, NTOK, 256, 1024}, S, E); }
        if (G > 64) { if ((int)blockIdx.x >= 64) convert_tables(p, (int)blockIdx.x - 64, G - 64); }
        else convert_tables(p, (int)blockIdx.x, G);
    PHASE_END
    PHASE_BEGIN(PH_MIX)
        unsigned* ctl = (unsigned*)(p.ws + OFF_CTL);
        for (int t = blockIdx.x; t < 1024; t += G) mlstm_passA(p, t, lds);
        wg_signal(ctl, CNT_MLA);
        __syncthreads();
        for (int t = blockIdx.x; t < 2048; t += G) {
            const int rnd = t >> 8, w = t & 255; const int bsel = rnd >> 1; const int qgs = (rnd & 1) ? w : (511 - w);
            dsa_task(p, (bsel << 9) | qgs, lds); }
        wg_wait(ctl, CNT_MLA, (unsigned)G);
        for (int t = blockIdx.x; t < 256; t += G) mlstm_scan(p, t, lds);
        wg_signal(ctl, CNT_SCAN);
        wg_wait(ctl, CNT_SCAN, (unsigned)G);
        for (int t = blockIdx.x; t < 1024; t += G) mlstm_passB(p, t, lds);
    PHASE_END
    PHASE_BEGIN(PH_GEMM_OUT)
        {   pg8::StaticOrder S; S.init(NTOK, 1024, G, blockIdx.x);
            EpiOut E; E.x = p.x; E.ada = (const float*)(p.ws + OFF_ADA); E.out = p.out;
            pg8::gemm_phase(lds, pg8::Gemm{(const bf16_t*)(p.ws + OFF_ACT), (const bf16_t*)(p.ws + OFF_WOUT), NTOK, 1024, 1024}, S, E); }
    PHASE_END
    PHASE_BEGIN(PH_H2) norm_mod_rows(p.out, p.norm2_g, (const float*)(p.ws + OFF_ADA), 3072, 4096, (bf16_t*)(p.ws + OFF_ACT)); PHASE_END
    PHASE_BEGIN(PH_GEMM_Q)
        {   pg8::StaticOrder S; S.init(NTOK, 1024, G, blockIdx.x);
            EpiQry E; E.O = (bf16_t*)(p.ws + OFF_QRY);
            pg8::gemm_phase(lds, pg8::Gemm{(const bf16_t*)(p.ws + OFF_ACT), (const bf16_t*)(p.ws + OFF_WPQ), NTOK, 1024, 1024}, S, E); }
    PHASE_END
    PHASE_BEGIN(PH_ROUTE) for (int t = blockIdx.x; t < 512; t += G) peer_route(p, t, lds); PHASE_END
    PHASE_BEGIN(PH_EXPERT) peer_experts(p, last_rep); PHASE_END
}

extern "C" void kernel_launch(void* const* d_in, const int* in_sizes, int n_in, void* d_out, int out_size, void* d_ws, size_t ws_size, hipStream_t stream) {
    static int grid = 0;
    if (grid == 0) {
        int dev = 0, cus = 0, per_cu = 0;
        if (hipGetDevice(&dev) != hipSuccess || hipDeviceGetAttribute(&cus, hipDeviceAttributeMultiprocessorCount, dev) != hipSuccess) { fprintf(stderr, "kernel_launch: device query failed\n"); grid = -1; return; }
        if (hipFuncSetAttribute((const void*)hymba_fwd, hipFuncAttributeMaxDynamicSharedMemorySize, LDS_BYTES) != hipSuccess) { fprintf(stderr, "kernel_launch: hipFuncSetAttribute failed\n"); grid = -1; return; }
        if (hipOccupancyMaxActiveBlocksPerMultiprocessor(&per_cu, (const void*)hymba_fwd, NTHREADS, LDS_BYTES) != hipSuccess || per_cu < 1) { fprintf(stderr, "kernel_launch: occupancy query says %d blocks/CU\n", per_cu); }
        (void)hipGetLastError();
        grid = cus;
        if (ws_size < WS_END || n_in != 17) { fprintf(stderr, "kernel_launch: unexpected sizes (ws %zu, n_in %d)\n", ws_size, n_in); grid = -1; return; }
    }
    if (grid < 0) return;
    (void)hipMemsetAsync((char*)d_ws + OFF_CTL, 0, CTL_BYTES, stream);
    Params p{};
    p.x = (const float*)d_in[0]; p.c = (const float*)d_in[1]; p.w_ada = (const float*)d_in[2]; p.b_ada = (const float*)d_in[3]; p.norm1_g = (const float*)d_in[4];
    p.w_in = (const float*)d_in[5]; p.b_in = (const float*)d_in[6]; p.conv_qk = (const float*)d_in[7]; p.out_norm_m = (const float*)d_in[8]; p.out_norm_a = (const float*)d_in[9];
    p.w_out = (const float*)d_in[10]; p.norm2_g = (const float*)d_in[11]; p.w_peer_q = (const float*)d_in[12]; p.sub_keys = (const float*)d_in[13]; p.peer_u = (const float*)d_in[14];
    p.peer_v = (const float*)d_in[15]; p.final_g = (const float*)d_in[16];
    p.out = (float*)d_out; p.ws = (unsigned char*)d_ws; p.ph_lo = 0; p.ph_hi = PH_COUNT;
    void* args[] = {&p};
    hipError_t e = hipLaunchCooperativeKernel((const void*)hymba_fwd, dim3(grid), dim3(NTHREADS), args, LDS_BYTES, stream);
    if (e != hipSuccess) fprintf(stderr, "kernel_launch: cooperative launch failed: %s (grid %d)\n", hipGetErrorString(e), grid);
}
```

```cpp
#include <hip/hip_runtime.h>
#include <stdint.h>
#define REP_PHASE -1
#define DSA_REP 0
#include <cstdio>

#define LAS __attribute__((address_space(3)))
typedef unsigned short bf16_t;
typedef short bf16x8 __attribute__((ext_vector_type(8)));
typedef float f32x4 __attribute__((ext_vector_type(4)));
typedef float f32x2 __attribute__((ext_vector_type(2)));
typedef float f32x16 __attribute__((ext_vector_type(16)));
typedef unsigned u32x4 __attribute__((ext_vector_type(4)));
typedef unsigned u32x2 __attribute__((ext_vector_type(2)));

constexpr int NTOK = 16384, DM = 1024, SEQ = 4096;
constexpr int NIN_PAD = 3328;
constexpr int LDS_BYTES = 163840 - 64;
constexpr int NTHREADS = 512;

constexpr size_t MiB = 1024 * 1024;
constexpr size_t OFF_CTL = 0;
constexpr size_t CTL_BYTES = 16384;
constexpr size_t OFF_ADA = 64 * 1024;
constexpr size_t OFF_BIAS = 192 * 1024;
constexpr size_t OFF_SK = 256 * 1024;
constexpr size_t OFF_WIN = 512 * 1024;
constexpr size_t OFF_WOUT = 7 * MiB;
constexpr size_t OFF_WPQ = 9 * MiB;
constexpr size_t OFF_ACT = 11 * MiB;
constexpr size_t OFF_MQ = 43 * MiB;
constexpr size_t OFF_MK = 59 * MiB;
constexpr size_t OFF_MV = 75 * MiB;
constexpr size_t OFF_MO = 91 * MiB;
constexpr size_t OFF_AQ = 107 * MiB;
constexpr size_t OFF_IQ = 123 * MiB;
constexpr size_t OFF_AK = 139 * MiB;
constexpr size_t OFF_AV = 141 * MiB;
constexpr size_t OFF_IK = 143 * MiB;
constexpr size_t OFF_GATE = 145 * MiB;
constexpr size_t OFF_KV = 146 * MiB;
constexpr size_t OFF_KS = 178 * MiB;
constexpr size_t OFF_MLOC = 178 * MiB + 512 * 1024;
constexpr size_t OFF_BLAST = OFF_MLOC + 4096;
constexpr size_t OFF_M0 = OFF_BLAST + 4096;
constexpr size_t OFF_UT = 179 * MiB;
constexpr size_t OFF_VT = 195 * MiB;
constexpr size_t WS_END = 211 * MiB;
constexpr float PEER_SU = 812.8f;
constexpr float PEER_SV = 8.443f;
constexpr float PEER_SC = 2048.f;
constexpr size_t OFF_QRY = OFF_MQ;
constexpr size_t OFF_EIDX = OFF_MV;
constexpr size_t OFF_GW = OFF_MV + 8 * MiB;

struct Params {
    const float* x; const float* c; const float* w_ada; const float* b_ada; const float* norm1_g;
    const float* w_in; const float* b_in; const float* conv_qk; const float* out_norm_m; const float* out_norm_a;
    const float* w_out; const float* norm2_g; const float* w_peer_q; const float* sub_keys; const float* peer_u;
    const float* peer_v; const float* final_g;
    float* out; unsigned char* ws;
    int ph_lo, ph_hi;
};

__device__ __forceinline__ int opaque_tid() { int t = threadIdx.x; asm volatile("" : "+v"(t)); return t; }
__device__ __forceinline__ float bf2f(unsigned short b) { return __uint_as_float(((unsigned)b) << 16); }
__device__ __forceinline__ unsigned pack2(float lo, float hi) { unsigned r; asm("v_cvt_pk_bf16_f32 %0, %1, %2" : "=v"(r) : "v"(lo), "v"(hi)); return r; }
__device__ __forceinline__ unsigned short f2bf(float f) { return (unsigned short)(pack2(f, 0.f) & 0xffffu); }
__device__ __forceinline__ unsigned short f2bf_sw(float f) { unsigned u = __float_as_uint(f); u += 0x7FFFu + ((u >> 16) & 1u); return (unsigned short)(u >> 16); }
__device__ __forceinline__ float lo16(unsigned w) { return __uint_as_float(w << 16); }
__device__ __forceinline__ float hi16(unsigned w) { return __uint_as_float(w & 0xffff0000u); }
__device__ __forceinline__ float wave_sum_dpp(float v);
__device__ __forceinline__ float wave_sum(float v) { return wave_sum_dpp(v); }
__device__ __forceinline__ int wave_sum_i32_uniform(int v) {
    v += __builtin_amdgcn_update_dpp(0, v, 0xB1, 0xF, 0xF, true);
    v += __builtin_amdgcn_update_dpp(0, v, 0x4E, 0xF, 0xF, true);
    v += __builtin_amdgcn_update_dpp(0, v, 0x141, 0xF, 0xF, true);
    v += __builtin_amdgcn_update_dpp(0, v, 0x140, 0xF, 0xF, true);
    return __builtin_amdgcn_readlane(v, 0) + __builtin_amdgcn_readlane(v, 16) + __builtin_amdgcn_readlane(v, 32) + __builtin_amdgcn_readlane(v, 48);
}
__device__ __forceinline__ float wave_scan_add(float v, int lane) {
#pragma unroll
    for (int o = 1; o < 64; o <<= 1) { const float t = __shfl_up(v, o); if (lane >= o) v += t; }
    return v;
}
__device__ __forceinline__ float wave_scan_max(float v, int lane) {
#pragma unroll
    for (int o = 1; o < 64; o <<= 1) { const float t = __shfl_up(v, o); if (lane >= o) v = fmaxf(v, t); }
    return v;
}
__device__ __forceinline__ float wave_max(float v) {
#pragma unroll
    for (int o = 32; o >= 1; o >>= 1) v = fmaxf(v, __shfl_xor(v, o));
    return v;
}
#define dppf(v, ctrl) __uint_as_float((unsigned)__builtin_amdgcn_update_dpp(0, (int)__float_as_uint(v), (ctrl), 0xF, 0xF, true))
__device__ __forceinline__ float rlanef(float v, int l) { return __uint_as_float((unsigned)__builtin_amdgcn_readlane((int)__float_as_uint(v), l)); }
__device__ __forceinline__ float wave_sum_dpp(float v) {
    v += dppf(v, 0xB1); v += dppf(v, 0x4E); v += dppf(v, 0x141); v += dppf(v, 0x140);
    return (rlanef(v, 0) + rlanef(v, 16)) + (rlanef(v, 32) + rlanef(v, 48));
}
__device__ __forceinline__ float wave_max_dpp(float v) {
    v = fmaxf(v, dppf(v, 0xB1)); v = fmaxf(v, dppf(v, 0x4E)); v = fmaxf(v, dppf(v, 0x141)); v = fmaxf(v, dppf(v, 0x140));
    return fmaxf(fmaxf(rlanef(v, 0), rlanef(v, 16)), fmaxf(rlanef(v, 32), rlanef(v, 48)));
}
template <int STRIDE>
__device__ __forceinline__ unsigned xchg_u32(unsigned x, int lane) {
    if constexpr (STRIDE == 1) return (unsigned)__builtin_amdgcn_update_dpp(0, (int)x, 0xB1, 0xF, 0xF, true);
    else if constexpr (STRIDE == 2) return (unsigned)__builtin_amdgcn_update_dpp(0, (int)x, 0x4E, 0xF, 0xF, true);
    else if constexpr (STRIDE == 4) {
        const unsigned up = (unsigned)__builtin_amdgcn_update_dpp(0, (int)x, 0x104, 0xF, 0xF, true);
        const unsigned dn = (unsigned)__builtin_amdgcn_update_dpp(0, (int)x, 0x114, 0xF, 0xF, true);
        return (lane & 4) ? dn : up;
    }
    else if constexpr (STRIDE == 8) return (unsigned)__builtin_amdgcn_update_dpp(0, (int)x, 0x128, 0xF, 0xF, true);
    else if constexpr (STRIDE == 16) { const u32x2 r_ = __builtin_amdgcn_permlane16_swap(x, x, false, false); return (lane & 16) ? r_[0] : r_[1]; }
    else { const u32x2 r_ = __builtin_amdgcn_permlane32_swap(x, x, false, false); return (lane & 32) ? r_[0] : r_[1]; }
}
template <int STRIDE> __device__ __forceinline__ float xchg_f32(float x, int lane) { return __uint_as_float(xchg_u32<STRIDE>(__float_as_uint(x), lane)); }
__device__ __forceinline__ float row16_sum(float v) { v += dppf(v, 0xB1); v += dppf(v, 0x4E); v += dppf(v, 0x141); v += dppf(v, 0x140); return v; }
__device__ __forceinline__ float oct_sum(float v) { v += dppf(v, 0xB1); v += dppf(v, 0x4E); v += dppf(v, 0x141); return v; }
__device__ __forceinline__ float siluf(float x) { return x * __builtin_amdgcn_rcpf(1.f + __expf(-x)); }
__device__ __forceinline__ float sigmoidf_(float x) { return __builtin_amdgcn_rcpf(1.f + __expf(-x)); }
__device__ __forceinline__ float logsigmoidf_(float x) { return fminf(x, 0.f) - log1pf(__expf(-fabsf(x))); }

#define XB_TMO      128
#define XB_XCNT(j)  (256  + 64 * (j))
#define XB_XSUB(j)  (1280 + 64 * (j))
#define XB_XGEN(j)  (2304 + 64 * (j))
#define XB_TOP      3328
#define XB_TOPGEN   3392
#define XCD_BAR_WORDS 3456
#define XB_SPIN_CAP (1u << 22)
__device__ __forceinline__ unsigned xb_ld(unsigned* p)              { return __hip_atomic_load(p, __ATOMIC_RELAXED, __HIP_MEMORY_SCOPE_AGENT); }
__device__ __forceinline__ unsigned xb_add(unsigned* p, unsigned v) { return __hip_atomic_fetch_add(p, v, __ATOMIC_RELAXED, __HIP_MEMORY_SCOPE_AGENT); }
__device__ __forceinline__ unsigned xb_xcc_id() { return (unsigned)__builtin_amdgcn_s_getreg((3 << 11) | 20) & 0xFu; }
#define XB_SPIN(cond, bar) do { unsigned _sp = 0; while (cond) { __builtin_amdgcn_s_sleep(1); \
    if ((++_sp & 255u) == 0u) { if (xb_ld(&(bar)[XB_TMO])) break; if (_sp > XB_SPIN_CAP) { atomicAdd(&(bar)[XB_TMO], 1u); break; } } } } while (0)
struct XcdBarrier { unsigned* bar; unsigned x; volatile LAS unsigned* st; };
__device__ __forceinline__ XcdBarrier xcd_barrier_post(unsigned* bar, volatile LAS unsigned* st) {
    XcdBarrier b; b.bar = bar; b.x = xb_xcc_id(); b.st = st;
    if (threadIdx.x == 0) (void)xb_add(&bar[XB_XCNT(b.x)], 1u);
    return b;
}
__device__ __forceinline__ void xcd_barrier_complete(unsigned* bar, unsigned x, unsigned& nloc, unsigned& nx) {
    const unsigned G = gridDim.x * gridDim.y * gridDim.z;
    unsigned sum, cnt, mine, sp = 0u;
    for (;;) {
        sum = 0u; cnt = 0u; mine = 0u;
#pragma unroll
        for (unsigned j = 0; j < 16; ++j) { const unsigned c = xb_ld(&bar[XB_XCNT(j)]); sum += c; cnt += (c > 0u) ? 1u : 0u; mine = (j == x) ? c : mine; }
        if (sum == G) break;
        __builtin_amdgcn_s_sleep(1);
        if ((++sp & 255u) == 0u) { if (xb_ld(&bar[XB_TMO])) break; if (sp > XB_SPIN_CAP) { atomicAdd(&bar[XB_TMO], 1u); break; } }
    }
    nloc = mine > 0u ? mine : 1u; nx = cnt > 0u ? cnt : 1u;
}
__device__ __forceinline__ void xcd_barrier(const XcdBarrier& b) {
    asm volatile("s_waitcnt vmcnt(0)" ::: "memory");
    __syncthreads();
    if (threadIdx.x == 0) {
        unsigned* bar = b.bar;
        __builtin_amdgcn_s_waitcnt(0);
        unsigned nloc = b.st[0], nx = b.st[1];
        if (nloc == 0u) { xcd_barrier_complete(bar, b.x, nloc, nx); b.st[0] = nloc; b.st[1] = nx; }
        const unsigned old = xb_add(&bar[XB_XSUB(b.x)], 1u);
        const unsigned gen = old / nloc;
        if (old + 1u == (gen + 1u) * nloc) {
            __builtin_amdgcn_fence(__ATOMIC_RELEASE, "agent");
            asm volatile("s_waitcnt vmcnt(0)" ::: "memory");
            const unsigned og = xb_add(&bar[XB_TOP], 1u);
            const unsigned tg = og / nx;
            if (og + 1u == (tg + 1u) * nx) xb_add(&bar[XB_TOPGEN], 1u);
            else XB_SPIN(xb_ld(&bar[XB_TOPGEN]) == tg, bar);
            __builtin_amdgcn_fence(__ATOMIC_ACQUIRE, "agent");
            xb_add(&bar[XB_XGEN(b.x)], 1u);
            asm volatile("s_waitcnt vmcnt(0)" ::: "memory");
        } else {
            XB_SPIN(xb_ld(&bar[XB_XGEN(b.x)]) == gen, bar);
            __builtin_amdgcn_fence(__ATOMIC_ACQUIRE, "agent");
            asm volatile("s_waitcnt vmcnt(0)" ::: "memory");
        }
    }
    __syncthreads();
}

#define CNT_ADA  3600
#define CNT_MLA  3664
#define CNT_SCAN 3728
__device__ __forceinline__ void wg_signal(unsigned* ctl, int word) {
    asm volatile("s_waitcnt vmcnt(0)" ::: "memory");
    __syncthreads();
    if (threadIdx.x == 0) {
        __builtin_amdgcn_fence(__ATOMIC_RELEASE, "agent");
        asm volatile("s_waitcnt vmcnt(0)" ::: "memory");
        (void)xb_add(&ctl[word], 1u);
    }
}
__device__ __forceinline__ void wg_wait(unsigned* ctl, int word, unsigned need) {
    if (threadIdx.x == 0) {
        XB_SPIN(xb_ld(&ctl[word]) < need, ctl);
        __builtin_amdgcn_fence(__ATOMIC_ACQUIRE, "agent");
        asm volatile("s_waitcnt vmcnt(0)" ::: "memory");
    }
    __syncthreads();
}

namespace pg8 {
constexpr int BM = 256, BK = 64, HALF = 128, HTB = HALF * BK * 2, STAGE_BYTES = 8 * HTB, NXCD = 8, WGM = 8;
__host__ __device__ __forceinline__ int lds_byte(int r, int c) { const int st = (r >> 4) * 2 + (c >> 5), rr = r & 15, cc = c & 31, ob = rr * 64 + cc * 2; return st * 1024 + (ob ^ (((ob >> 9) & 1) << 5)); }
__host__ __device__ __forceinline__ void stage_rc(int b, int& R, int& C) { const int st = b / 1024, sb = b % 1024, swz = sb ^ (((sb >> 9) & 1) << 5); R = (st >> 1) * 16 + swz / 64; C = (st & 1) * 32 + (swz % 64) / 2; }
__host__ __device__ __forceinline__ int perm32(int rho) { const int n = rho >> 4, i = rho & 15; return 8 * (i >> 2) + 4 * n + (i & 3); }
struct Unit { int pm, pn; };
struct Gemm { const bf16_t* A; const bf16_t* Bt; int M, N, K; };
struct StaticOrder {
    int nM, nN, nwg, G, c;
    __host__ __device__ void init(int M, int N, int G_, int c_) { nM = M / BM; nN = N / BM; nwg = nM * nN; G = G_; c = c_; }
    __host__ __device__ bool next(int i, Unit& u) const {
        const long L = (long)i * G + c; if (L >= nwg) return false;
        int wgid = (int)L; { const int q = nwg / NXCD, r = nwg % NXCD, xcd = wgid % NXCD, off = wgid / NXCD; wgid = (xcd < r ? xcd * (q + 1) : r * (q + 1) + (xcd - r) * q) + off; }
        const int nig = WGM * nN, gid = wgid / nig, fm = gid * WGM, gsz = (nM - fm) < WGM ? (nM - fm) : WGM;
        u.pm = fm + ((wgid % nig) % gsz); u.pn = (wgid % nig) / gsz; return true;
    }
    __device__ __forceinline__ void a_ready(const Unit&) const {}
    __device__ __forceinline__ void done(const Unit&) const {}
};
__device__ __forceinline__ unsigned cvt_pk_bf16(float lo, float hi) { unsigned r; asm volatile("v_cvt_pk_bf16_f32 %0, %1, %2" : "=v"(r) : "v"(lo), "v"(hi)); return r; }

template <class Epi, class Sched>
__device__ __forceinline__ void gemm_phase(LAS unsigned char* lds, const Gemm g, const Sched& S, const Epi& E) {
    const int tid = threadIdx.x, wid = __builtin_amdgcn_readfirstlane(tid >> 6), lane = tid & 63, wr = wid >> 2, wc = wid & 3, fr = lane & 15, fq = lane >> 4;
    const int K = g.K, nt = K / BK;
    unsigned voffA[2], voffB[2];
#pragma unroll
    for (int i = 0; i < 2; ++i) { int R, C; stage_rc(tid * 16 + i * 8192, R, C); const int Rb = Epi::PERM ? ((R & ~31) + perm32(R & 31)) : R;
        voffA[i] = (unsigned)(R * K + C) * 2u; voffB[i] = (unsigned)(Rb * K + C) * 2u; }
    const size_t kstep = (size_t)(BK * 2);
    const size_t hstep = (size_t)HALF * K * 2;
    const size_t tstep = 2 * hstep;
    const unsigned ldsw = (unsigned)wid * 1024u;
    const int aoff = lds_byte(wr * 64 + fr, fq * 8), boff = lds_byte(wc * 32 + fr, fq * 8);
#define PG8_SA(b, h) (((b) * 2 + (h)) * HTB)
#define PG8_SB(b, h) ((4 + (b) * 2 + (h)) * HTB)
#define PG8_STAGE(bufoff, gbase, voff) do { _Pragma("unroll") for (int _i = 0; _i < 2; ++_i) \
        __builtin_amdgcn_global_load_lds((const unsigned*)((const char*)(gbase) + (voff)[_i]), (LAS unsigned*)(lds + (bufoff) + ldsw + _i * 8192), 16, 0, 0); } while (0)
#define PG8_LDA(dst, b, h) do { _Pragma("unroll") for (int m = 0; m < 4; ++m) _Pragma("unroll") for (int k = 0; k < 2; ++k) dst[m][k] = *(const LAS bf16x8*)(lds + PG8_SA(b, h) + aoff + m * 2048 + k * 1024); } while (0)
#define PG8_LDB(dst, b, h) do { _Pragma("unroll") for (int n = 0; n < 2; ++n) _Pragma("unroll") for (int k = 0; k < 2; ++k) dst[n][k] = *(const LAS bf16x8*)(lds + PG8_SB(b, h) + boff + n * 2048 + k * 1024); } while (0)
#define PG8_MMA(ai, bj, At, Bt) do { __builtin_amdgcn_s_setprio(1); _Pragma("unroll") for (int m = 0; m < 4; ++m) _Pragma("unroll") for (int n = 0; n < 2; ++n) _Pragma("unroll") for (int k = 0; k < 2; ++k) \
        acc[ai][bj][m][n] = __builtin_amdgcn_mfma_f32_16x16x32_bf16(Bt[n][k], At[m][k], acc[ai][bj][m][n], 0, 0, 0); __builtin_amdgcn_s_setprio(0); } while (0)
#define PG8_WAIT_V(n) asm volatile("s_waitcnt vmcnt(" #n ")" ::: "memory")
#define PG8_WAIT_L(n) asm volatile("s_waitcnt lgkmcnt(" #n ")" ::: "memory")
#define PG8_BAR __builtin_amdgcn_s_barrier()
#define PG8_SCHED __builtin_amdgcn_sched_barrier(0)
    Unit cur, nxt; int ui = 0;
    if (!S.next(0, cur)) return;
    f32x4 acc[2][2][4][2];
#pragma unroll
    for (int a = 0; a < 2; ++a)
#pragma unroll
        for (int b = 0; b < 2; ++b)
#pragma unroll
            for (int m = 0; m < 4; ++m)
#pragma unroll
                for (int n = 0; n < 2; ++n) acc[a][b][m][n] = (f32x4){0.f, 0.f, 0.f, 0.f};
    bf16x8 At[4][2], B0[2][2], B1[2][2];
    const char* cA = (const char*)g.A + (size_t)cur.pm * tstep; const char* cB = (const char*)g.Bt + (size_t)cur.pn * tstep;
    S.a_ready(cur);
    PG8_STAGE(PG8_SB(0, 0), cB, voffB); PG8_STAGE(PG8_SA(0, 0), cA, voffA); PG8_STAGE(PG8_SB(0, 1), cB + hstep, voffB); PG8_STAGE(PG8_SA(0, 1), cA + hstep, voffA);
    if (wr == 1) PG8_BAR;
    PG8_WAIT_V(4); PG8_BAR;
    PG8_STAGE(PG8_SB(1, 0), cB + kstep, voffB); PG8_STAGE(PG8_SA(1, 0), cA + kstep, voffA); PG8_STAGE(PG8_SB(1, 1), cB + hstep + kstep, voffB);
    PG8_WAIT_V(6); PG8_BAR;
    for (;;) {
        const bool has_next = S.next(ui + 1, nxt);
        const char* nA = has_next ? (const char*)g.A + (size_t)nxt.pm * tstep : cA; const char* nB = has_next ? (const char*)g.Bt + (size_t)nxt.pn * tstep : cB;
        for (int t = 0; t < nt; t += 2) {
            const bool last = (t == nt - 2);
            const char* a1 = cA + (size_t)(t + 1) * kstep;
            const char* a2 = last ? nA : cA + (size_t)(t + 2) * kstep; const char* b2 = last ? nB : cB + (size_t)(t + 2) * kstep;
            const char* a3 = a2 + kstep; const char* b3 = b2 + kstep;
            if (last && has_next) S.a_ready(nxt);
            PG8_LDB(B0, 0, 0); PG8_SCHED; PG8_LDA(At, 0, 0); PG8_STAGE(PG8_SA(1, 1), a1 + hstep, voffA);
            PG8_WAIT_L(8); PG8_BAR; PG8_WAIT_L(0); PG8_MMA(0, 0, At, B0); PG8_BAR; PG8_SCHED;
            PG8_LDB(B1, 0, 1); PG8_STAGE(PG8_SB(0, 0), b2, voffB);
            PG8_BAR; PG8_WAIT_L(0); PG8_MMA(0, 1, At, B1); PG8_BAR;
            PG8_LDA(At, 0, 1); PG8_STAGE(PG8_SA(0, 0), a2, voffA);
            PG8_BAR; PG8_WAIT_L(0); PG8_MMA(1, 0, At, B0); PG8_BAR; PG8_SCHED;
            PG8_STAGE(PG8_SB(0, 1), b2 + hstep, voffB);
            PG8_WAIT_V(6); PG8_BAR; PG8_MMA(1, 1, At, B1); PG8_BAR;
            PG8_LDB(B0, 1, 0); PG8_SCHED; PG8_LDA(At, 1, 0); PG8_STAGE(PG8_SA(0, 1), a2 + hstep, voffA);
            PG8_WAIT_L(8); PG8_BAR; PG8_WAIT_L(0); PG8_MMA(0, 0, At, B0); PG8_BAR; PG8_SCHED;
            PG8_LDB(B1, 1, 1); PG8_STAGE(PG8_SB(1, 0), b3, voffB);
            PG8_BAR; PG8_WAIT_L(0); PG8_MMA(0, 1, At, B1); PG8_BAR;
            PG8_LDA(At, 1, 1); PG8_STAGE(PG8_SA(1, 0), a3, voffA);
            PG8_BAR; PG8_WAIT_L(0); PG8_MMA(1, 0, At, B0); PG8_BAR; PG8_SCHED;
            PG8_STAGE(PG8_SB(1, 1), b3 + hstep, voffB);
            PG8_WAIT_V(6); PG8_BAR; PG8_MMA(1, 1, At, B1); PG8_BAR;
        }
        asm volatile("s_nop 15\n\ts_nop 15" ::: "memory");
        E(acc, cur, wr, wc, fr, fq); S.done(cur);
        if (!has_next) break;
#pragma unroll
        for (int a = 0; a < 2; ++a)
#pragma unroll
            for (int b = 0; b < 2; ++b)
#pragma unroll
                for (int m = 0; m < 4; ++m)
#pragma unroll
                    for (int n = 0; n < 2; ++n) acc[a][b][m][n] = (f32x4){0.f, 0.f, 0.f, 0.f};
        cur = nxt; cA = nA; cB = nB; ++ui;
    }
    PG8_WAIT_V(0);
    if (wr == 0) PG8_BAR;
    PG8_BAR;
#undef PG8_SA
#undef PG8_SB
#undef PG8_STAGE
#undef PG8_LDA
#undef PG8_LDB
#undef PG8_MMA
#undef PG8_WAIT_V
#undef PG8_WAIT_L
#undef PG8_BAR
#undef PG8_SCHED
}
}

struct EpiInMain {
    static constexpr bool PERM = true;
    unsigned char* ws; const float* bias;
    __device__ __forceinline__ void operator()(const f32x4 (&acc)[2][2][4][2], const pg8::Unit& u, int wr, int wc, int fr, int fq) const {
        const int row0 = u.pm * 256 + wr * 64 + fr;
        const int cl0 = wc * 32 + 8 * fq;
        bf16_t* base = (bf16_t*)(ws + OFF_MQ + (size_t)(u.pn >> 1) * (16 * MiB)) + (u.pn & 1) * 256 + cl0;
        const float* bp = bias + u.pn * 256 + cl0;
#pragma unroll
        for (int bj = 0; bj < 2; ++bj) {
            const f32x4 b0 = *(const f32x4*)(bp + bj * 128), b1 = *(const f32x4*)(bp + bj * 128 + 4);
#pragma unroll
            for (int ai = 0; ai < 2; ++ai)
#pragma unroll
                for (int m = 0; m < 4; ++m) {
                    const f32x4 v0 = acc[ai][bj][m][0] + b0, v1 = acc[ai][bj][m][1] + b1;
                    u32x4 o; o[0] = pg8::cvt_pk_bf16(v0[0], v0[1]); o[1] = pg8::cvt_pk_bf16(v0[2], v0[3]); o[2] = pg8::cvt_pk_bf16(v1[0], v1[1]); o[3] = pg8::cvt_pk_bf16(v1[2], v1[3]);
                    *(u32x4*)(base + (size_t)(row0 + ai * 128 + m * 16) * 512 + bj * 128) = o;
                }
        }
    }
};
struct EpiInTail {
    static constexpr bool PERM = true;
    unsigned char* ws; const float* bias;
    __device__ __forceinline__ void operator()(const f32x4 (&acc)[2][2][4][2], const pg8::Unit& u, int wr, int wc, int fr, int fq) const {
        const int row0 = u.pm * 256 + wr * 64 + fr;
        const int cl0 = wc * 32 + 8 * fq;
#pragma unroll
        for (int bj = 0; bj < 2; ++bj) {
            const int cl = bj * 128 + cl0;
            if (cl >= 208) continue;
            const f32x4 b0 = *(const f32x4*)(bias + cl), b1 = *(const f32x4*)(bias + cl + 4);
            if (cl < 192) {
                bf16_t* dst = (bf16_t*)(ws + OFF_AK + (size_t)(cl >> 6) * (2 * MiB)) + (cl & 63);
#pragma unroll
                for (int ai = 0; ai < 2; ++ai)
#pragma unroll
                    for (int m = 0; m < 4; ++m) {
                        const f32x4 v0 = acc[ai][bj][m][0] + b0, v1 = acc[ai][bj][m][1] + b1;
                        u32x4 o; o[0] = pg8::cvt_pk_bf16(v0[0], v0[1]); o[1] = pg8::cvt_pk_bf16(v0[2], v0[3]); o[2] = pg8::cvt_pk_bf16(v1[0], v1[1]); o[3] = pg8::cvt_pk_bf16(v1[2], v1[3]);
                        *(u32x4*)(dst + (size_t)(row0 + ai * 128 + m * 16) * 64) = o;
                    }
            } else {
                float* dst = (float*)(ws + OFF_GATE) + (cl - 192);
#pragma unroll
                for (int ai = 0; ai < 2; ++ai)
#pragma unroll
                    for (int m = 0; m < 4; ++m) {
                        float* d = dst + (size_t)(row0 + ai * 128 + m * 16) * 16;
                        *(f32x4*)d = acc[ai][bj][m][0] + b0; *(f32x4*)(d + 4) = acc[ai][bj][m][1] + b1;
                    }
            }
        }
    }
};
struct EpiOut {
    static constexpr bool PERM = false;
    const float* x; const float* ada; float* out;
    __device__ __forceinline__ void operator()(const f32x4 (&acc)[2][2][4][2], const pg8::Unit& u, int wr, int wc, int fr, int fq) const {
        const int row0 = u.pm * 256 + wr * 64 + fr, col0 = u.pn * 256 + wc * 32 + 4 * fq;
        const int b = (u.pm * 256) >> 12;
        f32x4 gv[2][2];
#pragma unroll
        for (int bj = 0; bj < 2; ++bj)
#pragma unroll
            for (int n = 0; n < 2; ++n) gv[bj][n] = *(const f32x4*)(ada + b * 6144 + 2048 + col0 + bj * 128 + n * 16);
#pragma unroll
        for (int ai = 0; ai < 2; ++ai)
#pragma unroll
            for (int m = 0; m < 4; ++m) {
                const size_t ro = (size_t)(row0 + ai * 128 + m * 16) * 1024 + col0;
#pragma unroll
                for (int bj = 0; bj < 2; ++bj)
#pragma unroll
                    for (int n = 0; n < 2; ++n) {
                        const f32x4 xv = *(const f32x4*)(x + ro + bj * 128 + n * 16);
                        *(f32x4*)(out + ro + bj * 128 + n * 16) = xv + gv[bj][n] * acc[ai][bj][m][n];
                    }
            }
    }
};
struct EpiQry {
    static constexpr bool PERM = true;
    bf16_t* O;
    __device__ __forceinline__ void operator()(const f32x4 (&acc)[2][2][4][2], const pg8::Unit& u, int wr, int wc, int fr, int fq) const {
        const int row0 = u.pm * 256 + wr * 64 + fr, col0 = u.pn * 256 + wc * 32 + 8 * fq;
#pragma unroll
        for (int ai = 0; ai < 2; ++ai)
#pragma unroll
            for (int m = 0; m < 4; ++m) {
                bf16_t* rowp = O + (size_t)(row0 + ai * 128 + m * 16) * 1024 + col0;
#pragma unroll
                for (int bj = 0; bj < 2; ++bj) {
                    const f32x4 v0 = acc[ai][bj][m][0], v1 = acc[ai][bj][m][1];
                    u32x4 o; o[0] = pg8::cvt_pk_bf16(v0[0], v0[1]); o[1] = pg8::cvt_pk_bf16(v0[2], v0[3]); o[2] = pg8::cvt_pk_bf16(v1[0], v1[1]); o[3] = pg8::cvt_pk_bf16(v1[2], v1[3]);
                    *(u32x4*)(rowp + bj * 128) = o;
                }
            }
    }
};

__device__ __forceinline__ int inperm_src(int n) {
    if (n < 2048) return n;
    if (n < 2560) return 2056 + (n - 2048);
    if (n < 3072) return 2696 + (n - 2560);
    if (n < 3136) return 2568 + (n - 3072);
    if (n < 3200) return 2632 + (n - 3136);
    if (n < 3264) return 3208 + (n - 3200);
    if (n < 3268) return 2048 + (n - 3264);
    if (n < 3272) return 2052 + (n - 3268);
    if (n < 3280) return 3272 + (n - 3272);
    return -1;
}
template <bool PERMUTE>
__device__ __forceinline__ void transpose_tile(const float* src, int ld, bf16_t* dst, int n0, int k0, LAS float* t) {
    const int tid = threadIdx.x;
    for (int i = tid; i < 4096; i += NTHREADS) {
        const int kk = i >> 6, nn = i & 63;
        const int sc = PERMUTE ? inperm_src(n0 + nn) : (n0 + nn);
        t[kk * 65 + nn] = sc >= 0 ? src[(size_t)(k0 + kk) * ld + sc] : 0.f;
    }
    __syncthreads();
    for (int i = tid; i < 2048; i += NTHREADS) {
        const int nn = i >> 5, kp = (i & 31) * 2;
        ((unsigned*)dst)[((size_t)(n0 + nn) * 1024 + k0 + kp) >> 1] = pack2(t[kp * 65 + nn], t[(kp + 1) * 65 + nn]);
    }
    __syncthreads();
}
__device__ __forceinline__ void convert_chunk(const float* src, bf16_t* dst, size_t e0, int n) {
    for (int i = threadIdx.x * 8; i < n; i += NTHREADS * 8) {
        const f32x4 a = *(const f32x4*)(src + e0 + i), b = *(const f32x4*)(src + e0 + i + 4);
        u32x4 o; o[0] = pack2(a[0], a[1]); o[1] = pack2(a[2], a[3]); o[2] = pack2(b[0], b[1]); o[3] = pack2(b[2], b[3]);
        *(u32x4*)(dst + e0 + i) = o;
    }
}
__device__ __forceinline__ unsigned pack4_fp8(float a, float b, float c, float d) {
    a = fminf(fmaxf(a, -448.f), 448.f); b = fminf(fmaxf(b, -448.f), 448.f); c = fminf(fmaxf(c, -448.f), 448.f); d = fminf(fmaxf(d, -448.f), 448.f);
    int w = 0;
    w = __builtin_amdgcn_cvt_pk_fp8_f32(a, b, w, false);
    w = __builtin_amdgcn_cvt_pk_fp8_f32(c, d, w, true);
    return (unsigned)w;
}
__device__ __forceinline__ void convert_chunk_fp8(const float* src, unsigned char* dst, size_t e0, int n, float scale) {
    for (int i = threadIdx.x * 16; i < n; i += NTHREADS * 16) {
        const f32x4 a = *(const f32x4*)(src + e0 + i), b = *(const f32x4*)(src + e0 + i + 4), c = *(const f32x4*)(src + e0 + i + 8), d = *(const f32x4*)(src + e0 + i + 12);
        u32x4 o; o[0] = pack4_fp8(a[0] * scale, a[1] * scale, a[2] * scale, a[3] * scale); o[1] = pack4_fp8(b[0] * scale, b[1] * scale, b[2] * scale, b[3] * scale);
        o[2] = pack4_fp8(c[0] * scale, c[1] * scale, c[2] * scale, c[3] * scale); o[3] = pack4_fp8(d[0] * scale, d[1] * scale, d[2] * scale, d[3] * scale);
        *(u32x4*)(dst + e0 + i) = o;
    }
}
__device__ __forceinline__ unsigned pack8_fp4(const f32x4 a, const f32x4 b, float scale) {
    float v[8] = {a[0] * scale, a[1] * scale, a[2] * scale, a[3] * scale, b[0] * scale, b[1] * scale, b[2] * scale, b[3] * scale};
#pragma unroll
    for (int i = 0; i < 8; ++i) v[i] = fminf(fmaxf(v[i], -6.f), 6.f);
    unsigned w = 0;
    w = __builtin_amdgcn_cvt_scalef32_pk_fp4_f32(w, v[0], v[1], 1.0f, 0);
    w = __builtin_amdgcn_cvt_scalef32_pk_fp4_f32(w, v[2], v[3], 1.0f, 1);
    w = __builtin_amdgcn_cvt_scalef32_pk_fp4_f32(w, v[4], v[5], 1.0f, 2);
    w = __builtin_amdgcn_cvt_scalef32_pk_fp4_f32(w, v[6], v[7], 1.0f, 3);
    return w;
}
__device__ __forceinline__ void convert_chunk_fp4(const float* src, unsigned char* dst, size_t e0, int n, float scale) {
    for (int i = threadIdx.x * 32; i < n; i += NTHREADS * 32) {
        u32x4 o;
#pragma unroll
        for (int k = 0; k < 4; ++k) o[k] = pack8_fp4(*(const f32x4*)(src + e0 + i + 8 * k), *(const f32x4*)(src + e0 + i + 8 * k + 4), scale);
        *(u32x4*)(dst + ((e0 + i) >> 1)) = o;
    }
}
__device__ __forceinline__ unsigned pack4_i8(float a, float b, float c, float d, float scale) {
    const int ia = (int)fminf(fmaxf(rintf(a * scale), -127.f), 127.f), ib = (int)fminf(fmaxf(rintf(b * scale), -127.f), 127.f);
    const int ic = (int)fminf(fmaxf(rintf(c * scale), -127.f), 127.f), id = (int)fminf(fmaxf(rintf(d * scale), -127.f), 127.f);
    return (unsigned)(ia & 0xFF) | ((unsigned)(ib & 0xFF) << 8) | ((unsigned)(ic & 0xFF) << 16) | ((unsigned)(id & 0xFF) << 24);
}
__device__ __forceinline__ void convert_chunk_i8(const float* src, unsigned char* dst, size_t e0, int n, float scale) {
    for (int i = threadIdx.x * 16; i < n; i += NTHREADS * 16) {
        const f32x4 a = *(const f32x4*)(src + e0 + i), b = *(const f32x4*)(src + e0 + i + 4), c = *(const f32x4*)(src + e0 + i + 8), d = *(const f32x4*)(src + e0 + i + 12);
        u32x4 o; o[0] = pack4_i8(a[0], a[1], a[2], a[3], scale); o[1] = pack4_i8(b[0], b[1], b[2], b[3], scale); o[2] = pack4_i8(c[0], c[1], c[2], c[3], scale); o[3] = pack4_i8(d[0], d[1], d[2], d[3], scale);
        *(u32x4*)(dst + e0 + i) = o;
    }
}
__device__ __forceinline__ unsigned pack8_i4(const f32x4 a, const f32x4 b, float scale) {
    unsigned w = 0;
#pragma unroll
    for (int k = 0; k < 4; ++k) {
        const int qa = (int)fminf(fmaxf(rintf(a[k] * scale), -7.f), 7.f) + 8, qb = (int)fminf(fmaxf(rintf(b[k] * scale), -7.f), 7.f) + 8;
        w |= (unsigned)qa << (4 * k); w |= (unsigned)qb << (4 * (k + 4));
    }
    return w;
}
__device__ __forceinline__ void convert_chunk_i4(const float* src, unsigned char* dst, size_t e0, int n, float scale) {
    for (int i = threadIdx.x * 32; i < n; i += NTHREADS * 32) {
        u32x4 o;
#pragma unroll
        for (int k = 0; k < 4; ++k) o[k] = pack8_i4(*(const f32x4*)(src + e0 + i + 8 * k), *(const f32x4*)(src + e0 + i + 8 * k + 4), scale);
        *(u32x4*)(dst + ((e0 + i) >> 1)) = o;
    }
}
__device__ __forceinline__ void convert_tables(const Params& p, int first, int stride) {
    for (int it = first; it < 1024; it += stride) {
        const int tsel = it >> 9; const size_t e0 = (size_t)(it & 511) * 32768;
        if (tsel) convert_chunk_i4(p.peer_v, p.ws + OFF_VT, e0, 32768, PEER_SV); else convert_chunk_i8(p.peer_u, p.ws + OFF_UT, e0, 32768, PEER_SU);
    }
}
__device__ __forceinline__ void phase0(const Params& p, LAS unsigned char* lds) {
    const int tid = threadIdx.x;
    float* ada = (float*)(p.ws + OFF_ADA);
    LAS float* lf = (LAS float*)lds;
    constexpr int N_ADA = 192, N_WIN = 52 * 16, N_WOUT = 256, N_WPQ = 256, N_SK = 4, N_BIAS = 1;
    constexpr int NITEMS = N_ADA + N_WIN + N_WOUT + N_WPQ + N_SK + N_BIAS;
    if (blockIdx.x < N_ADA) {
        {
            const int it = blockIdx.x;
            LAS float* sc = lf; LAS float* red = lf + 4096;
            for (int i = tid; i < 4096; i += NTHREADS) sc[i] = siluf(p.c[i]);
            __syncthreads();
            const int col = tid & 31, kg = tid >> 5, c0 = it * 32;
            float a0 = 0.f, a1 = 0.f, a2 = 0.f, a3 = 0.f;
            const float* w = p.w_ada + c0 + col;
#pragma unroll 8
            for (int j = 0; j < 64; ++j) { const int k = kg + 16 * j; const float wv = w[(size_t)k * 6144];
                a0 += sc[k] * wv; a1 += sc[1024 + k] * wv; a2 += sc[2048 + k] * wv; a3 += sc[3072 + k] * wv; }
            red[(kg * 4 + 0) * 32 + col] = a0; red[(kg * 4 + 1) * 32 + col] = a1; red[(kg * 4 + 2) * 32 + col] = a2; red[(kg * 4 + 3) * 32 + col] = a3;
            __syncthreads();
            if (tid < 128) { const int b = tid >> 5, cc = tid & 31; float s = 0.f;
                for (int g = 0; g < 16; ++g) s += red[(g * 4 + b) * 32 + cc];
                ada[b * 6144 + c0 + cc] = s + p.b_ada[c0 + cc]; }
        }
        wg_signal((unsigned*)(p.ws + OFF_CTL), CNT_ADA);
        __syncthreads();
    }
    for (int item = N_ADA + ((blockIdx.x + gridDim.x - N_ADA) % gridDim.x); item < NITEMS; item += gridDim.x) {
        int it = item;
        it -= N_ADA;
        if (it < N_WIN) { transpose_tile<true>(p.w_in, 3280, (bf16_t*)(p.ws + OFF_WIN), (it >> 4) * 64, (it & 15) * 64, lf); continue; }
        it -= N_WIN;
        if (it < N_WOUT) { transpose_tile<false>(p.w_out, 1024, (bf16_t*)(p.ws + OFF_WOUT), (it >> 4) * 64, (it & 15) * 64, lf); continue; }
        it -= N_WOUT;
        if (it < N_WPQ) { transpose_tile<false>(p.w_peer_q, 1024, (bf16_t*)(p.ws + OFF_WPQ), (it >> 4) * 64, (it & 15) * 64, lf); continue; }
        it -= N_WPQ;

        if (it < N_SK) { convert_chunk(p.sub_keys, (bf16_t*)(p.ws + OFF_SK), (size_t)it * 32768, 32768); continue; }
        it -= N_SK;
        { float* bias = (float*)(p.ws + OFF_BIAS);
          for (int n = tid; n < NIN_PAD; n += NTHREADS) { const int s = inperm_src(n); bias[n] = s >= 0 ? p.b_in[s] : 0.f; } }
    }
}

__device__ __forceinline__ void norm_mod_rows(const float* X, const float* g, const float* ada, int sh_off, int sc_off, bf16_t* out) {
    const int wid = threadIdx.x >> 6, lane = threadIdx.x & 63;
    for (int row = (blockIdx.x * 8 + wid) * 2; row < NTOK; row += gridDim.x * 16) {
        const int b = row >> 12;
        f32x4 v[2][4]; float ss[2] = {0.f, 0.f};
#pragma unroll
        for (int rr = 0; rr < 2; ++rr)
#pragma unroll
            for (int j = 0; j < 4; ++j) v[rr][j] = *(const f32x4*)(X + (size_t)(row + rr) * 1024 + 4 * (lane + 64 * j));
#pragma unroll
        for (int rr = 0; rr < 2; ++rr)
#pragma unroll
            for (int j = 0; j < 4; ++j) ss[rr] += v[rr][j][0] * v[rr][j][0] + v[rr][j][1] * v[rr][j][1] + v[rr][j][2] * v[rr][j][2] + v[rr][j][3] * v[rr][j][3];
        ss[0] = wave_sum(ss[0]); ss[1] = wave_sum(ss[1]);
        const float rstd0 = rsqrtf(ss[0] * (1.f / 1024.f) + 1e-6f), rstd1 = rsqrtf(ss[1] * (1.f / 1024.f) + 1e-6f);
#pragma unroll
        for (int j = 0; j < 4; ++j) {
            const int c = 4 * (lane + 64 * j);
            const f32x4 gg = *(const f32x4*)(g + c), sc = *(const f32x4*)(ada + b * 6144 + sc_off + c), sh = *(const f32x4*)(ada + b * 6144 + sh_off + c);
#pragma unroll
            for (int rr = 0; rr < 2; ++rr) {
                const float rstd = rr ? rstd1 : rstd0;
                float h[4];
#pragma unroll
                for (int i = 0; i < 4; ++i) h[i] = (v[rr][j][i] * rstd * gg[i]) * (1.f + sc[i]) + sh[i];
                u32x2 o; o[0] = pack2(h[0], h[1]); o[1] = pack2(h[2], h[3]);
                *(u32x2*)(out + (size_t)(row + rr) * 1024 + c) = o;
            }
        }
    }
}

__device__ __forceinline__ bf16x8 lds_frag(const LAS bf16_t* base, int row, int stride, int kofs) { return *(const LAS bf16x8*)(base + row * stride + kofs); }

__device__ __forceinline__ void conv_silu8(const bf16_t* src, const float* cw  , int row, int tpos, int col, float scale, float (&o)[8]) {
    float acc[8];
#pragma unroll
    for (int i = 0; i < 8; ++i) acc[i] = 0.f;
#pragma unroll
    for (int j = 0; j < 4; ++j) {
        const int tt = tpos - 3 + j;
        if (tt >= 0) {
            const u32x4 xv = *(const u32x4*)(src + (size_t)(row - 3 + j) * 512 + col);
            const f32x4 w0 = *(const f32x4*)(cw + j * 1024), w1 = *(const f32x4*)(cw + j * 1024 + 4);
            acc[0] += w0[0] * lo16(xv[0]); acc[1] += w0[1] * hi16(xv[0]); acc[2] += w0[2] * lo16(xv[1]); acc[3] += w0[3] * hi16(xv[1]);
            acc[4] += w1[0] * lo16(xv[2]); acc[5] += w1[1] * hi16(xv[2]); acc[6] += w1[2] * lo16(xv[3]); acc[7] += w1[3] * hi16(xv[3]);
        }
    }
#pragma unroll
    for (int i = 0; i < 8; ++i) o[i] = siluf(acc[i]) * scale;
}

__device__ __forceinline__ void mlstm_passA(const Params& p, int task, LAS unsigned char* lds) {
    const int tid = opaque_tid(), wid = tid >> 6, lane = tid & 63;
    const int bh = task >> 6, c = task & 63, b = bh >> 2, h = bh & 3;
    const int row0 = b * SEQ + c * 64;
    const float* gates = (const float*)(p.ws + OFF_GATE);
    const bf16_t* MK = (const bf16_t*)(p.ws + OFF_MK); const bf16_t* MV = (const bf16_t*)(p.ws + OFF_MV);
    LAS bf16_t* KT = (LAS bf16_t*)lds;
    LAS bf16_t* VT = KT + 128 * 72;
    LAS float* sc = (LAS float*)(VT + 128 * 72);
    LAS float* lsg = sc; LAS float* ig = sc + 64; LAS float* wloc = sc + 128; LAS float* misc = sc + 192;
    if (tid < 64) {
        const float f = gates[(size_t)(row0 + tid) * 16 + 4 + h], iv = gates[(size_t)(row0 + tid) * 16 + h];
        const float bc = wave_scan_add(logsigmoidf_(f), lane);
        const float bl = __shfl(bc, 63);
        const float a = bl - bc + iv;
        const float m = wave_max(a);
        lsg[tid] = bc; ig[tid] = iv; wloc[tid] = __expf(a - m);
        if (tid == 0) { misc[0] = m; misc[1] = bl; }
    }
    __syncthreads();
    for (int pc = tid; pc < 1024; pc += NTHREADS) {
        const int s = pc >> 4, dg = pc & 15;
        float kk[8];
        conv_silu8(MK, p.conv_qk + 512 + h * 128 + dg * 8, row0 + s, c * 64 + s, h * 128 + dg * 8, 1.f, kk);
#pragma unroll
        for (int i = 0; i < 8; ++i) KT[(dg * 8 + i) * 72 + s] = f2bf(kk[i]);
        const u32x4 vv = *(const u32x4*)(MV + (size_t)(row0 + s) * 512 + h * 128 + dg * 8);
        const float w = wloc[s];
#pragma unroll
        for (int i = 0; i < 4; ++i) { VT[(dg * 8 + 2 * i) * 72 + s] = f2bf(lo16(vv[i]) * w); VT[(dg * 8 + 2 * i + 1) * 72 + s] = f2bf(hi16(vv[i]) * w); }
    }
    __syncthreads();
    {
        const int r = lane & 15, g = lane >> 4;
        bf16x8 a0 = lds_frag(VT, wid * 16 + r, 72, 8 * g), a1 = lds_frag(VT, wid * 16 + r, 72, 8 * g + 32);
        bf16_t* KV = (bf16_t*)(p.ws + OFF_KV) + (size_t)task * 16384;
#pragma unroll
        for (int dt = 0; dt < 8; ++dt) {
            f32x4 acc = {0.f, 0.f, 0.f, 0.f};
            acc = __builtin_amdgcn_mfma_f32_16x16x32_bf16(a0, lds_frag(KT, dt * 16 + r, 72, 8 * g), acc, 0, 0, 0);
            acc = __builtin_amdgcn_mfma_f32_16x16x32_bf16(a1, lds_frag(KT, dt * 16 + r, 72, 8 * g + 32), acc, 0, 0, 0);
#pragma unroll
            for (int j = 0; j < 4; ++j) KV[(wid * 16 + 4 * g + j) * 128 + dt * 16 + r] = f2bf_sw(acc[j]);
        }
    }
    if (tid < 128) {
        float s = 0.f;
        for (int i = 0; i < 64; ++i) s += wloc[i] * bf2f(KT[tid * 72 + i]);
        ((float*)(p.ws + OFF_KS))[(size_t)task * 128 + tid] = s;
    }
    if (tid == 0) { ((float*)(p.ws + OFF_MLOC))[task] = misc[0]; ((float*)(p.ws + OFF_BLAST))[task] = misc[1]; }
    __syncthreads();
}

__device__ __forceinline__ void mlstm_scan(const Params& p, int item, LAS unsigned char* lds) {
    const int tid = opaque_tid();
    const int bh = item >> 4, blk = item & 15;
    LAS float* dec = (LAS float*)lds; LAS float* inj = dec + 64;
    if (tid == 0) {
        const float* ML = (const float*)(p.ws + OFF_MLOC); const float* BL = (const float*)(p.ws + OFF_BLAST); float* M0 = (float*)(p.ws + OFF_M0);
        float m = 0.f;
        for (int c = 0; c < 64; ++c) {
            const float ml = ML[bh * 64 + c], bl = BL[bh * 64 + c];
            if (blk == 0) M0[bh * 64 + c] = m;
            const float mn = fmaxf(bl + m, ml);
            dec[c] = __expf(bl + m - mn); inj[c] = __expf(ml - mn); m = mn;
        }
    }
    __syncthreads();
    unsigned* KV = (unsigned*)(p.ws + OFF_KV) + (size_t)bh * 64 * 8192 + blk * 512 + tid;
    float s0 = 0.f, s1 = 0.f;
#pragma unroll 8
    for (int c = 0; c < 64; ++c) {
        const unsigned w = KV[(size_t)c * 8192];
        KV[(size_t)c * 8192] = pack2(s0, s1);
        s0 = dec[c] * s0 + inj[c] * lo16(w); s1 = dec[c] * s1 + inj[c] * hi16(w);
    }
    if (blk == 0 && tid < 128) {
        float* KS = (float*)(p.ws + OFF_KS) + (size_t)bh * 64 * 128 + tid;
        float s = 0.f;
        for (int c = 0; c < 64; ++c) { const float k = KS[c * 128]; KS[c * 128] = s; s = dec[c] * s + inj[c] * k; }
    }
    __syncthreads();
}

__device__ __forceinline__ void mlstm_passB(const Params& p, int task, LAS unsigned char* lds) {
    const int tid = opaque_tid(), wid = tid >> 6, lane = tid & 63;
    const int bh = task >> 6, c = task & 63, b = bh >> 2, h = bh & 3;
    const int row0 = b * SEQ + c * 64;
    const float* gates = (const float*)(p.ws + OFF_GATE);
    const bf16_t* MQ = (const bf16_t*)(p.ws + OFF_MQ); const bf16_t* MK = (const bf16_t*)(p.ws + OFF_MK);
    const bf16_t* MV = (const bf16_t*)(p.ws + OFF_MV); const bf16_t* MO = (const bf16_t*)(p.ws + OFF_MO);
    LAS bf16_t* Q = (LAS bf16_t*)lds;
    LAS bf16_t* K = Q + 64 * 136;
    LAS bf16_t* VT = K + 64 * 136;
    LAS bf16_t* C0 = VT + 128 * 72;
    LAS bf16_t* P = C0 + 128 * 136;
    LAS float* sc = (LAS float*)(P + 64 * 72);
    LAS float* bcum = sc; LAS float* ig = sc + 64; LAS float* cs = sc + 128; LAS float* rb = sc + 192; LAS float* wint = sc + 256;
    LAS float* emt = sc + 320; LAS float* rinv = sc + 384; LAS float* qn = sc + 448; LAS float* n0 = sc + 512; LAS float* rowpart = sc + 640;
    LAS float* H = (LAS float*)lds;
    if (tid < 64) {
        const float f = gates[(size_t)(row0 + tid) * 16 + 4 + h], iv = gates[(size_t)(row0 + tid) * 16 + h];
        const float m0 = ((const float*)(p.ws + OFF_M0))[task];
        const float sc_ = wave_scan_add(logsigmoidf_(f), lane);
        const float cst = iv - sc_;
        const float pm = wave_scan_max(cst, lane);
        const float m_intra = sc_ + pm, m_inter = sc_ + m0, mt = fmaxf(m_inter, m_intra);
        bcum[tid] = sc_; ig[tid] = iv; cs[tid] = cst; rb[tid] = sc_ - mt; wint[tid] = __expf(m_inter - mt); emt[tid] = __expf(-mt);
    }
    if (tid >= 64 && tid < 192) n0[tid - 64] = ((const float*)(p.ws + OFF_KS))[(size_t)task * 128 + tid - 64];
    for (int pc = tid; pc < 1024; pc += NTHREADS) {
        const int s = pc >> 4, dg = pc & 15;
        float qq[8], kk[8];
        conv_silu8(MQ, p.conv_qk + h * 128 + dg * 8, row0 + s, c * 64 + s, h * 128 + dg * 8, 0.08838834764831845f, qq);
        conv_silu8(MK, p.conv_qk + 512 + h * 128 + dg * 8, row0 + s, c * 64 + s, h * 128 + dg * 8, 1.f, kk);
        u32x4 qo, ko;
#pragma unroll
        for (int i = 0; i < 4; ++i) { qo[i] = pack2(qq[2 * i], qq[2 * i + 1]); ko[i] = pack2(kk[2 * i], kk[2 * i + 1]); }
        *(LAS u32x4*)(Q + s * 136 + dg * 8) = qo; *(LAS u32x4*)(K + s * 136 + dg * 8) = ko;
        const u32x4 vv = *(const u32x4*)(MV + (size_t)(row0 + s) * 512 + h * 128 + dg * 8);
#pragma unroll
        for (int i = 0; i < 4; ++i) { VT[(dg * 8 + 2 * i) * 72 + s] = (bf16_t)(vv[i] & 0xffffu); VT[(dg * 8 + 2 * i + 1) * 72 + s] = (bf16_t)(vv[i] >> 16); }
    }
    {
        const bf16_t* KV = (const bf16_t*)(p.ws + OFF_KV) + (size_t)task * 16384;
        for (int pc = tid; pc < 2048; pc += NTHREADS) { const int e = pc >> 4, dg = pc & 15;
            *(LAS u32x4*)(C0 + e * 136 + dg * 8) = *(const u32x4*)(KV + e * 128 + dg * 8); }
    }
    __syncthreads();
    const int r = lane & 15, g = lane >> 4;
    {
        const int t = tid >> 3, part = tid & 7; float s = 0.f;
#pragma unroll
        for (int i = 0; i < 16; ++i) s += bf2f(Q[t * 136 + part * 16 + i]) * n0[part * 16 + i];
        s = oct_sum(s);
        if (part == 0) qn[t] = s;
    }
    {
        const int rt = wid >> 1;
#pragma unroll
        for (int cc = 0; cc < 2; ++cc) {
            const int ct = 2 * (wid & 1) + cc;
            f32x4 acc = {0.f, 0.f, 0.f, 0.f};
#pragma unroll
            for (int ks = 0; ks < 4; ++ks)
                acc = __builtin_amdgcn_mfma_f32_16x16x32_bf16(lds_frag(Q, rt * 16 + r, 136, 8 * g + 32 * ks), lds_frag(K, ct * 16 + r, 136, 8 * g + 32 * ks), acc, 0, 0, 0);
            const int scol = ct * 16 + r; const float csv = cs[scol];
#pragma unroll
            for (int j = 0; j < 4; ++j) {
                const int t = rt * 16 + 4 * g + j;
                float pv = (scol <= t) ? acc[j] * __expf(rb[t] + csv) : 0.f;
                P[t * 72 + scol] = f2bf(pv);
                pv = row16_sum(pv);
                if (r == 0) rowpart[t * 4 + ct] = pv;
            }
        }
    }
    __syncthreads();
    if (tid < 64) {
        const float den = rowpart[tid * 4] + rowpart[tid * 4 + 1] + rowpart[tid * 4 + 2] + rowpart[tid * 4 + 3] + wint[tid] * qn[tid];
        rinv[tid] = 1.f / fmaxf(fabsf(den), emt[tid]);
    }
    f32x4 hacc[4];
    {
        const int rt = wid >> 1;
#pragma unroll
        for (int ee = 0; ee < 4; ++ee) {
            const int et = 4 * (wid & 1) + ee;
            f32x4 a1 = {0.f, 0.f, 0.f, 0.f}, a2 = {0.f, 0.f, 0.f, 0.f};
#pragma unroll
            for (int ks = 0; ks < 2; ++ks)
                a1 = __builtin_amdgcn_mfma_f32_16x16x32_bf16(lds_frag(P, rt * 16 + r, 72, 8 * g + 32 * ks), lds_frag(VT, et * 16 + r, 72, 8 * g + 32 * ks), a1, 0, 0, 0);
#pragma unroll
            for (int ks = 0; ks < 4; ++ks)
                a2 = __builtin_amdgcn_mfma_f32_16x16x32_bf16(lds_frag(Q, rt * 16 + r, 136, 8 * g + 32 * ks), lds_frag(C0, et * 16 + r, 136, 8 * g + 32 * ks), a2, 0, 0, 0);
#pragma unroll
            for (int j = 0; j < 4; ++j) { const int t = rt * 16 + 4 * g + j; hacc[ee][j] = a1[j] + wint[t] * a2[j]; }
        }
    }
    __syncthreads();
    {
        const int rt = wid >> 1;
#pragma unroll
        for (int ee = 0; ee < 4; ++ee) {
            const int et = 4 * (wid & 1) + ee;
#pragma unroll
            for (int j = 0; j < 4; ++j) { const int t = rt * 16 + 4 * g + j; H[t * 132 + et * 16 + r] = hacc[ee][j] * rinv[t]; }
        }
    }
    __syncthreads();
    {
        const int t = tid >> 3, part = tid & 7;
        float hv[16]; float ss = 0.f;
#pragma unroll
        for (int i = 0; i < 16; ++i) { hv[i] = H[t * 132 + part * 16 + i]; ss += hv[i] * hv[i]; }
        ss = oct_sum(ss);
        const float rstd = rsqrtf(ss * (1.f / 128.f) + 1e-6f);
        const int col = h * 128 + part * 16;
        const u32x4 m0v = *(const u32x4*)(MO + (size_t)(row0 + t) * 512 + col), m1v = *(const u32x4*)(MO + (size_t)(row0 + t) * 512 + col + 8);
        float mo[16];
#pragma unroll
        for (int i = 0; i < 4; ++i) { mo[2 * i] = lo16(m0v[i]); mo[2 * i + 1] = hi16(m0v[i]); mo[8 + 2 * i] = lo16(m1v[i]); mo[8 + 2 * i + 1] = hi16(m1v[i]); }
        float o[16];
#pragma unroll
        for (int i = 0; i < 16; ++i) o[i] = (hv[i] * rstd * p.out_norm_m[col + i]) * sigmoidf_(mo[i]);
        u32x4 o0, o1;
#pragma unroll
        for (int i = 0; i < 4; ++i) { o0[i] = pack2(o[2 * i], o[2 * i + 1]); o1[i] = pack2(o[8 + 2 * i], o[8 + 2 * i + 1]); }
        bf16_t* dst = (bf16_t*)(p.ws + OFF_ACT) + (size_t)(row0 + t) * 1024 + col;
        *(u32x4*)dst = o0; *(u32x4*)(dst + 8) = o1;
    }
    __syncthreads();
}

__device__ __forceinline__ unsigned f2sortable(float f) { const unsigned u = __float_as_uint(f); return (u & 0x80000000u) ? ~u : (u | 0x80000000u); }
#define CNT4(c0, c1, c2, c3, a, b, cc, d, thr) asm volatile( \
    "v_cmp_ge_u32 s[40:41], %4, %8\n\tv_cmp_ge_u32 s[42:43], %5, %8\n\tv_cmp_ge_u32 s[44:45], %6, %8\n\tv_cmp_ge_u32 s[46:47], %7, %8\n\t" \
    "v_addc_co_u32 %0, s[48:49], 0, %0, s[40:41]\n\tv_addc_co_u32 %1, s[50:51], 0, %1, s[42:43]\n\tv_addc_co_u32 %2, s[52:53], 0, %2, s[44:45]\n\tv_addc_co_u32 %3, s[54:55], 0, %3, s[46:47]" \
    : "+v"(c0), "+v"(c1), "+v"(c2), "+v"(c3) : "v"(a), "v"(b), "v"(cc), "v"(d), "v"(thr) \
    : "s40", "s41", "s42", "s43", "s44", "s45", "s46", "s47", "s48", "s49", "s50", "s51", "s52", "s53", "s54", "s55")
template <int NR>
__device__ __forceinline__ int count_geN(const unsigned (&u)[NR], unsigned thr) {
    int c0 = 0, c1 = 0, c2 = 0, c3 = 0;
#pragma unroll
    for (int j = 0; j < NR; j += 4) CNT4(c0, c1, c2, c3, u[j], u[j + 1], u[j + 2], u[j + 3], thr);
    return (c0 + c1) + (c2 + c3);
}
template <int NR>
__device__ __forceinline__ void select_topk(const LAS float* srow, LAS int* lq, int t, int n, int lane) {
    unsigned u[NR];
#pragma unroll
    for (int j = 0; j < NR; ++j) { const int key = lane + 64 * j; u[j] = (key <= t) ? ((f2sortable(srow[key]) & 0xFFFFF000u) | (unsigned)(4095 - key)) : 0u; }
    unsigned tau = 1u;
    if (n > 256) {
        tau = 0u;
        for (int bit = 31; bit >= 0; --bit) {
            const unsigned cand = tau | (1u << bit);
            const int cnt = wave_sum_i32_uniform(count_geN<NR>(u, cand));
            if (cnt >= 256) { tau = cand; if (cnt == 256) break; }
        }
    }
    const int c = count_geN<NR>(u, tau);
    int pre = c;
#pragma unroll
    for (int o = 1; o < 64; o <<= 1) { const int v = __shfl_up(pre, o); if (lane >= o) pre += v; }
    int pos = pre - c;
    int keyv = lane;
#pragma unroll
    for (int j = 0; j < NR; ++j) {
        const bool sel = u[j] >= tau;
        const int slot = sel ? pos : (256 + lane);
        lq[slot] = keyv;
        pos += sel ? 1 : 0; keyv += 64;
    }
}
__device__ __forceinline__ void dsa_task(const Params& p, int task, LAS unsigned char* lds) {
    const int tid = opaque_tid(), wid = __builtin_amdgcn_readfirstlane(tid >> 6), lane = tid & 63;
    const int b = task >> 9, qg = task & 511, t0 = qg * 8, rowb = b * SEQ;
    const bf16_t* IQ = (const bf16_t*)(p.ws + OFF_IQ); const bf16_t* IK = (const bf16_t*)(p.ws + OFF_IK);
    const bf16_t* AQ = (const bf16_t*)(p.ws + OFF_AQ); const bf16_t* AK = (const bf16_t*)(p.ws + OFF_AK); const bf16_t* AV = (const bf16_t*)(p.ws + OFF_AV);
    const float* gates = (const float*)(p.ws + OFF_GATE);
    LAS float* scores = (LAS float*)lds;
    LAS int* lists = (LAS int*)(lds + 131072);
    const int ntile = (t0 + 8 + 31) >> 5;
#pragma unroll 1
    for (int rr0 = 0; rr0 < ((DSA_REP & 1) ? 2 : 1); ++rr0)
    {
        const int r = lane & 31, hh = lane >> 5;
        bf16x8 af[2][4]; float wv[2][4][4];
#pragma unroll
        for (int rt = 0; rt < 2; ++rt) {
            const size_t qrow = (size_t)(rowb + t0 + 4 * rt + (r >> 3));
#pragma unroll
            for (int ks = 0; ks < 4; ++ks) af[rt][ks] = *(const bf16x8*)(IQ + qrow * 512 + (r & 7) * 64 + 16 * ks + 8 * hh);
#pragma unroll
            for (int q4 = 0; q4 < 4; ++q4)
#pragma unroll
                for (int h4 = 0; h4 < 4; ++h4) wv[rt][q4][h4] = gates[(size_t)(rowb + t0 + 4 * rt + q4) * 16 + 8 + h4 + 4 * hh] * 0.04419417382415922f;
        }
        bf16x8 bfr[4], bnx[4];
        if (wid < ntile) {
#pragma unroll
            for (int ks = 0; ks < 4; ++ks) bfr[ks] = *(const bf16x8*)(IK + (size_t)(rowb + 32 * wid + r) * 64 + 16 * ks + 8 * hh);
        }
        for (int kt = wid; kt < ntile; kt += 8) {
            if (kt + 8 < ntile) {
#pragma unroll
                for (int ks = 0; ks < 4; ++ks) bnx[ks] = *(const bf16x8*)(IK + (size_t)(rowb + 32 * (kt + 8) + r) * 64 + 16 * ks + 8 * hh);
            }
            const int key = 32 * kt + r;
#pragma unroll
            for (int rt = 0; rt < 2; ++rt) {
                f32x16 acc;
#pragma unroll
                for (int i = 0; i < 16; ++i) acc[i] = 0.f;
#pragma unroll
                for (int ks = 0; ks < 4; ++ks) acc = __builtin_amdgcn_mfma_f32_32x32x16_bf16(af[rt][ks], bfr[ks], acc, 0, 0, 0);
                float part[4];
#pragma unroll
                for (int q4 = 0; q4 < 4; ++q4) {
                    part[q4] = 0.f;
#pragma unroll
                    for (int h4 = 0; h4 < 4; ++h4) part[q4] += fmaxf(acc[q4 * 4 + h4], 0.f) * wv[rt][q4][h4];
                }
                float tot[2];
#pragma unroll
                for (int i = 0; i < 2; ++i) { const u32x2 r_ = __builtin_amdgcn_permlane32_swap(__float_as_uint(part[i]), __float_as_uint(part[i + 2]), false, false); tot[i] = __uint_as_float(r_[0]) + __uint_as_float(r_[1]); }
#pragma unroll
                for (int i = 0; i < 2; ++i) { const int qq = 4 * rt + 2 * hh + i; scores[qq * 4096 + key] = (key <= t0 + qq) ? tot[i] : -INFINITY; }
            }
#pragma unroll
            for (int ks = 0; ks < 4; ++ks) bfr[ks] = bnx[ks];
        }
    }
    __syncthreads();
    const int qq = wid, t = t0 + qq, n = t + 1;
    const int nsel = n < 256 ? n : 256;
#pragma unroll 1
    for (int rr1 = 0; rr1 < ((DSA_REP & 2) ? 2 : 1); ++rr1)
    {
        const LAS float* srow = scores + qq * 4096; LAS int* lq = lists + qq * 320;
        const int nreg = (t >> 6) + 1;
        if (nreg <= 8) select_topk<8>(srow, lq, t, n, lane);
        else if (nreg <= 16) select_topk<16>(srow, lq, t, n, lane);
        else if (nreg <= 24) select_topk<24>(srow, lq, t, n, lane);
        else if (nreg <= 32) select_topk<32>(srow, lq, t, n, lane);
        else if (nreg <= 40) select_topk<40>(srow, lq, t, n, lane);
        else if (nreg <= 48) select_topk<48>(srow, lq, t, n, lane);
        else if (nreg <= 56) select_topk<56>(srow, lq, t, n, lane);
        else select_topk<64>(srow, lq, t, n, lane);
    }
    asm volatile("s_waitcnt lgkmcnt(0)" ::: "memory");
#pragma unroll 1
    for (int rr2 = 0; rr2 < ((DSA_REP & 4) ? 2 : 1); ++rr2) {
    {
        const int r = lane & 15, g = lane >> 4;
        const size_t qrow = (size_t)(rowb + t);
        bf16x8 bq[2];
#pragma unroll
        for (int ks = 0; ks < 2; ++ks) {
            if (r < 8) bq[ks] = *(const bf16x8*)(AQ + qrow * 512 + r * 64 + 8 * g + 32 * ks);
            else { bq[ks] = (bf16x8){0, 0, 0, 0, 0, 0, 0, 0}; }
        }
        LAS float* Pl = scores + qq * 4096;
#pragma unroll 1
        for (int half = 0; half < 2; ++half) {
            bf16x8 a0[8], a1[8];
#pragma unroll
            for (int i = 0; i < 8; ++i) {
                const int jp = 16 * (half * 8 + i) + r;
                const int key = (jp < nsel) ? lists[qq * 320 + jp] : 0;
                a0[i] = *(const bf16x8*)(AK + (size_t)(rowb + key) * 64 + 8 * g); a1[i] = *(const bf16x8*)(AK + (size_t)(rowb + key) * 64 + 8 * g + 32);
            }
#pragma unroll
            for (int i = 0; i < 8; ++i) {
                const int kt = half * 8 + i;
                f32x4 acc = {0.f, 0.f, 0.f, 0.f};
                acc = __builtin_amdgcn_mfma_f32_16x16x32_bf16(a0[i], bq[0], acc, 0, 0, 0);
                acc = __builtin_amdgcn_mfma_f32_16x16x32_bf16(a1[i], bq[1], acc, 0, 0, 0);
                if (r < 8) *(LAS f32x4*)(Pl + r * 260 + 16 * kt + 4 * g) = acc * 0.125f;
            }
        }
        asm volatile("s_waitcnt lgkmcnt(0)" ::: "memory");
        const int hd = lane & 7, ch = lane >> 3;
        f32x4 pv[8];
        float mx = -INFINITY;
#pragma unroll
        for (int i = 0; i < 8; ++i) {
            pv[i] = *(const LAS f32x4*)(Pl + hd * 260 + ch * 32 + 4 * i);
#pragma unroll
            for (int j = 0; j < 4; ++j) if (ch * 32 + 4 * i + j < nsel) mx = fmaxf(mx, pv[i][j]);
        }
        mx = fmaxf(mx, dppf(mx, 0x128));
        mx = fmaxf(mx, xchg_f32<16>(mx, lane)); mx = fmaxf(mx, xchg_f32<32>(mx, lane));
        float sm = 0.f;
#pragma unroll
        for (int i = 0; i < 8; ++i)
#pragma unroll
            for (int j = 0; j < 4; ++j) { const float e = (ch * 32 + 4 * i + j < nsel) ? __expf(pv[i][j] - mx) : 0.f; pv[i][j] = e; sm += e; }
        sm += dppf(sm, 0x128); sm += xchg_f32<16>(sm, lane); sm += xchg_f32<32>(sm, lane);
        const float inv = __builtin_amdgcn_rcpf(sm);
        LAS bf16_t* Pt = (LAS bf16_t*)((LAS unsigned char*)Pl + 9216);
#pragma unroll
        for (int i = 0; i < 4; ++i) {
            u32x4 o;
            o[0] = pack2(pv[2 * i][0] * inv, pv[2 * i][1] * inv); o[1] = pack2(pv[2 * i][2] * inv, pv[2 * i][3] * inv);
            o[2] = pack2(pv[2 * i + 1][0] * inv, pv[2 * i + 1][1] * inv); o[3] = pack2(pv[2 * i + 1][2] * inv, pv[2 * i + 1][3] * inv);
            *(LAS u32x4*)(Pt + hd * 264 + ch * 32 + 8 * i) = o;
        }
    }
    asm volatile("s_waitcnt lgkmcnt(0)" ::: "memory");
    {
        typedef short s16x4 __attribute__((ext_vector_type(4)));
        const int r = lane & 15, g = lane >> 4;
        LAS unsigned char* wb = (LAS unsigned char*)(scores + qq * 4096);
        const LAS bf16_t* Pt = (const LAS bf16_t*)(wb + 9216);
        const int nchunk = (nsel + 31) >> 5;
        const int kl = lane >> 3, dc = lane & 7;
        f32x4 acc[4];
#pragma unroll
        for (int ct = 0; ct < 4; ++ct) acc[ct] = (f32x4){0.f, 0.f, 0.f, 0.f};
        u32x4 vq[4], vn[4];
#pragma unroll
        for (int i = 0; i < 4; ++i) {
            const int jp = kl + 8 * i;
            const int key = (jp < nsel) ? lists[qq * 320 + jp] : 0;
            vq[i] = *(const u32x4*)(AV + (size_t)(rowb + key) * 64 + dc * 8);
        }
#pragma unroll 1
        for (int c = 0; c < nchunk; ++c) {
            LAS unsigned char* vb = wb + (c & 1) * 4608;
#pragma unroll
            for (int i = 0; i < 4; ++i) *(LAS u32x4*)(vb + (kl + 8 * i) * 144 + dc * 16) = vq[i];
            if (c + 1 < nchunk) {
#pragma unroll
                for (int i = 0; i < 4; ++i) {
                    const int jp = 32 * (c + 1) + kl + 8 * i;
                    const int key = (jp < nsel) ? lists[qq * 320 + jp] : 0;
                    vn[i] = *(const u32x4*)(AV + (size_t)(rowb + key) * 64 + dc * 8);
                }
            }
            bf16x8 a = *(const LAS bf16x8*)(Pt + (r & 7) * 264 + 32 * c + 8 * g);
            if (r >= 8) a = (bf16x8){0, 0, 0, 0, 0, 0, 0, 0};
#pragma unroll
            for (int ct = 0; ct < 4; ++ct) {
                LAS unsigned char* ba = vb + (8 * g + (r >> 2)) * 144 + (16 * ct + 4 * (r & 3)) * 2;
                const s16x4 b0 = __builtin_amdgcn_ds_read_tr16_b64_v4i16((LAS s16x4*)ba);
                const s16x4 b1 = __builtin_amdgcn_ds_read_tr16_b64_v4i16((LAS s16x4*)(ba + 4 * 144));
                bf16x8 bb; bb[0] = b0[0]; bb[1] = b0[1]; bb[2] = b0[2]; bb[3] = b0[3]; bb[4] = b1[0]; bb[5] = b1[1]; bb[6] = b1[2]; bb[7] = b1[3];
                acc[ct] = __builtin_amdgcn_mfma_f32_16x16x32_bf16(a, bb, acc[ct], 0, 0, 0);
            }
#pragma unroll
            for (int i = 0; i < 4; ++i) vq[i] = vn[i];
        }
        bf16_t* dst = (bf16_t*)(p.ws + OFF_ACT) + (size_t)(rowb + t) * 1024 + 512;
#pragma unroll
        for (int j = 0; j < 4; ++j) {
            float ss = acc[0][j] * acc[0][j] + acc[1][j] * acc[1][j] + acc[2][j] * acc[2][j] + acc[3][j] * acc[3][j];
            ss = row16_sum(ss);
            const float rstd = rsqrtf(ss * (1.f / 64.f) + 1e-6f);
            if (g < 2) {
                const int hd = 4 * g + j;
#pragma unroll
                for (int ct = 0; ct < 4; ++ct) dst[hd * 64 + 16 * ct + r] = f2bf(acc[ct][j] * rstd * p.out_norm_a[hd * 64 + 16 * ct + r]);
            }
        }
    }
    }
    __syncthreads();
}

__device__ __forceinline__ float sortable2f(unsigned s) { return __uint_as_float((s & 0x80000000u) ? (s ^ 0x80000000u) : ~s); }
#define CE_DESC(x, y) do { const unsigned mx_ = max(x, y), mn_ = min(x, y); (x) = mx_; (y) = mn_; } while (0)
template <int BASE, int N>
__device__ __forceinline__ void bitonic_sort16_desc(unsigned (&a)[N]) {
#pragma unroll
    for (int k = 2; k <= 16; k <<= 1) {
#pragma unroll
        for (int j = k >> 1; j > 0; j >>= 1) {
#pragma unroll
            for (int i = 0; i < 16; ++i) {
                const int l = i ^ j;
                if (l > i) {
                    if ((i & k) == 0) CE_DESC(a[BASE + i], a[BASE + l]);
                    else CE_DESC(a[BASE + l], a[BASE + i]);
                }
            }
        }
    }
}
template <int BASE, int N>
__device__ __forceinline__ void bitonic_merge16_desc(unsigned (&a)[N]) {
#pragma unroll
    for (int j = 8; j > 0; j >>= 1) {
#pragma unroll
        for (int i = 0; i < 16; ++i) { const int l = i ^ j; if (l > i) CE_DESC(a[BASE + i], a[BASE + l]); }
    }
}
template <int BA, int BB, int N>
__device__ __forceinline__ void top16_merge(unsigned (&a)[N]) {
#pragma unroll
    for (int i = 0; i < 16; ++i) a[BA + i] = max(a[BA + i], a[BB + 15 - i]);
    bitonic_merge16_desc<BA, N>(a);
}
__device__ __forceinline__ void top16_of_64(unsigned (&a)[64]) {
    bitonic_sort16_desc<0, 64>(a); bitonic_sort16_desc<16, 64>(a); bitonic_sort16_desc<32, 64>(a); bitonic_sort16_desc<48, 64>(a);
    top16_merge<0, 16, 64>(a); top16_merge<32, 48, 64>(a); top16_merge<0, 32, 64>(a);
}
__device__ __forceinline__ void peer_route(const Params& p, int task, LAS unsigned char* lds) {
    const int tid = opaque_tid(), wid = __builtin_amdgcn_readfirstlane(tid >> 6), lane = tid & 63;
    const int n0 = task * 32, head = wid;
    const int r = lane & 31, hh = lane >> 5;
    const bf16_t* QRY = (const bf16_t*)(p.ws + OFF_QRY); const bf16_t* SK = (const bf16_t*)(p.ws + OFF_SK);
    LAS unsigned* tkl = (LAS unsigned*)lds + wid * (32 * 64);
#pragma unroll 1
    for (int p2 = 0; p2 < 2; ++p2) {
        const int grp = head * 2 + p2;
        bf16x8 bq[4];
#pragma unroll
        for (int ks = 0; ks < 4; ++ks) bq[ks] = *(const bf16x8*)(QRY + (size_t)(n0 + r) * 1024 + grp * 64 + 16 * ks + 8 * hh);
        unsigned key[64];
#pragma unroll
        for (int kt = 0; kt < 4; ++kt) {
            f32x16 acc;
#pragma unroll
            for (int i = 0; i < 16; ++i) acc[i] = 0.f;
#pragma unroll
            for (int ks = 0; ks < 4; ++ks) {
                const bf16x8 a = *(const bf16x8*)(SK + (size_t)(grp * 128 + 32 * kt + r) * 64 + 16 * ks + 8 * hh);
                acc = __builtin_amdgcn_mfma_f32_32x32x16_bf16(a, bq[ks], acc, 0, 0, 0);
            }
#pragma unroll
            for (int reg = 0; reg < 16; ++reg) {
                const int idx = 32 * kt + (reg & 3) + 8 * (reg >> 2) + 4 * hh;
                key[kt * 16 + reg] = (f2sortable(acc[reg]) & ~0x7Fu) | (unsigned)(127 - idx);
            }
        }
        top16_of_64(key);
        unsigned mg[16];
#pragma unroll
        for (int i = 0; i < 16; ++i) mg[i] = max(key[i], xchg_u32<32>(key[15 - i], lane));
        bitonic_merge16_desc<0, 16>(mg);
#pragma unroll
        for (int k = 0; k < 16; ++k) tkl[(p2 * 16 + k) * 64 + lane] = mg[k];
    }
    float v1[16], v2[16];
#pragma unroll
    for (int k = 0; k < 16; ++k) { v1[k] = sortable2f(tkl[k * 64 + lane] & ~0x7Fu); v2[k] = sortable2f(tkl[(16 + k) * 64 + lane] & ~0x7Fu); }
    unsigned ck[64];
    {
        int ci = 0;
#pragma unroll
        for (int a = 0; a < 16; ++a) {
#pragma unroll
            for (int bb = 0; bb < 16 / (a + 1); ++bb) { ck[ci] = (f2sortable(v1[a] + v2[bb]) & ~0xFFu) | (unsigned)(255 - (16 * a + bb)); ++ci; }
        }
#pragma unroll
        for (int i = 50; i < 64; ++i) ck[i] = 0u;
    }
    top16_of_64(ck);
    float tv[16]; int te[16];
    float sum = 0.f;
#pragma unroll
    for (int k = 0; k < 16; ++k) {
        const int flat = 255 - (int)(ck[k] & 0xFFu);
        const int i1 = 127 - (int)(tkl[(flat >> 4) * 64 + lane] & 0x7Fu), i2 = 127 - (int)(tkl[(16 + (flat & 15)) * 64 + lane] & 0x7Fu);
        te[k] = i1 * 128 + i2;
        tv[k] = __expf(sortable2f(ck[k] & ~0xFFu) - sortable2f(ck[0] & ~0xFFu)); sum += tv[k];
    }
    const float inv = 1.f / sum;
    if (hh == 0) {
        int* EI = (int*)(p.ws + OFF_EIDX) + (size_t)(n0 + r) * 128 + head * 16;
#pragma unroll
        for (int q = 0; q < 4; ++q) { u32x4 o; o[0] = te[4 * q]; o[1] = te[4 * q + 1]; o[2] = te[4 * q + 2]; o[3] = te[4 * q + 3]; *(u32x4*)(EI + 4 * q) = o; }
    } else {
        float* GW = (float*)(p.ws + OFF_GW) + (size_t)(n0 + r) * 128 + head * 16;
#pragma unroll
        for (int q = 0; q < 4; ++q) { f32x4 o; o[0] = tv[4 * q] * inv; o[1] = tv[4 * q + 1] * inv; o[2] = tv[4 * q + 2] * inv; o[3] = tv[4 * q + 3] * inv; *(f32x4*)(GW + 4 * q) = o; }
    }
}

__device__ __forceinline__ float gelu_exact(float a) { return 0.5f * a * (1.f + erff(a * 0.70710678118654752440f)); }
__device__ __forceinline__ float gelu_as(float v) {
    const float av = fabsf(v), t = __builtin_amdgcn_rcpf(av * 0.2316418882f + 1.0f);
    float q = t * 0.5307027145f + (-0.7265760135f); q = q * t + 0.7107068705f; q = q * t + (-0.142248368f); q = q * t + 0.127414796f; q = q * t;
    const float e = __builtin_amdgcn_exp2f((v * v) * (-0.72134752044f));
    const float m = v * (q * e), rr = v - m;
    return v < 0.f ? m : rr;
}
__device__ __forceinline__ void dec16_fp8(const u32x4 w, float (&f)[16]) {
#pragma unroll
    for (int i = 0; i < 4; ++i) {
        const f32x2 lo = __builtin_amdgcn_cvt_pk_f32_fp8((int)w[i], false), hi = __builtin_amdgcn_cvt_pk_f32_fp8((int)w[i], true);
        f[4 * i] = lo[0]; f[4 * i + 1] = lo[1]; f[4 * i + 2] = hi[0]; f[4 * i + 3] = hi[1];
    }
}
__device__ __forceinline__ void sort_pairs128(int& k_lo, int& k_hi, float& g_lo, float& g_hi, int lane) {
#pragma unroll
    for (int size = 2; size <= 128; size <<= 1) {
#pragma unroll
        for (int stride = size >> 1; stride >= 1; stride >>= 1) {
            if (stride == 64) {
                const bool sw = k_hi < k_lo;
                const int ta = sw ? k_hi : k_lo, tb = sw ? k_lo : k_hi; const float ga = sw ? g_hi : g_lo, gb = sw ? g_lo : g_hi;
                k_lo = ta; k_hi = tb; g_lo = ga; g_hi = gb;
            } else {
                int p_lo, p_hi; float q_lo, q_hi;
                if (stride == 1) { p_lo = (int)xchg_u32<1>((unsigned)k_lo, lane); p_hi = (int)xchg_u32<1>((unsigned)k_hi, lane); q_lo = xchg_f32<1>(g_lo, lane); q_hi = xchg_f32<1>(g_hi, lane); }
                else if (stride == 2) { p_lo = (int)xchg_u32<2>((unsigned)k_lo, lane); p_hi = (int)xchg_u32<2>((unsigned)k_hi, lane); q_lo = xchg_f32<2>(g_lo, lane); q_hi = xchg_f32<2>(g_hi, lane); }
                else if (stride == 4) { p_lo = (int)xchg_u32<4>((unsigned)k_lo, lane); p_hi = (int)xchg_u32<4>((unsigned)k_hi, lane); q_lo = xchg_f32<4>(g_lo, lane); q_hi = xchg_f32<4>(g_hi, lane); }
                else if (stride == 8) { p_lo = (int)xchg_u32<8>((unsigned)k_lo, lane); p_hi = (int)xchg_u32<8>((unsigned)k_hi, lane); q_lo = xchg_f32<8>(g_lo, lane); q_hi = xchg_f32<8>(g_hi, lane); }
                else if (stride == 16) { p_lo = (int)xchg_u32<16>((unsigned)k_lo, lane); p_hi = (int)xchg_u32<16>((unsigned)k_hi, lane); q_lo = xchg_f32<16>(g_lo, lane); q_hi = xchg_f32<16>(g_hi, lane); }
                else { p_lo = (int)xchg_u32<32>((unsigned)k_lo, lane); p_hi = (int)xchg_u32<32>((unsigned)k_hi, lane); q_lo = xchg_f32<32>(g_lo, lane); q_hi = xchg_f32<32>(g_hi, lane); }
                const bool lower = (lane & stride) == 0;
                const bool asc_lo = (size >= 64) ? true : ((lane & size) == 0);
                const bool asc_hi = (size == 128) ? true : ((size == 64) ? false : ((lane & size) == 0));
                const bool min_lo = (lower == asc_lo), min_hi = (lower == asc_hi);
                const bool take_lo = min_lo ? (p_lo < k_lo) : (p_lo > k_lo);
                const bool take_hi = min_hi ? (p_hi < k_hi) : (p_hi > k_hi);
                k_lo = take_lo ? p_lo : k_lo; g_lo = take_lo ? q_lo : g_lo;
                k_hi = take_hi ? p_hi : k_hi; g_hi = take_hi ? q_hi : g_hi;
            }
        }
    }
}
__device__ __forceinline__ void peer_finish_row(const Params& p, const float* ada, int tok, int d0, const float (&acc)[16], bool do_store) {
    const int b = tok >> 12;
    float* orow = p.out + (size_t)tok * 1024 + d0;
    float xo[16]; float ss = 0.f;
#pragma unroll
    for (int q = 0; q < 4; ++q) {
        const f32x4 xv = *(const f32x4*)(orow + 4 * q), gv = *(const f32x4*)(ada + b * 6144 + 5120 + d0 + 4 * q);
#pragma unroll
        for (int i = 0; i < 4; ++i) { const float v = xv[i] + gv[i] * acc[q * 4 + i]; xo[q * 4 + i] = v; ss += v * v; }
    }
    ss = wave_sum(ss);
    const float rstd = rsqrtf(ss * (1.f / 1024.f) + 1e-6f);
#pragma unroll
    for (int q = 0; q < 4; ++q) {
        const f32x4 fg = *(const f32x4*)(p.final_g + d0 + 4 * q);
        f32x4 ov;
#pragma unroll
        for (int i = 0; i < 4; ++i) ov[i] = xo[q * 4 + i] * rstd * fg[i];
        if (do_store) *(f32x4*)(orow + 4 * q) = ov;
    }
}
struct PeTok { unsigned hq[4]; float ascale; int acc_hi[16], acc_lo[16]; int csum_hi, csum_lo; int k_lo, k_hi; float g_lo, g_hi; };
__device__ __forceinline__ void pe_tok_init(PeTok& t, const bf16_t* H2, const int* EI, const float* GW, int tok, int d0, int lane) {
    const u32x4 h0 = *(const u32x4*)(H2 + (size_t)tok * 1024 + d0), h1 = *(const u32x4*)(H2 + (size_t)tok * 1024 + d0 + 8);
    float hx[16];
#pragma unroll
    for (int i = 0; i < 4; ++i) { hx[2 * i] = lo16(h0[i]); hx[2 * i + 1] = hi16(h0[i]); hx[8 + 2 * i] = lo16(h1[i]); hx[8 + 2 * i + 1] = hi16(h1[i]); }
    float am = 0.f;
#pragma unroll
    for (int i = 0; i < 16; ++i) am = fmaxf(am, fabsf(hx[i]));
    am = fmaxf(wave_max_dpp(am), 1e-20f);
    const float hs = 127.f / am;
#pragma unroll
    for (int i = 0; i < 4; ++i) t.hq[i] = pack4_i8(hx[4 * i], hx[4 * i + 1], hx[4 * i + 2], hx[4 * i + 3], hs);
    t.ascale = am * (1.f / (127.f * PEER_SU));
#pragma unroll
    for (int i = 0; i < 16; ++i) { t.acc_hi[i] = 0; t.acc_lo[i] = 0; }
    t.csum_hi = 0; t.csum_lo = 0;
    t.k_lo = EI[(size_t)tok * 128 + lane]; t.k_hi = EI[(size_t)tok * 128 + 64 + lane];
    t.g_lo = GW[(size_t)tok * 128 + lane]; t.g_hi = GW[(size_t)tok * 128 + 64 + lane];
    sort_pairs128(t.k_lo, t.k_hi, t.g_lo, t.g_hi, lane);
}
__device__ __forceinline__ void pe_tok_result(const PeTok& t, float (&acc)[16]) {
    const int coff = 8 * (t.csum_hi * 128 + t.csum_lo);
#pragma unroll
    for (int i = 0; i < 4; ++i)
#pragma unroll
        for (int j = 0; j < 4; ++j) acc[8 * (i >> 1) + 2 * j + (i & 1)] = (float)(t.acc_hi[4 * i + j] * 128 + t.acc_lo[4 * i + j] - coff) * (1.f / (PEER_SC * PEER_SV));
}
__device__ __forceinline__ void pe_vgroup(PeTok& t, const u32x2 (&vv)[8], int base, int c0, int c1, int c2, int c3) {
    const int chi = ((c0 >> 7) & 0xFF) | (((c1 >> 7) & 0xFF) << 8) | (((c2 >> 7) & 0xFF) << 16) | (((c3 >> 7) & 0xFF) << 24);
    const int clo = (c0 & 127) | ((c1 & 127) << 8) | ((c2 & 127) << 16) | ((c3 & 127) << 24);
    t.csum_hi += (c0 >> 7) + (c1 >> 7) + (c2 >> 7) + (c3 >> 7); t.csum_lo += (c0 & 127) + (c1 & 127) + (c2 & 127) + (c3 & 127);
#pragma unroll
    for (int i = 0; i < 4; ++i) {
        const unsigned w0 = (vv[base][i >> 1] >> (4 * (i & 1))) & 0x0F0F0F0Fu, w1 = (vv[base + 1][i >> 1] >> (4 * (i & 1))) & 0x0F0F0F0Fu;
        const unsigned w2_ = (vv[base + 2][i >> 1] >> (4 * (i & 1))) & 0x0F0F0F0Fu, w3 = (vv[base + 3][i >> 1] >> (4 * (i & 1))) & 0x0F0F0F0Fu;
        const unsigned a0 = __builtin_amdgcn_perm(w1, w0, 0x05010400u), a1 = __builtin_amdgcn_perm(w1, w0, 0x07030602u);
        const unsigned b0 = __builtin_amdgcn_perm(w3, w2_, 0x05010400u), b1 = __builtin_amdgcn_perm(w3, w2_, 0x07030602u);
        const unsigned tt0 = __builtin_amdgcn_perm(b0, a0, 0x05040100u), tt1 = __builtin_amdgcn_perm(b0, a0, 0x07060302u);
        const unsigned tt2 = __builtin_amdgcn_perm(b1, a1, 0x05040100u), tt3 = __builtin_amdgcn_perm(b1, a1, 0x07060302u);
        t.acc_hi[4 * i + 0] = __builtin_amdgcn_sdot4((int)tt0, chi, t.acc_hi[4 * i + 0], false); t.acc_lo[4 * i + 0] = __builtin_amdgcn_sdot4((int)tt0, clo, t.acc_lo[4 * i + 0], false);
        t.acc_hi[4 * i + 1] = __builtin_amdgcn_sdot4((int)tt1, chi, t.acc_hi[4 * i + 1], false); t.acc_lo[4 * i + 1] = __builtin_amdgcn_sdot4((int)tt1, clo, t.acc_lo[4 * i + 1], false);
        t.acc_hi[4 * i + 2] = __builtin_amdgcn_sdot4((int)tt2, chi, t.acc_hi[4 * i + 2], false); t.acc_lo[4 * i + 2] = __builtin_amdgcn_sdot4((int)tt2, clo, t.acc_lo[4 * i + 2], false);
        t.acc_hi[4 * i + 3] = __builtin_amdgcn_sdot4((int)tt3, chi, t.acc_hi[4 * i + 3], false); t.acc_lo[4 * i + 3] = __builtin_amdgcn_sdot4((int)tt3, clo, t.acc_lo[4 * i + 3], false);
    }
}
__device__ __forceinline__ void peer_experts(const Params& p, bool do_store) {
    const int wid = threadIdx.x >> 6, lane = threadIdx.x & 63;
    const bf16_t* H2 = (const bf16_t*)(p.ws + OFF_ACT); const unsigned char* UT = p.ws + OFF_UT; const unsigned char* VT = p.ws + OFF_VT;
    const int* EI = (const int*)(p.ws + OFF_EIDX); const float* GW = (const float*)(p.ws + OFF_GW); const float* ada = (const float*)(p.ws + OFF_ADA);
    const int d0 = 16 * lane;
    const int stride = gridDim.x * 8;
    for (int tok0 = blockIdx.x * 8 + wid; tok0 < NTOK; tok0 += 2 * stride) {
        __syncthreads();
        const bool hasB = (tok0 + stride) < NTOK;
        const int tokA = tok0, tokB = hasB ? tok0 + stride : tok0;
        PeTok A, B;
        pe_tok_init(A, H2, EI, GW, tokA, d0, lane);
        pe_tok_init(B, H2, EI, GW, tokB, d0, lane);
        u32x4 uX[8], uY[8]; u32x2 vX[8], vY[8]; float gX[8], gY[8];
#define PE_ISSUE(UU, VV, GG, K0) do { _Pragma("unroll") for (int q = 0; q < 4; ++q) { \
            const unsigned ea_ = (unsigned)__builtin_amdgcn_readlane((K0) < 64 ? A.k_lo : A.k_hi, ((K0) + q) & 63), eb_ = (unsigned)__builtin_amdgcn_readlane((K0) < 64 ? B.k_lo : B.k_hi, ((K0) + q) & 63); \
            GG[q] = rlanef((K0) < 64 ? A.g_lo : A.g_hi, ((K0) + q) & 63); GG[4 + q] = rlanef((K0) < 64 ? B.g_lo : B.g_hi, ((K0) + q) & 63); \
            UU[q] = *(const u32x4*)(UT + (size_t)(ea_ * 1024u) + (unsigned)d0); VV[q] = *(const u32x2*)(VT + (size_t)(ea_ * 512u) + 8u * (unsigned)lane); \
            UU[4 + q] = *(const u32x4*)(UT + (size_t)(eb_ * 1024u) + (unsigned)d0); VV[4 + q] = *(const u32x2*)(VT + (size_t)(eb_ * 512u) + 8u * (unsigned)lane); } } while (0)
#define PE_COMPUTE(UU, VV, GG) do { \
            float sv[8]; \
            _Pragma("unroll") for (int q = 0; q < 8; ++q) { int d_ = 0; \
                _Pragma("unroll") for (int i = 0; i < 4; ++i) d_ = __builtin_amdgcn_sdot4((int)UU[q][i], (int)(q < 4 ? A.hq[i] : B.hq[i]), d_, false); \
                sv[q] = (float)d_ * (q < 4 ? A.ascale : B.ascale); } \
            float t4[4]; \
            _Pragma("unroll") for (int i = 0; i < 4; ++i) { const u32x2 r_ = __builtin_amdgcn_permlane32_swap(__float_as_uint(sv[i]), __float_as_uint(sv[i + 4]), false, false); t4[i] = __uint_as_float(r_[0]) + __uint_as_float(r_[1]); } \
            float w2[2]; \
            _Pragma("unroll") for (int i = 0; i < 2; ++i) { const u32x2 r_ = __builtin_amdgcn_permlane16_swap(__float_as_uint(t4[i]), __float_as_uint(t4[i + 2]), false, false); w2[i] = __uint_as_float(r_[0]) + __uint_as_float(r_[1]); } \
            _Pragma("unroll") for (int i = 0; i < 2; ++i) { w2[i] += dppf(w2[i], 0xB1); w2[i] += dppf(w2[i], 0x4E); w2[i] += dppf(w2[i], 0x141); w2[i] += dppf(w2[i], 0x140); } \
            float mine = 0.f, gmine = 0.f; \
            _Pragma("unroll") for (int q = 0; q < 8; ++q) { \
                const float tq = rlanef(w2[q & 1], 16 * (((q >> 1) & 1) + 2 * (q >> 2))); \
                mine = ((lane & 7) == q) ? tq : mine; gmine = ((lane & 7) == q) ? GG[q] : gmine; } \
            const float cmine = gmine * gelu_as(mine); \
            const int cqm = (int)fminf(fmaxf(rintf(cmine * PEER_SC), -16383.f), 16383.f);        \
            pe_vgroup(A, VV, 0, __builtin_amdgcn_readlane(cqm, 0), __builtin_amdgcn_readlane(cqm, 1), __builtin_amdgcn_readlane(cqm, 2), __builtin_amdgcn_readlane(cqm, 3)); \
            pe_vgroup(B, VV, 4, __builtin_amdgcn_readlane(cqm, 4), __builtin_amdgcn_readlane(cqm, 5), __builtin_amdgcn_readlane(cqm, 6), __builtin_amdgcn_readlane(cqm, 7)); } while (0)
        PE_ISSUE(uX, vX, gX, 0);
#pragma unroll 1
        for (int k0 = 0; k0 < 128; k0 += 8) {
            if ((k0 & 63) == 0 && k0) __syncthreads();
            PE_ISSUE(uY, vY, gY, k0 + 4);
            PE_COMPUTE(uX, vX, gX);
            if (k0 + 8 < 128) PE_ISSUE(uX, vX, gX, k0 + 8);
            PE_COMPUTE(uY, vY, gY);
        }
#undef PE_ISSUE
#undef PE_COMPUTE
        float acc[16];
        pe_tok_result(A, acc); peer_finish_row(p, ada, tokA, d0, acc, do_store);
        pe_tok_result(B, acc); peer_finish_row(p, ada, tokB, d0, acc, do_store && hasB);
    }
}

enum { PH_PREP = 0, PH_GEMM_IN, PH_MIX, PH_GEMM_OUT, PH_H2, PH_GEMM_Q, PH_ROUTE, PH_EXPERT, PH_COUNT };

typedef const __attribute__((address_space(4))) Params* KParams;
__device__ __forceinline__ const Params& kparams() {
    auto q = __builtin_amdgcn_kernarg_segment_ptr();
    asm volatile("" : "+s"(q));
    return *(const Params*)q;
}
#ifndef PHMASK
#define PHMASK 0xFFFF
#endif
#ifndef REP_PHASE
#define REP_PHASE -1
#endif
#define PHASE_BEGIN(idx) if (((PHMASK >> (idx)) & 1) && ph_lo <= (idx) && (idx) < ph_hi) { for (int rep = 0; rep < ((idx) == REP_PHASE ? 2 : 1); ++rep) { if ((idx) != ph_lo || rep) xcd_barrier(bar); const Params& p = kparams(); const int G = gridDim.x; (void)G; const bool last_rep = (rep == ((idx) == REP_PHASE ? 1 : 0)); (void)last_rep;
#define PHASE_END } }

__global__ void __launch_bounds__(NTHREADS, 2) hymba_fwd(Params p_) {
    extern __shared__ __attribute__((aligned(16))) unsigned char smem_raw[];
    LAS unsigned char* lds = (LAS unsigned char*)smem_raw;
    volatile LAS unsigned* xbw = (volatile LAS unsigned*)(lds + LDS_BYTES - 16);
    if (threadIdx.x == 0) { xbw[0] = 0u; xbw[1] = 0u; xbw[2] = 0u; xbw[3] = 0u; }
    __syncthreads();
    XcdBarrier bar = xcd_barrier_post((unsigned*)(p_.ws + OFF_CTL), xbw);
    const int ph_lo = p_.ph_lo, ph_hi = p_.ph_hi;

    PHASE_BEGIN(PH_PREP)
        phase0(p, lds);
        wg_wait((unsigned*)(p.ws + OFF_CTL), CNT_ADA, 192u);
        norm_mod_rows(p.x, p.norm1_g, (const float*)(p.ws + OFF_ADA), 0, 1024, (bf16_t*)(p.ws + OFF_ACT));
    PHASE_END
    PHASE_BEGIN(PH_GEMM_IN)
        {   pg8::StaticOrder S; S.init(NTOK, 3072, G, blockIdx.x);
            EpiInMain E; E.ws = p.ws; E.bias = (const float*)(p.ws + OFF_BIAS);
            pg8::gemm_phase(lds, pg8::Gemm{(const bf16_t*)(p.ws + OFF_ACT), (const bf16_t*)(p.ws + OFF_WIN), NTOK, 3072, 1024}, S, E); }
        {   pg8::StaticOrder S; S.init(NTOK, 256, G, blockIdx.x);
            EpiInTail E; E.ws = p.ws; E.bias = (const float*)(p.ws + OFF_BIAS) + 3072;
            pg8::gemm_phase(lds, pg8::Gemm{(const bf16_t*)(p.ws + OFF_ACT), (const bf16_t*)(p.ws + OFF_WIN) + (size_t)3072 * 1024, NTOK, 256, 1024}, S, E); }
        if (G > 64) { if ((int)blockIdx.x >= 64) convert_tables(p, (int)blockIdx.x - 64, G - 64); }
        else convert_tables(p, (int)blockIdx.x, G);
    PHASE_END
    PHASE_BEGIN(PH_MIX)
        unsigned* ctl = (unsigned*)(p.ws + OFF_CTL);
        for (int t = blockIdx.x; t < 1024; t += G) mlstm_passA(p, t, lds);
        wg_signal(ctl, CNT_MLA);
        __syncthreads();
        for (int t = blockIdx.x; t < 2048; t += G) {
            const int rnd = t >> 8, w = t & 255; const int bsel = rnd >> 1; const int qgs = (rnd & 1) ? w : (511 - w);
            dsa_task(p, (bsel << 9) | qgs, lds); }
        wg_wait(ctl, CNT_MLA, (unsigned)G);
        for (int t = blockIdx.x; t < 256; t += G) mlstm_scan(p, t, lds);
        wg_signal(ctl, CNT_SCAN);
        wg_wait(ctl, CNT_SCAN, (unsigned)G);
        for (int t = blockIdx.x; t < 1024; t += G) mlstm_passB(p, t, lds);
    PHASE_END
    PHASE_BEGIN(PH_GEMM_OUT)
        {   pg8::StaticOrder S; S.init(NTOK, 1024, G, blockIdx.x);
            EpiOut E; E.x = p.x; E.ada = (const float*)(p.ws + OFF_ADA); E.out = p.out;
            pg8::gemm_phase(lds, pg8::Gemm{(const bf16_t*)(p.ws + OFF_ACT), (const bf16_t*)(p.ws + OFF_WOUT), NTOK, 1024, 1024}, S, E); }
    PHASE_END
    PHASE_BEGIN(PH_H2) norm_mod_rows(p.out, p.norm2_g, (const float*)(p.ws + OFF_ADA), 3072, 4096, (bf16_t*)(p.ws + OFF_ACT)); PHASE_END
    PHASE_BEGIN(PH_GEMM_Q)
        {   pg8::StaticOrder S; S.init(NTOK, 1024, G, blockIdx.x);
            EpiQry E; E.O = (bf16_t*)(p.ws + OFF_QRY);
            pg8::gemm_phase(lds, pg8::Gemm{(const bf16_t*)(p.ws + OFF_ACT), (const bf16_t*)(p.ws + OFF_WPQ), NTOK, 1024, 1024}, S, E); }
    PHASE_END
    PHASE_BEGIN(PH_ROUTE) for (int t = blockIdx.x; t < 512; t += G) peer_route(p, t, lds); PHASE_END
    PHASE_BEGIN(PH_EXPERT) peer_experts(p, last_rep); PHASE_END
}

extern "C" void kernel_launch(void* const* d_in, const int* in_sizes, int n_in, void* d_out, int out_size, void* d_ws, size_t ws_size, hipStream_t stream) {
    static int grid = 0;
    if (grid == 0) {
        int dev = 0, cus = 0, per_cu = 0;
        if (hipGetDevice(&dev) != hipSuccess || hipDeviceGetAttribute(&cus, hipDeviceAttributeMultiprocessorCount, dev) != hipSuccess) { fprintf(stderr, "kernel_launch: device query failed\n"); grid = -1; return; }
        if (hipFuncSetAttribute((const void*)hymba_fwd, hipFuncAttributeMaxDynamicSharedMemorySize, LDS_BYTES) != hipSuccess) { fprintf(stderr, "kernel_launch: hipFuncSetAttribute failed\n"); grid = -1; return; }
        if (hipOccupancyMaxActiveBlocksPerMultiprocessor(&per_cu, (const void*)hymba_fwd, NTHREADS, LDS_BYTES) != hipSuccess || per_cu < 1) { fprintf(stderr, "kernel_launch: occupancy query says %d blocks/CU\n", per_cu); }
        (void)hipGetLastError();
        grid = cus;
        if (ws_size < WS_END || n_in != 17) { fprintf(stderr, "kernel_launch: unexpected sizes (ws %zu, n_in %d)\n", ws_size, n_in); grid = -1; return; }
    }
    if (grid < 0) return;
    (void)hipMemsetAsync((char*)d_ws + OFF_CTL, 0, CTL_BYTES, stream);
    Params p{};
    p.x = (const float*)d_in[0]; p.c = (const float*)d_in[1]; p.w_ada = (const float*)d_in[2]; p.b_ada = (const float*)d_in[3]; p.norm1_g = (const float*)d_in[4];
    p.w_in = (const float*)d_in[5]; p.b_in = (const float*)d_in[6]; p.conv_qk = (const float*)d_in[7]; p.out_norm_m = (const float*)d_in[8]; p.out_norm_a = (const float*)d_in[9];
    p.w_out = (const float*)d_in[10]; p.norm2_g = (const float*)d_in[11]; p.w_peer_q = (const float*)d_in[12]; p.sub_keys = (const float*)d_in[13]; p.peer_u = (const float*)d_in[14];
    p.peer_v = (const float*)d_in[15]; p.final_g = (const float*)d_in[16];
    p.out = (float*)d_out; p.ws = (unsigned char*)d_ws; p.ph_lo = 0; p.ph_hi = PH_COUNT;
    void* args[] = {&p};
    hipError_t e = hipLaunchCooperativeKernel((const void*)hymba_fwd, dim3(grid), dim3(NTHREADS), args, LDS_BYTES, stream);
    if (e != hipSuccess) fprintf(stderr, "kernel_launch: cooperative launch failed: %s (grid %d)\n", hipGetErrorString(e), grid);
}
```

```cpp
#include <hip/hip_runtime.h>
#include <stdint.h>
#define REP_PHASE -1
#define DSA_REP 0
#include <cstdio>

#define LAS __attribute__((address_space(3)))
typedef unsigned short bf16_t;
typedef short bf16x8 __attribute__((ext_vector_type(8)));
typedef float f32x4 __attribute__((ext_vector_type(4)));
typedef float f32x2 __attribute__((ext_vector_type(2)));
typedef float f32x16 __attribute__((ext_vector_type(16)));
typedef unsigned u32x4 __attribute__((ext_vector_type(4)));
typedef unsigned u32x2 __attribute__((ext_vector_type(2)));

constexpr int NTOK = 16384, DM = 1024, SEQ = 4096;
constexpr int NIN_PAD = 3328;
constexpr int LDS_BYTES = 163840 - 64;
constexpr int NTHREADS = 512;

constexpr size_t MiB = 1024 * 1024;
constexpr size_t OFF_CTL = 0;
constexpr size_t CTL_BYTES = 16384;
constexpr size_t OFF_ADA = 64 * 1024;
constexpr size_t OFF_BIAS = 192 * 1024;
constexpr size_t OFF_SK = 256 * 1024;
constexpr size_t OFF_WIN = 512 * 1024;
constexpr size_t OFF_WOUT = 7 * MiB;
constexpr size_t OFF_WPQ = 9 * MiB;
constexpr size_t OFF_ACT = 11 * MiB;
constexpr size_t OFF_MQ = 43 * MiB;
constexpr size_t OFF_MK = 59 * MiB;
constexpr size_t OFF_MV = 75 * MiB;
constexpr size_t OFF_MO = 91 * MiB;
constexpr size_t OFF_AQ = 107 * MiB;
constexpr size_t OFF_IQ = 123 * MiB;
constexpr size_t OFF_AK = 139 * MiB;
constexpr size_t OFF_AV = 141 * MiB;
constexpr size_t OFF_IK = 143 * MiB;
constexpr size_t OFF_GATE = 145 * MiB;
constexpr size_t OFF_KV = 146 * MiB;
constexpr size_t OFF_KS = 178 * MiB;
constexpr size_t OFF_MLOC = 178 * MiB + 512 * 1024;
constexpr size_t OFF_BLAST = OFF_MLOC + 4096;
constexpr size_t OFF_M0 = OFF_BLAST + 4096;
constexpr size_t OFF_UT = 179 * MiB;
constexpr size_t OFF_VT = 195 * MiB;
constexpr size_t WS_END = 211 * MiB;
constexpr float PEER_SU = 812.8f;
constexpr float PEER_SV = 8.443f;
constexpr float PEER_SC = 2048.f;
constexpr size_t OFF_QRY = OFF_MQ;
constexpr size_t OFF_EIDX = OFF_MV;
constexpr size_t OFF_GW = OFF_MV + 8 * MiB;

struct Params {
    const float* x; const float* c; const float* w_ada; const float* b_ada; const float* norm1_g;
    const float* w_in; const float* b_in; const float* conv_qk; const float* out_norm_m; const float* out_norm_a;
    const float* w_out; const float* norm2_g; const float* w_peer_q; const float* sub_keys; const float* peer_u;
    const float* peer_v; const float* final_g;
    float* out; unsigned char* ws;
    int ph_lo, ph_hi;
};

__device__ __forceinline__ int opaque_tid() { int t = threadIdx.x; asm volatile("" : "+v"(t)); return t; }
__device__ __forceinline__ float bf2f(unsigned short b) { return __uint_as_float(((unsigned)b) << 16); }
__device__ __forceinline__ unsigned pack2(float lo, float hi) { unsigned r; asm("v_cvt_pk_bf16_f32 %0, %1, %2" : "=v"(r) : "v"(lo), "v"(hi)); return r; }
__device__ __forceinline__ unsigned short f2bf(float f) { return (unsigned short)(pack2(f, 0.f) & 0xffffu); }
__device__ __forceinline__ unsigned short f2bf_sw(float f) { unsigned u = __float_as_uint(f); u += 0x7FFFu + ((u >> 16) & 1u); return (unsigned short)(u >> 16); }
__device__ __forceinline__ float lo16(unsigned w) { return __uint_as_float(w << 16); }
__device__ __forceinline__ float hi16(unsigned w) { return __uint_as_float(w & 0xffff0000u); }
__device__ __forceinline__ float wave_sum_dpp(float v);
__device__ __forceinline__ float wave_sum(float v) { return wave_sum_dpp(v); }
__device__ __forceinline__ int wave_sum_i32_uniform(int v) {
    v += __builtin_amdgcn_update_dpp(0, v, 0xB1, 0xF, 0xF, true);
    v += __builtin_amdgcn_update_dpp(0, v, 0x4E, 0xF, 0xF, true);
    v += __builtin_amdgcn_update_dpp(0, v, 0x141, 0xF, 0xF, true);
    v += __builtin_amdgcn_update_dpp(0, v, 0x140, 0xF, 0xF, true);
    return __builtin_amdgcn_readlane(v, 0) + __builtin_amdgcn_readlane(v, 16) + __builtin_amdgcn_readlane(v, 32) + __builtin_amdgcn_readlane(v, 48);
}
__device__ __forceinline__ float wave_scan_add(float v, int lane) {
#pragma unroll
    for (int o = 1; o < 64; o <<= 1) { const float t = __shfl_up(v, o); if (lane >= o) v += t; }
    return v;
}
__device__ __forceinline__ float wave_scan_max(float v, int lane) {
#pragma unroll
    for (int o = 1; o < 64; o <<= 1) { const float t = __shfl_up(v, o); if (lane >= o) v = fmaxf(v, t); }
    return v;
}
__device__ __forceinline__ float wave_max(float v) {
#pragma unroll
    for (int o = 32; o >= 1; o >>= 1) v = fmaxf(v, __shfl_xor(v, o));
    return v;
}
#define dppf(v, ctrl) __uint_as_float((unsigned)__builtin_amdgcn_update_dpp(0, (int)__float_as_uint(v), (ctrl), 0xF, 0xF, true))
__device__ __forceinline__ float rlanef(float v, int l) { return __uint_as_float((unsigned)__builtin_amdgcn_readlane((int)__float_as_uint(v), l)); }
__device__ __forceinline__ float wave_sum_dpp(float v) {
    v += dppf(v, 0xB1); v += dppf(v, 0x4E); v += dppf(v, 0x141); v += dppf(v, 0x140);
    return (rlanef(v, 0) + rlanef(v, 16)) + (rlanef(v, 32) + rlanef(v, 48));
}
__device__ __forceinline__ float wave_max_dpp(float v) {
    v = fmaxf(v, dppf(v, 0xB1)); v = fmaxf(v, dppf(v, 0x4E)); v = fmaxf(v, dppf(v, 0x141)); v = fmaxf(v, dppf(v, 0x140));
    return fmaxf(fmaxf(rlanef(v, 0), rlanef(v, 16)), fmaxf(rlanef(v, 32), rlanef(v, 48)));
}
template <int STRIDE>
__device__ __forceinline__ unsigned xchg_u32(unsigned x, int lane) {
    if constexpr (STRIDE == 1) return (unsigned)__builtin_amdgcn_update_dpp(0, (int)x, 0xB1, 0xF, 0xF, true);
    else if constexpr (STRIDE == 2) return (unsigned)__builtin_amdgcn_update_dpp(0, (int)x, 0x4E, 0xF, 0xF, true);
    else if constexpr (STRIDE == 4) {
        const unsigned up = (unsigned)__builtin_amdgcn_update_dpp(0, (int)x, 0x104, 0xF, 0xF, true);
        const unsigned dn = (unsigned)__builtin_amdgcn_update_dpp(0, (int)x, 0x114, 0xF, 0xF, true);
        return (lane & 4) ? dn : up;
    }
    else if constexpr (STRIDE == 8) return (unsigned)__builtin_amdgcn_update_dpp(0, (int)x, 0x128, 0xF, 0xF, true);
    else if constexpr (STRIDE == 16) { const u32x2 r_ = __builtin_amdgcn_permlane16_swap(x, x, false, false); return (lane & 16) ? r_[0] : r_[1]; }
    else { const u32x2 r_ = __builtin_amdgcn_permlane32_swap(x, x, false, false); return (lane & 32) ? r_[0] : r_[1]; }
}
template <int STRIDE> __device__ __forceinline__ float xchg_f32(float x, int lane) { return __uint_as_float(xchg_u32<STRIDE>(__float_as_uint(x), lane)); }
__device__ __forceinline__ float row16_sum(float v) { v += dppf(v, 0xB1); v += dppf(v, 0x4E); v += dppf(v, 0x141); v += dppf(v, 0x140); return v; }
__device__ __forceinline__ float oct_sum(float v) { v += dppf(v, 0xB1); v += dppf(v, 0x4E); v += dppf(v, 0x141); return v; }
__device__ __forceinline__ float siluf(float x) { return x * __builtin_amdgcn_rcpf(1.f + __expf(-x)); }
__device__ __forceinline__ float sigmoidf_(float x) { return __builtin_amdgcn_rcpf(1.f + __expf(-x)); }
__device__ __forceinline__ float logsigmoidf_(float x) { return fminf(x, 0.f) - log1pf(__expf(-fabsf(x))); }

#define XB_TMO      128
#define XB_XCNT(j)  (256  + 64 * (j))
#define XB_XSUB(j)  (1280 + 64 * (j))
#define XB_XGEN(j)  (2304 + 64 * (j))
#define XB_TOP      3328
#define XB_TOPGEN   3392
#define XCD_BAR_WORDS 3456
#define XB_SPIN_CAP (1u << 22)
__device__ __forceinline__ unsigned xb_ld(unsigned* p)              { return __hip_atomic_load(p, __ATOMIC_RELAXED, __HIP_MEMORY_SCOPE_AGENT); }
__device__ __forceinline__ unsigned xb_add(unsigned* p, unsigned v) { return __hip_atomic_fetch_add(p, v, __ATOMIC_RELAXED, __HIP_MEMORY_SCOPE_AGENT); }
__device__ __forceinline__ unsigned xb_xcc_id() { return (unsigned)__builtin_amdgcn_s_getreg((3 << 11) | 20) & 0xFu; }
#define XB_SPIN(cond, bar) do { unsigned _sp = 0; while (cond) { __builtin_amdgcn_s_sleep(1); \
    if ((++_sp & 255u) == 0u) { if (xb_ld(&(bar)[XB_TMO])) break; if (_sp > XB_SPIN_CAP) { atomicAdd(&(bar)[XB_TMO], 1u); break; } } } } while (0)
struct XcdBarrier { unsigned* bar; unsigned x; volatile LAS unsigned* st; };
__device__ __forceinline__ XcdBarrier xcd_barrier_post(unsigned* bar, volatile LAS unsigned* st) {
    XcdBarrier b; b.bar = bar; b.x = xb_xcc_id(); b.st = st;
    if (threadIdx.x == 0) (void)xb_add(&bar[XB_XCNT(b.x)], 1u);
    return b;
}
__device__ __forceinline__ void xcd_barrier_complete(unsigned* bar, unsigned x, unsigned& nloc, unsigned& nx) {
    const unsigned G = gridDim.x * gridDim.y * gridDim.z;
    unsigned sum, cnt, mine, sp = 0u;
    for (;;) {
        sum = 0u; cnt = 0u; mine = 0u;
#pragma unroll
        for (unsigned j = 0; j < 16; ++j) { const unsigned c = xb_ld(&bar[XB_XCNT(j)]); sum += c; cnt += (c > 0u) ? 1u : 0u; mine = (j == x) ? c : mine; }
        if (sum == G) break;
        __builtin_amdgcn_s_sleep(1);
        if ((++sp & 255u) == 0u) { if (xb_ld(&bar[XB_TMO])) break; if (sp > XB_SPIN_CAP) { atomicAdd(&bar[XB_TMO], 1u); break; } }
    }
    nloc = mine > 0u ? mine : 1u; nx = cnt > 0u ? cnt : 1u;
}
__device__ __forceinline__ void xcd_barrier(const XcdBarrier& b) {
    asm volatile("s_waitcnt vmcnt(0)" ::: "memory");
    __syncthreads();
    if (threadIdx.x == 0) {
        unsigned* bar = b.bar;
        __builtin_amdgcn_s_waitcnt(0);
        unsigned nloc = b.st[0], nx = b.st[1];
        if (nloc == 0u) { xcd_barrier_complete(bar, b.x, nloc, nx); b.st[0] = nloc; b.st[1] = nx; }
        const unsigned old = xb_add(&bar[XB_XSUB(b.x)], 1u);
        const unsigned gen = old / nloc;
        if (old + 1u == (gen + 1u) * nloc) {
            __builtin_amdgcn_fence(__ATOMIC_RELEASE, "agent");
            asm volatile("s_waitcnt vmcnt(0)" ::: "memory");
            const unsigned og = xb_add(&bar[XB_TOP], 1u);
            const unsigned tg = og / nx;
            if (og + 1u == (tg + 1u) * nx) xb_add(&bar[XB_TOPGEN], 1u);
            else XB_SPIN(xb_ld(&bar[XB_TOPGEN]) == tg, bar);
            __builtin_amdgcn_fence(__ATOMIC_ACQUIRE, "agent");
            xb_add(&bar[XB_XGEN(b.x)], 1u);
            asm volatile("s_waitcnt vmcnt(0)" ::: "memory");
        } else {
            XB_SPIN(xb_ld(&bar[XB_XGEN(b.x)]) == gen, bar);
            __builtin_amdgcn_fence(__ATOMIC_ACQUIRE, "agent");
            asm volatile("s_waitcnt vmcnt(0)" ::: "memory");
        }
    }
    __syncthreads();
}

#define CNT_ADA  3600
#define CNT_MLA  3664
#define CNT_SCAN 3728
__device__ __forceinline__ void wg_signal(unsigned* ctl, int word) {
    asm volatile("s_waitcnt vmcnt(0)" ::: "memory");
    __syncthreads();
    if (threadIdx.x == 0) {
        __builtin_amdgcn_fence(__ATOMIC_RELEASE, "agent");
        asm volatile("s_waitcnt vmcnt(0)" ::: "memory");
        (void)xb_add(&ctl[word], 1u);
    }
}
__device__ __forceinline__ void wg_wait(unsigned* ctl, int word, unsigned need) {
    if (threadIdx.x == 0) {
        XB_SPIN(xb_ld(&ctl[word]) < need, ctl);
        __builtin_amdgcn_fence(__ATOMIC_ACQUIRE, "agent");
        asm volatile("s_waitcnt vmcnt(0)" ::: "memory");
    }
    __syncthreads();
}

namespace pg8 {
constexpr int BM = 256, BK = 64, HALF = 128, HTB = HALF * BK * 2, STAGE_BYTES = 8 * HTB, NXCD = 8, WGM = 8;
__host__ __device__ __forceinline__ int lds_byte(int r, int c) { const int st = (r >> 4) * 2 + (c >> 5), rr = r & 15, cc = c & 31, ob = rr * 64 + cc * 2; return st * 1024 + (ob ^ (((ob >> 9) & 1) << 5)); }
__host__ __device__ __forceinline__ void stage_rc(int b, int& R, int& C) { const int st = b / 1024, sb = b % 1024, swz = sb ^ (((sb >> 9) & 1) << 5); R = (st >> 1) * 16 + swz / 64; C = (st & 1) * 32 + (swz % 64) / 2; }
__host__ __device__ __forceinline__ int perm32(int rho) { const int n = rho >> 4, i = rho & 15; return 8 * (i >> 2) + 4 * n + (i & 3); }
struct Unit { int pm, pn; };
struct Gemm { const bf16_t* A; const bf16_t* Bt; int M, N, K; };
struct StaticOrder {
    int nM, nN, nwg, G, c;
    __host__ __device__ void init(int M, int N, int G_, int c_) { nM = M / BM; nN = N / BM; nwg = nM * nN; G = G_; c = c_; }
    __host__ __device__ bool next(int i, Unit& u) const {
        const long L = (long)i * G + c; if (L >= nwg) return false;
        int wgid = (int)L; { const int q = nwg / NXCD, r = nwg % NXCD, xcd = wgid % NXCD, off = wgid / NXCD; wgid = (xcd < r ? xcd * (q + 1) : r * (q + 1) + (xcd - r) * q) + off; }
        const int nig = WGM * nN, gid = wgid / nig, fm = gid * WGM, gsz = (nM - fm) < WGM ? (nM - fm) : WGM;
        u.pm = fm + ((wgid % nig) % gsz); u.pn = (wgid % nig) / gsz; return true;
    }
    __device__ __forceinline__ void a_ready(const Unit&) const {}
    __device__ __forceinline__ void done(const Unit&) const {}
};
__device__ __forceinline__ unsigned cvt_pk_bf16(float lo, float hi) { unsigned r; asm volatile("v_cvt_pk_bf16_f32 %0, %1, %2" : "=v"(r) : "v"(lo), "v"(hi)); return r; }

template <class Epi, class Sched>
__device__ __forceinline__ void gemm_phase(LAS unsigned char* lds, const Gemm g, const Sched& S, const Epi& E) {
    const int tid = threadIdx.x, wid = __builtin_amdgcn_readfirstlane(tid >> 6), lane = tid & 63, wr = wid >> 2, wc = wid & 3, fr = lane & 15, fq = lane >> 4;
    const int K = g.K, nt = K / BK;
    unsigned voffA[2], voffB[2];
#pragma unroll
    for (int i = 0; i < 2; ++i) { int R, C; stage_rc(tid * 16 + i * 8192, R, C); const int Rb = Epi::PERM ? ((R & ~31) + perm32(R & 31)) : R;
        voffA[i] = (unsigned)(R * K + C) * 2u; voffB[i] = (unsigned)(Rb * K + C) * 2u; }
    const size_t kstep = (size_t)(BK * 2);
    const size_t hstep = (size_t)HALF * K * 2;
    const size_t tstep = 2 * hstep;
    const unsigned ldsw = (unsigned)wid * 1024u;
    const int aoff = lds_byte(wr * 64 + fr, fq * 8), boff = lds_byte(wc * 32 + fr, fq * 8);
#define PG8_SA(b, h) (((b) * 2 + (h)) * HTB)
#define PG8_SB(b, h) ((4 + (b) * 2 + (h)) * HTB)
#define PG8_STAGE(bufoff, gbase, voff) do { _Pragma("unroll") for (int _i = 0; _i < 2; ++_i) \
        __builtin_amdgcn_global_load_lds((const unsigned*)((const char*)(gbase) + (voff)[_i]), (LAS unsigned*)(lds + (bufoff) + ldsw + _i * 8192), 16, 0, 0); } while (0)
#define PG8_LDA(dst, b, h) do { _Pragma("unroll") for (int m = 0; m < 4; ++m) _Pragma("unroll") for (int k = 0; k < 2; ++k) dst[m][k] = *(const LAS bf16x8*)(lds + PG8_SA(b, h) + aoff + m * 2048 + k * 1024); } while (0)
#define PG8_LDB(dst, b, h) do { _Pragma("unroll") for (int n = 0; n < 2; ++n) _Pragma("unroll") for (int k = 0; k < 2; ++k) dst[n][k] = *(const LAS bf16x8*)(lds + PG8_SB(b, h) + boff + n * 2048 + k * 1024); } while (0)
#define PG8_MMA(ai, bj, At, Bt) do { __builtin_amdgcn_s_setprio(1); _Pragma("unroll") for (int m = 0; m < 4; ++m) _Pragma("unroll") for (int n = 0; n < 2; ++n) _Pragma("unroll") for (int k = 0; k < 2; ++k) \
        acc[ai][bj][m][n] = __builtin_amdgcn_mfma_f32_16x16x32_bf16(Bt[n][k], At[m][k], acc[ai][bj][m][n], 0, 0, 0); __builtin_amdgcn_s_setprio(0); } while (0)
#define PG8_WAIT_V(n) asm volatile("s_waitcnt vmcnt(" #n ")" ::: "memory")
#define PG8_WAIT_L(n) asm volatile("s_waitcnt lgkmcnt(" #n ")" ::: "memory")
#define PG8_BAR __builtin_amdgcn_s_barrier()
#define PG8_SCHED __builtin_amdgcn_sched_barrier(0)
    Unit cur, nxt; int ui = 0;
    if (!S.next(0, cur)) return;
    f32x4 acc[2][2][4][2];
#pragma unroll
    for (int a = 0; a < 2; ++a)
#pragma unroll
        for (int b = 0; b < 2; ++b)
#pragma unroll
            for (int m = 0; m < 4; ++m)
#pragma unroll
                for (int n = 0; n < 2; ++n) acc[a][b][m][n] = (f32x4){0.f, 0.f, 0.f, 0.f};
    bf16x8 At[4][2], B0[2][2], B1[2][2];
    const char* cA = (const char*)g.A + (size_t)cur.pm * tstep; const char* cB = (const char*)g.Bt + (size_t)cur.pn * tstep;
    S.a_ready(cur);
    PG8_STAGE(PG8_SB(0, 0), cB, voffB); PG8_STAGE(PG8_SA(0, 0), cA, voffA); PG8_STAGE(PG8_SB(0, 1), cB + hstep, voffB); PG8_STAGE(PG8_SA(0, 1), cA + hstep, voffA);
    if (wr == 1) PG8_BAR;
    PG8_WAIT_V(4); PG8_BAR;
    PG8_STAGE(PG8_SB(1, 0), cB + kstep, voffB); PG8_STAGE(PG8_SA(1, 0), cA + kstep, voffA); PG8_STAGE(PG8_SB(1, 1), cB + hstep + kstep, voffB);
    PG8_WAIT_V(6); PG8_BAR;
    for (;;) {
        const bool has_next = S.next(ui + 1, nxt);
        const char* nA = has_next ? (const char*)g.A + (size_t)nxt.pm * tstep : cA; const char* nB = has_next ? (const char*)g.Bt + (size_t)nxt.pn * tstep : cB;
        for (int t = 0; t < nt; t += 2) {
            const bool last = (t == nt - 2);
            const char* a1 = cA + (size_t)(t + 1) * kstep;
            const char* a2 = last ? nA : cA + (size_t)(t + 2) * kstep; const char* b2 = last ? nB : cB + (size_t)(t + 2) * kstep;
            const char* a3 = a2 + kstep; const char* b3 = b2 + kstep;
            if (last && has_next) S.a_ready(nxt);
            PG8_LDB(B0, 0, 0); PG8_SCHED; PG8_LDA(At, 0, 0); PG8_STAGE(PG8_SA(1, 1), a1 + hstep, voffA);
            PG8_WAIT_L(8); PG8_BAR; PG8_WAIT_L(0); PG8_MMA(0, 0, At, B0); PG8_BAR; PG8_SCHED;
            PG8_LDB(B1, 0, 1); PG8_STAGE(PG8_SB(0, 0), b2, voffB);
            PG8_BAR; PG8_WAIT_L(0); PG8_MMA(0, 1, At, B1); PG8_BAR;
            PG8_LDA(At, 0, 1); PG8_STAGE(PG8_SA(0, 0), a2, voffA);
            PG8_BAR; PG8_WAIT_L(0); PG8_MMA(1, 0, At, B0); PG8_BAR; PG8_SCHED;
            PG8_STAGE(PG8_SB(0, 1), b2 + hstep, voffB);
            PG8_WAIT_V(6); PG8_BAR; PG8_MMA(1, 1, At, B1); PG8_BAR;
            PG8_LDB(B0, 1, 0); PG8_SCHED; PG8_LDA(At, 1, 0); PG8_STAGE(PG8_SA(0, 1), a2 + hstep, voffA);
            PG8_WAIT_L(8); PG8_BAR; PG8_WAIT_L(0); PG8_MMA(0, 0, At, B0); PG8_BAR; PG8_SCHED;
            PG8_LDB(B1, 1, 1); PG8_STAGE(PG8_SB(1, 0), b3, voffB);
            PG8_BAR; PG8_WAIT_L(0); PG8_MMA(0, 1, At, B1); PG8_BAR;
            PG8_LDA(At, 1, 1); PG8_STAGE(PG8_SA(1, 0), a3, voffA);
            PG8_BAR; PG8_WAIT_L(0); PG8_MMA(1, 0, At, B0); PG8_BAR; PG8_SCHED;
            PG8_STAGE(PG8_SB(1, 1), b3 + hstep, voffB);
            PG8_WAIT_V(6); PG8_BAR; PG8_MMA(1, 1, At, B1); PG8_BAR;
        }
        asm volatile("s_nop 15\n\ts_nop 15" ::: "memory");
        E(acc, cur, wr, wc, fr, fq); S.done(cur);
        if (!has_next) break;
#pragma unroll
        for (int a = 0; a < 2; ++a)
#pragma unroll
            for (int b = 0; b < 2; ++b)
#pragma unroll
                for (int m = 0; m < 4; ++m)
#pragma unroll
                    for (int n = 0; n < 2; ++n) acc[a][b][m][n] = (f32x4){0.f, 0.f, 0.f, 0.f};
        cur = nxt; cA = nA; cB = nB; ++ui;
    }
    PG8_WAIT_V(0);
    if (wr == 0) PG8_BAR;
    PG8_BAR;
#undef PG8_SA
#undef PG8_SB
#undef PG8_STAGE
#undef PG8_LDA
#undef PG8_LDB
#undef PG8_MMA
#undef PG8_WAIT_V
#undef PG8_WAIT_L
#undef PG8_BAR
#undef PG8_SCHED
}
}

struct EpiInMain {
    static constexpr bool PERM = true;
    unsigned char* ws; const float* bias;
    __device__ __forceinline__ void operator()(const f32x4 (&acc)[2][2][4][2], const pg8::Unit& u, int wr, int wc, int fr, int fq) const {
        const int row0 = u.pm * 256 + wr * 64 + fr;
        const int cl0 = wc * 32 + 8 * fq;
        bf16_t* base = (bf16_t*)(ws + OFF_MQ + (size_t)(u.pn >> 1) * (16 * MiB)) + (u.pn & 1) * 256 + cl0;
        const float* bp = bias + u.pn * 256 + cl0;
#pragma unroll
        for (int bj = 0; bj < 2; ++bj) {
            const f32x4 b0 = *(const f32x4*)(bp + bj * 128), b1 = *(const f32x4*)(bp + bj * 128 + 4);
#pragma unroll
            for (int ai = 0; ai < 2; ++ai)
#pragma unroll
                for (int m = 0; m < 4; ++m) {
                    const f32x4 v0 = acc[ai][bj][m][0] + b0, v1 = acc[ai][bj][m][1] + b1;
                    u32x4 o; o[0] = pg8::cvt_pk_bf16(v0[0], v0[1]); o[1] = pg8::cvt_pk_bf16(v0[2], v0[3]); o[2] = pg8::cvt_pk_bf16(v1[0], v1[1]); o[3] = pg8::cvt_pk_bf16(v1[2], v1[3]);
                    *(u32x4*)(base + (size_t)(row0 + ai * 128 + m * 16) * 512 + bj * 128) = o;
                }
        }
    }
};
struct EpiInTail {
    static constexpr bool PERM = true;
    unsigned char* ws; const float* bias;
    __device__ __forceinline__ void operator()(const f32x4 (&acc)[2][2][4][2], const pg8::Unit& u, int wr, int wc, int fr, int fq) const {
        const int row0 = u.pm * 256 + wr * 64 + fr;
        const int cl0 = wc * 32 + 8 * fq;
#pragma unroll
        for (int bj = 0; bj < 2; ++bj) {
            const int cl = bj * 128 + cl0;
            if (cl >= 208) continue;
            const f32x4 b0 = *(const f32x4*)(bias + cl), b1 = *(const f32x4*)(bias + cl + 4);
            if (cl < 192) {
                bf16_t* dst = (bf16_t*)(ws + OFF_AK + (size_t)(cl >> 6) * (2 * MiB)) + (cl & 63);
#pragma unroll
                for (int ai = 0; ai < 2; ++ai)
#pragma unroll
                    for (int m = 0; m < 4; ++m) {
                        const f32x4 v0 = acc[ai][bj][m][0] + b0, v1 = acc[ai][bj][m][1] + b1;
                        u32x4 o; o[0] = pg8::cvt_pk_bf16(v0[0], v0[1]); o[1] = pg8::cvt_pk_bf16(v0[2], v0[3]); o[2] = pg8::cvt_pk_bf16(v1[0], v1[1]); o[3] = pg8::cvt_pk_bf16(v1[2], v1[3]);
                        *(u32x4*)(dst + (size_t)(row0 + ai * 128 + m * 16) * 64) = o;
                    }
            } else {
                float* dst = (float*)(ws + OFF_GATE) + (cl - 192);
#pragma unroll
                for (int ai = 0; ai < 2; ++ai)
#pragma unroll
                    for (int m = 0; m < 4; ++m) {
                        float* d = dst + (size_t)(row0 + ai * 128 + m * 16) * 16;
                        *(f32x4*)d = acc[ai][bj][m][0] + b0; *(f32x4*)(d + 4) = acc[ai][bj][m][1] + b1;
                    }
            }
        }
    }
};
struct EpiOut {
    static constexpr bool PERM = false;
    const float* x; const float* ada; float* out;
    __device__ __forceinline__ void operator()(const f32x4 (&acc)[2][2][4][2], const pg8::Unit& u, int wr, int wc, int fr, int fq) const {
        const int row0 = u.pm * 256 + wr * 64 + fr, col0 = u.pn * 256 + wc * 32 + 4 * fq;
        const int b = (u.pm * 256) >> 12;
        f32x4 gv[2][2];
#pragma unroll
        for (int bj = 0; bj < 2; ++bj)
#pragma unroll
            for (int n = 0; n < 2; ++n) gv[bj][n] = *(const f32x4*)(ada + b * 6144 + 2048 + col0 + bj * 128 + n * 16);
#pragma unroll
        for (int ai = 0; ai < 2; ++ai)
#pragma unroll
            for (int m = 0; m < 4; ++m) {
                const size_t ro = (size_t)(row0 + ai * 128 + m * 16) * 1024 + col0;
#pragma unroll
                for (int bj = 0; bj < 2; ++bj)
#pragma unroll
                    for (int n = 0; n < 2; ++n) {
                        const f32x4 xv = *(const f32x4*)(x + ro + bj * 128 + n * 16);
                        *(f32x4*)(out + ro + bj * 128 + n * 16) = xv + gv[bj][n] * acc[ai][bj][m][n];
                    }
            }
    }
};
struct EpiQry {
    static constexpr bool PERM = true;
    bf16_t* O;
    __device__ __forceinline__ void operator()(const f32x4 (&acc)[2][2][4][2], const pg8::Unit& u, int wr, int wc, int fr, int fq) const {
        const int row0 = u.pm * 256 + wr * 64 + fr, col0 = u.pn * 256 + wc * 32 + 8 * fq;
#pragma unroll
        for (int ai = 0; ai < 2; ++ai)
#pragma unroll
            for (int m = 0; m < 4; ++m) {
                bf16_t* rowp = O + (size_t)(row0 + ai * 128 + m * 16) * 1024 + col0;
#pragma unroll
                for (int bj = 0; bj < 2; ++bj) {
                    const f32x4 v0 = acc[ai][bj][m][0], v1 = acc[ai][bj][m][1];
                    u32x4 o; o[0] = pg8::cvt_pk_bf16(v0[0], v0[1]); o[1] = pg8::cvt_pk_bf16(v0[2], v0[3]); o[2] = pg8::cvt_pk_bf16(v1[0], v1[1]); o[3] = pg8::cvt_pk_bf16(v1[2], v1[3]);
                    *(u32x4*)(rowp + bj * 128) = o;
                }
            }
    }
};

__device__ __forceinline__ int inperm_src(int n) {
    if (n < 2048) return n;
    if (n < 2560) return 2056 + (n - 2048);
    if (n < 3072) return 2696 + (n - 2560);
    if (n < 3136) return 2568 + (n - 3072);
    if (n < 3200) return 2632 + (n - 3136);
    if (n < 3264) return 3208 + (n - 3200);
    if (n < 3268) return 2048 + (n - 3264);
    if (n < 3272) return 2052 + (n - 3268);
    if (n < 3280) return 3272 + (n - 3272);
    return -1;
}
template <bool PERMUTE>
__device__ __forceinline__ void transpose_tile(const float* src, int ld, bf16_t* dst, int n0, int k0, LAS float* t) {
    const int tid = threadIdx.x;
    for (int i = tid; i < 4096; i += NTHREADS) {
        const int kk = i >> 6, nn = i & 63;
        const int sc = PERMUTE ? inperm_src(n0 + nn) : (n0 + nn);
        t[kk * 65 + nn] = sc >= 0 ? src[(size_t)(k0 + kk) * ld + sc] : 0.f;
    }
    __syncthreads();
    for (int i = tid; i < 2048; i += NTHREADS) {
        const int nn = i >> 5, kp = (i & 31) * 2;
        ((unsigned*)dst)[((size_t)(n0 + nn) * 1024 + k0 + kp) >> 1] = pack2(t[kp * 65 + nn], t[(kp + 1) * 65 + nn]);
    }
    __syncthreads();
}
__device__ __forceinline__ void convert_chunk(const float* src, bf16_t* dst, size_t e0, int n) {
    for (int i = threadIdx.x * 8; i < n; i += NTHREADS * 8) {
        const f32x4 a = *(const f32x4*)(src + e0 + i), b = *(const f32x4*)(src + e0 + i + 4);
        u32x4 o; o[0] = pack2(a[0], a[1]); o[1] = pack2(a[2], a[3]); o[2] = pack2(b[0], b[1]); o[3] = pack2(b[2], b[3]);
        *(u32x4*)(dst + e0 + i) = o;
    }
}
__device__ __forceinline__ unsigned pack4_fp8(float a, float b, float c, float d) {
    a = fminf(fmaxf(a, -448.f), 448.f); b = fminf(fmaxf(b, -448.f), 448.f); c = fminf(fmaxf(c, -448.f), 448.f); d = fminf(fmaxf(d, -448.f), 448.f);
    int w = 0;
    w = __builtin_amdgcn_cvt_pk_fp8_f32(a, b, w, false);
    w = __builtin_amdgcn_cvt_pk_fp8_f32(c, d, w, true);
    return (unsigned)w;
}
__device__ __forceinline__ void convert_chunk_fp8(const float* src, unsigned char* dst, size_t e0, int n, float scale) {
    for (int i = threadIdx.x * 16; i < n; i += NTHREADS * 16) {
        const f32x4 a = *(const f32x4*)(src + e0 + i), b = *(const f32x4*)(src + e0 + i + 4), c = *(const f32x4*)(src + e0 + i + 8), d = *(const f32x4*)(src + e0 + i + 12);
        u32x4 o; o[0] = pack4_fp8(a[0] * scale, a[1] * scale, a[2] * scale, a[3] * scale); o[1] = pack4_fp8(b[0] * scale, b[1] * scale, b[2] * scale, b[3] * scale);
        o[2] = pack4_fp8(c[0] * scale, c[1] * scale, c[2] * scale, c[3] * scale); o[3] = pack4_fp8(d[0] * scale, d[1] * scale, d[2] * scale, d[3] * scale);
        *(u32x4*)(dst + e0 + i) = o;
    }
}
__device__ __forceinline__ unsigned pack8_fp4(const f32x4 a, const f32x4 b, float scale) {
    float v[8] = {a[0] * scale, a[1] * scale, a[2] * scale, a[3] * scale, b[0] * scale, b[1] * scale, b[2] * scale, b[3] * scale};
#pragma unroll
    for (int i = 0; i < 8; ++i) v[i] = fminf(fmaxf(v[i], -6.f), 6.f);
    unsigned w = 0;
    w = __builtin_amdgcn_cvt_scalef32_pk_fp4_f32(w, v[0], v[1], 1.0f, 0);
    w = __builtin_amdgcn_cvt_scalef32_pk_fp4_f32(w, v[2], v[3], 1.0f, 1);
    w = __builtin_amdgcn_cvt_scalef32_pk_fp4_f32(w, v[4], v[5], 1.0f, 2);
    w = __builtin_amdgcn_cvt_scalef32_pk_fp4_f32(w, v[6], v[7], 1.0f, 3);
    return w;
}
__device__ __forceinline__ void convert_chunk_fp4(const float* src, unsigned char* dst, size_t e0, int n, float scale) {
    for (int i = threadIdx.x * 32; i < n; i += NTHREADS * 32) {
        u32x4 o;
#pragma unroll
        for (int k = 0; k < 4; ++k) o[k] = pack8_fp4(*(const f32x4*)(src + e0 + i + 8 * k), *(const f32x4*)(src + e0 + i + 8 * k + 4), scale);
        *(u32x4*)(dst + ((e0 + i) >> 1)) = o;
    }
}
__device__ __forceinline__ unsigned pack4_i8(float a, float b, float c, float d, float scale) {
    const int ia = (int)fminf(fmaxf(rintf(a * scale), -127.f), 127.f), ib = (int)fminf(fmaxf(rintf(b * scale), -127.f), 127.f);
    const int ic = (int)fminf(fmaxf(rintf(c * scale), -127.f), 127.f), id = (int)fminf(fmaxf(rintf(d * scale), -127.f), 127.f);
    return (unsigned)(ia & 0xFF) | ((unsigned)(ib & 0xFF) << 8) | ((unsigned)(ic & 0xFF) << 16) | ((unsigned)(id & 0xFF) << 24);
}
__device__ __forceinline__ void convert_chunk_i8(const float* src, unsigned char* dst, size_t e0, int n, float scale) {
    for (int i = threadIdx.x * 16; i < n; i += NTHREADS * 16) {
        const f32x4 a = *(const f32x4*)(src + e0 + i), b = *(const f32x4*)(src + e0 + i + 4), c = *(const f32x4*)(src + e0 + i + 8), d = *(const f32x4*)(src + e0 + i + 12);
        u32x4 o; o[0] = pack4_i8(a[0], a[1], a[2], a[3], scale); o[1] = pack4_i8(b[0], b[1], b[2], b[3], scale); o[2] = pack4_i8(c[0], c[1], c[2], c[3], scale); o[3] = pack4_i8(d[0], d[1], d[2], d[3], scale);
        *(u32x4*)(dst + e0 + i) = o;
    }
}
__device__ __forceinline__ unsigned pack8_i4(const f32x4 a, const f32x4 b, float scale) {
    unsigned w = 0;
#pragma unroll
    for (int k = 0; k < 4; ++k) {
        const int qa = (int)fminf(fmaxf(rintf(a[k] * scale), -7.f), 7.f) + 8, qb = (int)fminf(fmaxf(rintf(b[k] * scale), -7.f), 7.f) + 8;
        w |= (unsigned)qa << (4 * k); w |= (unsigned)qb << (4 * (k + 4));
    }
    return w;
}
__device__ __forceinline__ void convert_chunk_i4(const float* src, unsigned char* dst, size_t e0, int n, float scale) {
    for (int i = threadIdx.x * 32; i < n; i += NTHREADS * 32) {
        u32x4 o;
#pragma unroll
        for (int k = 0; k < 4; ++k) o[k] = pack8_i4(*(const f32x4*)(src + e0 + i + 8 * k), *(const f32x4*)(src + e0 + i + 8 * k + 4), scale);
        *(u32x4*)(dst + ((e0 + i) >> 1)) = o;
    }
}
__device__ __forceinline__ void convert_tables(const Params& p, int first, int stride) {
    for (int it = first; it < 1024; it += stride) {
        const int tsel = it >> 9; const size_t e0 = (size_t)(it & 511) * 32768;
        if (tsel) convert_chunk_i4(p.peer_v, p.ws + OFF_VT, e0, 32768, PEER_SV); else convert_chunk_i8(p.peer_u, p.ws + OFF_UT, e0, 32768, PEER_SU);
    }
}
__device__ __forceinline__ void phase0(const Params& p, LAS unsigned char* lds) {
    const int tid = threadIdx.x;
    float* ada = (float*)(p.ws + OFF_ADA);
    LAS float* lf = (LAS float*)lds;
    constexpr int N_ADA = 192, N_WIN = 52 * 16, N_WOUT = 256, N_WPQ = 256, N_SK = 4, N_BIAS = 1;
    constexpr int NITEMS = N_ADA + N_WIN + N_WOUT + N_WPQ + N_SK + N_BIAS;
    if (blockIdx.x < N_ADA) {
        {
            const int it = blockIdx.x;
            LAS float* sc = lf; LAS float* red = lf + 4096;
            for (int i = tid; i < 4096; i += NTHREADS) sc[i] = siluf(p.c[i]);
            __syncthreads();
            const int col = tid & 31, kg = tid >> 5, c0 = it * 32;
            float a0 = 0.f, a1 = 0.f, a2 = 0.f, a3 = 0.f;
            const float* w = p.w_ada + c0 + col;
#pragma unroll 8
            for (int j = 0; j < 64; ++j) { const int k = kg + 16 * j; const float wv = w[(size_t)k * 6144];
                a0 += sc[k] * wv; a1 += sc[1024 + k] * wv; a2 += sc[2048 + k] * wv; a3 += sc[3072 + k] * wv; }
            red[(kg * 4 + 0) * 32 + col] = a0; red[(kg * 4 + 1) * 32 + col] = a1; red[(kg * 4 + 2) * 32 + col] = a2; red[(kg * 4 + 3) * 32 + col] = a3;
            __syncthreads();
            if (tid < 128) { const int b = tid >> 5, cc = tid & 31; float s = 0.f;
                for (int g = 0; g < 16; ++g) s += red[(g * 4 + b) * 32 + cc];
                ada[b * 6144 + c0 + cc] = s + p.b_ada[c0 + cc]; }
        }
        wg_signal((unsigned*)(p.ws + OFF_CTL), CNT_ADA);
        __syncthreads();
    }
    for (int item = N_ADA + ((blockIdx.x + gridDim.x - N_ADA) % gridDim.x); item < NITEMS; item += gridDim.x) {
        int it = item;
        it -= N_ADA;
        if (it < N_WIN) { transpose_tile<true>(p.w_in, 3280, (bf16_t*)(p.ws + OFF_WIN), (it >> 4) * 64, (it & 15) * 64, lf); continue; }
        it -= N_WIN;
        if (it < N_WOUT) { transpose_tile<false>(p.w_out, 1024, (bf16_t*)(p.ws + OFF_WOUT), (it >> 4) * 64, (it & 15) * 64, lf); continue; }
        it -= N_WOUT;
        if (it < N_WPQ) { transpose_tile<false>(p.w_peer_q, 1024, (bf16_t*)(p.ws + OFF_WPQ), (it >> 4) * 64, (it & 15) * 64, lf); continue; }
        it -= N_WPQ;

        if (it < N_SK) { convert_chunk(p.sub_keys, (bf16_t*)(p.ws + OFF_SK), (size_t)it * 32768, 32768); continue; }
        it -= N_SK;
        { float* bias = (float*)(p.ws + OFF_BIAS);
          for (int n = tid; n < NIN_PAD; n += NTHREADS) { const int s = inperm_src(n); bias[n] = s >= 0 ? p.b_in[s] : 0.f; } }
    }
}

__device__ __forceinline__ void norm_mod_rows(const float* X, const float* g, const float* ada, int sh_off, int sc_off, bf16_t* out) {
    const int wid = threadIdx.x >> 6, lane = threadIdx.x & 63;
    for (int row = (blockIdx.x * 8 + wid) * 2; row < NTOK; row += gridDim.x * 16) {
        const int b = row >> 12;
        f32x4 v[2][4]; float ss[2] = {0.f, 0.f};
#pragma unroll
        for (int rr = 0; rr < 2; ++rr)
#pragma unroll
            for (int j = 0; j < 4; ++j) v[rr][j] = *(const f32x4*)(X + (size_t)(row + rr) * 1024 + 4 * (lane + 64 * j));
#pragma unroll
        for (int rr = 0; rr < 2; ++rr)
#pragma unroll
            for (int j = 0; j < 4; ++j) ss[rr] += v[rr][j][0] * v[rr][j][0] + v[rr][j][1] * v[rr][j][1] + v[rr][j][2] * v[rr][j][2] + v[rr][j][3] * v[rr][j][3];
        ss[0] = wave_sum(ss[0]); ss[1] = wave_sum(ss[1]);
        const float rstd0 = rsqrtf(ss[0] * (1.f / 1024.f) + 1e-6f), rstd1 = rsqrtf(ss[1] * (1.f / 1024.f) + 1e-6f);
#pragma unroll
        for (int j = 0; j < 4; ++j) {
            const int c = 4 * (lane + 64 * j);
            const f32x4 gg = *(const f32x4*)(g + c), sc = *(const f32x4*)(ada + b * 6144 + sc_off + c), sh = *(const f32x4*)(ada + b * 6144 + sh_off + c);
#pragma unroll
            for (int rr = 0; rr < 2; ++rr) {
                const float rstd = rr ? rstd1 : rstd0;
                float h[4];
#pragma unroll
                for (int i = 0; i < 4; ++i) h[i] = (v[rr][j][i] * rstd * gg[i]) * (1.f + sc[i]) + sh[i];
                u32x2 o; o[0] = pack2(h[0], h[1]); o[1] = pack2(h[2], h[3]);
                *(u32x2*)(out + (size_t)(row + rr) * 1024 + c) = o;
            }
        }
    }
}

__device__ __forceinline__ bf16x8 lds_frag(const LAS bf16_t* base, int row, int stride, int kofs) { return *(const LAS bf16x8*)(base + row * stride + kofs); }

__device__ __forceinline__ void conv_silu8(const bf16_t* src, const float* cw  , int row, int tpos, int col, float scale, float (&o)[8]) {
    float acc[8];
#pragma unroll
    for (int i = 0; i < 8; ++i) acc[i] = 0.f;
#pragma unroll
    for (int j = 0; j < 4; ++j) {
        const int tt = tpos - 3 + j;
        if (tt >= 0) {
            const u32x4 xv = *(const u32x4*)(src + (size_t)(row - 3 + j) * 512 + col);
            const f32x4 w0 = *(const f32x4*)(cw + j * 1024), w1 = *(const f32x4*)(cw + j * 1024 + 4);
            acc[0] += w0[0] * lo16(xv[0]); acc[1] += w0[1] * hi16(xv[0]); acc[2] += w0[2] * lo16(xv[1]); acc[3] += w0[3] * hi16(xv[1]);
            acc[4] += w1[0] * lo16(xv[2]); acc[5] += w1[1] * hi16(xv[2]); acc[6] += w1[2] * lo16(xv[3]); acc[7] += w1[3] * hi16(xv[3]);
        }
    }
#pragma unroll
    for (int i = 0; i < 8; ++i) o[i] = siluf(acc[i]) * scale;
}

__device__ __forceinline__ void mlstm_passA(const Params& p, int task, LAS unsigned char* lds) {
    const int tid = opaque_tid(), wid = tid >> 6, lane = tid & 63;
    const int bh = task >> 6, c = task & 63, b = bh >> 2, h = bh & 3;
    const int row0 = b * SEQ + c * 64;
    const float* gates = (const float*)(p.ws + OFF_GATE);
    const bf16_t* MK = (const bf16_t*)(p.ws + OFF_MK); const bf16_t* MV = (const bf16_t*)(p.ws + OFF_MV);
    LAS bf16_t* KT = (LAS bf16_t*)lds;
    LAS bf16_t* VT = KT + 128 * 72;
    LAS float* sc = (LAS float*)(VT + 128 * 72);
    LAS float* lsg = sc; LAS float* ig = sc + 64; LAS float* wloc = sc + 128; LAS float* misc = sc + 192;
    if (tid < 64) {
        const float f = gates[(size_t)(row0 + tid) * 16 + 4 + h], iv = gates[(size_t)(row0 + tid) * 16 + h];
        const float bc = wave_scan_add(logsigmoidf_(f), lane);
        const float bl = __shfl(bc, 63);
        const float a = bl - bc + iv;
        const float m = wave_max(a);
        lsg[tid] = bc; ig[tid] = iv; wloc[tid] = __expf(a - m);
        if (tid == 0) { misc[0] = m; misc[1] = bl; }
    }
    __syncthreads();
    for (int pc = tid; pc < 1024; pc += NTHREADS) {
        const int s = pc >> 4, dg = pc & 15;
        float kk[8];
        conv_silu8(MK, p.conv_qk + 512 + h * 128 + dg * 8, row0 + s, c * 64 + s, h * 128 + dg * 8, 1.f, kk);
#pragma unroll
        for (int i = 0; i < 8; ++i) KT[(dg * 8 + i) * 72 + s] = f2bf(kk[i]);
        const u32x4 vv = *(const u32x4*)(MV + (size_t)(row0 + s) * 512 + h * 128 + dg * 8);
        const float w = wloc[s];
#pragma unroll
        for (int i = 0; i < 4; ++i) { VT[(dg * 8 + 2 * i) * 72 + s] = f2bf(lo16(vv[i]) * w); VT[(dg * 8 + 2 * i + 1) * 72 + s] = f2bf(hi16(vv[i]) * w); }
    }
    __syncthreads();
    {
        const int r = lane & 15, g = lane >> 4;
        bf16x8 a0 = lds_frag(VT, wid * 16 + r, 72, 8 * g), a1 = lds_frag(VT, wid * 16 + r, 72, 8 * g + 32);
        bf16_t* KV = (bf16_t*)(p.ws + OFF_KV) + (size_t)task * 16384;
#pragma unroll
        for (int dt = 0; dt < 8; ++dt) {
            f32x4 acc = {0.f, 0.f, 0.f, 0.f};
            acc = __builtin_amdgcn_mfma_f32_16x16x32_bf16(a0, lds_frag(KT, dt * 16 + r, 72, 8 * g), acc, 0, 0, 0);
            acc = __builtin_amdgcn_mfma_f32_16x16x32_bf16(a1, lds_frag(KT, dt * 16 + r, 72, 8 * g + 32), acc, 0, 0, 0);
#pragma unroll
            for (int j = 0; j < 4; ++j) KV[(wid * 16 + 4 * g + j) * 128 + dt * 16 + r] = f2bf_sw(acc[j]);
        }
    }
    if (tid < 128) {
        float s = 0.f;
        for (int i = 0; i < 64; ++i) s += wloc[i] * bf2f(KT[tid * 72 + i]);
        ((float*)(p.ws + OFF_KS))[(size_t)task * 128 + tid] = s;
    }
    if (tid == 0) { ((float*)(p.ws + OFF_MLOC))[task] = misc[0]; ((float*)(p.ws + OFF_BLAST))[task] = misc[1]; }
    __syncthreads();
}

__device__ __forceinline__ void mlstm_scan(const Params& p, int item, LAS unsigned char* lds) {
    const int tid = opaque_tid();
    const int bh = item >> 4, blk = item & 15;
    LAS float* dec = (LAS float*)lds; LAS float* inj = dec + 64;
    if (tid == 0) {
        const float* ML = (const float*)(p.ws + OFF_MLOC); const float* BL = (const float*)(p.ws + OFF_BLAST); float* M0 = (float*)(p.ws + OFF_M0);
        float m = 0.f;
        for (int c = 0; c < 64; ++c) {
            const float ml = ML[bh * 64 + c], bl = BL[bh * 64 + c];
            if (blk == 0) M0[bh * 64 + c] = m;
            const float mn = fmaxf(bl + m, ml);
            dec[c] = __expf(bl + m - mn); inj[c] = __expf(ml - mn); m = mn;
        }
    }
    __syncthreads();
    unsigned* KV = (unsigned*)(p.ws + OFF_KV) + (size_t)bh * 64 * 8192 + blk * 512 + tid;
    float s0 = 0.f, s1 = 0.f;
#pragma unroll 8
    for (int c = 0; c < 64; ++c) {
        const unsigned w = KV[(size_t)c * 8192];
        KV[(size_t)c * 8192] = pack2(s0, s1);
        s0 = dec[c] * s0 + inj[c] * lo16(w); s1 = dec[c] * s1 + inj[c] * hi16(w);
    }
    if (blk == 0 && tid < 128) {
        float* KS = (float*)(p.ws + OFF_KS) + (size_t)bh * 64 * 128 + tid;
        float s = 0.f;
        for (int c = 0; c < 64; ++c) { const float k = KS[c * 128]; KS[c * 128] = s; s = dec[c] * s + inj[c] * k; }
    }
    __syncthreads();
}

__device__ __forceinline__ void mlstm_passB(const Params& p, int task, LAS unsigned char* lds) {
    const int tid = opaque_tid(), wid = tid >> 6, lane = tid & 63;
    const int bh = task >> 6, c = task & 63, b = bh >> 2, h = bh & 3;
    const int row0 = b * SEQ + c * 64;
    const float* gates = (const float*)(p.ws + OFF_GATE);
    const bf16_t* MQ = (const bf16_t*)(p.ws + OFF_MQ); const bf16_t* MK = (const bf16_t*)(p.ws + OFF_MK);
    const bf16_t* MV = (const bf16_t*)(p.ws + OFF_MV); const bf16_t* MO = (const bf16_t*)(p.ws + OFF_MO);
    LAS bf16_t* Q = (LAS bf16_t*)lds;
    LAS bf16_t* K = Q + 64 * 136;
    LAS bf16_t* VT = K + 64 * 136;
    LAS bf16_t* C0 = VT + 128 * 72;
    LAS bf16_t* P = C0 + 128 * 136;
    LAS float* sc = (LAS float*)(P + 64 * 72);
    LAS float* bcum = sc; LAS float* ig = sc + 64; LAS float* cs = sc + 128; LAS float* rb = sc + 192; LAS float* wint = sc + 256;
    LAS float* emt = sc + 320; LAS float* rinv = sc + 384; LAS float* qn = sc + 448; LAS float* n0 = sc + 512; LAS float* rowpart = sc + 640;
    LAS float* H = (LAS float*)lds;
    if (tid < 64) {
        const float f = gates[(size_t)(row0 + tid) * 16 + 4 + h], iv = gates[(size_t)(row0 + tid) * 16 + h];
        const float m0 = ((const float*)(p.ws + OFF_M0))[task];
        const float sc_ = wave_scan_add(logsigmoidf_(f), lane);
        const float cst = iv - sc_;
        const float pm = wave_scan_max(cst, lane);
        const float m_intra = sc_ + pm, m_inter = sc_ + m0, mt = fmaxf(m_inter, m_intra);
        bcum[tid] = sc_; ig[tid] = iv; cs[tid] = cst; rb[tid] = sc_ - mt; wint[tid] = __expf(m_inter - mt); emt[tid] = __expf(-mt);
    }
    if (tid >= 64 && tid < 192) n0[tid - 64] = ((const float*)(p.ws + OFF_KS))[(size_t)task * 128 + tid - 64];
    for (int pc = tid; pc < 1024; pc += NTHREADS) {
        const int s = pc >> 4, dg = pc & 15;
        float qq[8], kk[8];
        conv_silu8(MQ, p.conv_qk + h * 128 + dg * 8, row0 + s, c * 64 + s, h * 128 + dg * 8, 0.08838834764831845f, qq);
        conv_silu8(MK, p.conv_qk + 512 + h * 128 + dg * 8, row0 + s, c * 64 + s, h * 128 + dg * 8, 1.f, kk);
        u32x4 qo, ko;
#pragma unroll
        for (int i = 0; i < 4; ++i) { qo[i] = pack2(qq[2 * i], qq[2 * i + 1]); ko[i] = pack2(kk[2 * i], kk[2 * i + 1]); }
        *(LAS u32x4*)(Q + s * 136 + dg * 8) = qo; *(LAS u32x4*)(K + s * 136 + dg * 8) = ko;
        const u32x4 vv = *(const u32x4*)(MV + (size_t)(row0 + s) * 512 + h * 128 + dg * 8);
#pragma unroll
        for (int i = 0; i < 4; ++i) { VT[(dg * 8 + 2 * i) * 72 + s] = (bf16_t)(vv[i] & 0xffffu); VT[(dg * 8 + 2 * i + 1) * 72 + s] = (bf16_t)(vv[i] >> 16); }
    }
    {
        const bf16_t* KV = (const bf16_t*)(p.ws + OFF_KV) + (size_t)task * 16384;
        for (int pc = tid; pc < 2048; pc += NTHREADS) { const int e = pc >> 4, dg = pc & 15;
            *(LAS u32x4*)(C0 + e * 136 + dg * 8) = *(const u32x4*)(KV + e * 128 + dg * 8); }
    }
    __syncthreads();
    const int r = lane & 15, g = lane >> 4;
    {
        const int t = tid >> 3, part = tid & 7; float s = 0.f;
#pragma unroll
        for (int i = 0; i < 16; ++i) s += bf2f(Q[t * 136 + part * 16 + i]) * n0[part * 16 + i];
        s = oct_sum(s);
        if (part == 0) qn[t] = s;
    }
    {
        const int rt = wid >> 1;
#pragma unroll
        for (int cc = 0; cc < 2; ++cc) {
            const int ct = 2 * (wid & 1) + cc;
            f32x4 acc = {0.f, 0.f, 0.f, 0.f};
#pragma unroll
            for (int ks = 0; ks < 4; ++ks)
                acc = __builtin_amdgcn_mfma_f32_16x16x32_bf16(lds_frag(Q, rt * 16 + r, 136, 8 * g + 32 * ks), lds_frag(K, ct * 16 + r, 136, 8 * g + 32 * ks), acc, 0, 0, 0);
            const int scol = ct * 16 + r; const float csv = cs[scol];
#pragma unroll
            for (int j = 0; j < 4; ++j) {
                const int t = rt * 16 + 4 * g + j;
                float pv = (scol <= t) ? acc[j] * __expf(rb[t] + csv) : 0.f;
                P[t * 72 + scol] = f2bf(pv);
                pv = row16_sum(pv);
                if (r == 0) rowpart[t * 4 + ct] = pv;
            }
        }
    }
    __syncthreads();
    if (tid < 64) {
        const float den = rowpart[tid * 4] + rowpart[tid * 4 + 1] + rowpart[tid * 4 + 2] + rowpart[tid * 4 + 3] + wint[tid] * qn[tid];
        rinv[tid] = 1.f / fmaxf(fabsf(den), emt[tid]);
    }
    f32x4 hacc[4];
    {
        const int rt = wid >> 1;
#pragma unroll
        for (int ee = 0; ee < 4; ++ee) {
            const int et = 4 * (wid & 1) + ee;
            f32x4 a1 = {0.f, 0.f, 0.f, 0.f}, a2 = {0.f, 0.f, 0.f, 0.f};
#pragma unroll
            for (int ks = 0; ks < 2; ++ks)
                a1 = __builtin_amdgcn_mfma_f32_16x16x32_bf16(lds_frag(P, rt * 16 + r, 72, 8 * g + 32 * ks), lds_frag(VT, et * 16 + r, 72, 8 * g + 32 * ks), a1, 0, 0, 0);
#pragma unroll
            for (int ks = 0; ks < 4; ++ks)
                a2 = __builtin_amdgcn_mfma_f32_16x16x32_bf16(lds_frag(Q, rt * 16 + r, 136, 8 * g + 32 * ks), lds_frag(C0, et * 16 + r, 136, 8 * g + 32 * ks), a2, 0, 0, 0);
#pragma unroll
            for (int j = 0; j < 4; ++j) { const int t = rt * 16 + 4 * g + j; hacc[ee][j] = a1[j] + wint[t] * a2[j]; }
        }
    }
    __syncthreads();
    {
        const int rt = wid >> 1;
#pragma unroll
        for (int ee = 0; ee < 4; ++ee) {
            const int et = 4 * (wid & 1) + ee;
#pragma unroll
            for (int j = 0; j < 4; ++j) { const int t = rt * 16 + 4 * g + j; H[t * 132 + et * 16 + r] = hacc[ee][j] * rinv[t]; }
        }
    }
    __syncthreads();
    {
        const int t = tid >> 3, part = tid & 7;
        float hv[16]; float ss = 0.f;
#pragma unroll
        for (int i = 0; i < 16; ++i) { hv[i] = H[t * 132 + part * 16 + i]; ss += hv[i] * hv[i]; }
        ss = oct_sum(ss);
        const float rstd = rsqrtf(ss * (1.f / 128.f) + 1e-6f);
        const int col = h * 128 + part * 16;
        const u32x4 m0v = *(const u32x4*)(MO + (size_t)(row0 + t) * 512 + col), m1v = *(const u32x4*)(MO + (size_t)(row0 + t) * 512 + col + 8);
        float mo[16];
#pragma unroll
        for (int i = 0; i < 4; ++i) { mo[2 * i] = lo16(m0v[i]); mo[2 * i + 1] = hi16(m0v[i]); mo[8 + 2 * i] = lo16(m1v[i]); mo[8 + 2 * i + 1] = hi16(m1v[i]); }
        float o[16];
#pragma unroll
        for (int i = 0; i < 16; ++i) o[i] = (hv[i] * rstd * p.out_norm_m[col + i]) * sigmoidf_(mo[i]);
        u32x4 o0, o1;
#pragma unroll
        for (int i = 0; i < 4; ++i) { o0[i] = pack2(o[2 * i], o[2 * i + 1]); o1[i] = pack2(o[8 + 2 * i], o[8 + 2 * i + 1]); }
        bf16_t* dst = (bf16_t*)(p.ws + OFF_ACT) + (size_t)(row0 + t) * 1024 + col;
        *(u32x4*)dst = o0; *(u32x4*)(dst + 8) = o1;
    }
    __syncthreads();
}

__device__ __forceinline__ unsigned f2sortable(float f) { const unsigned u = __float_as_uint(f); return (u & 0x80000000u) ? ~u : (u | 0x80000000u); }
#define CNT4(c0, c1, c2, c3, a, b, cc, d, thr) asm volatile( \
    "v_cmp_ge_u32 s[40:41], %4, %8\n\tv_cmp_ge_u32 s[42:43], %5, %8\n\tv_cmp_ge_u32 s[44:45], %6, %8\n\tv_cmp_ge_u32 s[46:47], %7, %8\n\t" \
    "v_addc_co_u32 %0, s[48:49], 0, %0, s[40:41]\n\tv_addc_co_u32 %1, s[50:51], 0, %1, s[42:43]\n\tv_addc_co_u32 %2, s[52:53], 0, %2, s[44:45]\n\tv_addc_co_u32 %3, s[54:55], 0, %3, s[46:47]" \
    : "+v"(c0), "+v"(c1), "+v"(c2), "+v"(c3) : "v"(a), "v"(b), "v"(cc), "v"(d), "v"(thr) \
    : "s40", "s41", "s42", "s43", "s44", "s45", "s46", "s47", "s48", "s49", "s50", "s51", "s52", "s53", "s54", "s55")
template <int NR>
__device__ __forceinline__ int count_geN(const unsigned (&u)[NR], unsigned thr) {
    int c0 = 0, c1 = 0, c2 = 0, c3 = 0;
#pragma unroll
    for (int j = 0; j < NR; j += 4) CNT4(c0, c1, c2, c3, u[j], u[j + 1], u[j + 2], u[j + 3], thr);
    return (c0 + c1) + (c2 + c3);
}
template <int NR>
__device__ __forceinline__ void select_topk(const LAS float* srow, LAS int* lq, int t, int n, int lane) {
    unsigned u[NR];
#pragma unroll
    for (int j = 0; j < NR; ++j) { const int key = lane + 64 * j; u[j] = (key <= t) ? ((f2sortable(srow[key]) & 0xFFFFF000u) | (unsigned)(4095 - key)) : 0u; }
    unsigned tau = 1u;
    if (n > 256) {
        tau = 0u;
        for (int bit = 31; bit >= 0; --bit) {
            const unsigned cand = tau | (1u << bit);
            const int cnt = wave_sum_i32_uniform(count_geN<NR>(u, cand));
            if (cnt >= 256) { tau = cand; if (cnt == 256) break; }
        }
    }
    const int c = count_geN<NR>(u, tau);
    int pre = c;
#pragma unroll
    for (int o = 1; o < 64; o <<= 1) { const int v = __shfl_up(pre, o); if (lane >= o) pre += v; }
    int pos = pre - c;
    int keyv = lane;
#pragma unroll
    for (int j = 0; j < NR; ++j) {
        const bool sel = u[j] >= tau;
        const int slot = sel ? pos : (256 + lane);
        lq[slot] = keyv;
        pos += sel ? 1 : 0; keyv += 64;
    }
}
__device__ __forceinline__ void dsa_task(const Params& p, int task, LAS unsigned char* lds) {
    const int tid = opaque_tid(), wid = __builtin_amdgcn_readfirstlane(tid >> 6), lane = tid & 63;
    const int b = task >> 9, qg = task & 511, t0 = qg * 8, rowb = b * SEQ;
    const bf16_t* IQ = (const bf16_t*)(p.ws + OFF_IQ); const bf16_t* IK = (const bf16_t*)(p.ws + OFF_IK);
    const bf16_t* AQ = (const bf16_t*)(p.ws + OFF_AQ); const bf16_t* AK = (const bf16_t*)(p.ws + OFF_AK); const bf16_t* AV = (const bf16_t*)(p.ws + OFF_AV);
    const float* gates = (const float*)(p.ws + OFF_GATE);
    LAS float* scores = (LAS float*)lds;
    LAS int* lists = (LAS int*)(lds + 131072);
    const int ntile = (t0 + 8 + 31) >> 5;
#pragma unroll 1
    for (int rr0 = 0; rr0 < ((DSA_REP & 1) ? 2 : 1); ++rr0)
    {
        const int r = lane & 31, hh = lane >> 5;
        bf16x8 af[2][4]; float wv[2][4][4];
#pragma unroll
        for (int rt = 0; rt < 2; ++rt) {
            const size_t qrow = (size_t)(rowb + t0 + 4 * rt + (r >> 3));
#pragma unroll
            for (int ks = 0; ks < 4; ++ks) af[rt][ks] = *(const bf16x8*)(IQ + qrow * 512 + (r & 7) * 64 + 16 * ks + 8 * hh);
#pragma unroll
            for (int q4 = 0; q4 < 4; ++q4)
#pragma unroll
                for (int h4 = 0; h4 < 4; ++h4) wv[rt][q4][h4] = gates[(size_t)(rowb + t0 + 4 * rt + q4) * 16 + 8 + h4 + 4 * hh] * 0.04419417382415922f;
        }
        bf16x8 bfr[4], bnx[4];
        if (wid < ntile) {
#pragma unroll
            for (int ks = 0; ks < 4; ++ks) bfr[ks] = *(const bf16x8*)(IK + (size_t)(rowb + 32 * wid + r) * 64 + 16 * ks + 8 * hh);
        }
        for (int kt = wid; kt < ntile; kt += 8) {
            if (kt + 8 < ntile) {
#pragma unroll
                for (int ks = 0; ks < 4; ++ks) bnx[ks] = *(const bf16x8*)(IK + (size_t)(rowb + 32 * (kt + 8) + r) * 64 + 16 * ks + 8 * hh);
            }
            const int key = 32 * kt + r;
#pragma unroll
            for (int rt = 0; rt < 2; ++rt) {
                f32x16 acc;
#pragma unroll
                for (int i = 0; i < 16; ++i) acc[i] = 0.f;
#pragma unroll
                for (int ks = 0; ks < 4; ++ks) acc = __builtin_amdgcn_mfma_f32_32x32x16_bf16(af[rt][ks], bfr[ks], acc, 0, 0, 0);
                float part[4];
#pragma unroll
                for (int q4 = 0; q4 < 4; ++q4) {
                    part[q4] = 0.f;
#pragma unroll
                    for (int h4 = 0; h4 < 4; ++h4) part[q4] += fmaxf(acc[q4 * 4 + h4], 0.f) * wv[rt][q4][h4];
                }
                float tot[2];
#pragma unroll
                for (int i = 0; i < 2; ++i) { const u32x2 r_ = __builtin_amdgcn_permlane32_swap(__float_as_uint(part[i]), __float_as_uint(part[i + 2]), false, false); tot[i] = __uint_as_float(r_[0]) + __uint_as_float(r_[1]); }
#pragma unroll
                for (int i = 0; i < 2; ++i) { const int qq = 4 * rt + 2 * hh + i; scores[qq * 4096 + key] = (key <= t0 + qq) ? tot[i] : -INFINITY; }
            }
#pragma unroll
            for (int ks = 0; ks < 4; ++ks) bfr[ks] = bnx[ks];
        }
    }
    __syncthreads();
    const int qq = wid, t = t0 + qq, n = t + 1;
    const int nsel = n < 256 ? n : 256;
#pragma unroll 1
    for (int rr1 = 0; rr1 < ((DSA_REP & 2) ? 2 : 1); ++rr1)
    {
        const LAS float* srow = scores + qq * 4096; LAS int* lq = lists + qq * 320;
        const int nreg = (t >> 6) + 1;
        if (nreg <= 8) select_topk<8>(srow, lq, t, n, lane);
        else if (nreg <= 16) select_topk<16>(srow, lq, t, n, lane);
        else if (nreg <= 24) select_topk<24>(srow, lq, t, n, lane);
        else if (nreg <= 32) select_topk<32>(srow, lq, t, n, lane);
        else if (nreg <= 40) select_topk<40>(srow, lq, t, n, lane);
        else if (nreg <= 48) select_topk<48>(srow, lq, t, n, lane);
        else if (nreg <= 56) select_topk<56>(srow, lq, t, n, lane);
        else select_topk<64>(srow, lq, t, n, lane);
    }
    asm volatile("s_waitcnt lgkmcnt(0)" ::: "memory");
#pragma unroll 1
    for (int rr2 = 0; rr2 < ((DSA_REP & 4) ? 2 : 1); ++rr2) {
    {
        const int r = lane & 15, g = lane >> 4;
        const size_t qrow = (size_t)(rowb + t);
        bf16x8 bq[2];
#pragma unroll
        for (int ks = 0; ks < 2; ++ks) {
            if (r < 8) bq[ks] = *(const bf16x8*)(AQ + qrow * 512 + r * 64 + 8 * g + 32 * ks);
            else { bq[ks] = (bf16x8){0, 0, 0, 0, 0, 0, 0, 0}; }
        }
        LAS float* Pl = scores + qq * 4096;
#pragma unroll 1
        for (int half = 0; half < 2; ++half) {
            bf16x8 a0[8], a1[8];
#pragma unroll
            for (int i = 0; i < 8; ++i) {
                const int jp = 16 * (half * 8 + i) + r;
                const int key = (jp < nsel) ? lists[qq * 320 + jp] : 0;
                a0[i] = *(const bf16x8*)(AK + (size_t)(rowb + key) * 64 + 8 * g); a1[i] = *(const bf16x8*)(AK + (size_t)(rowb + key) * 64 + 8 * g + 32);
            }
#pragma unroll
            for (int i = 0; i < 8; ++i) {
                const int kt = half * 8 + i;
                f32x4 acc = {0.f, 0.f, 0.f, 0.f};
                acc = __builtin_amdgcn_mfma_f32_16x16x32_bf16(a0[i], bq[0], acc, 0, 0, 0);
                acc = __builtin_amdgcn_mfma_f32_16x16x32_bf16(a1[i], bq[1], acc, 0, 0, 0);
                if (r < 8) *(LAS f32x4*)(Pl + r * 260 + 16 * kt + 4 * g) = acc * 0.125f;
            }
        }
        asm volatile("s_waitcnt lgkmcnt(0)" ::: "memory");
        const int hd = lane & 7, ch = lane >> 3;
        f32x4 pv[8];
        float mx = -INFINITY;
#pragma unroll
        for (int i = 0; i < 8; ++i) {
            pv[i] = *(const LAS f32x4*)(Pl + hd * 260 + ch * 32 + 4 * i);
#pragma unroll
            for (int j = 0; j < 4; ++j) if (ch * 32 + 4 * i + j < nsel) mx = fmaxf(mx, pv[i][j]);
        }
        mx = fmaxf(mx, dppf(mx, 0x128));
        mx = fmaxf(mx, xchg_f32<16>(mx, lane)); mx = fmaxf(mx, xchg_f32<32>(mx, lane));
        float sm = 0.f;
#pragma unroll
        for (int i = 0; i < 8; ++i)
#pragma unroll
            for (int j = 0; j < 4; ++j) { const float e = (ch * 32 + 4 * i + j < nsel) ? __expf(pv[i][j] - mx) : 0.f; pv[i][j] = e; sm += e; }
        sm += dppf(sm, 0x128); sm += xchg_f32<16>(sm, lane); sm += xchg_f32<32>(sm, lane);
        const float inv = __builtin_amdgcn_rcpf(sm);
        LAS bf16_t* Pt = (LAS bf16_t*)((LAS unsigned char*)Pl + 9216);
#pragma unroll
        for (int i = 0; i < 4; ++i) {
            u32x4 o;
            o[0] = pack2(pv[2 * i][0] * inv, pv[2 * i][1] * inv); o[1] = pack2(pv[2 * i][2] * inv, pv[2 * i][3] * inv);
            o[2] = pack2(pv[2 * i + 1][0] * inv, pv[2 * i + 1][1] * inv); o[3] = pack2(pv[2 * i + 1][2] * inv, pv[2 * i + 1][3] * inv);
            *(LAS u32x4*)(Pt + hd * 264 + ch * 32 + 8 * i) = o;
        }
    }
    asm volatile("s_waitcnt lgkmcnt(0)" ::: "memory");
    {
        typedef short s16x4 __attribute__((ext_vector_type(4)));
        const int r = lane & 15, g = lane >> 4;
        LAS unsigned char* wb = (LAS unsigned char*)(scores + qq * 4096);
        const LAS bf16_t* Pt = (const LAS bf16_t*)(wb + 9216);
        const int nchunk = (nsel + 31) >> 5;
        const int kl = lane >> 3, dc = lane & 7;
        f32x4 acc[4];
#pragma unroll
        for (int ct = 0; ct < 4; ++ct) acc[ct] = (f32x4){0.f, 0.f, 0.f, 0.f};
        u32x4 vq[4], vn[4];
#pragma unroll
        for (int i = 0; i < 4; ++i) {
            const int jp = kl + 8 * i;
            const int key = (jp < nsel) ? lists[qq * 320 + jp] : 0;
            vq[i] = *(const u32x4*)(AV + (size_t)(rowb + key) * 64 + dc * 8);
        }
#pragma unroll 1
        for (int c = 0; c < nchunk; ++c) {
            LAS unsigned char* vb = wb + (c & 1) * 4608;
#pragma unroll
            for (int i = 0; i < 4; ++i) *(LAS u32x4*)(vb + (kl + 8 * i) * 144 + dc * 16) = vq[i];
            if (c + 1 < nchunk) {
#pragma unroll
                for (int i = 0; i < 4; ++i) {
                    const int jp = 32 * (c + 1) + kl + 8 * i;
                    const int key = (jp < nsel) ? lists[qq * 320 + jp] : 0;
                    vn[i] = *(const u32x4*)(AV + (size_t)(rowb + key) * 64 + dc * 8);
                }
            }
            bf16x8 a = *(const LAS bf16x8*)(Pt + (r & 7) * 264 + 32 * c + 8 * g);
            if (r >= 8) a = (bf16x8){0, 0, 0, 0, 0, 0, 0, 0};
#pragma unroll
            for (int ct = 0; ct < 4; ++ct) {
                LAS unsigned char* ba = vb + (8 * g + (r >> 2)) * 144 + (16 * ct + 4 * (r & 3)) * 2;
                const s16x4 b0 = __builtin_amdgcn_ds_read_tr16_b64_v4i16((LAS s16x4*)ba);
                const s16x4 b1 = __builtin_amdgcn_ds_read_tr16_b64_v4i16((LAS s16x4*)(ba + 4 * 144));
                bf16x8 bb; bb[0] = b0[0]; bb[1] = b0[1]; bb[2] = b0[2]; bb[3] = b0[3]; bb[4] = b1[0]; bb[5] = b1[1]; bb[6] = b1[2]; bb[7] = b1[3];
                acc[ct] = __builtin_amdgcn_mfma_f32_16x16x32_bf16(a, bb, acc[ct], 0, 0, 0);
            }
#pragma unroll
            for (int i = 0; i < 4; ++i) vq[i] = vn[i];
        }
        bf16_t* dst = (bf16_t*)(p.ws + OFF_ACT) + (size_t)(rowb + t) * 1024 + 512;
#pragma unroll
        for (int j = 0; j < 4; ++j) {
            float ss = acc[0][j] * acc[0][j] + acc[1][j] * acc[1][j] + acc[2][j] * acc[2][j] + acc[3][j] * acc[3][j];
            ss = row16_sum(ss);
            const float rstd = rsqrtf(ss * (1.f / 64.f) + 1e-6f);
            if (g < 2) {
                const int hd = 4 * g + j;
#pragma unroll
                for (int ct = 0; ct < 4; ++ct) dst[hd * 64 + 16 * ct + r] = f2bf(acc[ct][j] * rstd * p.out_norm_a[hd * 64 + 16 * ct + r]);
            }
        }
    }
    }
    __syncthreads();
}

__device__ __forceinline__ float sortable2f(unsigned s) { return __uint_as_float((s & 0x80000000u) ? (s ^ 0x80000000u) : ~s); }
#define CE_DESC(x, y) do { const unsigned mx_ = max(x, y), mn_ = min(x, y); (x) = mx_; (y) = mn_; } while (0)
template <int BASE, int N>
__device__ __forceinline__ void bitonic_sort16_desc(unsigned (&a)[N]) {
#pragma unroll
    for (int k = 2; k <= 16; k <<= 1) {
#pragma unroll
        for (int j = k >> 1; j > 0; j >>= 1) {
#pragma unroll
            for (int i = 0; i < 16; ++i) {
                const int l = i ^ j;
                if (l > i) {
                    if ((i & k) == 0) CE_DESC(a[BASE + i], a[BASE + l]);
                    else CE_DESC(a[BASE + l], a[BASE + i]);
                }
            }
        }
    }
}
template <int BASE, int N>
__device__ __forceinline__ void bitonic_merge16_desc(unsigned (&a)[N]) {
#pragma unroll
    for (int j = 8; j > 0; j >>= 1) {
#pragma unroll
        for (int i = 0; i < 16; ++i) { const int l = i ^ j; if (l > i) CE_DESC(a[BASE + i], a[BASE + l]); }
    }
}
template <int BA, int BB, int N>
__device__ __forceinline__ void top16_merge(unsigned (&a)[N]) {
#pragma unroll
    for (int i = 0; i < 16; ++i) a[BA + i] = max(a[BA + i], a[BB + 15 - i]);
    bitonic_merge16_desc<BA, N>(a);
}
__device__ __forceinline__ void top16_of_64(unsigned (&a)[64]) {
    bitonic_sort16_desc<0, 64>(a); bitonic_sort16_desc<16, 64>(a); bitonic_sort16_desc<32, 64>(a); bitonic_sort16_desc<48, 64>(a);
    top16_merge<0, 16, 64>(a); top16_merge<32, 48, 64>(a); top16_merge<0, 32, 64>(a);
}
__device__ __forceinline__ void peer_route(const Params& p, int task, LAS unsigned char* lds) {
    const int tid = opaque_tid(), wid = __builtin_amdgcn_readfirstlane(tid >> 6), lane = tid & 63;
    const int n0 = task * 32, head = wid;
    const int r = lane & 31, hh = lane >> 5;
    const bf16_t* QRY = (const bf16_t*)(p.ws + OFF_QRY); const bf16_t* SK = (const bf16_t*)(p.ws + OFF_SK);
    LAS unsigned* tkl = (LAS unsigned*)lds + wid * (32 * 64);
#pragma unroll 1
    for (int p2 = 0; p2 < 2; ++p2) {
        const int grp = head * 2 + p2;
        bf16x8 bq[4];
#pragma unroll
        for (int ks = 0; ks < 4; ++ks) bq[ks] = *(const bf16x8*)(QRY + (size_t)(n0 + r) * 1024 + grp * 64 + 16 * ks + 8 * hh);
        unsigned key[64];
#pragma unroll
        for (int kt = 0; kt < 4; ++kt) {
            f32x16 acc;
#pragma unroll
            for (int i = 0; i < 16; ++i) acc[i] = 0.f;
#pragma unroll
            for (int ks = 0; ks < 4; ++ks) {
                const bf16x8 a = *(const bf16x8*)(SK + (size_t)(grp * 128 + 32 * kt + r) * 64 + 16 * ks + 8 * hh);
                acc = __builtin_amdgcn_mfma_f32_32x32x16_bf16(a, bq[ks], acc, 0, 0, 0);
            }
#pragma unroll
            for (int reg = 0; reg < 16; ++reg) {
                const int idx = 32 * kt + (reg & 3) + 8 * (reg >> 2) + 4 * hh;
                key[kt * 16 + reg] = (f2sortable(acc[reg]) & ~0x7Fu) | (unsigned)(127 - idx);
            }
        }
        top16_of_64(key);
        unsigned mg[16];
#pragma unroll
        for (int i = 0; i < 16; ++i) mg[i] = max(key[i], xchg_u32<32>(key[15 - i], lane));
        bitonic_merge16_desc<0, 16>(mg);
#pragma unroll
        for (int k = 0; k < 16; ++k) tkl[(p2 * 16 + k) * 64 + lane] = mg[k];
    }
    float v1[16], v2[16];
#pragma unroll
    for (int k = 0; k < 16; ++k) { v1[k] = sortable2f(tkl[k * 64 + lane] & ~0x7Fu); v2[k] = sortable2f(tkl[(16 + k) * 64 + lane] & ~0x7Fu); }
    unsigned ck[64];
    {
        int ci = 0;
#pragma unroll
        for (int a = 0; a < 16; ++a) {
#pragma unroll
            for (int bb = 0; bb < 16 / (a + 1); ++bb) { ck[ci] = (f2sortable(v1[a] + v2[bb]) & ~0xFFu) | (unsigned)(255 - (16 * a + bb)); ++ci; }
        }
#pragma unroll
        for (int i = 50; i < 64; ++i) ck[i] = 0u;
    }
    top16_of_64(ck);
    float tv[16]; int te[16];
    float sum = 0.f;
#pragma unroll
    for (int k = 0; k < 16; ++k) {
        const int flat = 255 - (int)(ck[k] & 0xFFu);
        const int i1 = 127 - (int)(tkl[(flat >> 4) * 64 + lane] & 0x7Fu), i2 = 127 - (int)(tkl[(16 + (flat & 15)) * 64 + lane] & 0x7Fu);
        te[k] = i1 * 128 + i2;
        tv[k] = __expf(sortable2f(ck[k] & ~0xFFu) - sortable2f(ck[0] & ~0xFFu)); sum += tv[k];
    }
    const float inv = 1.f / sum;
    if (hh == 0) {
        int* EI = (int*)(p.ws + OFF_EIDX) + (size_t)(n0 + r) * 128 + head * 16;
#pragma unroll
        for (int q = 0; q < 4; ++q) { u32x4 o; o[0] = te[4 * q]; o[1] = te[4 * q + 1]; o[2] = te[4 * q + 2]; o[3] = te[4 * q + 3]; *(u32x4*)(EI + 4 * q) = o; }
    } else {
        float* GW = (float*)(p.ws + OFF_GW) + (size_t)(n0 + r) * 128 + head * 16;
#pragma unroll
        for (int q = 0; q < 4; ++q) { f32x4 o; o[0] = tv[4 * q] * inv; o[1] = tv[4 * q + 1] * inv; o[2] = tv[4 * q + 2] * inv; o[3] = tv[4 * q + 3] * inv; *(f32x4*)(GW + 4 * q) = o; }
    }
}

__device__ __forceinline__ float gelu_exact(float a) { return 0.5f * a * (1.f + erff(a * 0.70710678118654752440f)); }
__device__ __forceinline__ float gelu_as(float v) {
    const float av = fabsf(v), t = __builtin_amdgcn_rcpf(av * 0.2316418882f + 1.0f);
    float q = t * 0.5307027145f + (-0.7265760135f); q = q * t + 0.7107068705f; q = q * t + (-0.142248368f); q = q * t + 0.127414796f; q = q * t;
    const float e = __builtin_amdgcn_exp2f((v * v) * (-0.72134752044f));
    const float m = v * (q * e), rr = v - m;
    return v < 0.f ? m : rr;
}
__device__ __forceinline__ void dec16_fp8(const u32x4 w, float (&f)[16]) {
#pragma unroll
    for (int i = 0; i < 4; ++i) {
        const f32x2 lo = __builtin_amdgcn_cvt_pk_f32_fp8((int)w[i], false), hi = __builtin_amdgcn_cvt_pk_f32_fp8((int)w[i], true);
        f[4 * i] = lo[0]; f[4 * i + 1] = lo[1]; f[4 * i + 2] = hi[0]; f[4 * i + 3] = hi[1];
    }
}
__device__ __forceinline__ void sort_pairs128(int& k_lo, int& k_hi, float& g_lo, float& g_hi, int lane) {
#pragma unroll
    for (int size = 2; size <= 128; size <<= 1) {
#pragma unroll
        for (int stride = size >> 1; stride >= 1; stride >>= 1) {
            if (stride == 64) {
                const bool sw = k_hi < k_lo;
                const int ta = sw ? k_hi : k_lo, tb = sw ? k_lo : k_hi; const float ga = sw ? g_hi : g_lo, gb = sw ? g_lo : g_hi;
                k_lo = ta; k_hi = tb; g_lo = ga; g_hi = gb;
            } else {
                int p_lo, p_hi; float q_lo, q_hi;
                if (stride == 1) { p_lo = (int)xchg_u32<1>((unsigned)k_lo, lane); p_hi = (int)xchg_u32<1>((unsigned)k_hi, lane); q_lo = xchg_f32<1>(g_lo, lane); q_hi = xchg_f32<1>(g_hi, lane); }
                else if (stride == 2) { p_lo = (int)xchg_u32<2>((unsigned)k_lo, lane); p_hi = (int)xchg_u32<2>((unsigned)k_hi, lane); q_lo = xchg_f32<2>(g_lo, lane); q_hi = xchg_f32<2>(g_hi, lane); }
                else if (stride == 4) { p_lo = (int)xchg_u32<4>((unsigned)k_lo, lane); p_hi = (int)xchg_u32<4>((unsigned)k_hi, lane); q_lo = xchg_f32<4>(g_lo, lane); q_hi = xchg_f32<4>(g_hi, lane); }
                else if (stride == 8) { p_lo = (int)xchg_u32<8>((unsigned)k_lo, lane); p_hi = (int)xchg_u32<8>((unsigned)k_hi, lane); q_lo = xchg_f32<8>(g_lo, lane); q_hi = xchg_f32<8>(g_hi, lane); }
                else if (stride == 16) { p_lo = (int)xchg_u32<16>((unsigned)k_lo, lane); p_hi = (int)xchg_u32<16>((unsigned)k_hi, lane); q_lo = xchg_f32<16>(g_lo, lane); q_hi = xchg_f32<16>(g_hi, lane); }
                else { p_lo = (int)xchg_u32<32>((unsigned)k_lo, lane); p_hi = (int)xchg_u32<32>((unsigned)k_hi, lane); q_lo = xchg_f32<32>(g_lo, lane); q_hi = xchg_f32<32>(g_hi, lane); }
                const bool lower = (lane & stride) == 0;
                const bool asc_lo = (size >= 64) ? true : ((lane & size) == 0);
                const bool asc_hi = (size == 128) ? true : ((size == 64) ? false : ((lane & size) == 0));
                const bool min_lo = (lower == asc_lo), min_hi = (lower == asc_hi);
                const bool take_lo = min_lo ? (p_lo < k_lo) : (p_lo > k_lo);
                const bool take_hi = min_hi ? (p_hi < k_hi) : (p_hi > k_hi);
                k_lo = take_lo ? p_lo : k_lo; g_lo = take_lo ? q_lo : g_lo;
                k_hi = take_hi ? p_hi : k_hi; g_hi = take_hi ? q_hi : g_hi;
            }
        }
    }
}
__device__ __forceinline__ void peer_finish_row(const Params& p, const float* ada, int tok, int d0, const float (&acc)[16], bool do_store) {
    const int b = tok >> 12;
    float* orow = p.out + (size_t)tok * 1024 + d0;
    float xo[16]; float ss = 0.f;
#pragma unroll
    for (int q = 0; q < 4; ++q) {
        const f32x4 xv = *(const f32x4*)(orow + 4 * q), gv = *(const f32x4*)(ada + b * 6144 + 5120 + d0 + 4 * q);
#pragma unroll
        for (int i = 0; i < 4; ++i) { const float v = xv[i] + gv[i] * acc[q * 4 + i]; xo[q * 4 + i] = v; ss += v * v; }
    }
    ss = wave_sum(ss);
    const float rstd = rsqrtf(ss * (1.f / 1024.f) + 1e-6f);
#pragma unroll
    for (int q = 0; q < 4; ++q) {
        const f32x4 fg = *(const f32x4*)(p.final_g + d0 + 4 * q);
        f32x4 ov;
#pragma unroll
        for (int i = 0; i < 4; ++i) ov[i] = xo[q * 4 + i] * rstd * fg[i];
        if (do_store) *(f32x4*)(orow + 4 * q) = ov;
    }
}
struct PeTok { unsigned hq[4]; float ascale; int acc[16]; int csum; int k_lo, k_hi; float g_lo, g_hi; };
__device__ __forceinline__ void pe_tok_init(PeTok& t, const bf16_t* H2, const int* EI, const float* GW, int tok, int d0, int lane) {
    const u32x4 h0 = *(const u32x4*)(H2 + (size_t)tok * 1024 + d0), h1 = *(const u32x4*)(H2 + (size_t)tok * 1024 + d0 + 8);
    float hx[16];
#pragma unroll
    for (int i = 0; i < 4; ++i) { hx[2 * i] = lo16(h0[i]); hx[2 * i + 1] = hi16(h0[i]); hx[8 + 2 * i] = lo16(h1[i]); hx[8 + 2 * i + 1] = hi16(h1[i]); }
    float am = 0.f;
#pragma unroll
    for (int i = 0; i < 16; ++i) am = fmaxf(am, fabsf(hx[i]));
    am = fmaxf(wave_max_dpp(am), 1e-20f);
    const float hs = 127.f / am;
#pragma unroll
    for (int i = 0; i < 4; ++i) t.hq[i] = pack4_i8(hx[4 * i], hx[4 * i + 1], hx[4 * i + 2], hx[4 * i + 3], hs);
    t.ascale = am * (1.f / (127.f * PEER_SU));
#pragma unroll
    for (int i = 0; i < 16; ++i) t.acc[i] = 0;
    t.csum = 0;
    t.k_lo = EI[(size_t)tok * 128 + lane]; t.k_hi = EI[(size_t)tok * 128 + 64 + lane];
    t.g_lo = GW[(size_t)tok * 128 + lane]; t.g_hi = GW[(size_t)tok * 128 + 64 + lane];
    sort_pairs128(t.k_lo, t.k_hi, t.g_lo, t.g_hi, lane);
}
__device__ __forceinline__ void pe_tok_result(const PeTok& t, float (&acc)[16]) {
    const int coff = 8 * t.csum;
#pragma unroll
    for (int i = 0; i < 4; ++i)
#pragma unroll
        for (int j = 0; j < 4; ++j) acc[8 * (i >> 1) + 2 * j + (i & 1)] = (float)(t.acc[4 * i + j] - coff) * (1.f / (PEER_SC * PEER_SV));
}
typedef short s16x2 __attribute__((ext_vector_type(2)));
__device__ __forceinline__ int dot2_i16(unsigned a, int b, int c) { return __builtin_amdgcn_sdot2(__builtin_bit_cast(s16x2, a), __builtin_bit_cast(s16x2, b), c, false); }
__device__ __forceinline__ void pe_vgroup(PeTok& t, const u32x2 (&vv)[8], int base, int c0, int c1, int c2, int c3) {
    const int c01 = (c0 & 0xFFFF) | (c1 << 16), c23 = (c2 & 0xFFFF) | (c3 << 16);
    t.csum += c0 + c1 + c2 + c3;
#pragma unroll
    for (int i = 0; i < 4; ++i) {
        const unsigned w0 = (vv[base][i >> 1] >> (4 * (i & 1))) & 0x0F0F0F0Fu, w1 = (vv[base + 1][i >> 1] >> (4 * (i & 1))) & 0x0F0F0F0Fu;
        const unsigned w2_ = (vv[base + 2][i >> 1] >> (4 * (i & 1))) & 0x0F0F0F0Fu, w3 = (vv[base + 3][i >> 1] >> (4 * (i & 1))) & 0x0F0F0F0Fu;
        t.acc[4 * i + 0] = dot2_i16(__builtin_amdgcn_perm(w3, w2_, 0x0c040c00u), c23, dot2_i16(__builtin_amdgcn_perm(w1, w0, 0x0c040c00u), c01, t.acc[4 * i + 0]));
        t.acc[4 * i + 1] = dot2_i16(__builtin_amdgcn_perm(w3, w2_, 0x0c050c01u), c23, dot2_i16(__builtin_amdgcn_perm(w1, w0, 0x0c050c01u), c01, t.acc[4 * i + 1]));
        t.acc[4 * i + 2] = dot2_i16(__builtin_amdgcn_perm(w3, w2_, 0x0c060c02u), c23, dot2_i16(__builtin_amdgcn_perm(w1, w0, 0x0c060c02u), c01, t.acc[4 * i + 2]));
        t.acc[4 * i + 3] = dot2_i16(__builtin_amdgcn_perm(w3, w2_, 0x0c070c03u), c23, dot2_i16(__builtin_amdgcn_perm(w1, w0, 0x0c070c03u), c01, t.acc[4 * i + 3]));
    }
}
#ifndef PE_SYNC_MASK
#define PE_SYNC_MASK 63
#endif
__device__ __forceinline__ void peer_experts(const Params& p, bool do_store) {
    const int wid = threadIdx.x >> 6, lane = threadIdx.x & 63;
    const bf16_t* H2 = (const bf16_t*)(p.ws + OFF_ACT); const unsigned char* UT = p.ws + OFF_UT; const unsigned char* VT = p.ws + OFF_VT;
    const int* EI = (const int*)(p.ws + OFF_EIDX); const float* GW = (const float*)(p.ws + OFF_GW); const float* ada = (const float*)(p.ws + OFF_ADA);
    const int d0 = 16 * lane;
    const int stride = gridDim.x * 8;
    for (int tok0 = blockIdx.x * 8 + wid; tok0 < NTOK; tok0 += 4 * stride) {
        __syncthreads();
        int tk[4]; bool has[4];
#pragma unroll
        for (int i = 0; i < 4; ++i) { has[i] = (tok0 + i * stride) < NTOK; tk[i] = has[i] ? tok0 + i * stride : tok0; }
        PeTok T[4];
#pragma unroll
        for (int i = 0; i < 4; ++i) pe_tok_init(T[i], H2, EI, GW, tk[i], d0, lane);
        u32x4 uX[8], uY[8]; u32x2 vX[8], vY[8]; float gX[8], gY[8];
#define PE_ISSUE(UU, VV, GG, K0, A, B) do { _Pragma("unroll") for (int q = 0; q < 4; ++q) { \
            const unsigned ea_ = (unsigned)__builtin_amdgcn_readlane((K0) < 64 ? A.k_lo : A.k_hi, ((K0) + q) & 63), eb_ = (unsigned)__builtin_amdgcn_readlane((K0) < 64 ? B.k_lo : B.k_hi, ((K0) + q) & 63); \
            GG[q] = rlanef((K0) < 64 ? A.g_lo : A.g_hi, ((K0) + q) & 63); GG[4 + q] = rlanef((K0) < 64 ? B.g_lo : B.g_hi, ((K0) + q) & 63); \
            UU[q] = *(const u32x4*)(UT + (size_t)(ea_ * 1024u) + (unsigned)d0); VV[q] = *(const u32x2*)(VT + (size_t)(ea_ * 512u) + 8u * (unsigned)lane); \
            UU[4 + q] = *(const u32x4*)(UT + (size_t)(eb_ * 1024u) + (unsigned)d0); VV[4 + q] = *(const u32x2*)(VT + (size_t)(eb_ * 512u) + 8u * (unsigned)lane); } } while (0)
#define PE_COMPUTE(UU, VV, GG, A, B) do { \
            float sv[8]; \
            _Pragma("unroll") for (int q = 0; q < 8; ++q) { int d_ = 0; \
                _Pragma("unroll") for (int i = 0; i < 4; ++i) d_ = __builtin_amdgcn_sdot4((int)UU[q][i], (int)(q < 4 ? A.hq[i] : B.hq[i]), d_, false); \
                sv[q] = (float)d_ * (q < 4 ? A.ascale : B.ascale); } \
            float t4[4]; \
            _Pragma("unroll") for (int i = 0; i < 4; ++i) { const u32x2 r_ = __builtin_amdgcn_permlane32_swap(__float_as_uint(sv[i]), __float_as_uint(sv[i + 4]), false, false); t4[i] = __uint_as_float(r_[0]) + __uint_as_float(r_[1]); } \
            float w2[2]; \
            _Pragma("unroll") for (int i = 0; i < 2; ++i) { const u32x2 r_ = __builtin_amdgcn_permlane16_swap(__float_as_uint(t4[i]), __float_as_uint(t4[i + 2]), false, false); w2[i] = __uint_as_float(r_[0]) + __uint_as_float(r_[1]); } \
            _Pragma("unroll") for (int i = 0; i < 2; ++i) { w2[i] += dppf(w2[i], 0xB1); w2[i] += dppf(w2[i], 0x4E); w2[i] += dppf(w2[i], 0x141); w2[i] += dppf(w2[i], 0x140); } \
            float mine = 0.f, gmine = 0.f; \
            _Pragma("unroll") for (int q = 0; q < 8; ++q) { \
                const float tq = rlanef(w2[q & 1], 16 * (((q >> 1) & 1) + 2 * (q >> 2))); \
                mine = ((lane & 7) == q) ? tq : mine; gmine = ((lane & 7) == q) ? GG[q] : gmine; } \
            const float cmine = gmine * gelu_as(mine); \
            const int cqm = (int)fminf(fmaxf(rintf(cmine * PEER_SC), -16383.f), 16383.f);        \
            pe_vgroup(A, VV, 0, __builtin_amdgcn_readlane(cqm, 0), __builtin_amdgcn_readlane(cqm, 1), __builtin_amdgcn_readlane(cqm, 2), __builtin_amdgcn_readlane(cqm, 3)); \
            pe_vgroup(B, VV, 4, __builtin_amdgcn_readlane(cqm, 4), __builtin_amdgcn_readlane(cqm, 5), __builtin_amdgcn_readlane(cqm, 6), __builtin_amdgcn_readlane(cqm, 7)); } while (0)
        PE_ISSUE(uX, vX, gX, 0, T[0], T[1]);
#pragma unroll 1
        for (int k0 = 0; k0 < 128; k0 += 4) {
            if ((k0 & PE_SYNC_MASK) == 0 && k0) __syncthreads();
            PE_ISSUE(uY, vY, gY, k0, T[2], T[3]);
            PE_COMPUTE(uX, vX, gX, T[0], T[1]);
            if (k0 + 4 < 128) PE_ISSUE(uX, vX, gX, k0 + 4, T[0], T[1]);
            PE_COMPUTE(uY, vY, gY, T[2], T[3]);
        }
#undef PE_ISSUE
#undef PE_COMPUTE
        float acc[16];
#pragma unroll
        for (int i = 0; i < 4; ++i) { pe_tok_result(T[i], acc); peer_finish_row(p, ada, tk[i], d0, acc, do_store && has[i]); }
    }
}

enum { PH_PREP = 0, PH_GEMM_IN, PH_MIX, PH_GEMM_OUT, PH_H2, PH_GEMM_Q, PH_ROUTE, PH_EXPERT, PH_COUNT };

typedef const __attribute__((address_space(4))) Params* KParams;
__device__ __forceinline__ const Params& kparams() {
    auto q = __builtin_amdgcn_kernarg_segment_ptr();
    asm volatile("" : "+s"(q));
    return *(const Params*)q;
}
#ifndef PHMASK
#define PHMASK 0xFFFF
#endif
#ifndef REP_PHASE
#define REP_PHASE -1
#endif
#define PHASE_BEGIN(idx) if (((PHMASK >> (idx)) & 1) && ph_lo <= (idx) && (idx) < ph_hi) { for (int rep = 0; rep < ((idx) == REP_PHASE ? 2 : 1); ++rep) { if ((idx) != ph_lo || rep) xcd_barrier(bar); const Params& p = kparams(); const int G = gridDim.x; (void)G; const bool last_rep = (rep == ((idx) == REP_PHASE ? 1 : 0)); (void)last_rep;
#define PHASE_END } }

__global__ void __launch_bounds__(NTHREADS, 2) hymba_fwd(Params p_) {
    extern __shared__ __attribute__((aligned(16))) unsigned char smem_raw[];
    LAS unsigned char* lds = (LAS unsigned char*)smem_raw;
    volatile LAS unsigned* xbw = (volatile LAS unsigned*)(lds + LDS_BYTES - 16);
    if (threadIdx.x == 0) { xbw[0] = 0u; xbw[1] = 0u; xbw[2] = 0u; xbw[3] = 0u; }
    __syncthreads();
    XcdBarrier bar = xcd_barrier_post((unsigned*)(p_.ws + OFF_CTL), xbw);
    const int ph_lo = p_.ph_lo, ph_hi = p_.ph_hi;

    PHASE_BEGIN(PH_PREP)
        phase0(p, lds);
        wg_wait((unsigned*)(p.ws + OFF_CTL), CNT_ADA, 192u);
        norm_mod_rows(p.x, p.norm1_g, (const float*)(p.ws + OFF_ADA), 0, 1024, (bf16_t*)(p.ws + OFF_ACT));
    PHASE_END
    PHASE_BEGIN(PH_GEMM_IN)
        {   pg8::StaticOrder S; S.init(NTOK, 3072, G, blockIdx.x);
            EpiInMain E; E.ws = p.ws; E.bias = (const float*)(p.ws + OFF_BIAS);
            pg8::gemm_phase(lds, pg8::Gemm{(const bf16_t*)(p.ws + OFF_ACT), (const bf16_t*)(p.ws + OFF_WIN), NTOK, 3072, 1024}, S, E); }
        {   pg8::StaticOrder S; S.init(NTOK, 256, G, blockIdx.x);
            EpiInTail E; E.ws = p.ws; E.bias = (const float*)(p.ws + OFF_BIAS) + 3072;
            pg8::gemm_phase(lds, pg8::Gemm{(const bf16_t*)(p.ws + OFF_ACT), (const bf16_t*)(p.ws + OFF_WIN) + (size_t)3072 * 1024, NTOK, 256, 1024}, S, E); }
        if (G > 64) { if ((int)blockIdx.x >= 64) convert_tables(p, (int)blockIdx.x - 64, G - 64); }
        else convert_tables(p, (int)blockIdx.x, G);
    PHASE_END
    PHASE_BEGIN(PH_MIX)
        unsigned* ctl = (unsigned*)(p.ws + OFF_CTL);
        for (int t = blockIdx.x; t < 1024; t += G) mlstm_passA(p, t, lds);
        wg_signal(ctl, CNT_MLA);
        __syncthreads();
        for (int t = blockIdx.x; t < 2048; t += G) {
            const int rnd = t >> 8, w = t & 255; const int bsel = rnd >> 1; const int qgs = (rnd & 1) ? w : (511 - w);
            dsa_task(p, (bsel << 9) | qgs, lds); }
        wg_wait(ctl, CNT_MLA, (unsigned)G);
        for (int t = blockIdx.x; t < 256; t += G) mlstm_scan(p, t, lds);
        wg_signal(ctl, CNT_SCAN);
        wg_wait(ctl, CNT_SCAN, (unsigned)G);
        for (int t = blockIdx.x; t < 1024; t += G) mlstm_passB(p, t, lds);
    PHASE_END
    PHASE_BEGIN(PH_GEMM_OUT)
        {   pg8::StaticOrder S; S.init(NTOK, 1024, G, blockIdx.x);
            EpiOut E; E.x = p.x; E.ada = (const float*)(p.ws + OFF_ADA); E.out = p.out;
            pg8::gemm_phase(lds, pg8::Gemm{(const bf16_t*)(p.ws + OFF_ACT), (const bf16_t*)(p.ws + OFF_WOUT), NTOK, 1024, 1024}, S, E); }
    PHASE_END
    PHASE_BEGIN(PH_H2) norm_mod_rows(p.out, p.norm2_g, (const float*)(p.ws + OFF_ADA), 3072, 4096, (bf16_t*)(p.ws + OFF_ACT)); PHASE_END
    PHASE_BEGIN(PH_GEMM_Q)
        {   pg8::StaticOrder S; S.init(NTOK, 1024, G, blockIdx.x);
            EpiQry E; E.O = (bf16_t*)(p.ws + OFF_QRY);
            pg8::gemm_phase(lds, pg8::Gemm{(const bf16_t*)(p.ws + OFF_ACT), (const bf16_t*)(p.ws + OFF_WPQ), NTOK, 1024, 1024}, S, E); }
    PHASE_END
    PHASE_BEGIN(PH_ROUTE) for (int t = blockIdx.x; t < 512; t += G) peer_route(p, t, lds); PHASE_END
    PHASE_BEGIN(PH_EXPERT) peer_experts(p, last_rep); PHASE_END
}

extern "C" void kernel_launch(void* const* d_in, const int* in_sizes, int n_in, void* d_out, int out_size, void* d_ws, size_t ws_size, hipStream_t stream) {
    static int grid = 0;
    if (grid == 0) {
        int dev = 0, cus = 0, per_cu = 0;
        if (hipGetDevice(&dev) != hipSuccess || hipDeviceGetAttribute(&cus, hipDeviceAttributeMultiprocessorCount, dev) != hipSuccess) { fprintf(stderr, "kernel_launch: device query failed\n"); grid = -1; return; }
        if (hipFuncSetAttribute((const void*)hymba_fwd, hipFuncAttributeMaxDynamicSharedMemorySize, LDS_BYTES) != hipSuccess) { fprintf(stderr, "kernel_launch: hipFuncSetAttribute failed\n"); grid = -1; return; }
        if (hipOccupancyMaxActiveBlocksPerMultiprocessor(&per_cu, (const void*)hymba_fwd, NTHREADS, LDS_BYTES) != hipSuccess || per_cu < 1) { fprintf(stderr, "kernel_launch: occupancy query says %d blocks/CU\n", per_cu); }
        (void)hipGetLastError();
        grid = cus;
        if (ws_size < WS_END || n_in != 17) { fprintf(stderr, "kernel_launch: unexpected sizes (ws %zu, n_in %d)\n", ws_size, n_in); grid = -1; return; }
    }
    if (grid < 0) return;
    (void)hipMemsetAsync((char*)d_ws + OFF_CTL, 0, CTL_BYTES, stream);
    Params p{};
    p.x = (const float*)d_in[0]; p.c = (const float*)d_in[1]; p.w_ada = (const float*)d_in[2]; p.b_ada = (const float*)d_in[3]; p.norm1_g = (const float*)d_in[4];
    p.w_in = (const float*)d_in[5]; p.b_in = (const float*)d_in[6]; p.conv_qk = (const float*)d_in[7]; p.out_norm_m = (const float*)d_in[8]; p.out_norm_a = (const float*)d_in[9];
    p.w_out = (const float*)d_in[10]; p.norm2_g = (const float*)d_in[11]; p.w_peer_q = (const float*)d_in[12]; p.sub_keys = (const float*)d_in[13]; p.peer_u = (const float*)d_in[14];
    p.peer_v = (const float*)d_in[15]; p.final_g = (const float*)d_in[16];
    p.out = (float*)d_out; p.ws = (unsigned char*)d_ws; p.ph_lo = 0; p.ph_hi = PH_COUNT;
    void* args[] = {&p};
    hipError_t e = hipLaunchCooperativeKernel((const void*)hymba_fwd, dim3(grid), dim3(NTHREADS), args, LDS_BYTES, stream);
    if (e != hipSuccess) fprintf(stderr, "kernel_launch: cooperative launch failed: %s (grid %d)\n", hipGetErrorString(e), grid);
}
```

```cpp
#include <hip/hip_runtime.h>
#include <stdint.h>
#define REP_PHASE -1
#define DSA_REP 0
#include <cstdio>

#define LAS __attribute__((address_space(3)))
typedef unsigned short bf16_t;
typedef short bf16x8 __attribute__((ext_vector_type(8)));
typedef float f32x4 __attribute__((ext_vector_type(4)));
typedef float f32x2 __attribute__((ext_vector_type(2)));
typedef float f32x16 __attribute__((ext_vector_type(16)));
typedef unsigned u32x4 __attribute__((ext_vector_type(4)));
typedef unsigned u32x2 __attribute__((ext_vector_type(2)));

constexpr int NTOK = 16384, DM = 1024, SEQ = 4096;
constexpr int NIN_PAD = 3328;
constexpr int LDS_BYTES = 163840 - 64;
constexpr int NTHREADS = 512;

constexpr size_t MiB = 1024 * 1024;
constexpr size_t OFF_CTL = 0;
constexpr size_t CTL_BYTES = 16384;
constexpr size_t OFF_ADA = 64 * 1024;
constexpr size_t OFF_BIAS = 192 * 1024;
constexpr size_t OFF_SK = 256 * 1024;
constexpr size_t OFF_WIN = 512 * 1024;
constexpr size_t OFF_WOUT = 7 * MiB;
constexpr size_t OFF_WPQ = 9 * MiB;
constexpr size_t OFF_ACT = 11 * MiB;
constexpr size_t OFF_MQ = 43 * MiB;
constexpr size_t OFF_MK = 59 * MiB;
constexpr size_t OFF_MV = 75 * MiB;
constexpr size_t OFF_MO = 91 * MiB;
constexpr size_t OFF_AQ = 107 * MiB;
constexpr size_t OFF_IQ = 123 * MiB;
constexpr size_t OFF_AK = 139 * MiB;
constexpr size_t OFF_AV = 141 * MiB;
constexpr size_t OFF_IK = 143 * MiB;
constexpr size_t OFF_GATE = 145 * MiB;
constexpr size_t OFF_KV = 146 * MiB;
constexpr size_t OFF_KS = 178 * MiB;
constexpr size_t OFF_MLOC = 178 * MiB + 512 * 1024;
constexpr size_t OFF_BLAST = OFF_MLOC + 4096;
constexpr size_t OFF_M0 = OFF_BLAST + 4096;
constexpr size_t OFF_UT = 179 * MiB;
constexpr size_t OFF_VT = 195 * MiB;
constexpr size_t WS_END = 211 * MiB;
constexpr float PEER_SU = 812.8f;
constexpr float PEER_SV = 8.443f;
constexpr float PEER_SC = 2048.f;
constexpr size_t OFF_QRY = OFF_MQ;
constexpr size_t OFF_EIDX = OFF_MV;
constexpr size_t OFF_GW = OFF_MV + 8 * MiB;

struct Params {
    const float* x; const float* c; const float* w_ada; const float* b_ada; const float* norm1_g;
    const float* w_in; const float* b_in; const float* conv_qk; const float* out_norm_m; const float* out_norm_a;
    const float* w_out; const float* norm2_g; const float* w_peer_q; const float* sub_keys; const float* peer_u;
    const float* peer_v; const float* final_g;
    float* out; unsigned char* ws;
    int ph_lo, ph_hi;
};

__device__ __forceinline__ int opaque_tid() { int t = threadIdx.x; asm volatile("" : "+v"(t)); return t; }
__device__ __forceinline__ float bf2f(unsigned short b) { return __uint_as_float(((unsigned)b) << 16); }
__device__ __forceinline__ unsigned pack2(float lo, float hi) { unsigned r; asm("v_cvt_pk_bf16_f32 %0, %1, %2" : "=v"(r) : "v"(lo), "v"(hi)); return r; }
__device__ __forceinline__ unsigned short f2bf(float f) { return (unsigned short)(pack2(f, 0.f) & 0xffffu); }
__device__ __forceinline__ unsigned short f2bf_sw(float f) { unsigned u = __float_as_uint(f); u += 0x7FFFu + ((u >> 16) & 1u); return (unsigned short)(u >> 16); }
__device__ __forceinline__ float lo16(unsigned w) { return __uint_as_float(w << 16); }
__device__ __forceinline__ float hi16(unsigned w) { return __uint_as_float(w & 0xffff0000u); }
__device__ __forceinline__ float wave_sum_dpp(float v);
__device__ __forceinline__ float wave_sum(float v) { return wave_sum_dpp(v); }
__device__ __forceinline__ int wave_sum_i32_uniform(int v) {
    v += __builtin_amdgcn_update_dpp(0, v, 0xB1, 0xF, 0xF, true);
    v += __builtin_amdgcn_update_dpp(0, v, 0x4E, 0xF, 0xF, true);
    v += __builtin_amdgcn_update_dpp(0, v, 0x141, 0xF, 0xF, true);
    v += __builtin_amdgcn_update_dpp(0, v, 0x140, 0xF, 0xF, true);
    return __builtin_amdgcn_readlane(v, 0) + __builtin_amdgcn_readlane(v, 16) + __builtin_amdgcn_readlane(v, 32) + __builtin_amdgcn_readlane(v, 48);
}
__device__ __forceinline__ float wave_scan_add(float v, int lane) {
#pragma unroll
    for (int o = 1; o < 64; o <<= 1) { const float t = __shfl_up(v, o); if (lane >= o) v += t; }
    return v;
}
__device__ __forceinline__ float wave_scan_max(float v, int lane) {
#pragma unroll
    for (int o = 1; o < 64; o <<= 1) { const float t = __shfl_up(v, o); if (lane >= o) v = fmaxf(v, t); }
    return v;
}
__device__ __forceinline__ float wave_max(float v) {
#pragma unroll
    for (int o = 32; o >= 1; o >>= 1) v = fmaxf(v, __shfl_xor(v, o));
    return v;
}
#define dppf(v, ctrl) __uint_as_float((unsigned)__builtin_amdgcn_update_dpp(0, (int)__float_as_uint(v), (ctrl), 0xF, 0xF, true))
__device__ __forceinline__ float rlanef(float v, int l) { return __uint_as_float((unsigned)__builtin_amdgcn_readlane((int)__float_as_uint(v), l)); }
__device__ __forceinline__ float wave_sum_dpp(float v) {
    v += dppf(v, 0xB1); v += dppf(v, 0x4E); v += dppf(v, 0x141); v += dppf(v, 0x140);
    return (rlanef(v, 0) + rlanef(v, 16)) + (rlanef(v, 32) + rlanef(v, 48));
}
__device__ __forceinline__ float wave_max_dpp(float v) {
    v = fmaxf(v, dppf(v, 0xB1)); v = fmaxf(v, dppf(v, 0x4E)); v = fmaxf(v, dppf(v, 0x141)); v = fmaxf(v, dppf(v, 0x140));
    return fmaxf(fmaxf(rlanef(v, 0), rlanef(v, 16)), fmaxf(rlanef(v, 32), rlanef(v, 48)));
}
template <int STRIDE>
__device__ __forceinline__ unsigned xchg_u32(unsigned x, int lane) {
    if constexpr (STRIDE == 1) return (unsigned)__builtin_amdgcn_update_dpp(0, (int)x, 0xB1, 0xF, 0xF, true);
    else if constexpr (STRIDE == 2) return (unsigned)__builtin_amdgcn_update_dpp(0, (int)x, 0x4E, 0xF, 0xF, true);
    else if constexpr (STRIDE == 4) {
        const unsigned up = (unsigned)__builtin_amdgcn_update_dpp(0, (int)x, 0x104, 0xF, 0xF, true);
        const unsigned dn = (unsigned)__builtin_amdgcn_update_dpp(0, (int)x, 0x114, 0xF, 0xF, true);
        return (lane & 4) ? dn : up;
    }
    else if constexpr (STRIDE == 8) return (unsigned)__builtin_amdgcn_update_dpp(0, (int)x, 0x128, 0xF, 0xF, true);
    else if constexpr (STRIDE == 16) { const u32x2 r_ = __builtin_amdgcn_permlane16_swap(x, x, false, false); return (lane & 16) ? r_[0] : r_[1]; }
    else { const u32x2 r_ = __builtin_amdgcn_permlane32_swap(x, x, false, false); return (lane & 32) ? r_[0] : r_[1]; }
}
template <int STRIDE> __device__ __forceinline__ float xchg_f32(float x, int lane) { return __uint_as_float(xchg_u32<STRIDE>(__float_as_uint(x), lane)); }
__device__ __forceinline__ float row16_sum(float v) { v += dppf(v, 0xB1); v += dppf(v, 0x4E); v += dppf(v, 0x141); v += dppf(v, 0x140); return v; }
__device__ __forceinline__ float oct_sum(float v) { v += dppf(v, 0xB1); v += dppf(v, 0x4E); v += dppf(v, 0x141); return v; }
__device__ __forceinline__ float siluf(float x) { return x * __builtin_amdgcn_rcpf(1.f + __expf(-x)); }
__device__ __forceinline__ float sigmoidf_(float x) { return __builtin_amdgcn_rcpf(1.f + __expf(-x)); }
__device__ __forceinline__ float logsigmoidf_(float x) { return fminf(x, 0.f) - log1pf(__expf(-fabsf(x))); }

#define XB_TMO      128
#define XB_XCNT(j)  (256  + 64 * (j))
#define XB_XSUB(j)  (1280 + 64 * (j))
#define XB_XGEN(j)  (2304 + 64 * (j))
#define XB_TOP      3328
#define XB_TOPGEN   3392
#define XCD_BAR_WORDS 3456
#define XB_SPIN_CAP (1u << 22)
__device__ __forceinline__ unsigned xb_ld(unsigned* p)              { return __hip_atomic_load(p, __ATOMIC_RELAXED, __HIP_MEMORY_SCOPE_AGENT); }
__device__ __forceinline__ unsigned xb_add(unsigned* p, unsigned v) { return __hip_atomic_fetch_add(p, v, __ATOMIC_RELAXED, __HIP_MEMORY_SCOPE_AGENT); }
__device__ __forceinline__ unsigned xb_xcc_id() { return (unsigned)__builtin_amdgcn_s_getreg((3 << 11) | 20) & 0xFu; }
#define XB_SPIN(cond, bar) do { unsigned _sp = 0; while (cond) { __builtin_amdgcn_s_sleep(1); \
    if ((++_sp & 255u) == 0u) { if (xb_ld(&(bar)[XB_TMO])) break; if (_sp > XB_SPIN_CAP) { atomicAdd(&(bar)[XB_TMO], 1u); break; } } } } while (0)
struct XcdBarrier { unsigned* bar; unsigned x; volatile LAS unsigned* st; };
__device__ __forceinline__ XcdBarrier xcd_barrier_post(unsigned* bar, volatile LAS unsigned* st) {
    XcdBarrier b; b.bar = bar; b.x = xb_xcc_id(); b.st = st;
    if (threadIdx.x == 0) (void)xb_add(&bar[XB_XCNT(b.x)], 1u);
    return b;
}
__device__ __forceinline__ void xcd_barrier_complete(unsigned* bar, unsigned x, unsigned& nloc, unsigned& nx) {
    const unsigned G = gridDim.x * gridDim.y * gridDim.z;
    unsigned sum, cnt, mine, sp = 0u;
    for (;;) {
        sum = 0u; cnt = 0u; mine = 0u;
#pragma unroll
        for (unsigned j = 0; j < 16; ++j) { const unsigned c = xb_ld(&bar[XB_XCNT(j)]); sum += c; cnt += (c > 0u) ? 1u : 0u; mine = (j == x) ? c : mine; }
        if (sum == G) break;
        __builtin_amdgcn_s_sleep(1);
        if ((++sp & 255u) == 0u) { if (xb_ld(&bar[XB_TMO])) break; if (sp > XB_SPIN_CAP) { atomicAdd(&bar[XB_TMO], 1u); break; } }
    }
    nloc = mine > 0u ? mine : 1u; nx = cnt > 0u ? cnt : 1u;
}
__device__ __forceinline__ void xcd_barrier(const XcdBarrier& b) {
    asm volatile("s_waitcnt vmcnt(0)" ::: "memory");
    __syncthreads();
    if (threadIdx.x == 0) {
        unsigned* bar = b.bar;
        __builtin_amdgcn_s_waitcnt(0);
        unsigned nloc = b.st[0], nx = b.st[1];
        if (nloc == 0u) { xcd_barrier_complete(bar, b.x, nloc, nx); b.st[0] = nloc; b.st[1] = nx; }
        const unsigned old = xb_add(&bar[XB_XSUB(b.x)], 1u);
        const unsigned gen = old / nloc;
        if (old + 1u == (gen + 1u) * nloc) {
            __builtin_amdgcn_fence(__ATOMIC_RELEASE, "agent");
            asm volatile("s_waitcnt vmcnt(0)" ::: "memory");
            const unsigned og = xb_add(&bar[XB_TOP], 1u);
            const unsigned tg = og / nx;
            if (og + 1u == (tg + 1u) * nx) xb_add(&bar[XB_TOPGEN], 1u);
            else XB_SPIN(xb_ld(&bar[XB_TOPGEN]) == tg, bar);
            __builtin_amdgcn_fence(__ATOMIC_ACQUIRE, "agent");
            xb_add(&bar[XB_XGEN(b.x)], 1u);
            asm volatile("s_waitcnt vmcnt(0)" ::: "memory");
        } else {
            XB_SPIN(xb_ld(&bar[XB_XGEN(b.x)]) == gen, bar);
            __builtin_amdgcn_fence(__ATOMIC_ACQUIRE, "agent");
            asm volatile("s_waitcnt vmcnt(0)" ::: "memory");
        }
    }
    __syncthreads();
}

#define CNT_ADA  3600
#define CNT_MLA  3664
#define CNT_SCAN 3728
__device__ __forceinline__ void wg_signal(unsigned* ctl, int word) {
    asm volatile("s_waitcnt vmcnt(0)" ::: "memory");
    __syncthreads();
    if (threadIdx.x == 0) {
        __builtin_amdgcn_fence(__ATOMIC_RELEASE, "agent");
        asm volatile("s_waitcnt vmcnt(0)" ::: "memory");
        (void)xb_add(&ctl[word], 1u);
    }
}
__device__ __forceinline__ void wg_wait(unsigned* ctl, int word, unsigned need) {
    if (threadIdx.x == 0) {
        XB_SPIN(xb_ld(&ctl[word]) < need, ctl);
        __builtin_amdgcn_fence(__ATOMIC_ACQUIRE, "agent");
        asm volatile("s_waitcnt vmcnt(0)" ::: "memory");
    }
    __syncthreads();
}

namespace pg8 {
constexpr int BM = 256, BK = 64, HALF = 128, HTB = HALF * BK * 2, STAGE_BYTES = 8 * HTB, NXCD = 8, WGM = 8;
__host__ __device__ __forceinline__ int lds_byte(int r, int c) { const int st = (r >> 4) * 2 + (c >> 5), rr = r & 15, cc = c & 31, ob = rr * 64 + cc * 2; return st * 1024 + (ob ^ (((ob >> 9) & 1) << 5)); }
__host__ __device__ __forceinline__ void stage_rc(int b, int& R, int& C) { const int st = b / 1024, sb = b % 1024, swz = sb ^ (((sb >> 9) & 1) << 5); R = (st >> 1) * 16 + swz / 64; C = (st & 1) * 32 + (swz % 64) / 2; }
__host__ __device__ __forceinline__ int perm32(int rho) { const int n = rho >> 4, i = rho & 15; return 8 * (i >> 2) + 4 * n + (i & 3); }
struct Unit { int pm, pn; };
struct Gemm { const bf16_t* A; const bf16_t* Bt; int M, N, K; };
struct StaticOrder {
    int nM, nN, nwg, G, c;
    __host__ __device__ void init(int M, int N, int G_, int c_) { nM = M / BM; nN = N / BM; nwg = nM * nN; G = G_; c = c_; }
    __host__ __device__ bool next(int i, Unit& u) const {
        const long L = (long)i * G + c; if (L >= nwg) return false;
        int wgid = (int)L; { const int q = nwg / NXCD, r = nwg % NXCD, xcd = wgid % NXCD, off = wgid / NXCD; wgid = (xcd < r ? xcd * (q + 1) : r * (q + 1) + (xcd - r) * q) + off; }
        const int nig = WGM * nN, gid = wgid / nig, fm = gid * WGM, gsz = (nM - fm) < WGM ? (nM - fm) : WGM;
        u.pm = fm + ((wgid % nig) % gsz); u.pn = (wgid % nig) / gsz; return true;
    }
    __device__ __forceinline__ void a_ready(const Unit&) const {}
    __device__ __forceinline__ void done(const Unit&) const {}
};
__device__ __forceinline__ unsigned cvt_pk_bf16(float lo, float hi) { unsigned r; asm volatile("v_cvt_pk_bf16_f32 %0, %1, %2" : "=v"(r) : "v"(lo), "v"(hi)); return r; }

template <class Epi, class Sched>
__device__ __forceinline__ void gemm_phase(LAS unsigned char* lds, const Gemm g, const Sched& S, const Epi& E) {
    const int tid = threadIdx.x, wid = __builtin_amdgcn_readfirstlane(tid >> 6), lane = tid & 63, wr = wid >> 2, wc = wid & 3, fr = lane & 15, fq = lane >> 4;
    const int K = g.K, nt = K / BK;
    unsigned voffA[2], voffB[2];
#pragma unroll
    for (int i = 0; i < 2; ++i) { int R, C; stage_rc(tid * 16 + i * 8192, R, C); const int Rb = Epi::PERM ? ((R & ~31) + perm32(R & 31)) : R;
        voffA[i] = (unsigned)(R * K + C) * 2u; voffB[i] = (unsigned)(Rb * K + C) * 2u; }
    const size_t kstep = (size_t)(BK * 2);
    const size_t hstep = (size_t)HALF * K * 2;
    const size_t tstep = 2 * hstep;
    const unsigned ldsw = (unsigned)wid * 1024u;
    const int aoff = lds_byte(wr * 64 + fr, fq * 8), boff = lds_byte(wc * 32 + fr, fq * 8);
#define PG8_SA(b, h) (((b) * 2 + (h)) * HTB)
#define PG8_SB(b, h) ((4 + (b) * 2 + (h)) * HTB)
#define PG8_STAGE(bufoff, gbase, voff) do { _Pragma("unroll") for (int _i = 0; _i < 2; ++_i) \
        __builtin_amdgcn_global_load_lds((const unsigned*)((const char*)(gbase) + (voff)[_i]), (LAS unsigned*)(lds + (bufoff) + ldsw + _i * 8192), 16, 0, 0); } while (0)
#define PG8_LDA(dst, b, h) do { _Pragma("unroll") for (int m = 0; m < 4; ++m) _Pragma("unroll") for (int k = 0; k < 2; ++k) dst[m][k] = *(const LAS bf16x8*)(lds + PG8_SA(b, h) + aoff + m * 2048 + k * 1024); } while (0)
#define PG8_LDB(dst, b, h) do { _Pragma("unroll") for (int n = 0; n < 2; ++n) _Pragma("unroll") for (int k = 0; k < 2; ++k) dst[n][k] = *(const LAS bf16x8*)(lds + PG8_SB(b, h) + boff + n * 2048 + k * 1024); } while (0)
#define PG8_MMA(ai, bj, At, Bt) do { __builtin_amdgcn_s_setprio(1); _Pragma("unroll") for (int m = 0; m < 4; ++m) _Pragma("unroll") for (int n = 0; n < 2; ++n) _Pragma("unroll") for (int k = 0; k < 2; ++k) \
        acc[ai][bj][m][n] = __builtin_amdgcn_mfma_f32_16x16x32_bf16(Bt[n][k], At[m][k], acc[ai][bj][m][n], 0, 0, 0); __builtin_amdgcn_s_setprio(0); } while (0)
#define PG8_WAIT_V(n) asm volatile("s_waitcnt vmcnt(" #n ")" ::: "memory")
#define PG8_WAIT_L(n) asm volatile("s_waitcnt lgkmcnt(" #n ")" ::: "memory")
#define PG8_BAR __builtin_amdgcn_s_barrier()
#define PG8_SCHED __builtin_amdgcn_sched_barrier(0)
    Unit cur, nxt; int ui = 0;
    if (!S.next(0, cur)) return;
    f32x4 acc[2][2][4][2];
#pragma unroll
    for (int a = 0; a < 2; ++a)
#pragma unroll
        for (int b = 0; b < 2; ++b)
#pragma unroll
            for (int m = 0; m < 4; ++m)
#pragma unroll
                for (int n = 0; n < 2; ++n) acc[a][b][m][n] = (f32x4){0.f, 0.f, 0.f, 0.f};
    bf16x8 At[4][2], B0[2][2], B1[2][2];
    const char* cA = (const char*)g.A + (size_t)cur.pm * tstep; const char* cB = (const char*)g.Bt + (size_t)cur.pn * tstep;
    S.a_ready(cur);
    PG8_STAGE(PG8_SB(0, 0), cB, voffB); PG8_STAGE(PG8_SA(0, 0), cA, voffA); PG8_STAGE(PG8_SB(0, 1), cB + hstep, voffB); PG8_STAGE(PG8_SA(0, 1), cA + hstep, voffA);
    if (wr == 1) PG8_BAR;
    PG8_WAIT_V(4); PG8_BAR;
    PG8_STAGE(PG8_SB(1, 0), cB + kstep, voffB); PG8_STAGE(PG8_SA(1, 0), cA + kstep, voffA); PG8_STAGE(PG8_SB(1, 1), cB + hstep + kstep, voffB);
    PG8_WAIT_V(6); PG8_BAR;
    for (;;) {
        const bool has_next = S.next(ui + 1, nxt);
        const char* nA = has_next ? (const char*)g.A + (size_t)nxt.pm * tstep : cA; const char* nB = has_next ? (const char*)g.Bt + (size_t)nxt.pn * tstep : cB;
        for (int t = 0; t < nt; t += 2) {
            const bool last = (t == nt - 2);
            const char* a1 = cA + (size_t)(t + 1) * kstep;
            const char* a2 = last ? nA : cA + (size_t)(t + 2) * kstep; const char* b2 = last ? nB : cB + (size_t)(t + 2) * kstep;
            const char* a3 = a2 + kstep; const char* b3 = b2 + kstep;
            if (last && has_next) S.a_ready(nxt);
            PG8_LDB(B0, 0, 0); PG8_SCHED; PG8_LDA(At, 0, 0); PG8_STAGE(PG8_SA(1, 1), a1 + hstep, voffA);
            PG8_WAIT_L(8); PG8_BAR; PG8_WAIT_L(0); PG8_MMA(0, 0, At, B0); PG8_BAR; PG8_SCHED;
            PG8_LDB(B1, 0, 1); PG8_STAGE(PG8_SB(0, 0), b2, voffB);
            PG8_BAR; PG8_WAIT_L(0); PG8_MMA(0, 1, At, B1); PG8_BAR;
            PG8_LDA(At, 0, 1); PG8_STAGE(PG8_SA(0, 0), a2, voffA);
            PG8_BAR; PG8_WAIT_L(0); PG8_MMA(1, 0, At, B0); PG8_BAR; PG8_SCHED;
            PG8_STAGE(PG8_SB(0, 1), b2 + hstep, voffB);
            PG8_WAIT_V(6); PG8_BAR; PG8_MMA(1, 1, At, B1); PG8_BAR;
            PG8_LDB(B0, 1, 0); PG8_SCHED; PG8_LDA(At, 1, 0); PG8_STAGE(PG8_SA(0, 1), a2 + hstep, voffA);
            PG8_WAIT_L(8); PG8_BAR; PG8_WAIT_L(0); PG8_MMA(0, 0, At, B0); PG8_BAR; PG8_SCHED;
            PG8_LDB(B1, 1, 1); PG8_STAGE(PG8_SB(1, 0), b3, voffB);
            PG8_BAR; PG8_WAIT_L(0); PG8_MMA(0, 1, At, B1); PG8_BAR;
            PG8_LDA(At, 1, 1); PG8_STAGE(PG8_SA(1, 0), a3, voffA);
            PG8_BAR; PG8_WAIT_L(0); PG8_MMA(1, 0, At, B0); PG8_BAR; PG8_SCHED;
            PG8_STAGE(PG8_SB(1, 1), b3 + hstep, voffB);
            PG8_WAIT_V(6); PG8_BAR; PG8_MMA(1, 1, At, B1); PG8_BAR;
        }
        asm volatile("s_nop 15\n\ts_nop 15" ::: "memory");
        E(acc, cur, wr, wc, fr, fq); S.done(cur);
        if (!has_next) break;
#pragma unroll
        for (int a = 0; a < 2; ++a)
#pragma unroll
            for (int b = 0; b < 2; ++b)
#pragma unroll
                for (int m = 0; m < 4; ++m)
#pragma unroll
                    for (int n = 0; n < 2; ++n) acc[a][b][m][n] = (f32x4){0.f, 0.f, 0.f, 0.f};
        cur = nxt; cA = nA; cB = nB; ++ui;
    }
    PG8_WAIT_V(0);
    if (wr == 0) PG8_BAR;
    PG8_BAR;
#undef PG8_SA
#undef PG8_SB
#undef PG8_STAGE
#undef PG8_LDA
#undef PG8_LDB
#undef PG8_MMA
#undef PG8_WAIT_V
#undef PG8_WAIT_L
#undef PG8_BAR
#undef PG8_SCHED
}
}

struct EpiInMain {
    static constexpr bool PERM = true;
    unsigned char* ws; const float* bias;
    __device__ __forceinline__ void operator()(const f32x4 (&acc)[2][2][4][2], const pg8::Unit& u, int wr, int wc, int fr, int fq) const {
        const int row0 = u.pm * 256 + wr * 64 + fr;
        const int cl0 = wc * 32 + 8 * fq;
        bf16_t* base = (bf16_t*)(ws + OFF_MQ + (size_t)(u.pn >> 1) * (16 * MiB)) + (u.pn & 1) * 256 + cl0;
        const float* bp = bias + u.pn * 256 + cl0;
#pragma unroll
        for (int bj = 0; bj < 2; ++bj) {
            const f32x4 b0 = *(const f32x4*)(bp + bj * 128), b1 = *(const f32x4*)(bp + bj * 128 + 4);
#pragma unroll
            for (int ai = 0; ai < 2; ++ai)
#pragma unroll
                for (int m = 0; m < 4; ++m) {
                    const f32x4 v0 = acc[ai][bj][m][0] + b0, v1 = acc[ai][bj][m][1] + b1;
                    u32x4 o; o[0] = pg8::cvt_pk_bf16(v0[0], v0[1]); o[1] = pg8::cvt_pk_bf16(v0[2], v0[3]); o[2] = pg8::cvt_pk_bf16(v1[0], v1[1]); o[3] = pg8::cvt_pk_bf16(v1[2], v1[3]);
                    *(u32x4*)(base + (size_t)(row0 + ai * 128 + m * 16) * 512 + bj * 128) = o;
                }
        }
    }
};
struct EpiInTail {
    static constexpr bool PERM = true;
    unsigned char* ws; const float* bias;
    __device__ __forceinline__ void operator()(const f32x4 (&acc)[2][2][4][2], const pg8::Unit& u, int wr, int wc, int fr, int fq) const {
        const int row0 = u.pm * 256 + wr * 64 + fr;
        const int cl0 = wc * 32 + 8 * fq;
#pragma unroll
        for (int bj = 0; bj < 2; ++bj) {
            const int cl = bj * 128 + cl0;
            if (cl >= 208) continue;
            const f32x4 b0 = *(const f32x4*)(bias + cl), b1 = *(const f32x4*)(bias + cl + 4);
            if (cl < 192) {
                bf16_t* dst = (bf16_t*)(ws + OFF_AK + (size_t)(cl >> 6) * (2 * MiB)) + (cl & 63);
#pragma unroll
                for (int ai = 0; ai < 2; ++ai)
#pragma unroll
                    for (int m = 0; m < 4; ++m) {
                        const f32x4 v0 = acc[ai][bj][m][0] + b0, v1 = acc[ai][bj][m][1] + b1;
                        u32x4 o; o[0] = pg8::cvt_pk_bf16(v0[0], v0[1]); o[1] = pg8::cvt_pk_bf16(v0[2], v0[3]); o[2] = pg8::cvt_pk_bf16(v1[0], v1[1]); o[3] = pg8::cvt_pk_bf16(v1[2], v1[3]);
                        *(u32x4*)(dst + (size_t)(row0 + ai * 128 + m * 16) * 64) = o;
                    }
            } else {
                float* dst = (float*)(ws + OFF_GATE) + (cl - 192);
#pragma unroll
                for (int ai = 0; ai < 2; ++ai)
#pragma unroll
                    for (int m = 0; m < 4; ++m) {
                        float* d = dst + (size_t)(row0 + ai * 128 + m * 16) * 16;
                        *(f32x4*)d = acc[ai][bj][m][0] + b0; *(f32x4*)(d + 4) = acc[ai][bj][m][1] + b1;
                    }
            }
        }
    }
};
struct EpiOut {
    static constexpr bool PERM = false;
    const float* x; const float* ada; float* out;
    __device__ __forceinline__ void operator()(const f32x4 (&acc)[2][2][4][2], const pg8::Unit& u, int wr, int wc, int fr, int fq) const {
        const int row0 = u.pm * 256 + wr * 64 + fr, col0 = u.pn * 256 + wc * 32 + 4 * fq;
        const int b = (u.pm * 256) >> 12;
        f32x4 gv[2][2];
#pragma unroll
        for (int bj = 0; bj < 2; ++bj)
#pragma unroll
            for (int n = 0; n < 2; ++n) gv[bj][n] = *(const f32x4*)(ada + b * 6144 + 2048 + col0 + bj * 128 + n * 16);
#pragma unroll
        for (int ai = 0; ai < 2; ++ai)
#pragma unroll
            for (int m = 0; m < 4; ++m) {
                const size_t ro = (size_t)(row0 + ai * 128 + m * 16) * 1024 + col0;
#pragma unroll
                for (int bj = 0; bj < 2; ++bj)
#pragma unroll
                    for (int n = 0; n < 2; ++n) {
                        const f32x4 xv = *(const f32x4*)(x + ro + bj * 128 + n * 16);
                        *(f32x4*)(out + ro + bj * 128 + n * 16) = xv + gv[bj][n] * acc[ai][bj][m][n];
                    }
            }
    }
};
struct EpiQry {
    static constexpr bool PERM = true;
    bf16_t* O;
    __device__ __forceinline__ void operator()(const f32x4 (&acc)[2][2][4][2], const pg8::Unit& u, int wr, int wc, int fr, int fq) const {
        const int row0 = u.pm * 256 + wr * 64 + fr, col0 = u.pn * 256 + wc * 32 + 8 * fq;
#pragma unroll
        for (int ai = 0; ai < 2; ++ai)
#pragma unroll
            for (int m = 0; m < 4; ++m) {
                bf16_t* rowp = O + (size_t)(row0 + ai * 128 + m * 16) * 1024 + col0;
#pragma unroll
                for (int bj = 0; bj < 2; ++bj) {
                    const f32x4 v0 = acc[ai][bj][m][0], v1 = acc[ai][bj][m][1];
                    u32x4 o; o[0] = pg8::cvt_pk_bf16(v0[0], v0[1]); o[1] = pg8::cvt_pk_bf16(v0[2], v0[3]); o[2] = pg8::cvt_pk_bf16(v1[0], v1[1]); o[3] = pg8::cvt_pk_bf16(v1[2], v1[3]);
                    *(u32x4*)(rowp + bj * 128) = o;
                }
            }
    }
};

__device__ __forceinline__ int inperm_src(int n) {
    if (n < 2048) return n;
    if (n < 2560) return 2056 + (n - 2048);
    if (n < 3072) return 2696 + (n - 2560);
    if (n < 3136) return 2568 + (n - 3072);
    if (n < 3200) return 2632 + (n - 3136);
    if (n < 3264) return 3208 + (n - 3200);
    if (n < 3268) return 2048 + (n - 3264);
    if (n < 3272) return 2052 + (n - 3268);
    if (n < 3280) return 3272 + (n - 3272);
    return -1;
}
template <bool PERMUTE>
__device__ __forceinline__ void transpose_tile(const float* src, int ld, bf16_t* dst, int n0, int k0, LAS float* t) {
    const int tid = threadIdx.x;
    for (int i = tid; i < 4096; i += NTHREADS) {
        const int kk = i >> 6, nn = i & 63;
        const int sc = PERMUTE ? inperm_src(n0 + nn) : (n0 + nn);
        t[kk * 65 + nn] = sc >= 0 ? src[(size_t)(k0 + kk) * ld + sc] : 0.f;
    }
    __syncthreads();
    for (int i = tid; i < 2048; i += NTHREADS) {
        const int nn = i >> 5, kp = (i & 31) * 2;
        ((unsigned*)dst)[((size_t)(n0 + nn) * 1024 + k0 + kp) >> 1] = pack2(t[kp * 65 + nn], t[(kp + 1) * 65 + nn]);
    }
    __syncthreads();
}
__device__ __forceinline__ void convert_chunk(const float* src, bf16_t* dst, size_t e0, int n) {
    for (int i = threadIdx.x * 8; i < n; i += NTHREADS * 8) {
        const f32x4 a = *(const f32x4*)(src + e0 + i), b = *(const f32x4*)(src + e0 + i + 4);
        u32x4 o; o[0] = pack2(a[0], a[1]); o[1] = pack2(a[2], a[3]); o[2] = pack2(b[0], b[1]); o[3] = pack2(b[2], b[3]);
        *(u32x4*)(dst + e0 + i) = o;
    }
}
__device__ __forceinline__ unsigned pack4_fp8(float a, float b, float c, float d) {
    a = fminf(fmaxf(a, -448.f), 448.f); b = fminf(fmaxf(b, -448.f), 448.f); c = fminf(fmaxf(c, -448.f), 448.f); d = fminf(fmaxf(d, -448.f), 448.f);
    int w = 0;
    w = __builtin_amdgcn_cvt_pk_fp8_f32(a, b, w, false);
    w = __builtin_amdgcn_cvt_pk_fp8_f32(c, d, w, true);
    return (unsigned)w;
}
__device__ __forceinline__ void convert_chunk_fp8(const float* src, unsigned char* dst, size_t e0, int n, float scale) {
    for (int i = threadIdx.x * 16; i < n; i += NTHREADS * 16) {
        const f32x4 a = *(const f32x4*)(src + e0 + i), b = *(const f32x4*)(src + e0 + i + 4), c = *(const f32x4*)(src + e0 + i + 8), d = *(const f32x4*)(src + e0 + i + 12);
        u32x4 o; o[0] = pack4_fp8(a[0] * scale, a[1] * scale, a[2] * scale, a[3] * scale); o[1] = pack4_fp8(b[0] * scale, b[1] * scale, b[2] * scale, b[3] * scale);
        o[2] = pack4_fp8(c[0] * scale, c[1] * scale, c[2] * scale, c[3] * scale); o[3] = pack4_fp8(d[0] * scale, d[1] * scale, d[2] * scale, d[3] * scale);
        *(u32x4*)(dst + e0 + i) = o;
    }
}
__device__ __forceinline__ unsigned pack8_fp4(const f32x4 a, const f32x4 b, float scale) {
    float v[8] = {a[0] * scale, a[1] * scale, a[2] * scale, a[3] * scale, b[0] * scale, b[1] * scale, b[2] * scale, b[3] * scale};
#pragma unroll
    for (int i = 0; i < 8; ++i) v[i] = fminf(fmaxf(v[i], -6.f), 6.f);
    unsigned w = 0;
    w = __builtin_amdgcn_cvt_scalef32_pk_fp4_f32(w, v[0], v[1], 1.0f, 0);
    w = __builtin_amdgcn_cvt_scalef32_pk_fp4_f32(w, v[2], v[3], 1.0f, 1);
    w = __builtin_amdgcn_cvt_scalef32_pk_fp4_f32(w, v[4], v[5], 1.0f, 2);
    w = __builtin_amdgcn_cvt_scalef32_pk_fp4_f32(w, v[6], v[7], 1.0f, 3);
    return w;
}
__device__ __forceinline__ void convert_chunk_fp4(const float* src, unsigned char* dst, size_t e0, int n, float scale) {
    for (int i = threadIdx.x * 32; i < n; i += NTHREADS * 32) {
        u32x4 o;
#pragma unroll
        for (int k = 0; k < 4; ++k) o[k] = pack8_fp4(*(const f32x4*)(src + e0 + i + 8 * k), *(const f32x4*)(src + e0 + i + 8 * k + 4), scale);
        *(u32x4*)(dst + ((e0 + i) >> 1)) = o;
    }
}
__device__ __forceinline__ unsigned pack4_i8(float a, float b, float c, float d, float scale) {
    const int ia = (int)fminf(fmaxf(rintf(a * scale), -127.f), 127.f), ib = (int)fminf(fmaxf(rintf(b * scale), -127.f), 127.f);
    const int ic = (int)fminf(fmaxf(rintf(c * scale), -127.f), 127.f), id = (int)fminf(fmaxf(rintf(d * scale), -127.f), 127.f);
    return (unsigned)(ia & 0xFF) | ((unsigned)(ib & 0xFF) << 8) | ((unsigned)(ic & 0xFF) << 16) | ((unsigned)(id & 0xFF) << 24);
}
__device__ __forceinline__ void convert_chunk_i8(const float* src, unsigned char* dst, size_t e0, int n, float scale) {
    for (int i = threadIdx.x * 16; i < n; i += NTHREADS * 16) {
        const f32x4 a = *(const f32x4*)(src + e0 + i), b = *(const f32x4*)(src + e0 + i + 4), c = *(const f32x4*)(src + e0 + i + 8), d = *(const f32x4*)(src + e0 + i + 12);
        u32x4 o; o[0] = pack4_i8(a[0], a[1], a[2], a[3], scale); o[1] = pack4_i8(b[0], b[1], b[2], b[3], scale); o[2] = pack4_i8(c[0], c[1], c[2], c[3], scale); o[3] = pack4_i8(d[0], d[1], d[2], d[3], scale);
        *(u32x4*)(dst + e0 + i) = o;
    }
}
__device__ __forceinline__ unsigned pack8_i4(const f32x4 a, const f32x4 b, float scale) {
    unsigned w = 0;
#pragma unroll
    for (int k = 0; k < 4; ++k) {
        const int qa = (int)fminf(fmaxf(rintf(a[k] * scale), -7.f), 7.f) + 8, qb = (int)fminf(fmaxf(rintf(b[k] * scale), -7.f), 7.f) + 8;
        w |= (unsigned)qa << (4 * k); w |= (unsigned)qb << (4 * (k + 4));
    }
    return w;
}
__device__ __forceinline__ void convert_chunk_i4(const float* src, unsigned char* dst, size_t e0, int n, float scale) {
    for (int i = threadIdx.x * 32; i < n; i += NTHREADS * 32) {
        u32x4 o;
#pragma unroll
        for (int k = 0; k < 4; ++k) o[k] = pack8_i4(*(const f32x4*)(src + e0 + i + 8 * k), *(const f32x4*)(src + e0 + i + 8 * k + 4), scale);
        *(u32x4*)(dst + ((e0 + i) >> 1)) = o;
    }
}
__device__ __forceinline__ void convert_tables(const Params& p, int first, int stride) {
    for (int it = first; it < 1024; it += stride) {
        const int tsel = it >> 9; const size_t e0 = (size_t)(it & 511) * 32768;
        if (tsel) convert_chunk_i4(p.peer_v, p.ws + OFF_VT, e0, 32768, PEER_SV); else convert_chunk_i8(p.peer_u, p.ws + OFF_UT, e0, 32768, PEER_SU);
    }
}
__device__ __forceinline__ void phase0(const Params& p, LAS unsigned char* lds) {
    const int tid = threadIdx.x;
    float* ada = (float*)(p.ws + OFF_ADA);
    LAS float* lf = (LAS float*)lds;
    constexpr int N_ADA = 192, N_WIN = 52 * 16, N_WOUT = 256, N_WPQ = 256, N_SK = 4, N_BIAS = 1;
    constexpr int NITEMS = N_ADA + N_WIN + N_WOUT + N_WPQ + N_SK + N_BIAS;
    if (blockIdx.x < N_ADA) {
        {
            const int it = blockIdx.x;
            LAS float* sc = lf; LAS float* red = lf + 4096;
            for (int i = tid; i < 4096; i += NTHREADS) sc[i] = siluf(p.c[i]);
            __syncthreads();
            const int col = tid & 31, kg = tid >> 5, c0 = it * 32;
            float a0 = 0.f, a1 = 0.f, a2 = 0.f, a3 = 0.f;
            const float* w = p.w_ada + c0 + col;
#pragma unroll 8
            for (int j = 0; j < 64; ++j) { const int k = kg + 16 * j; const float wv = w[(size_t)k * 6144];
                a0 += sc[k] * wv; a1 += sc[1024 + k] * wv; a2 += sc[2048 + k] * wv; a3 += sc[3072 + k] * wv; }
            red[(kg * 4 + 0) * 32 + col] = a0; red[(kg * 4 + 1) * 32 + col] = a1; red[(kg * 4 + 2) * 32 + col] = a2; red[(kg * 4 + 3) * 32 + col] = a3;
            __syncthreads();
            if (tid < 128) { const int b = tid >> 5, cc = tid & 31; float s = 0.f;
                for (int g = 0; g < 16; ++g) s += red[(g * 4 + b) * 32 + cc];
                ada[b * 6144 + c0 + cc] = s + p.b_ada[c0 + cc]; }
        }
        wg_signal((unsigned*)(p.ws + OFF_CTL), CNT_ADA);
        __syncthreads();
    }
    for (int item = N_ADA + ((blockIdx.x + gridDim.x - N_ADA) % gridDim.x); item < NITEMS; item += gridDim.x) {
        int it = item;
        it -= N_ADA;
        if (it < N_WIN) { transpose_tile<true>(p.w_in, 3280, (bf16_t*)(p.ws + OFF_WIN), (it >> 4) * 64, (it & 15) * 64, lf); continue; }
        it -= N_WIN;
        if (it < N_WOUT) { transpose_tile<false>(p.w_out, 1024, (bf16_t*)(p.ws + OFF_WOUT), (it >> 4) * 64, (it & 15) * 64, lf); continue; }
        it -= N_WOUT;
        if (it < N_WPQ) { transpose_tile<false>(p.w_peer_q, 1024, (bf16_t*)(p.ws + OFF_WPQ), (it >> 4) * 64, (it & 15) * 64, lf); continue; }
        it -= N_WPQ;

        if (it < N_SK) { convert_chunk(p.sub_keys, (bf16_t*)(p.ws + OFF_SK), (size_t)it * 32768, 32768); continue; }
        it -= N_SK;
        { float* bias = (float*)(p.ws + OFF_BIAS);
          for (int n = tid; n < NIN_PAD; n += NTHREADS) { const int s = inperm_src(n); bias[n] = s >= 0 ? p.b_in[s] : 0.f; } }
    }
}

__device__ __forceinline__ void norm_mod_rows(const float* X, const float* g, const float* ada, int sh_off, int sc_off, bf16_t* out) {
    const int wid = threadIdx.x >> 6, lane = threadIdx.x & 63;
    for (int row = (blockIdx.x * 8 + wid) * 2; row < NTOK; row += gridDim.x * 16) {
        const int b = row >> 12;
        f32x4 v[2][4]; float ss[2] = {0.f, 0.f};
#pragma unroll
        for (int rr = 0; rr < 2; ++rr)
#pragma unroll
            for (int j = 0; j < 4; ++j) v[rr][j] = *(const f32x4*)(X + (size_t)(row + rr) * 1024 + 4 * (lane + 64 * j));
#pragma unroll
        for (int rr = 0; rr < 2; ++rr)
#pragma unroll
            for (int j = 0; j < 4; ++j) ss[rr] += v[rr][j][0] * v[rr][j][0] + v[rr][j][1] * v[rr][j][1] + v[rr][j][2] * v[rr][j][2] + v[rr][j][3] * v[rr][j][3];
        ss[0] = wave_sum(ss[0]); ss[1] = wave_sum(ss[1]);
        const float rstd0 = rsqrtf(ss[0] * (1.f / 1024.f) + 1e-6f), rstd1 = rsqrtf(ss[1] * (1.f / 1024.f) + 1e-6f);
#pragma unroll
        for (int j = 0; j < 4; ++j) {
            const int c = 4 * (lane + 64 * j);
            const f32x4 gg = *(const f32x4*)(g + c), sc = *(const f32x4*)(ada + b * 6144 + sc_off + c), sh = *(const f32x4*)(ada + b * 6144 + sh_off + c);
#pragma unroll
            for (int rr = 0; rr < 2; ++rr) {
                const float rstd = rr ? rstd1 : rstd0;
                float h[4];
#pragma unroll
                for (int i = 0; i < 4; ++i) h[i] = (v[rr][j][i] * rstd * gg[i]) * (1.f + sc[i]) + sh[i];
                u32x2 o; o[0] = pack2(h[0], h[1]); o[1] = pack2(h[2], h[3]);
                *(u32x2*)(out + (size_t)(row + rr) * 1024 + c) = o;
            }
        }
    }
}

__device__ __forceinline__ bf16x8 lds_frag(const LAS bf16_t* base, int row, int stride, int kofs) { return *(const LAS bf16x8*)(base + row * stride + kofs); }

__device__ __forceinline__ void conv_silu8(const bf16_t* src, const float* cw  , int row, int tpos, int col, float scale, float (&o)[8]) {
    float acc[8];
#pragma unroll
    for (int i = 0; i < 8; ++i) acc[i] = 0.f;
#pragma unroll
    for (int j = 0; j < 4; ++j) {
        const int tt = tpos - 3 + j;
        if (tt >= 0) {
            const u32x4 xv = *(const u32x4*)(src + (size_t)(row - 3 + j) * 512 + col);
            const f32x4 w0 = *(const f32x4*)(cw + j * 1024), w1 = *(const f32x4*)(cw + j * 1024 + 4);
            acc[0] += w0[0] * lo16(xv[0]); acc[1] += w0[1] * hi16(xv[0]); acc[2] += w0[2] * lo16(xv[1]); acc[3] += w0[3] * hi16(xv[1]);
            acc[4] += w1[0] * lo16(xv[2]); acc[5] += w1[1] * hi16(xv[2]); acc[6] += w1[2] * lo16(xv[3]); acc[7] += w1[3] * hi16(xv[3]);
        }
    }
#pragma unroll
    for (int i = 0; i < 8; ++i) o[i] = siluf(acc[i]) * scale;
}

__device__ __forceinline__ void mlstm_passA(const Params& p, int task, LAS unsigned char* lds) {
    const int tid = opaque_tid(), wid = tid >> 6, lane = tid & 63;
    const int bh = task >> 6, c = task & 63, b = bh >> 2, h = bh & 3;
    const int row0 = b * SEQ + c * 64;
    const float* gates = (const float*)(p.ws + OFF_GATE);
    const bf16_t* MK = (const bf16_t*)(p.ws + OFF_MK); const bf16_t* MV = (const bf16_t*)(p.ws + OFF_MV);
    LAS bf16_t* KT = (LAS bf16_t*)lds;
    LAS bf16_t* VT = KT + 128 * 72;
    LAS float* sc = (LAS float*)(VT + 128 * 72);
    LAS float* lsg = sc; LAS float* ig = sc + 64; LAS float* wloc = sc + 128; LAS float* misc = sc + 192;
    if (tid < 64) {
        const float f = gates[(size_t)(row0 + tid) * 16 + 4 + h], iv = gates[(size_t)(row0 + tid) * 16 + h];
        const float bc = wave_scan_add(logsigmoidf_(f), lane);
        const float bl = __shfl(bc, 63);
        const float a = bl - bc + iv;
        const float m = wave_max(a);
        lsg[tid] = bc; ig[tid] = iv; wloc[tid] = __expf(a - m);
        if (tid == 0) { misc[0] = m; misc[1] = bl; }
    }
    __syncthreads();
    for (int pc = tid; pc < 1024; pc += NTHREADS) {
        const int s = pc >> 4, dg = pc & 15;
        float kk[8];
        conv_silu8(MK, p.conv_qk + 512 + h * 128 + dg * 8, row0 + s, c * 64 + s, h * 128 + dg * 8, 1.f, kk);
#pragma unroll
        for (int i = 0; i < 8; ++i) KT[(dg * 8 + i) * 72 + s] = f2bf(kk[i]);
        const u32x4 vv = *(const u32x4*)(MV + (size_t)(row0 + s) * 512 + h * 128 + dg * 8);
        const float w = wloc[s];
#pragma unroll
        for (int i = 0; i < 4; ++i) { VT[(dg * 8 + 2 * i) * 72 + s] = f2bf(lo16(vv[i]) * w); VT[(dg * 8 + 2 * i + 1) * 72 + s] = f2bf(hi16(vv[i]) * w); }
    }
    __syncthreads();
    {
        const int r = lane & 15, g = lane >> 4;
        bf16x8 a0 = lds_frag(VT, wid * 16 + r, 72, 8 * g), a1 = lds_frag(VT, wid * 16 + r, 72, 8 * g + 32);
        bf16_t* KV = (bf16_t*)(p.ws + OFF_KV) + (size_t)task * 16384;
#pragma unroll
        for (int dt = 0; dt < 8; ++dt) {
            f32x4 acc = {0.f, 0.f, 0.f, 0.f};
            acc = __builtin_amdgcn_mfma_f32_16x16x32_bf16(a0, lds_frag(KT, dt * 16 + r, 72, 8 * g), acc, 0, 0, 0);
            acc = __builtin_amdgcn_mfma_f32_16x16x32_bf16(a1, lds_frag(KT, dt * 16 + r, 72, 8 * g + 32), acc, 0, 0, 0);
#pragma unroll
            for (int j = 0; j < 4; ++j) KV[(wid * 16 + 4 * g + j) * 128 + dt * 16 + r] = f2bf_sw(acc[j]);
        }
    }
    if (tid < 128) {
        float s = 0.f;
        for (int i = 0; i < 64; ++i) s += wloc[i] * bf2f(KT[tid * 72 + i]);
        ((float*)(p.ws + OFF_KS))[(size_t)task * 128 + tid] = s;
    }
    if (tid == 0) { ((float*)(p.ws + OFF_MLOC))[task] = misc[0]; ((float*)(p.ws + OFF_BLAST))[task] = misc[1]; }
    __syncthreads();
}

__device__ __forceinline__ void mlstm_scan(const Params& p, int item, LAS unsigned char* lds) {
    const int tid = opaque_tid();
    const int bh = item >> 4, blk = item & 15;
    LAS float* dec = (LAS float*)lds; LAS float* inj = dec + 64;
    if (tid == 0) {
        const float* ML = (const float*)(p.ws + OFF_MLOC); const float* BL = (const float*)(p.ws + OFF_BLAST); float* M0 = (float*)(p.ws + OFF_M0);
        float m = 0.f;
        for (int c = 0; c < 64; ++c) {
            const float ml = ML[bh * 64 + c], bl = BL[bh * 64 + c];
            if (blk == 0) M0[bh * 64 + c] = m;
            const float mn = fmaxf(bl + m, ml);
            dec[c] = __expf(bl + m - mn); inj[c] = __expf(ml - mn); m = mn;
        }
    }
    __syncthreads();
    unsigned* KV = (unsigned*)(p.ws + OFF_KV) + (size_t)bh * 64 * 8192 + blk * 512 + tid;
    float s0 = 0.f, s1 = 0.f;
#pragma unroll 8
    for (int c = 0; c < 64; ++c) {
        const unsigned w = KV[(size_t)c * 8192];
        KV[(size_t)c * 8192] = pack2(s0, s1);
        s0 = dec[c] * s0 + inj[c] * lo16(w); s1 = dec[c] * s1 + inj[c] * hi16(w);
    }
    if (blk == 0 && tid < 128) {
        float* KS = (float*)(p.ws + OFF_KS) + (size_t)bh * 64 * 128 + tid;
        float s = 0.f;
        for (int c = 0; c < 64; ++c) { const float k = KS[c * 128]; KS[c * 128] = s; s = dec[c] * s + inj[c] * k; }
    }
    __syncthreads();
}

__device__ __forceinline__ void mlstm_passB(const Params& p, int task, LAS unsigned char* lds) {
    const int tid = opaque_tid(), wid = tid >> 6, lane = tid & 63;
    const int bh = task >> 6, c = task & 63, b = bh >> 2, h = bh & 3;
    const int row0 = b * SEQ + c * 64;
    const float* gates = (const float*)(p.ws + OFF_GATE);
    const bf16_t* MQ = (const bf16_t*)(p.ws + OFF_MQ); const bf16_t* MK = (const bf16_t*)(p.ws + OFF_MK);
    const bf16_t* MV = (const bf16_t*)(p.ws + OFF_MV); const bf16_t* MO = (const bf16_t*)(p.ws + OFF_MO);
    LAS bf16_t* Q = (LAS bf16_t*)lds;
    LAS bf16_t* K = Q + 64 * 136;
    LAS bf16_t* VT = K + 64 * 136;
    LAS bf16_t* C0 = VT + 128 * 72;
    LAS bf16_t* P = C0 + 128 * 136;
    LAS float* sc = (LAS float*)(P + 64 * 72);
    LAS float* bcum = sc; LAS float* ig = sc + 64; LAS float* cs = sc + 128; LAS float* rb = sc + 192; LAS float* wint = sc + 256;
    LAS float* emt = sc + 320; LAS float* rinv = sc + 384; LAS float* qn = sc + 448; LAS float* n0 = sc + 512; LAS float* rowpart = sc + 640;
    LAS float* H = (LAS float*)lds;
    if (tid < 64) {
        const float f = gates[(size_t)(row0 + tid) * 16 + 4 + h], iv = gates[(size_t)(row0 + tid) * 16 + h];
        const float m0 = ((const float*)(p.ws + OFF_M0))[task];
        const float sc_ = wave_scan_add(logsigmoidf_(f), lane);
        const float cst = iv - sc_;
        const float pm = wave_scan_max(cst, lane);
        const float m_intra = sc_ + pm, m_inter = sc_ + m0, mt = fmaxf(m_inter, m_intra);
        bcum[tid] = sc_; ig[tid] = iv; cs[tid] = cst; rb[tid] = sc_ - mt; wint[tid] = __expf(m_inter - mt); emt[tid] = __expf(-mt);
    }
    if (tid >= 64 && tid < 192) n0[tid - 64] = ((const float*)(p.ws + OFF_KS))[(size_t)task * 128 + tid - 64];
    for (int pc = tid; pc < 1024; pc += NTHREADS) {
        const int s = pc >> 4, dg = pc & 15;
        float qq[8], kk[8];
        conv_silu8(MQ, p.conv_qk + h * 128 + dg * 8, row0 + s, c * 64 + s, h * 128 + dg * 8, 0.08838834764831845f, qq);
        conv_silu8(MK, p.conv_qk + 512 + h * 128 + dg * 8, row0 + s, c * 64 + s, h * 128 + dg * 8, 1.f, kk);
        u32x4 qo, ko;
#pragma unroll
        for (int i = 0; i < 4; ++i) { qo[i] = pack2(qq[2 * i], qq[2 * i + 1]); ko[i] = pack2(kk[2 * i], kk[2 * i + 1]); }
        *(LAS u32x4*)(Q + s * 136 + dg * 8) = qo; *(LAS u32x4*)(K + s * 136 + dg * 8) = ko;
        const u32x4 vv = *(const u32x4*)(MV + (size_t)(row0 + s) * 512 + h * 128 + dg * 8);
#pragma unroll
        for (int i = 0; i < 4; ++i) { VT[(dg * 8 + 2 * i) * 72 + s] = (bf16_t)(vv[i] & 0xffffu); VT[(dg * 8 + 2 * i + 1) * 72 + s] = (bf16_t)(vv[i] >> 16); }
    }
    {
        const bf16_t* KV = (const bf16_t*)(p.ws + OFF_KV) + (size_t)task * 16384;
        for (int pc = tid; pc < 2048; pc += NTHREADS) { const int e = pc >> 4, dg = pc & 15;
            *(LAS u32x4*)(C0 + e * 136 + dg * 8) = *(const u32x4*)(KV + e * 128 + dg * 8); }
    }
    __syncthreads();
    const int r = lane & 15, g = lane >> 4;
    {
        const int t = tid >> 3, part = tid & 7; float s = 0.f;
#pragma unroll
        for (int i = 0; i < 16; ++i) s += bf2f(Q[t * 136 + part * 16 + i]) * n0[part * 16 + i];
        s = oct_sum(s);
        if (part == 0) qn[t] = s;
    }
    {
        const int rt = wid >> 1;
#pragma unroll
        for (int cc = 0; cc < 2; ++cc) {
            const int ct = 2 * (wid & 1) + cc;
            f32x4 acc = {0.f, 0.f, 0.f, 0.f};
#pragma unroll
            for (int ks = 0; ks < 4; ++ks)
                acc = __builtin_amdgcn_mfma_f32_16x16x32_bf16(lds_frag(Q, rt * 16 + r, 136, 8 * g + 32 * ks), lds_frag(K, ct * 16 + r, 136, 8 * g + 32 * ks), acc, 0, 0, 0);
            const int scol = ct * 16 + r; const float csv = cs[scol];
#pragma unroll
            for (int j = 0; j < 4; ++j) {
                const int t = rt * 16 + 4 * g + j;
                float pv = (scol <= t) ? acc[j] * __expf(rb[t] + csv) : 0.f;
                P[t * 72 + scol] = f2bf(pv);
                pv = row16_sum(pv);
                if (r == 0) rowpart[t * 4 + ct] = pv;
            }
        }
    }
    __syncthreads();
    if (tid < 64) {
        const float den = rowpart[tid * 4] + rowpart[tid * 4 + 1] + rowpart[tid * 4 + 2] + rowpart[tid * 4 + 3] + wint[tid] * qn[tid];
        rinv[tid] = 1.f / fmaxf(fabsf(den), emt[tid]);
    }
    f32x4 hacc[4];
    {
        const int rt = wid >> 1;
#pragma unroll
        for (int ee = 0; ee < 4; ++ee) {
            const int et = 4 * (wid & 1) + ee;
            f32x4 a1 = {0.f, 0.f, 0.f, 0.f}, a2 = {0.f, 0.f, 0.f, 0.f};
#pragma unroll
            for (int ks = 0; ks < 2; ++ks)
                a1 = __builtin_amdgcn_mfma_f32_16x16x32_bf16(lds_frag(P, rt * 16 + r, 72, 8 * g + 32 * ks), lds_frag(VT, et * 16 + r, 72, 8 * g + 32 * ks), a1, 0, 0, 0);
#pragma unroll
            for (int ks = 0; ks < 4; ++ks)
                a2 = __builtin_amdgcn_mfma_f32_16x16x32_bf16(lds_frag(Q, rt * 16 + r, 136, 8 * g + 32 * ks), lds_frag(C0, et * 16 + r, 136, 8 * g + 32 * ks), a2, 0, 0, 0);
#pragma unroll
            for (int j = 0; j < 4; ++j) { const int t = rt * 16 + 4 * g + j; hacc[ee][j] = a1[j] + wint[t] * a2[j]; }
        }
    }
    __syncthreads();
    {
        const int rt = wid >> 1;
#pragma unroll
        for (int ee = 0; ee < 4; ++ee) {
            const int et = 4 * (wid & 1) + ee;
#pragma unroll
            for (int j = 0; j < 4; ++j) { const int t = rt * 16 + 4 * g + j; H[t * 132 + et * 16 + r] = hacc[ee][j] * rinv[t]; }
        }
    }
    __syncthreads();
    {
        const int t = tid >> 3, part = tid & 7;
        float hv[16]; float ss = 0.f;
#pragma unroll
        for (int i = 0; i < 16; ++i) { hv[i] = H[t * 132 + part * 16 + i]; ss += hv[i] * hv[i]; }
        ss = oct_sum(ss);
        const float rstd = rsqrtf(ss * (1.f / 128.f) + 1e-6f);
        const int col = h * 128 + part * 16;
        const u32x4 m0v = *(const u32x4*)(MO + (size_t)(row0 + t) * 512 + col), m1v = *(const u32x4*)(MO + (size_t)(row0 + t) * 512 + col + 8);
        float mo[16];
#pragma unroll
        for (int i = 0; i < 4; ++i) { mo[2 * i] = lo16(m0v[i]); mo[2 * i + 1] = hi16(m0v[i]); mo[8 + 2 * i] = lo16(m1v[i]); mo[8 + 2 * i + 1] = hi16(m1v[i]); }
        float o[16];
#pragma unroll
        for (int i = 0; i < 16; ++i) o[i] = (hv[i] * rstd * p.out_norm_m[col + i]) * sigmoidf_(mo[i]);
        u32x4 o0, o1;
#pragma unroll
        for (int i = 0; i < 4; ++i) { o0[i] = pack2(o[2 * i], o[2 * i + 1]); o1[i] = pack2(o[8 + 2 * i], o[8 + 2 * i + 1]); }
        bf16_t* dst = (bf16_t*)(p.ws + OFF_ACT) + (size_t)(row0 + t) * 1024 + col;
        *(u32x4*)dst = o0; *(u32x4*)(dst + 8) = o1;
    }
    __syncthreads();
}

__device__ __forceinline__ unsigned f2sortable(float f) { const unsigned u = __float_as_uint(f); return (u & 0x80000000u) ? ~u : (u | 0x80000000u); }
#define CNT4(c0, c1, c2, c3, a, b, cc, d, thr) asm volatile( \
    "v_cmp_ge_u32 s[40:41], %4, %8\n\tv_cmp_ge_u32 s[42:43], %5, %8\n\tv_cmp_ge_u32 s[44:45], %6, %8\n\tv_cmp_ge_u32 s[46:47], %7, %8\n\t" \
    "v_addc_co_u32 %0, s[48:49], 0, %0, s[40:41]\n\tv_addc_co_u32 %1, s[50:51], 0, %1, s[42:43]\n\tv_addc_co_u32 %2, s[52:53], 0, %2, s[44:45]\n\tv_addc_co_u32 %3, s[54:55], 0, %3, s[46:47]" \
    : "+v"(c0), "+v"(c1), "+v"(c2), "+v"(c3) : "v"(a), "v"(b), "v"(cc), "v"(d), "v"(thr) \
    : "s40", "s41", "s42", "s43", "s44", "s45", "s46", "s47", "s48", "s49", "s50", "s51", "s52", "s53", "s54", "s55")
template <int NR>
__device__ __forceinline__ int count_geN(const unsigned (&u)[NR], unsigned thr) {
    int c0 = 0, c1 = 0, c2 = 0, c3 = 0;
#pragma unroll
    for (int j = 0; j < NR; j += 4) CNT4(c0, c1, c2, c3, u[j], u[j + 1], u[j + 2], u[j + 3], thr);
    return (c0 + c1) + (c2 + c3);
}
template <int NR>
__device__ __forceinline__ void select_topk(const LAS float* srow, LAS int* lq, int t, int n, int lane) {
    unsigned u[NR];
#pragma unroll
    for (int j = 0; j < NR; ++j) { const int key = lane + 64 * j; u[j] = (key <= t) ? ((f2sortable(srow[key]) & 0xFFFFF000u) | (unsigned)(4095 - key)) : 0u; }
    unsigned tau = 1u;
    if (n > 256) {
        tau = 0u;
        for (int bit = 31; bit >= 0; --bit) {
            const unsigned cand = tau | (1u << bit);
            const int cnt = wave_sum_i32_uniform(count_geN<NR>(u, cand));
            if (cnt >= 256) { tau = cand; if (cnt == 256) break; }
        }
    }
    const int c = count_geN<NR>(u, tau);
    int pre = c;
#pragma unroll
    for (int o = 1; o < 64; o <<= 1) { const int v = __shfl_up(pre, o); if (lane >= o) pre += v; }
    int pos = pre - c;
    int keyv = lane;
#pragma unroll
    for (int j = 0; j < NR; ++j) {
        const bool sel = u[j] >= tau;
        const int slot = sel ? pos : (256 + lane);
        lq[slot] = keyv;
        pos += sel ? 1 : 0; keyv += 64;
    }
}
__device__ __forceinline__ unsigned wave_max_u32(unsigned v) {
    v = max(v, (unsigned)__builtin_amdgcn_update_dpp(0, (int)v, 0xB1, 0xF, 0xF, true)); v = max(v, (unsigned)__builtin_amdgcn_update_dpp(0, (int)v, 0x4E, 0xF, 0xF, true));
    v = max(v, (unsigned)__builtin_amdgcn_update_dpp(0, (int)v, 0x141, 0xF, 0xF, true)); v = max(v, (unsigned)__builtin_amdgcn_update_dpp(0, (int)v, 0x140, 0xF, 0xF, true));
    return max(max((unsigned)__builtin_amdgcn_readlane((int)v, 0), (unsigned)__builtin_amdgcn_readlane((int)v, 16)), max((unsigned)__builtin_amdgcn_readlane((int)v, 32), (unsigned)__builtin_amdgcn_readlane((int)v, 48)));
}
template <int NR>
__device__ __forceinline__ void select_topk2(LAS float* srow, LAS int* lq, int t, int n, int lane) {
    unsigned u[NR];
#pragma unroll
    for (int j = 0; j < NR; ++j) { const int key = lane + 64 * j; u[j] = (key <= t) ? ((f2sortable(srow[key]) & 0xFFFFF000u) | (unsigned)(4095 - key)) : 0u; }
    unsigned mx = 0u;
#pragma unroll
    for (int j = 0; j < NR; ++j) mx = max(mx, u[j]);
    mx = wave_max_u32(mx);
    unsigned tau = 0u; int bit = 31, G = n;
    {
        unsigned th = mx & 0xFF800000u;
#pragma unroll 1
        for (int s6 = 0; s6 < 6; ++s6) {
            const int cnt = wave_sum_i32_uniform(count_geN<NR>(u, th));
            if (cnt >= 256) { tau = th; bit = 22; G = cnt; break; }
            if (th < 0x00800000u) break;
            th -= 0x00800000u;
        }
    }
    while (G > 512 && bit >= 0) {
        const unsigned cand = tau | (1u << bit);
        const int cnt = wave_sum_i32_uniform(count_geN<NR>(u, cand));
        if (cnt >= 256) { tau = cand; G = cnt; }
        --bit;
    }
    LAS unsigned* buf = (LAS unsigned*)srow;
    {
        int base = 0;
#pragma unroll
        for (int j = 0; j < NR; ++j) {
            const bool m = u[j] >= tau;
            const unsigned long long mask = __builtin_amdgcn_ballot_w64(m);
            const int pos = base + (int)__builtin_amdgcn_mbcnt_hi((unsigned)(mask >> 32), __builtin_amdgcn_mbcnt_lo((unsigned)mask, 0u));
            if (m) buf[pos] = u[j];
            base += __builtin_popcountll(mask);
        }
    }
    unsigned c[8];
#pragma unroll
    for (int j = 0; j < 8; ++j) c[j] = (lane + 64 * j < G) ? buf[lane + 64 * j] : 0u;
    while (G > 256 && bit >= 0) {
        const unsigned cand = tau | (1u << bit);
        const int cnt = wave_sum_i32_uniform(count_geN<8>(c, cand));
        if (cnt >= 256) { tau = cand; G = cnt; }
        --bit;
    }
    {
        int base = 0;
#pragma unroll
        for (int j = 0; j < 8; ++j) {
            const bool m = c[j] >= tau;
            const unsigned long long mask = __builtin_amdgcn_ballot_w64(m);
            const int pos = base + (int)__builtin_amdgcn_mbcnt_hi((unsigned)(mask >> 32), __builtin_amdgcn_mbcnt_lo((unsigned)mask, 0u));
            if (m) lq[pos] = 4095 - (int)(c[j] & 4095u);
            base += __builtin_popcountll(mask);
        }
    }
}
__device__ __forceinline__ void dsa_task(const Params& p, int task, LAS unsigned char* lds) {
    const int tid = opaque_tid(), wid = __builtin_amdgcn_readfirstlane(tid >> 6), lane = tid & 63;
    const int b = task >> 9, qg = task & 511, t0 = qg * 8, rowb = b * SEQ;
    const bf16_t* IQ = (const bf16_t*)(p.ws + OFF_IQ); const bf16_t* IK = (const bf16_t*)(p.ws + OFF_IK);
    const bf16_t* AQ = (const bf16_t*)(p.ws + OFF_AQ); const bf16_t* AK = (const bf16_t*)(p.ws + OFF_AK); const bf16_t* AV = (const bf16_t*)(p.ws + OFF_AV);
    const float* gates = (const float*)(p.ws + OFF_GATE);
    LAS float* scores = (LAS float*)lds;
    LAS int* lists = (LAS int*)(lds + 131072);
    const int ntile = (t0 + 8 + 31) >> 5;
#pragma unroll 1
    for (int rr0 = 0; rr0 < ((DSA_REP & 1) ? 2 : 1); ++rr0)
    {
        const int r = lane & 31, hh = lane >> 5;
        bf16x8 af[2][4]; float wv[2][4][4];
#pragma unroll
        for (int rt = 0; rt < 2; ++rt) {
            const size_t qrow = (size_t)(rowb + t0 + 4 * rt + (r >> 3));
#pragma unroll
            for (int ks = 0; ks < 4; ++ks) af[rt][ks] = *(const bf16x8*)(IQ + qrow * 512 + (r & 7) * 64 + 16 * ks + 8 * hh);
#pragma unroll
            for (int q4 = 0; q4 < 4; ++q4)
#pragma unroll
                for (int h4 = 0; h4 < 4; ++h4) wv[rt][q4][h4] = gates[(size_t)(rowb + t0 + 4 * rt + q4) * 16 + 8 + h4 + 4 * hh] * 0.04419417382415922f;
        }
        bf16x8 bfr[4], bnx[4];
        if (wid < ntile) {
#pragma unroll
            for (int ks = 0; ks < 4; ++ks) bfr[ks] = *(const bf16x8*)(IK + (size_t)(rowb + 32 * wid + r) * 64 + 16 * ks + 8 * hh);
        }
        for (int kt = wid; kt < ntile; kt += 8) {
            if (kt + 8 < ntile) {
#pragma unroll
                for (int ks = 0; ks < 4; ++ks) bnx[ks] = *(const bf16x8*)(IK + (size_t)(rowb + 32 * (kt + 8) + r) * 64 + 16 * ks + 8 * hh);
            }
            const int key = 32 * kt + r;
#pragma unroll
            for (int rt = 0; rt < 2; ++rt) {
                f32x16 acc;
#pragma unroll
                for (int i = 0; i < 16; ++i) acc[i] = 0.f;
#pragma unroll
                for (int ks = 0; ks < 4; ++ks) acc = __builtin_amdgcn_mfma_f32_32x32x16_bf16(af[rt][ks], bfr[ks], acc, 0, 0, 0);
                float part[4];
#pragma unroll
                for (int q4 = 0; q4 < 4; ++q4) {
                    part[q4] = 0.f;
#pragma unroll
                    for (int h4 = 0; h4 < 4; ++h4) part[q4] += fmaxf(acc[q4 * 4 + h4], 0.f) * wv[rt][q4][h4];
                }
                float tot[2];
#pragma unroll
                for (int i = 0; i < 2; ++i) { const u32x2 r_ = __builtin_amdgcn_permlane32_swap(__float_as_uint(part[i]), __float_as_uint(part[i + 2]), false, false); tot[i] = __uint_as_float(r_[0]) + __uint_as_float(r_[1]); }
#pragma unroll
                for (int i = 0; i < 2; ++i) { const int qq = 4 * rt + 2 * hh + i; scores[qq * 4096 + key] = (key <= t0 + qq) ? tot[i] : -INFINITY; }
            }
#pragma unroll
            for (int ks = 0; ks < 4; ++ks) bfr[ks] = bnx[ks];
        }
    }
    __syncthreads();
    const int qq = wid, t = t0 + qq, n = t + 1;
    const int nsel = n < 256 ? n : 256;
#pragma unroll 1
    for (int rr1 = 0; rr1 < ((DSA_REP & 2) ? 2 : 1); ++rr1)
    {
        LAS float* srow = scores + qq * 4096; LAS int* lq = lists + qq * 320;
        const int nreg = (t >> 6) + 1;
        if (nreg <= 8) select_topk<8>(srow, lq, t, n, lane);
        else if (nreg <= 16) select_topk2<16>(srow, lq, t, n, lane);
        else if (nreg <= 24) select_topk2<24>(srow, lq, t, n, lane);
        else if (nreg <= 32) select_topk2<32>(srow, lq, t, n, lane);
        else if (nreg <= 40) select_topk2<40>(srow, lq, t, n, lane);
        else if (nreg <= 48) select_topk2<48>(srow, lq, t, n, lane);
        else if (nreg <= 56) select_topk2<56>(srow, lq, t, n, lane);
        else select_topk2<64>(srow, lq, t, n, lane);
    }
    asm volatile("s_waitcnt lgkmcnt(0)" ::: "memory");
#pragma unroll 1
    for (int rr2 = 0; rr2 < ((DSA_REP & 4) ? 2 : 1); ++rr2) {
    {
        const int r = lane & 15, g = lane >> 4;
        const size_t qrow = (size_t)(rowb + t);
        bf16x8 bq[2];
#pragma unroll
        for (int ks = 0; ks < 2; ++ks) {
            if (r < 8) bq[ks] = *(const bf16x8*)(AQ + qrow * 512 + r * 64 + 8 * g + 32 * ks);
            else { bq[ks] = (bf16x8){0, 0, 0, 0, 0, 0, 0, 0}; }
        }
        LAS float* Pl = scores + qq * 4096;
#pragma unroll 1
        for (int half = 0; half < 2; ++half) {
            bf16x8 a0[8], a1[8];
#pragma unroll
            for (int i = 0; i < 8; ++i) {
                const int jp = 16 * (half * 8 + i) + r;
                const int key = (jp < nsel) ? lists[qq * 320 + jp] : 0;
                a0[i] = *(const bf16x8*)(AK + (size_t)(rowb + key) * 64 + 8 * g); a1[i] = *(const bf16x8*)(AK + (size_t)(rowb + key) * 64 + 8 * g + 32);
            }
#pragma unroll
            for (int i = 0; i < 8; ++i) {
                const int kt = half * 8 + i;
                f32x4 acc = {0.f, 0.f, 0.f, 0.f};
                acc = __builtin_amdgcn_mfma_f32_16x16x32_bf16(a0[i], bq[0], acc, 0, 0, 0);
                acc = __builtin_amdgcn_mfma_f32_16x16x32_bf16(a1[i], bq[1], acc, 0, 0, 0);
                if (r < 8) *(LAS f32x4*)(Pl + r * 260 + 16 * kt + 4 * g) = acc * 0.125f;
            }
        }
        asm volatile("s_waitcnt lgkmcnt(0)" ::: "memory");
        const int hd = lane & 7, ch = lane >> 3;
        f32x4 pv[8];
        float mx = -INFINITY;
#pragma unroll
        for (int i = 0; i < 8; ++i) {
            pv[i] = *(const LAS f32x4*)(Pl + hd * 260 + ch * 32 + 4 * i);
#pragma unroll
            for (int j = 0; j < 4; ++j) if (ch * 32 + 4 * i + j < nsel) mx = fmaxf(mx, pv[i][j]);
        }
        mx = fmaxf(mx, dppf(mx, 0x128));
        mx = fmaxf(mx, xchg_f32<16>(mx, lane)); mx = fmaxf(mx, xchg_f32<32>(mx, lane));
        float sm = 0.f;
#pragma unroll
        for (int i = 0; i < 8; ++i)
#pragma unroll
            for (int j = 0; j < 4; ++j) { const float e = (ch * 32 + 4 * i + j < nsel) ? __expf(pv[i][j] - mx) : 0.f; pv[i][j] = e; sm += e; }
        sm += dppf(sm, 0x128); sm += xchg_f32<16>(sm, lane); sm += xchg_f32<32>(sm, lane);
        const float inv = __builtin_amdgcn_rcpf(sm);
        LAS bf16_t* Pt = (LAS bf16_t*)((LAS unsigned char*)Pl + 9216);
#pragma unroll
        for (int i = 0; i < 4; ++i) {
            u32x4 o;
            o[0] = pack2(pv[2 * i][0] * inv, pv[2 * i][1] * inv); o[1] = pack2(pv[2 * i][2] * inv, pv[2 * i][3] * inv);
            o[2] = pack2(pv[2 * i + 1][0] * inv, pv[2 * i + 1][1] * inv); o[3] = pack2(pv[2 * i + 1][2] * inv, pv[2 * i + 1][3] * inv);
            *(LAS u32x4*)(Pt + hd * 264 + ch * 32 + 8 * i) = o;
        }
    }
    asm volatile("s_waitcnt lgkmcnt(0)" ::: "memory");
    {
        typedef short s16x4 __attribute__((ext_vector_type(4)));
        const int r = lane & 15, g = lane >> 4;
        LAS unsigned char* wb = (LAS unsigned char*)(scores + qq * 4096);
        const LAS bf16_t* Pt = (const LAS bf16_t*)(wb + 9216);
        const int nchunk = (nsel + 31) >> 5;
        const int kl = lane >> 3, dc = lane & 7;
        f32x4 acc[4];
#pragma unroll
        for (int ct = 0; ct < 4; ++ct) acc[ct] = (f32x4){0.f, 0.f, 0.f, 0.f};
        u32x4 vq[4], vn[4];
#pragma unroll
        for (int i = 0; i < 4; ++i) {
            const int jp = kl + 8 * i;
            const int key = (jp < nsel) ? lists[qq * 320 + jp] : 0;
            vq[i] = *(const u32x4*)(AV + (size_t)(rowb + key) * 64 + dc * 8);
        }
#pragma unroll 1
        for (int c = 0; c < nchunk; ++c) {
            LAS unsigned char* vb = wb + (c & 1) * 4608;
#pragma unroll
            for (int i = 0; i < 4; ++i) *(LAS u32x4*)(vb + (kl + 8 * i) * 144 + dc * 16) = vq[i];
            if (c + 1 < nchunk) {
#pragma unroll
                for (int i = 0; i < 4; ++i) {
                    const int jp = 32 * (c + 1) + kl + 8 * i;
                    const int key = (jp < nsel) ? lists[qq * 320 + jp] : 0;
                    vn[i] = *(const u32x4*)(AV + (size_t)(rowb + key) * 64 + dc * 8);
                }
            }
            bf16x8 a = *(const LAS bf16x8*)(Pt + (r & 7) * 264 + 32 * c + 8 * g);
            if (r >= 8) a = (bf16x8){0, 0, 0, 0, 0, 0, 0, 0};
#pragma unroll
            for (int ct = 0; ct < 4; ++ct) {
                LAS unsigned char* ba = vb + (8 * g + (r >> 2)) * 144 + (16 * ct + 4 * (r & 3)) * 2;
                const s16x4 b0 = __builtin_amdgcn_ds_read_tr16_b64_v4i16((LAS s16x4*)ba);
                const s16x4 b1 = __builtin_amdgcn_ds_read_tr16_b64_v4i16((LAS s16x4*)(ba + 4 * 144));
                bf16x8 bb; bb[0] = b0[0]; bb[1] = b0[1]; bb[2] = b0[2]; bb[3] = b0[3]; bb[4] = b1[0]; bb[5] = b1[1]; bb[6] = b1[2]; bb[7] = b1[3];
                acc[ct] = __builtin_amdgcn_mfma_f32_16x16x32_bf16(a, bb, acc[ct], 0, 0, 0);
            }
#pragma unroll
            for (int i = 0; i < 4; ++i) vq[i] = vn[i];
        }
        bf16_t* dst = (bf16_t*)(p.ws + OFF_ACT) + (size_t)(rowb + t) * 1024 + 512;
#pragma unroll
        for (int j = 0; j < 4; ++j) {
            float ss = acc[0][j] * acc[0][j] + acc[1][j] * acc[1][j] + acc[2][j] * acc[2][j] + acc[3][j] * acc[3][j];
            ss = row16_sum(ss);
            const float rstd = rsqrtf(ss * (1.f / 64.f) + 1e-6f);
            if (g < 2) {
                const int hd = 4 * g + j;
#pragma unroll
                for (int ct = 0; ct < 4; ++ct) dst[hd * 64 + 16 * ct + r] = f2bf(acc[ct][j] * rstd * p.out_norm_a[hd * 64 + 16 * ct + r]);
            }
        }
    }
    }
    __syncthreads();
}

__device__ __forceinline__ float sortable2f(unsigned s) { return __uint_as_float((s & 0x80000000u) ? (s ^ 0x80000000u) : ~s); }
#define CE_DESC(x, y) do { const unsigned mx_ = max(x, y), mn_ = min(x, y); (x) = mx_; (y) = mn_; } while (0)
template <int BASE, int N>
__device__ __forceinline__ void bitonic_sort16_desc(unsigned (&a)[N]) {
#pragma unroll
    for (int k = 2; k <= 16; k <<= 1) {
#pragma unroll
        for (int j = k >> 1; j > 0; j >>= 1) {
#pragma unroll
            for (int i = 0; i < 16; ++i) {
                const int l = i ^ j;
                if (l > i) {
                    if ((i & k) == 0) CE_DESC(a[BASE + i], a[BASE + l]);
                    else CE_DESC(a[BASE + l], a[BASE + i]);
                }
            }
        }
    }
}
template <int BASE, int N>
__device__ __forceinline__ void bitonic_merge16_desc(unsigned (&a)[N]) {
#pragma unroll
    for (int j = 8; j > 0; j >>= 1) {
#pragma unroll
        for (int i = 0; i < 16; ++i) { const int l = i ^ j; if (l > i) CE_DESC(a[BASE + i], a[BASE + l]); }
    }
}
template <int BA, int BB, int N>
__device__ __forceinline__ void top16_merge(unsigned (&a)[N]) {
#pragma unroll
    for (int i = 0; i < 16; ++i) a[BA + i] = max(a[BA + i], a[BB + 15 - i]);
    bitonic_merge16_desc<BA, N>(a);
}
__device__ __forceinline__ void top16_of_64(unsigned (&a)[64]) {
    bitonic_sort16_desc<0, 64>(a); bitonic_sort16_desc<16, 64>(a); bitonic_sort16_desc<32, 64>(a); bitonic_sort16_desc<48, 64>(a);
    top16_merge<0, 16, 64>(a); top16_merge<32, 48, 64>(a); top16_merge<0, 32, 64>(a);
}
__device__ __forceinline__ void peer_route(const Params& p, int task, LAS unsigned char* lds) {
    const int tid = opaque_tid(), wid = __builtin_amdgcn_readfirstlane(tid >> 6), lane = tid & 63;
    const int n0 = task * 32, head = wid;
    const int r = lane & 31, hh = lane >> 5;
    const bf16_t* QRY = (const bf16_t*)(p.ws + OFF_QRY); const bf16_t* SK = (const bf16_t*)(p.ws + OFF_SK);
    LAS unsigned* tkl = (LAS unsigned*)lds + wid * (32 * 64);
#pragma unroll 1
    for (int p2 = 0; p2 < 2; ++p2) {
        const int grp = head * 2 + p2;
        bf16x8 bq[4];
#pragma unroll
        for (int ks = 0; ks < 4; ++ks) bq[ks] = *(const bf16x8*)(QRY + (size_t)(n0 + r) * 1024 + grp * 64 + 16 * ks + 8 * hh);
        unsigned key[64];
#pragma unroll
        for (int kt = 0; kt < 4; ++kt) {
            f32x16 acc;
#pragma unroll
            for (int i = 0; i < 16; ++i) acc[i] = 0.f;
#pragma unroll
            for (int ks = 0; ks < 4; ++ks) {
                const bf16x8 a = *(const bf16x8*)(SK + (size_t)(grp * 128 + 32 * kt + r) * 64 + 16 * ks + 8 * hh);
                acc = __builtin_amdgcn_mfma_f32_32x32x16_bf16(a, bq[ks], acc, 0, 0, 0);
            }
#pragma unroll
            for (int reg = 0; reg < 16; ++reg) {
                const int idx = 32 * kt + (reg & 3) + 8 * (reg >> 2) + 4 * hh;
                key[kt * 16 + reg] = (f2sortable(acc[reg]) & ~0x7Fu) | (unsigned)(127 - idx);
            }
        }
        top16_of_64(key);
        unsigned mg[16];
#pragma unroll
        for (int i = 0; i < 16; ++i) mg[i] = max(key[i], xchg_u32<32>(key[15 - i], lane));
        bitonic_merge16_desc<0, 16>(mg);
#pragma unroll
        for (int k = 0; k < 16; ++k) tkl[(p2 * 16 + k) * 64 + lane] = mg[k];
    }
    float v1[16], v2[16];
#pragma unroll
    for (int k = 0; k < 16; ++k) { v1[k] = sortable2f(tkl[k * 64 + lane] & ~0x7Fu); v2[k] = sortable2f(tkl[(16 + k) * 64 + lane] & ~0x7Fu); }
    unsigned ck[64];
    {
        int ci = 0;
#pragma unroll
        for (int a = 0; a < 16; ++a) {
#pragma unroll
            for (int bb = 0; bb < 16 / (a + 1); ++bb) { ck[ci] = (f2sortable(v1[a] + v2[bb]) & ~0xFFu) | (unsigned)(255 - (16 * a + bb)); ++ci; }
        }
#pragma unroll
        for (int i = 50; i < 64; ++i) ck[i] = 0u;
    }
    top16_of_64(ck);
    float tv[16]; int te[16];
    float sum = 0.f;
#pragma unroll
    for (int k = 0; k < 16; ++k) {
        const int flat = 255 - (int)(ck[k] & 0xFFu);
        const int i1 = 127 - (int)(tkl[(flat >> 4) * 64 + lane] & 0x7Fu), i2 = 127 - (int)(tkl[(16 + (flat & 15)) * 64 + lane] & 0x7Fu);
        te[k] = i1 * 128 + i2;
        tv[k] = __expf(sortable2f(ck[k] & ~0xFFu) - sortable2f(ck[0] & ~0xFFu)); sum += tv[k];
    }
    const float inv = 1.f / sum;
    if (hh == 0) {
        int* EI = (int*)(p.ws + OFF_EIDX) + (size_t)(n0 + r) * 128 + head * 16;
#pragma unroll
        for (int q = 0; q < 4; ++q) { u32x4 o; o[0] = te[4 * q]; o[1] = te[4 * q + 1]; o[2] = te[4 * q + 2]; o[3] = te[4 * q + 3]; *(u32x4*)(EI + 4 * q) = o; }
    } else {
        float* GW = (float*)(p.ws + OFF_GW) + (size_t)(n0 + r) * 128 + head * 16;
#pragma unroll
        for (int q = 0; q < 4; ++q) { f32x4 o; o[0] = tv[4 * q] * inv; o[1] = tv[4 * q + 1] * inv; o[2] = tv[4 * q + 2] * inv; o[3] = tv[4 * q + 3] * inv; *(f32x4*)(GW + 4 * q) = o; }
    }
}

__device__ __forceinline__ float gelu_exact(float a) { return 0.5f * a * (1.f + erff(a * 0.70710678118654752440f)); }
__device__ __forceinline__ float gelu_as(float v) {
    const float av = fabsf(v), t = __builtin_amdgcn_rcpf(av * 0.2316418882f + 1.0f);
    float q = t * 0.5307027145f + (-0.7265760135f); q = q * t + 0.7107068705f; q = q * t + (-0.142248368f); q = q * t + 0.127414796f; q = q * t;
    const float e = __builtin_amdgcn_exp2f((v * v) * (-0.72134752044f));
    const float m = v * (q * e), rr = v - m;
    return v < 0.f ? m : rr;
}
__device__ __forceinline__ void dec16_fp8(const u32x4 w, float (&f)[16]) {
#pragma unroll
    for (int i = 0; i < 4; ++i) {
        const f32x2 lo = __builtin_amdgcn_cvt_pk_f32_fp8((int)w[i], false), hi = __builtin_amdgcn_cvt_pk_f32_fp8((int)w[i], true);
        f[4 * i] = lo[0]; f[4 * i + 1] = lo[1]; f[4 * i + 2] = hi[0]; f[4 * i + 3] = hi[1];
    }
}
__device__ __forceinline__ void sort_pairs128(int& k_lo, int& k_hi, float& g_lo, float& g_hi, int lane) {
#pragma unroll
    for (int size = 2; size <= 128; size <<= 1) {
#pragma unroll
        for (int stride = size >> 1; stride >= 1; stride >>= 1) {
            if (stride == 64) {
                const bool sw = k_hi < k_lo;
                const int ta = sw ? k_hi : k_lo, tb = sw ? k_lo : k_hi; const float ga = sw ? g_hi : g_lo, gb = sw ? g_lo : g_hi;
                k_lo = ta; k_hi = tb; g_lo = ga; g_hi = gb;
            } else {
                int p_lo, p_hi; float q_lo, q_hi;
                if (stride == 1) { p_lo = (int)xchg_u32<1>((unsigned)k_lo, lane); p_hi = (int)xchg_u32<1>((unsigned)k_hi, lane); q_lo = xchg_f32<1>(g_lo, lane); q_hi = xchg_f32<1>(g_hi, lane); }
                else if (stride == 2) { p_lo = (int)xchg_u32<2>((unsigned)k_lo, lane); p_hi = (int)xchg_u32<2>((unsigned)k_hi, lane); q_lo = xchg_f32<2>(g_lo, lane); q_hi = xchg_f32<2>(g_hi, lane); }
                else if (stride == 4) { p_lo = (int)xchg_u32<4>((unsigned)k_lo, lane); p_hi = (int)xchg_u32<4>((unsigned)k_hi, lane); q_lo = xchg_f32<4>(g_lo, lane); q_hi = xchg_f32<4>(g_hi, lane); }
                else if (stride == 8) { p_lo = (int)xchg_u32<8>((unsigned)k_lo, lane); p_hi = (int)xchg_u32<8>((unsigned)k_hi, lane); q_lo = xchg_f32<8>(g_lo, lane); q_hi = xchg_f32<8>(g_hi, lane); }
                else if (stride == 16) { p_lo = (int)xchg_u32<16>((unsigned)k_lo, lane); p_hi = (int)xchg_u32<16>((unsigned)k_hi, lane); q_lo = xchg_f32<16>(g_lo, lane); q_hi = xchg_f32<16>(g_hi, lane); }
                else { p_lo = (int)xchg_u32<32>((unsigned)k_lo, lane); p_hi = (int)xchg_u32<32>((unsigned)k_hi, lane); q_lo = xchg_f32<32>(g_lo, lane); q_hi = xchg_f32<32>(g_hi, lane); }
                const bool lower = (lane & stride) == 0;
                const bool asc_lo = (size >= 64) ? true : ((lane & size) == 0);
                const bool asc_hi = (size == 128) ? true : ((size == 64) ? false : ((lane & size) == 0));
                const bool min_lo = (lower == asc_lo), min_hi = (lower == asc_hi);
                const bool take_lo = min_lo ? (p_lo < k_lo) : (p_lo > k_lo);
                const bool take_hi = min_hi ? (p_hi < k_hi) : (p_hi > k_hi);
                k_lo = take_lo ? p_lo : k_lo; g_lo = take_lo ? q_lo : g_lo;
                k_hi = take_hi ? p_hi : k_hi; g_hi = take_hi ? q_hi : g_hi;
            }
        }
    }
}
__device__ __forceinline__ void peer_finish_row(const Params& p, const float* ada, int tok, int d0, const float (&acc)[16], bool do_store) {
    const int b = tok >> 12;
    float* orow = p.out + (size_t)tok * 1024 + d0;
    float xo[16]; float ss = 0.f;
#pragma unroll
    for (int q = 0; q < 4; ++q) {
        const f32x4 xv = *(const f32x4*)(orow + 4 * q), gv = *(const f32x4*)(ada + b * 6144 + 5120 + d0 + 4 * q);
#pragma unroll
        for (int i = 0; i < 4; ++i) { const float v = xv[i] + gv[i] * acc[q * 4 + i]; xo[q * 4 + i] = v; ss += v * v; }
    }
    ss = wave_sum(ss);
    const float rstd = rsqrtf(ss * (1.f / 1024.f) + 1e-6f);
#pragma unroll
    for (int q = 0; q < 4; ++q) {
        const f32x4 fg = *(const f32x4*)(p.final_g + d0 + 4 * q);
        f32x4 ov;
#pragma unroll
        for (int i = 0; i < 4; ++i) ov[i] = xo[q * 4 + i] * rstd * fg[i];
        if (do_store) *(f32x4*)(orow + 4 * q) = ov;
    }
}
struct PeTok { unsigned hq[4]; float ascale; int acc[16]; int csum; int k_lo, k_hi; float g_lo, g_hi; };
__device__ __forceinline__ void pe_tok_init(PeTok& t, const bf16_t* H2, const int* EI, const float* GW, int tok, int d0, int lane) {
    const u32x4 h0 = *(const u32x4*)(H2 + (size_t)tok * 1024 + d0), h1 = *(const u32x4*)(H2 + (size_t)tok * 1024 + d0 + 8);
    float hx[16];
#pragma unroll
    for (int i = 0; i < 4; ++i) { hx[2 * i] = lo16(h0[i]); hx[2 * i + 1] = hi16(h0[i]); hx[8 + 2 * i] = lo16(h1[i]); hx[8 + 2 * i + 1] = hi16(h1[i]); }
    float am = 0.f;
#pragma unroll
    for (int i = 0; i < 16; ++i) am = fmaxf(am, fabsf(hx[i]));
    am = fmaxf(wave_max_dpp(am), 1e-20f);
    const float hs = 127.f / am;
#pragma unroll
    for (int i = 0; i < 4; ++i) t.hq[i] = pack4_i8(hx[4 * i], hx[4 * i + 1], hx[4 * i + 2], hx[4 * i + 3], hs);
    t.ascale = am * (1.f / (127.f * PEER_SU));
#pragma unroll
    for (int i = 0; i < 16; ++i) t.acc[i] = 0;
    t.csum = 0;
    t.k_lo = EI[(size_t)tok * 128 + lane]; t.k_hi = EI[(size_t)tok * 128 + 64 + lane];
    t.g_lo = GW[(size_t)tok * 128 + lane]; t.g_hi = GW[(size_t)tok * 128 + 64 + lane];
    sort_pairs128(t.k_lo, t.k_hi, t.g_lo, t.g_hi, lane);
}
__device__ __forceinline__ void pe_tok_result(const PeTok& t, float (&acc)[16]) {
    const int coff = 8 * t.csum;
#pragma unroll
    for (int i = 0; i < 4; ++i)
#pragma unroll
        for (int j = 0; j < 4; ++j) acc[8 * (i >> 1) + 2 * j + (i & 1)] = (float)(t.acc[4 * i + j] - coff) * (1.f / (PEER_SC * PEER_SV));
}
typedef short s16x2 __attribute__((ext_vector_type(2)));
__device__ __forceinline__ int dot2_i16(unsigned a, int b, int c) { return __builtin_amdgcn_sdot2(__builtin_bit_cast(s16x2, a), __builtin_bit_cast(s16x2, b), c, false); }
__device__ __forceinline__ void pe_vgroup(PeTok& t, const u32x2 (&vv)[8], int base, int c0, int c1, int c2, int c3) {
    const int c01 = (c0 & 0xFFFF) | (c1 << 16), c23 = (c2 & 0xFFFF) | (c3 << 16);
    t.csum += c0 + c1 + c2 + c3;
#pragma unroll
    for (int i = 0; i < 4; ++i) {
        const unsigned w0 = (vv[base][i >> 1] >> (4 * (i & 1))) & 0x0F0F0F0Fu, w1 = (vv[base + 1][i >> 1] >> (4 * (i & 1))) & 0x0F0F0F0Fu;
        const unsigned w2_ = (vv[base + 2][i >> 1] >> (4 * (i & 1))) & 0x0F0F0F0Fu, w3 = (vv[base + 3][i >> 1] >> (4 * (i & 1))) & 0x0F0F0F0Fu;
        t.acc[4 * i + 0] = dot2_i16(__builtin_amdgcn_perm(w3, w2_, 0x0c040c00u), c23, dot2_i16(__builtin_amdgcn_perm(w1, w0, 0x0c040c00u), c01, t.acc[4 * i + 0]));
        t.acc[4 * i + 1] = dot2_i16(__builtin_amdgcn_perm(w3, w2_, 0x0c050c01u), c23, dot2_i16(__builtin_amdgcn_perm(w1, w0, 0x0c050c01u), c01, t.acc[4 * i + 1]));
        t.acc[4 * i + 2] = dot2_i16(__builtin_amdgcn_perm(w3, w2_, 0x0c060c02u), c23, dot2_i16(__builtin_amdgcn_perm(w1, w0, 0x0c060c02u), c01, t.acc[4 * i + 2]));
        t.acc[4 * i + 3] = dot2_i16(__builtin_amdgcn_perm(w3, w2_, 0x0c070c03u), c23, dot2_i16(__builtin_amdgcn_perm(w1, w0, 0x0c070c03u), c01, t.acc[4 * i + 3]));
    }
}
#ifndef PE_SYNC_MASK
#define PE_SYNC_MASK 31
#endif
__device__ __forceinline__ void peer_experts(const Params& p, bool do_store) {
    const int wid = threadIdx.x >> 6, lane = threadIdx.x & 63;
    const bf16_t* H2 = (const bf16_t*)(p.ws + OFF_ACT); const unsigned char* UT = p.ws + OFF_UT; const unsigned char* VT = p.ws + OFF_VT;
    const int* EI = (const int*)(p.ws + OFF_EIDX); const float* GW = (const float*)(p.ws + OFF_GW); const float* ada = (const float*)(p.ws + OFF_ADA);
    const int d0 = 16 * lane;
    const int stride = gridDim.x * 8;
    for (int tok0 = blockIdx.x * 8 + wid; tok0 < NTOK; tok0 += 4 * stride) {
        __syncthreads();
        int tk[4]; bool has[4];
#pragma unroll
        for (int i = 0; i < 4; ++i) { has[i] = (tok0 + i * stride) < NTOK; tk[i] = has[i] ? tok0 + i * stride : tok0; }
        PeTok T[4];
#pragma unroll
        for (int i = 0; i < 4; ++i) pe_tok_init(T[i], H2, EI, GW, tk[i], d0, lane);
        u32x4 uX[8], uY[8]; u32x2 vX[8], vY[8]; float gX[8], gY[8];
#define PE_ISSUE(UU, VV, GG, K0, A, B) do { _Pragma("unroll") for (int q = 0; q < 4; ++q) { \
            const unsigned ea_ = (unsigned)__builtin_amdgcn_readlane((K0) < 64 ? A.k_lo : A.k_hi, ((K0) + q) & 63), eb_ = (unsigned)__builtin_amdgcn_readlane((K0) < 64 ? B.k_lo : B.k_hi, ((K0) + q) & 63); \
            GG[q] = rlanef((K0) < 64 ? A.g_lo : A.g_hi, ((K0) + q) & 63); GG[4 + q] = rlanef((K0) < 64 ? B.g_lo : B.g_hi, ((K0) + q) & 63); \
            UU[q] = *(const u32x4*)(UT + (size_t)(ea_ * 1024u) + (unsigned)d0); VV[q] = *(const u32x2*)(VT + (size_t)(ea_ * 512u) + 8u * (unsigned)lane); \
            UU[4 + q] = *(const u32x4*)(UT + (size_t)(eb_ * 1024u) + (unsigned)d0); VV[4 + q] = *(const u32x2*)(VT + (size_t)(eb_ * 512u) + 8u * (unsigned)lane); } } while (0)
#define PE_COMPUTE(UU, VV, GG, A, B) do { \
            float sv[8]; \
            _Pragma("unroll") for (int q = 0; q < 8; ++q) { int d_ = 0; \
                _Pragma("unroll") for (int i = 0; i < 4; ++i) d_ = __builtin_amdgcn_sdot4((int)UU[q][i], (int)(q < 4 ? A.hq[i] : B.hq[i]), d_, false); \
                sv[q] = (float)d_ * (q < 4 ? A.ascale : B.ascale); } \
            float t4[4]; \
            _Pragma("unroll") for (int i = 0; i < 4; ++i) { const u32x2 r_ = __builtin_amdgcn_permlane32_swap(__float_as_uint(sv[i]), __float_as_uint(sv[i + 4]), false, false); t4[i] = __uint_as_float(r_[0]) + __uint_as_float(r_[1]); } \
            float w2[2]; \
            _Pragma("unroll") for (int i = 0; i < 2; ++i) { const u32x2 r_ = __builtin_amdgcn_permlane16_swap(__float_as_uint(t4[i]), __float_as_uint(t4[i + 2]), false, false); w2[i] = __uint_as_float(r_[0]) + __uint_as_float(r_[1]); } \
            _Pragma("unroll") for (int i = 0; i < 2; ++i) { w2[i] += dppf(w2[i], 0xB1); w2[i] += dppf(w2[i], 0x4E); w2[i] += dppf(w2[i], 0x141); w2[i] += dppf(w2[i], 0x140); } \
            float mine = 0.f, gmine = 0.f; \
            _Pragma("unroll") for (int q = 0; q < 8; ++q) { \
                const float tq = rlanef(w2[q & 1], 16 * (((q >> 1) & 1) + 2 * (q >> 2))); \
                mine = ((lane & 7) == q) ? tq : mine; gmine = ((lane & 7) == q) ? GG[q] : gmine; } \
            const float cmine = gmine * gelu_as(mine); \
            const int cqm = (int)fminf(fmaxf(rintf(cmine * PEER_SC), -16383.f), 16383.f);        \
            pe_vgroup(A, VV, 0, __builtin_amdgcn_readlane(cqm, 0), __builtin_amdgcn_readlane(cqm, 1), __builtin_amdgcn_readlane(cqm, 2), __builtin_amdgcn_readlane(cqm, 3)); \
            pe_vgroup(B, VV, 4, __builtin_amdgcn_readlane(cqm, 4), __builtin_amdgcn_readlane(cqm, 5), __builtin_amdgcn_readlane(cqm, 6), __builtin_amdgcn_readlane(cqm, 7)); } while (0)
        PE_ISSUE(uX, vX, gX, 0, T[0], T[1]);
#pragma unroll 1
        for (int k0 = 0; k0 < 128; k0 += 4) {
            if ((k0 & PE_SYNC_MASK) == 0 && k0) __syncthreads();
            PE_ISSUE(uY, vY, gY, k0, T[2], T[3]);
            PE_COMPUTE(uX, vX, gX, T[0], T[1]);
            if (k0 + 4 < 128) PE_ISSUE(uX, vX, gX, k0 + 4, T[0], T[1]);
            PE_COMPUTE(uY, vY, gY, T[2], T[3]);
        }
#undef PE_ISSUE
#undef PE_COMPUTE
        float acc[16];
#pragma unroll
        for (int i = 0; i < 4; ++i) { pe_tok_result(T[i], acc); peer_finish_row(p, ada, tk[i], d0, acc, do_store && has[i]); }
    }
}

enum { PH_PREP = 0, PH_GEMM_IN, PH_MIX, PH_GEMM_OUT, PH_H2, PH_GEMM_Q, PH_ROUTE, PH_EXPERT, PH_COUNT };

typedef const __attribute__((address_space(4))) Params* KParams;
__device__ __forceinline__ const Params& kparams() {
    auto q = __builtin_amdgcn_kernarg_segment_ptr();
    asm volatile("" : "+s"(q));
    return *(const Params*)q;
}
#ifndef PHMASK
#define PHMASK 0xFFFF
#endif
#ifndef REP_PHASE
#define REP_PHASE -1
#endif
#define PHASE_BEGIN(idx) if (((PHMASK >> (idx)) & 1) && ph_lo <= (idx) && (idx) < ph_hi) { for (int rep = 0; rep < ((idx) == REP_PHASE ? 2 : 1); ++rep) { if ((idx) != ph_lo || rep) xcd_barrier(bar); const Params& p = kparams(); const int G = gridDim.x; (void)G; const bool last_rep = (rep == ((idx) == REP_PHASE ? 1 : 0)); (void)last_rep;
#define PHASE_END } }

__global__ void __launch_bounds__(NTHREADS, 2) hymba_fwd(Params p_) {
    extern __shared__ __attribute__((aligned(16))) unsigned char smem_raw[];
    LAS unsigned char* lds = (LAS unsigned char*)smem_raw;
    volatile LAS unsigned* xbw = (volatile LAS unsigned*)(lds + LDS_BYTES - 16);
    if (threadIdx.x == 0) { xbw[0] = 0u; xbw[1] = 0u; xbw[2] = 0u; xbw[3] = 0u; }
    __syncthreads();
    XcdBarrier bar = xcd_barrier_post((unsigned*)(p_.ws + OFF_CTL), xbw);
    const int ph_lo = p_.ph_lo, ph_hi = p_.ph_hi;

    PHASE_BEGIN(PH_PREP)
        phase0(p, lds);
        wg_wait((unsigned*)(p.ws + OFF_CTL), CNT_ADA, 192u);
        norm_mod_rows(p.x, p.norm1_g, (const float*)(p.ws + OFF_ADA), 0, 1024, (bf16_t*)(p.ws + OFF_ACT));
    PHASE_END
    PHASE_BEGIN(PH_GEMM_IN)
        {   pg8::StaticOrder S; S.init(NTOK, 3072, G, blockIdx.x);
            EpiInMain E; E.ws = p.ws; E.bias = (const float*)(p.ws + OFF_BIAS);
            pg8::gemm_phase(lds, pg8::Gemm{(const bf16_t*)(p.ws + OFF_ACT), (const bf16_t*)(p.ws + OFF_WIN), NTOK, 3072, 1024}, S, E); }
        {   pg8::StaticOrder S; S.init(NTOK, 256, G, blockIdx.x);
            EpiInTail E; E.ws = p.ws; E.bias = (const float*)(p.ws + OFF_BIAS) + 3072;
            pg8::gemm_phase(lds, pg8::Gemm{(const bf16_t*)(p.ws + OFF_ACT), (const bf16_t*)(p.ws + OFF_WIN) + (size_t)3072 * 1024, NTOK, 256, 1024}, S, E); }
        if (G > 64) { if ((int)blockIdx.x >= 64) convert_tables(p, (int)blockIdx.x - 64, G - 64); }
        else convert_tables(p, (int)blockIdx.x, G);
    PHASE_END
    PHASE_BEGIN(PH_MIX)
        unsigned* ctl = (unsigned*)(p.ws + OFF_CTL);
        for (int t = blockIdx.x; t < 1024; t += G) mlstm_passA(p, t, lds);
        wg_signal(ctl, CNT_MLA);
        __syncthreads();
        for (int t = blockIdx.x; t < 2048; t += G) {
            const int rnd = t >> 8, w = t & 255; const int bsel = rnd >> 1; const int qgs = (rnd & 1) ? w : (511 - w);
            dsa_task(p, (bsel << 9) | qgs, lds); }
        wg_wait(ctl, CNT_MLA, (unsigned)G);
        for (int t = blockIdx.x; t < 256; t += G) mlstm_scan(p, t, lds);
        wg_signal(ctl, CNT_SCAN);
        wg_wait(ctl, CNT_SCAN, (unsigned)G);
        for (int t = blockIdx.x; t < 1024; t += G) mlstm_passB(p, t, lds);
    PHASE_END
    PHASE_BEGIN(PH_GEMM_OUT)
        {   pg8::StaticOrder S; S.init(NTOK, 1024, G, blockIdx.x);
            EpiOut E; E.x = p.x; E.ada = (const float*)(p.ws + OFF_ADA); E.out = p.out;
            pg8::gemm_phase(lds, pg8::Gemm{(const bf16_t*)(p.ws + OFF_ACT), (const bf16_t*)(p.ws + OFF_WOUT), NTOK, 1024, 1024}, S, E); }
    PHASE_END
    PHASE_BEGIN(PH_H2) norm_mod_rows(p.out, p.norm2_g, (const float*)(p.ws + OFF_ADA), 3072, 4096, (bf16_t*)(p.ws + OFF_ACT)); PHASE_END
    PHASE_BEGIN(PH_GEMM_Q)
        {   pg8::StaticOrder S; S.init(NTOK, 1024, G, blockIdx.x);
            EpiQry E; E.O = (bf16_t*)(p.ws + OFF_QRY);
            pg8::gemm_phase(lds, pg8::Gemm{(const bf16_t*)(p.ws + OFF_ACT), (const bf16_t*)(p.ws + OFF_WPQ), NTOK, 1024, 1024}, S, E); }
    PHASE_END
    PHASE_BEGIN(PH_ROUTE) for (int t = blockIdx.x; t < 512; t += G) peer_route(p, t, lds); PHASE_END
    PHASE_BEGIN(PH_EXPERT) peer_experts(p, last_rep); PHASE_END
}

extern "C" void kernel_launch(void* const* d_in, const int* in_sizes, int n_in, void* d_out, int out_size, void* d_ws, size_t ws_size, hipStream_t stream) {
    static int grid = 0;
    if (grid == 0) {
        int dev = 0, cus = 0, per_cu = 0;
        if (hipGetDevice(&dev) != hipSuccess || hipDeviceGetAttribute(&cus, hipDeviceAttributeMultiprocessorCount, dev) != hipSuccess) { fprintf(stderr, "kernel_launch: device query failed\n"); grid = -1; return; }
        if (hipFuncSetAttribute((const void*)hymba_fwd, hipFuncAttributeMaxDynamicSharedMemorySize, LDS_BYTES) != hipSuccess) { fprintf(stderr, "kernel_launch: hipFuncSetAttribute failed\n"); grid = -1; return; }
        if (hipOccupancyMaxActiveBlocksPerMultiprocessor(&per_cu, (const void*)hymba_fwd, NTHREADS, LDS_BYTES) != hipSuccess || per_cu < 1) { fprintf(stderr, "kernel_launch: occupancy query says %d blocks/CU\n", per_cu); }
        (void)hipGetLastError();
        grid = cus;
        if (ws_size < WS_END || n_in != 17) { fprintf(stderr, "kernel_launch: unexpected sizes (ws %zu, n_in %d)\n", ws_size, n_in); grid = -1; return; }
    }
    if (grid < 0) return;
    (void)hipMemsetAsync((char*)d_ws + OFF_CTL, 0, CTL_BYTES, stream);
    Params p{};
    p.x = (const float*)d_in[0]; p.c = (const float*)d_in[1]; p.w_ada = (const float*)d_in[2]; p.b_ada = (const float*)d_in[3]; p.norm1_g = (const float*)d_in[4];
    p.w_in = (const float*)d_in[5]; p.b_in = (const float*)d_in[6]; p.conv_qk = (const float*)d_in[7]; p.out_norm_m = (const float*)d_in[8]; p.out_norm_a = (const float*)d_in[9];
    p.w_out = (const float*)d_in[10]; p.norm2_g = (const float*)d_in[11]; p.w_peer_q = (const float*)d_in[12]; p.sub_keys = (const float*)d_in[13]; p.peer_u = (const float*)d_in[14];
    p.peer_v = (const float*)d_in[15]; p.final_g = (const float*)d_in[16];
    p.out = (float*)d_out; p.ws = (unsigned char*)d_ws; p.ph_lo = 0; p.ph_hi = PH_COUNT;
    void* args[] = {&p};
    hipError_t e = hipLaunchCooperativeKernel((const void*)hymba_fwd, dim3(grid), dim3(NTHREADS), args, LDS_BYTES, stream);
    if (e != hipSuccess) fprintf(stderr, "kernel_launch: cooperative launch failed: %s (grid %d)\n", hipGetErrorString(e), grid);
}
```

```cpp
#include <hip/hip_runtime.h>
#include <stdint.h>
#define REP_PHASE -1
#define DSA_REP 0
#include <cstdio>

#define LAS __attribute__((address_space(3)))
typedef unsigned short bf16_t;
typedef short bf16x8 __attribute__((ext_vector_type(8)));
typedef float f32x4 __attribute__((ext_vector_type(4)));
typedef float f32x2 __attribute__((ext_vector_type(2)));
typedef float f32x16 __attribute__((ext_vector_type(16)));
typedef unsigned u32x4 __attribute__((ext_vector_type(4)));
typedef unsigned u32x2 __attribute__((ext_vector_type(2)));

constexpr int NTOK = 16384, DM = 1024, SEQ = 4096;
constexpr int NIN_PAD = 3328;
constexpr int LDS_BYTES = 163840 - 64;
constexpr int NTHREADS = 512;

constexpr size_t MiB = 1024 * 1024;
constexpr size_t OFF_CTL = 0;
constexpr size_t CTL_BYTES = 16384;
constexpr size_t OFF_ADA = 64 * 1024;
constexpr size_t OFF_BIAS = 192 * 1024;
constexpr size_t OFF_SK = 256 * 1024;
constexpr size_t OFF_WIN = 512 * 1024;
constexpr size_t OFF_WOUT = 7 * MiB;
constexpr size_t OFF_WPQ = 9 * MiB;
constexpr size_t OFF_ACT = 11 * MiB;
constexpr size_t OFF_MQ = 43 * MiB;
constexpr size_t OFF_MK = 59 * MiB;
constexpr size_t OFF_MV = 75 * MiB;
constexpr size_t OFF_MO = 91 * MiB;
constexpr size_t OFF_AQ = 107 * MiB;
constexpr size_t OFF_IQ = 123 * MiB;
constexpr size_t OFF_AK = 139 * MiB;
constexpr size_t OFF_AV = 141 * MiB;
constexpr size_t OFF_IK = 143 * MiB;
constexpr size_t OFF_GATE = 145 * MiB;
constexpr size_t OFF_KV = 146 * MiB;
constexpr size_t OFF_KS = 178 * MiB;
constexpr size_t OFF_MLOC = 178 * MiB + 512 * 1024;
constexpr size_t OFF_BLAST = OFF_MLOC + 4096;
constexpr size_t OFF_M0 = OFF_BLAST + 4096;
constexpr size_t OFF_UT = 179 * MiB;
constexpr size_t OFF_VT = 195 * MiB;
constexpr size_t WS_END = 211 * MiB;
constexpr float PEER_SU = 812.8f;
constexpr float PEER_SV = 8.443f;
constexpr float PEER_SC = 2048.f;
constexpr size_t OFF_QRY = OFF_MQ;
constexpr size_t OFF_EIDX = OFF_MV;
constexpr size_t OFF_GW = OFF_MV + 8 * MiB;

struct Params {
    const float* x; const float* c; const float* w_ada; const float* b_ada; const float* norm1_g;
    const float* w_in; const float* b_in; const float* conv_qk; const float* out_norm_m; const float* out_norm_a;
    const float* w_out; const float* norm2_g; const float* w_peer_q; const float* sub_keys; const float* peer_u;
    const float* peer_v; const float* final_g;
    float* out; unsigned char* ws;
    int ph_lo, ph_hi;
};

__device__ __forceinline__ int opaque_tid() { int t = threadIdx.x; asm volatile("" : "+v"(t)); return t; }
__device__ __forceinline__ float bf2f(unsigned short b) { return __uint_as_float(((unsigned)b) << 16); }
__device__ __forceinline__ unsigned pack2(float lo, float hi) { unsigned r; asm("v_cvt_pk_bf16_f32 %0, %1, %2" : "=v"(r) : "v"(lo), "v"(hi)); return r; }
__device__ __forceinline__ unsigned short f2bf(float f) { return (unsigned short)(pack2(f, 0.f) & 0xffffu); }
__device__ __forceinline__ unsigned short f2bf_sw(float f) { unsigned u = __float_as_uint(f); u += 0x7FFFu + ((u >> 16) & 1u); return (unsigned short)(u >> 16); }
__device__ __forceinline__ float lo16(unsigned w) { return __uint_as_float(w << 16); }
__device__ __forceinline__ float hi16(unsigned w) { return __uint_as_float(w & 0xffff0000u); }
__device__ __forceinline__ float wave_sum_dpp(float v);
__device__ __forceinline__ float wave_sum(float v) { return wave_sum_dpp(v); }
__device__ __forceinline__ int wave_sum_i32_uniform(int v) {
    v += __builtin_amdgcn_update_dpp(0, v, 0xB1, 0xF, 0xF, true);
    v += __builtin_amdgcn_update_dpp(0, v, 0x4E, 0xF, 0xF, true);
    v += __builtin_amdgcn_update_dpp(0, v, 0x141, 0xF, 0xF, true);
    v += __builtin_amdgcn_update_dpp(0, v, 0x140, 0xF, 0xF, true);
    return __builtin_amdgcn_readlane(v, 0) + __builtin_amdgcn_readlane(v, 16) + __builtin_amdgcn_readlane(v, 32) + __builtin_amdgcn_readlane(v, 48);
}
__device__ __forceinline__ float wave_scan_add(float v, int lane) {
#pragma unroll
    for (int o = 1; o < 64; o <<= 1) { const float t = __shfl_up(v, o); if (lane >= o) v += t; }
    return v;
}
__device__ __forceinline__ float wave_scan_max(float v, int lane) {
#pragma unroll
    for (int o = 1; o < 64; o <<= 1) { const float t = __shfl_up(v, o); if (lane >= o) v = fmaxf(v, t); }
    return v;
}
__device__ __forceinline__ float wave_max(float v) {
#pragma unroll
    for (int o = 32; o >= 1; o >>= 1) v = fmaxf(v, __shfl_xor(v, o));
    return v;
}
#define dppf(v, ctrl) __uint_as_float((unsigned)__builtin_amdgcn_update_dpp(0, (int)__float_as_uint(v), (ctrl), 0xF, 0xF, true))
__device__ __forceinline__ float rlanef(float v, int l) { return __uint_as_float((unsigned)__builtin_amdgcn_readlane((int)__float_as_uint(v), l)); }
__device__ __forceinline__ float wave_sum_dpp(float v) {
    v += dppf(v, 0xB1); v += dppf(v, 0x4E); v += dppf(v, 0x141); v += dppf(v, 0x140);
    return (rlanef(v, 0) + rlanef(v, 16)) + (rlanef(v, 32) + rlanef(v, 48));
}
__device__ __forceinline__ float wave_max_dpp(float v) {
    v = fmaxf(v, dppf(v, 0xB1)); v = fmaxf(v, dppf(v, 0x4E)); v = fmaxf(v, dppf(v, 0x141)); v = fmaxf(v, dppf(v, 0x140));
    return fmaxf(fmaxf(rlanef(v, 0), rlanef(v, 16)), fmaxf(rlanef(v, 32), rlanef(v, 48)));
}
template <int STRIDE>
__device__ __forceinline__ unsigned xchg_u32(unsigned x, int lane) {
    if constexpr (STRIDE == 1) return (unsigned)__builtin_amdgcn_update_dpp(0, (int)x, 0xB1, 0xF, 0xF, true);
    else if constexpr (STRIDE == 2) return (unsigned)__builtin_amdgcn_update_dpp(0, (int)x, 0x4E, 0xF, 0xF, true);
    else if constexpr (STRIDE == 4) {
        const unsigned up = (unsigned)__builtin_amdgcn_update_dpp(0, (int)x, 0x104, 0xF, 0xF, true);
        const unsigned dn = (unsigned)__builtin_amdgcn_update_dpp(0, (int)x, 0x114, 0xF, 0xF, true);
        return (lane & 4) ? dn : up;
    }
    else if constexpr (STRIDE == 8) return (unsigned)__builtin_amdgcn_update_dpp(0, (int)x, 0x128, 0xF, 0xF, true);
    else if constexpr (STRIDE == 16) { const u32x2 r_ = __builtin_amdgcn_permlane16_swap(x, x, false, false); return (lane & 16) ? r_[0] : r_[1]; }
    else { const u32x2 r_ = __builtin_amdgcn_permlane32_swap(x, x, false, false); return (lane & 32) ? r_[0] : r_[1]; }
}
template <int STRIDE> __device__ __forceinline__ float xchg_f32(float x, int lane) { return __uint_as_float(xchg_u32<STRIDE>(__float_as_uint(x), lane)); }
__device__ __forceinline__ float row16_sum(float v) { v += dppf(v, 0xB1); v += dppf(v, 0x4E); v += dppf(v, 0x141); v += dppf(v, 0x140); return v; }
__device__ __forceinline__ float oct_sum(float v) { v += dppf(v, 0xB1); v += dppf(v, 0x4E); v += dppf(v, 0x141); return v; }
__device__ __forceinline__ float siluf(float x) { return x * __builtin_amdgcn_rcpf(1.f + __expf(-x)); }
__device__ __forceinline__ float sigmoidf_(float x) { return __builtin_amdgcn_rcpf(1.f + __expf(-x)); }
__device__ __forceinline__ float logsigmoidf_(float x) { return fminf(x, 0.f) - log1pf(__expf(-fabsf(x))); }

#define XB_TMO      128
#define XB_XCNT(j)  (256  + 64 * (j))
#define XB_XSUB(j)  (1280 + 64 * (j))
#define XB_XGEN(j)  (2304 + 64 * (j))
#define XB_TOP      3328
#define XB_TOPGEN   3392
#define XCD_BAR_WORDS 3456
#define XB_SPIN_CAP (1u << 22)
__device__ __forceinline__ unsigned xb_ld(unsigned* p)              { return __hip_atomic_load(p, __ATOMIC_RELAXED, __HIP_MEMORY_SCOPE_AGENT); }
__device__ __forceinline__ unsigned xb_add(unsigned* p, unsigned v) { return __hip_atomic_fetch_add(p, v, __ATOMIC_RELAXED, __HIP_MEMORY_SCOPE_AGENT); }
__device__ __forceinline__ unsigned xb_xcc_id() { return (unsigned)__builtin_amdgcn_s_getreg((3 << 11) | 20) & 0xFu; }
#define XB_SPIN(cond, bar) do { unsigned _sp = 0; while (cond) { __builtin_amdgcn_s_sleep(1); \
    if ((++_sp & 255u) == 0u) { if (xb_ld(&(bar)[XB_TMO])) break; if (_sp > XB_SPIN_CAP) { atomicAdd(&(bar)[XB_TMO], 1u); break; } } } } while (0)
struct XcdBarrier { unsigned* bar; unsigned x; volatile LAS unsigned* st; };
__device__ __forceinline__ XcdBarrier xcd_barrier_post(unsigned* bar, volatile LAS unsigned* st) {
    XcdBarrier b; b.bar = bar; b.x = xb_xcc_id(); b.st = st;
    if (threadIdx.x == 0) (void)xb_add(&bar[XB_XCNT(b.x)], 1u);
    return b;
}
__device__ __forceinline__ void xcd_barrier_complete(unsigned* bar, unsigned x, unsigned& nloc, unsigned& nx) {
    const unsigned G = gridDim.x * gridDim.y * gridDim.z;
    unsigned sum, cnt, mine, sp = 0u;
    for (;;) {
        sum = 0u; cnt = 0u; mine = 0u;
#pragma unroll
        for (unsigned j = 0; j < 16; ++j) { const unsigned c = xb_ld(&bar[XB_XCNT(j)]); sum += c; cnt += (c > 0u) ? 1u : 0u; mine = (j == x) ? c : mine; }
        if (sum == G) break;
        __builtin_amdgcn_s_sleep(1);
        if ((++sp & 255u) == 0u) { if (xb_ld(&bar[XB_TMO])) break; if (sp > XB_SPIN_CAP) { atomicAdd(&bar[XB_TMO], 1u); break; } }
    }
    nloc = mine > 0u ? mine : 1u; nx = cnt > 0u ? cnt : 1u;
}
__device__ __forceinline__ void xcd_barrier(const XcdBarrier& b) {
    asm volatile("s_waitcnt vmcnt(0)" ::: "memory");
    __syncthreads();
    if (threadIdx.x == 0) {
        unsigned* bar = b.bar;
        __builtin_amdgcn_s_waitcnt(0);
        unsigned nloc = b.st[0], nx = b.st[1];
        if (nloc == 0u) { xcd_barrier_complete(bar, b.x, nloc, nx); b.st[0] = nloc; b.st[1] = nx; }
        const unsigned old = xb_add(&bar[XB_XSUB(b.x)], 1u);
        const unsigned gen = old / nloc;
        if (old + 1u == (gen + 1u) * nloc) {
            __builtin_amdgcn_fence(__ATOMIC_RELEASE, "agent");
            asm volatile("s_waitcnt vmcnt(0)" ::: "memory");
            const unsigned og = xb_add(&bar[XB_TOP], 1u);
            const unsigned tg = og / nx;
            if (og + 1u == (tg + 1u) * nx) xb_add(&bar[XB_TOPGEN], 1u);
            else XB_SPIN(xb_ld(&bar[XB_TOPGEN]) == tg, bar);
            __builtin_amdgcn_fence(__ATOMIC_ACQUIRE, "agent");
            xb_add(&bar[XB_XGEN(b.x)], 1u);
            asm volatile("s_waitcnt vmcnt(0)" ::: "memory");
        } else {
            XB_SPIN(xb_ld(&bar[XB_XGEN(b.x)]) == gen, bar);
            __builtin_amdgcn_fence(__ATOMIC_ACQUIRE, "agent");
            asm volatile("s_waitcnt vmcnt(0)" ::: "memory");
        }
    }
    __syncthreads();
}

#define CNT_ADA  3600
#define CNT_MLA  3664
#define CNT_SCAN 3728
__device__ __forceinline__ void wg_signal(unsigned* ctl, int word) {
    asm volatile("s_waitcnt vmcnt(0)" ::: "memory");
    __syncthreads();
    if (threadIdx.x == 0) {
        __builtin_amdgcn_fence(__ATOMIC_RELEASE, "agent");
        asm volatile("s_waitcnt vmcnt(0)" ::: "memory");
        (void)xb_add(&ctl[word], 1u);
    }
}
__device__ __forceinline__ void wg_wait(unsigned* ctl, int word, unsigned need) {
    if (threadIdx.x == 0) {
        XB_SPIN(xb_ld(&ctl[word]) < need, ctl);
        __builtin_amdgcn_fence(__ATOMIC_ACQUIRE, "agent");
        asm volatile("s_waitcnt vmcnt(0)" ::: "memory");
    }
    __syncthreads();
}

namespace pg8 {
constexpr int BM = 256, BK = 64, HALF = 128, HTB = HALF * BK * 2, STAGE_BYTES = 8 * HTB, NXCD = 8, WGM = 8;
__host__ __device__ __forceinline__ int lds_byte(int r, int c) { const int st = (r >> 4) * 2 + (c >> 5), rr = r & 15, cc = c & 31, ob = rr * 64 + cc * 2; return st * 1024 + (ob ^ (((ob >> 9) & 1) << 5)); }
__host__ __device__ __forceinline__ void stage_rc(int b, int& R, int& C) { const int st = b / 1024, sb = b % 1024, swz = sb ^ (((sb >> 9) & 1) << 5); R = (st >> 1) * 16 + swz / 64; C = (st & 1) * 32 + (swz % 64) / 2; }
__host__ __device__ __forceinline__ int perm32(int rho) { const int n = rho >> 4, i = rho & 15; return 8 * (i >> 2) + 4 * n + (i & 3); }
struct Unit { int pm, pn; };
struct Gemm { const bf16_t* A; const bf16_t* Bt; int M, N, K; };
struct StaticOrder {
    int nM, nN, nwg, G, c;
    __host__ __device__ void init(int M, int N, int G_, int c_) { nM = M / BM; nN = N / BM; nwg = nM * nN; G = G_; c = c_; }
    __host__ __device__ bool next(int i, Unit& u) const {
        const long L = (long)i * G + c; if (L >= nwg) return false;
        int wgid = (int)L; { const int q = nwg / NXCD, r = nwg % NXCD, xcd = wgid % NXCD, off = wgid / NXCD; wgid = (xcd < r ? xcd * (q + 1) : r * (q + 1) + (xcd - r) * q) + off; }
        const int nig = WGM * nN, gid = wgid / nig, fm = gid * WGM, gsz = (nM - fm) < WGM ? (nM - fm) : WGM;
        u.pm = fm + ((wgid % nig) % gsz); u.pn = (wgid % nig) / gsz; return true;
    }
    __device__ __forceinline__ void a_ready(const Unit&) const {}
    __device__ __forceinline__ void done(const Unit&) const {}
};
__device__ __forceinline__ unsigned cvt_pk_bf16(float lo, float hi) { unsigned r; asm volatile("v_cvt_pk_bf16_f32 %0, %1, %2" : "=v"(r) : "v"(lo), "v"(hi)); return r; }

template <class Epi, class Sched>
__device__ __forceinline__ void gemm_phase(LAS unsigned char* lds, const Gemm g, const Sched& S, const Epi& E) {
    const int tid = threadIdx.x, wid = __builtin_amdgcn_readfirstlane(tid >> 6), lane = tid & 63, wr = wid >> 2, wc = wid & 3, fr = lane & 15, fq = lane >> 4;
    const int K = g.K, nt = K / BK;
    unsigned voffA[2], voffB[2];
#pragma unroll
    for (int i = 0; i < 2; ++i) { int R, C; stage_rc(tid * 16 + i * 8192, R, C); const int Rb = Epi::PERM ? ((R & ~31) + perm32(R & 31)) : R;
        voffA[i] = (unsigned)(R * K + C) * 2u; voffB[i] = (unsigned)(Rb * K + C) * 2u; }
    const size_t kstep = (size_t)(BK * 2);
    const size_t hstep = (size_t)HALF * K * 2;
    const size_t tstep = 2 * hstep;
    const unsigned ldsw = (unsigned)wid * 1024u;
    const int aoff = lds_byte(wr * 64 + fr, fq * 8), boff = lds_byte(wc * 32 + fr, fq * 8);
#define PG8_SA(b, h) (((b) * 2 + (h)) * HTB)
#define PG8_SB(b, h) ((4 + (b) * 2 + (h)) * HTB)
#define PG8_STAGE(bufoff, gbase, voff) do { _Pragma("unroll") for (int _i = 0; _i < 2; ++_i) \
        __builtin_amdgcn_global_load_lds((const unsigned*)((const char*)(gbase) + (voff)[_i]), (LAS unsigned*)(lds + (bufoff) + ldsw + _i * 8192), 16, 0, 0); } while (0)
#define PG8_LDA(dst, b, h) do { _Pragma("unroll") for (int m = 0; m < 4; ++m) _Pragma("unroll") for (int k = 0; k < 2; ++k) dst[m][k] = *(const LAS bf16x8*)(lds + PG8_SA(b, h) + aoff + m * 2048 + k * 1024); } while (0)
#define PG8_LDB(dst, b, h) do { _Pragma("unroll") for (int n = 0; n < 2; ++n) _Pragma("unroll") for (int k = 0; k < 2; ++k) dst[n][k] = *(const LAS bf16x8*)(lds + PG8_SB(b, h) + boff + n * 2048 + k * 1024); } while (0)
#define PG8_MMA(ai, bj, At, Bt) do { __builtin_amdgcn_s_setprio(1); _Pragma("unroll") for (int m = 0; m < 4; ++m) _Pragma("unroll") for (int n = 0; n < 2; ++n) _Pragma("unroll") for (int k = 0; k < 2; ++k) \
        acc[ai][bj][m][n] = __builtin_amdgcn_mfma_f32_16x16x32_bf16(Bt[n][k], At[m][k], acc[ai][bj][m][n], 0, 0, 0); __builtin_amdgcn_s_setprio(0); } while (0)
#define PG8_WAIT_V(n) asm volatile("s_waitcnt vmcnt(" #n ")" ::: "memory")
#define PG8_WAIT_L(n) asm volatile("s_waitcnt lgkmcnt(" #n ")" ::: "memory")
#define PG8_BAR __builtin_amdgcn_s_barrier()
#define PG8_SCHED __builtin_amdgcn_sched_barrier(0)
    Unit cur, nxt; int ui = 0;
    if (!S.next(0, cur)) return;
    f32x4 acc[2][2][4][2];
#pragma unroll
    for (int a = 0; a < 2; ++a)
#pragma unroll
        for (int b = 0; b < 2; ++b)
#pragma unroll
            for (int m = 0; m < 4; ++m)
#pragma unroll
                for (int n = 0; n < 2; ++n) acc[a][b][m][n] = (f32x4){0.f, 0.f, 0.f, 0.f};
    bf16x8 At[4][2], B0[2][2], B1[2][2];
    const char* cA = (const char*)g.A + (size_t)cur.pm * tstep; const char* cB = (const char*)g.Bt + (size_t)cur.pn * tstep;
    S.a_ready(cur);
    PG8_STAGE(PG8_SB(0, 0), cB, voffB); PG8_STAGE(PG8_SA(0, 0), cA, voffA); PG8_STAGE(PG8_SB(0, 1), cB + hstep, voffB); PG8_STAGE(PG8_SA(0, 1), cA + hstep, voffA);
    if (wr == 1) PG8_BAR;
    PG8_WAIT_V(4); PG8_BAR;
    PG8_STAGE(PG8_SB(1, 0), cB + kstep, voffB); PG8_STAGE(PG8_SA(1, 0), cA + kstep, voffA); PG8_STAGE(PG8_SB(1, 1), cB + hstep + kstep, voffB);
    PG8_WAIT_V(6); PG8_BAR;
    for (;;) {
        const bool has_next = S.next(ui + 1, nxt);
        const char* nA = has_next ? (const char*)g.A + (size_t)nxt.pm * tstep : cA; const char* nB = has_next ? (const char*)g.Bt + (size_t)nxt.pn * tstep : cB;
        for (int t = 0; t < nt; t += 2) {
            const bool last = (t == nt - 2);
            const char* a1 = cA + (size_t)(t + 1) * kstep;
            const char* a2 = last ? nA : cA + (size_t)(t + 2) * kstep; const char* b2 = last ? nB : cB + (size_t)(t + 2) * kstep;
            const char* a3 = a2 + kstep; const char* b3 = b2 + kstep;
            if (last && has_next) S.a_ready(nxt);
            PG8_LDB(B0, 0, 0); PG8_SCHED; PG8_LDA(At, 0, 0); PG8_STAGE(PG8_SA(1, 1), a1 + hstep, voffA);
            PG8_WAIT_L(8); PG8_BAR; PG8_WAIT_L(0); PG8_MMA(0, 0, At, B0); PG8_BAR; PG8_SCHED;
            PG8_LDB(B1, 0, 1); PG8_STAGE(PG8_SB(0, 0), b2, voffB);
            PG8_BAR; PG8_WAIT_L(0); PG8_MMA(0, 1, At, B1); PG8_BAR;
            PG8_LDA(At, 0, 1); PG8_STAGE(PG8_SA(0, 0), a2, voffA);
            PG8_BAR; PG8_WAIT_L(0); PG8_MMA(1, 0, At, B0); PG8_BAR; PG8_SCHED;
            PG8_STAGE(PG8_SB(0, 1), b2 + hstep, voffB);
            PG8_WAIT_V(6); PG8_BAR; PG8_MMA(1, 1, At, B1); PG8_BAR;
            PG8_LDB(B0, 1, 0); PG8_SCHED; PG8_LDA(At, 1, 0); PG8_STAGE(PG8_SA(0, 1), a2 + hstep, voffA);
            PG8_WAIT_L(8); PG8_BAR; PG8_WAIT_L(0); PG8_MMA(0, 0, At, B0); PG8_BAR; PG8_SCHED;
            PG8_LDB(B1, 1, 1); PG8_STAGE(PG8_SB(1, 0), b3, voffB);
            PG8_BAR; PG8_WAIT_L(0); PG8_MMA(0, 1, At, B1); PG8_BAR;
            PG8_LDA(At, 1, 1); PG8_STAGE(PG8_SA(1, 0), a3, voffA);
            PG8_BAR; PG8_WAIT_L(0); PG8_MMA(1, 0, At, B0); PG8_BAR; PG8_SCHED;
            PG8_STAGE(PG8_SB(1, 1), b3 + hstep, voffB);
            PG8_WAIT_V(6); PG8_BAR; PG8_MMA(1, 1, At, B1); PG8_BAR;
        }
        asm volatile("s_nop 15\n\ts_nop 15" ::: "memory");
        E(acc, cur, wr, wc, fr, fq); S.done(cur);
        if (!has_next) break;
#pragma unroll
        for (int a = 0; a < 2; ++a)
#pragma unroll
            for (int b = 0; b < 2; ++b)
#pragma unroll
                for (int m = 0; m < 4; ++m)
#pragma unroll
                    for (int n = 0; n < 2; ++n) acc[a][b][m][n] = (f32x4){0.f, 0.f, 0.f, 0.f};
        cur = nxt; cA = nA; cB = nB; ++ui;
    }
    PG8_WAIT_V(0);
    if (wr == 0) PG8_BAR;
    PG8_BAR;
#undef PG8_SA
#undef PG8_SB
#undef PG8_STAGE
#undef PG8_LDA
#undef PG8_LDB
#undef PG8_MMA
#undef PG8_WAIT_V
#undef PG8_WAIT_L
#undef PG8_BAR
#undef PG8_SCHED
}
}

struct EpiInMain {
    static constexpr bool PERM = true;
    unsigned char* ws; const float* bias;
    __device__ __forceinline__ void operator()(const f32x4 (&acc)[2][2][4][2], const pg8::Unit& u, int wr, int wc, int fr, int fq) const {
        const int row0 = u.pm * 256 + wr * 64 + fr;
        const int cl0 = wc * 32 + 8 * fq;
        bf16_t* base = (bf16_t*)(ws + OFF_MQ + (size_t)(u.pn >> 1) * (16 * MiB)) + (u.pn & 1) * 256 + cl0;
        const float* bp = bias + u.pn * 256 + cl0;
#pragma unroll
        for (int bj = 0; bj < 2; ++bj) {
            const f32x4 b0 = *(const f32x4*)(bp + bj * 128), b1 = *(const f32x4*)(bp + bj * 128 + 4);
#pragma unroll
            for (int ai = 0; ai < 2; ++ai)
#pragma unroll
                for (int m = 0; m < 4; ++m) {
                    const f32x4 v0 = acc[ai][bj][m][0] + b0, v1 = acc[ai][bj][m][1] + b1;
                    u32x4 o; o[0] = pg8::cvt_pk_bf16(v0[0], v0[1]); o[1] = pg8::cvt_pk_bf16(v0[2], v0[3]); o[2] = pg8::cvt_pk_bf16(v1[0], v1[1]); o[3] = pg8::cvt_pk_bf16(v1[2], v1[3]);
                    *(u32x4*)(base + (size_t)(row0 + ai * 128 + m * 16) * 512 + bj * 128) = o;
                }
        }
    }
};
struct EpiInTail {
    static constexpr bool PERM = true;
    unsigned char* ws; const float* bias;
    __device__ __forceinline__ void operator()(const f32x4 (&acc)[2][2][4][2], const pg8::Unit& u, int wr, int wc, int fr, int fq) const {
        const int row0 = u.pm * 256 + wr * 64 + fr;
        const int cl0 = wc * 32 + 8 * fq;
#pragma unroll
        for (int bj = 0; bj < 2; ++bj) {
            const int cl = bj * 128 + cl0;
            if (cl >= 208) continue;
            const f32x4 b0 = *(const f32x4*)(bias + cl), b1 = *(const f32x4*)(bias + cl + 4);
            if (cl < 192) {
                bf16_t* dst = (bf16_t*)(ws + OFF_AK + (size_t)(cl >> 6) * (2 * MiB)) + (cl & 63);
#pragma unroll
                for (int ai = 0; ai < 2; ++ai)
#pragma unroll
                    for (int m = 0; m < 4; ++m) {
                        const f32x4 v0 = acc[ai][bj][m][0] + b0, v1 = acc[ai][bj][m][1] + b1;
                        u32x4 o; o[0] = pg8::cvt_pk_bf16(v0[0], v0[1]); o[1] = pg8::cvt_pk_bf16(v0[2], v0[3]); o[2] = pg8::cvt_pk_bf16(v1[0], v1[1]); o[3] = pg8::cvt_pk_bf16(v1[2], v1[3]);
                        const int row = row0 + ai * 128 + m * 16;
                        if (cl < 128) *(u32x4*)(dst + (size_t)row * 64) = o;
                        else *(u32x4*)((bf16_t*)(ws + OFF_IK) + (size_t)(row >> 5) * 2048 + (((cl - 128) >> 3) * 32 + (row & 31)) * 8) = o;
                    }
            } else {
                float* dst = (float*)(ws + OFF_GATE) + (cl - 192);
#pragma unroll
                for (int ai = 0; ai < 2; ++ai)
#pragma unroll
                    for (int m = 0; m < 4; ++m) {
                        float* d = dst + (size_t)(row0 + ai * 128 + m * 16) * 16;
                        *(f32x4*)d = acc[ai][bj][m][0] + b0; *(f32x4*)(d + 4) = acc[ai][bj][m][1] + b1;
                    }
            }
        }
    }
};
struct EpiOut {
    static constexpr bool PERM = false;
    const float* x; const float* ada; float* out;
    __device__ __forceinline__ void operator()(const f32x4 (&acc)[2][2][4][2], const pg8::Unit& u, int wr, int wc, int fr, int fq) const {
        const int row0 = u.pm * 256 + wr * 64 + fr, col0 = u.pn * 256 + wc * 32 + 4 * fq;
        const int b = (u.pm * 256) >> 12;
        f32x4 gv[2][2];
#pragma unroll
        for (int bj = 0; bj < 2; ++bj)
#pragma unroll
            for (int n = 0; n < 2; ++n) gv[bj][n] = *(const f32x4*)(ada + b * 6144 + 2048 + col0 + bj * 128 + n * 16);
#pragma unroll
        for (int ai = 0; ai < 2; ++ai)
#pragma unroll
            for (int m = 0; m < 4; ++m) {
                const size_t ro = (size_t)(row0 + ai * 128 + m * 16) * 1024 + col0;
#pragma unroll
                for (int bj = 0; bj < 2; ++bj)
#pragma unroll
                    for (int n = 0; n < 2; ++n) {
                        const f32x4 xv = *(const f32x4*)(x + ro + bj * 128 + n * 16);
                        *(f32x4*)(out + ro + bj * 128 + n * 16) = xv + gv[bj][n] * acc[ai][bj][m][n];
                    }
            }
    }
};
struct EpiQry {
    static constexpr bool PERM = true;
    bf16_t* O;
    __device__ __forceinline__ void operator()(const f32x4 (&acc)[2][2][4][2], const pg8::Unit& u, int wr, int wc, int fr, int fq) const {
        const int row0 = u.pm * 256 + wr * 64 + fr, col0 = u.pn * 256 + wc * 32 + 8 * fq;
#pragma unroll
        for (int ai = 0; ai < 2; ++ai)
#pragma unroll
            for (int m = 0; m < 4; ++m) {
                bf16_t* rowp = O + (size_t)(row0 + ai * 128 + m * 16) * 1024 + col0;
#pragma unroll
                for (int bj = 0; bj < 2; ++bj) {
                    const f32x4 v0 = acc[ai][bj][m][0], v1 = acc[ai][bj][m][1];
                    u32x4 o; o[0] = pg8::cvt_pk_bf16(v0[0], v0[1]); o[1] = pg8::cvt_pk_bf16(v0[2], v0[3]); o[2] = pg8::cvt_pk_bf16(v1[0], v1[1]); o[3] = pg8::cvt_pk_bf16(v1[2], v1[3]);
                    *(u32x4*)(rowp + bj * 128) = o;
                }
            }
    }
};

__device__ __forceinline__ int inperm_src(int n) {
    if (n < 2048) return n;
    if (n < 2560) return 2056 + (n - 2048);
    if (n < 3072) return 2696 + (n - 2560);
    if (n < 3136) return 2568 + (n - 3072);
    if (n < 3200) return 2632 + (n - 3136);
    if (n < 3264) return 3208 + (n - 3200);
    if (n < 3268) return 2048 + (n - 3264);
    if (n < 3272) return 2052 + (n - 3268);
    if (n < 3280) return 3272 + (n - 3272);
    return -1;
}
template <bool PERMUTE>
__device__ __forceinline__ void transpose_tile(const float* src, int ld, bf16_t* dst, int n0, int k0, LAS float* t) {
    const int tid = threadIdx.x;
    for (int i = tid; i < 4096; i += NTHREADS) {
        const int kk = i >> 6, nn = i & 63;
        const int sc = PERMUTE ? inperm_src(n0 + nn) : (n0 + nn);
        t[kk * 65 + nn] = sc >= 0 ? src[(size_t)(k0 + kk) * ld + sc] : 0.f;
    }
    __syncthreads();
    for (int i = tid; i < 2048; i += NTHREADS) {
        const int nn = i >> 5, kp = (i & 31) * 2;
        ((unsigned*)dst)[((size_t)(n0 + nn) * 1024 + k0 + kp) >> 1] = pack2(t[kp * 65 + nn], t[(kp + 1) * 65 + nn]);
    }
    __syncthreads();
}
__device__ __forceinline__ void convert_chunk(const float* src, bf16_t* dst, size_t e0, int n) {
    for (int i = threadIdx.x * 8; i < n; i += NTHREADS * 8) {
        const f32x4 a = *(const f32x4*)(src + e0 + i), b = *(const f32x4*)(src + e0 + i + 4);
        u32x4 o; o[0] = pack2(a[0], a[1]); o[1] = pack2(a[2], a[3]); o[2] = pack2(b[0], b[1]); o[3] = pack2(b[2], b[3]);
        *(u32x4*)(dst + e0 + i) = o;
    }
}
__device__ __forceinline__ unsigned pack4_fp8(float a, float b, float c, float d) {
    a = fminf(fmaxf(a, -448.f), 448.f); b = fminf(fmaxf(b, -448.f), 448.f); c = fminf(fmaxf(c, -448.f), 448.f); d = fminf(fmaxf(d, -448.f), 448.f);
    int w = 0;
    w = __builtin_amdgcn_cvt_pk_fp8_f32(a, b, w, false);
    w = __builtin_amdgcn_cvt_pk_fp8_f32(c, d, w, true);
    return (unsigned)w;
}
__device__ __forceinline__ void convert_chunk_fp8(const float* src, unsigned char* dst, size_t e0, int n, float scale) {
    for (int i = threadIdx.x * 16; i < n; i += NTHREADS * 16) {
        const f32x4 a = *(const f32x4*)(src + e0 + i), b = *(const f32x4*)(src + e0 + i + 4), c = *(const f32x4*)(src + e0 + i + 8), d = *(const f32x4*)(src + e0 + i + 12);
        u32x4 o; o[0] = pack4_fp8(a[0] * scale, a[1] * scale, a[2] * scale, a[3] * scale); o[1] = pack4_fp8(b[0] * scale, b[1] * scale, b[2] * scale, b[3] * scale);
        o[2] = pack4_fp8(c[0] * scale, c[1] * scale, c[2] * scale, c[3] * scale); o[3] = pack4_fp8(d[0] * scale, d[1] * scale, d[2] * scale, d[3] * scale);
        *(u32x4*)(dst + e0 + i) = o;
    }
}
__device__ __forceinline__ unsigned pack8_fp4(const f32x4 a, const f32x4 b, float scale) {
    float v[8] = {a[0] * scale, a[1] * scale, a[2] * scale, a[3] * scale, b[0] * scale, b[1] * scale, b[2] * scale, b[3] * scale};
#pragma unroll
    for (int i = 0; i < 8; ++i) v[i] = fminf(fmaxf(v[i], -6.f), 6.f);
    unsigned w = 0;
    w = __builtin_amdgcn_cvt_scalef32_pk_fp4_f32(w, v[0], v[1], 1.0f, 0);
    w = __builtin_amdgcn_cvt_scalef32_pk_fp4_f32(w, v[2], v[3], 1.0f, 1);
    w = __builtin_amdgcn_cvt_scalef32_pk_fp4_f32(w, v[4], v[5], 1.0f, 2);
    w = __builtin_amdgcn_cvt_scalef32_pk_fp4_f32(w, v[6], v[7], 1.0f, 3);
    return w;
}
__device__ __forceinline__ void convert_chunk_fp4(const float* src, unsigned char* dst, size_t e0, int n, float scale) {
    for (int i = threadIdx.x * 32; i < n; i += NTHREADS * 32) {
        u32x4 o;
#pragma unroll
        for (int k = 0; k < 4; ++k) o[k] = pack8_fp4(*(const f32x4*)(src + e0 + i + 8 * k), *(const f32x4*)(src + e0 + i + 8 * k + 4), scale);
        *(u32x4*)(dst + ((e0 + i) >> 1)) = o;
    }
}
__device__ __forceinline__ unsigned pack4_i8(float a, float b, float c, float d, float scale) {
    const int ia = (int)fminf(fmaxf(rintf(a * scale), -127.f), 127.f), ib = (int)fminf(fmaxf(rintf(b * scale), -127.f), 127.f);
    const int ic = (int)fminf(fmaxf(rintf(c * scale), -127.f), 127.f), id = (int)fminf(fmaxf(rintf(d * scale), -127.f), 127.f);
    return (unsigned)(ia & 0xFF) | ((unsigned)(ib & 0xFF) << 8) | ((unsigned)(ic & 0xFF) << 16) | ((unsigned)(id & 0xFF) << 24);
}
__device__ __forceinline__ void convert_chunk_i8(const float* src, unsigned char* dst, size_t e0, int n, float scale) {
    for (int i = threadIdx.x * 16; i < n; i += NTHREADS * 16) {
        const f32x4 a = *(const f32x4*)(src + e0 + i), b = *(const f32x4*)(src + e0 + i + 4), c = *(const f32x4*)(src + e0 + i + 8), d = *(const f32x4*)(src + e0 + i + 12);
        u32x4 o; o[0] = pack4_i8(a[0], a[1], a[2], a[3], scale); o[1] = pack4_i8(b[0], b[1], b[2], b[3], scale); o[2] = pack4_i8(c[0], c[1], c[2], c[3], scale); o[3] = pack4_i8(d[0], d[1], d[2], d[3], scale);
        *(u32x4*)(dst + e0 + i) = o;
    }
}
__device__ __forceinline__ unsigned pack8_i4(const f32x4 a, const f32x4 b, float scale) {
    unsigned w = 0;
#pragma unroll
    for (int k = 0; k < 4; ++k) {
        const int qa = (int)fminf(fmaxf(rintf(a[k] * scale), -7.f), 7.f) + 8, qb = (int)fminf(fmaxf(rintf(b[k] * scale), -7.f), 7.f) + 8;
        w |= (unsigned)qa << (4 * k); w |= (unsigned)qb << (4 * (k + 4));
    }
    return w;
}
__device__ __forceinline__ void convert_chunk_i4(const float* src, unsigned char* dst, size_t e0, int n, float scale) {
    for (int i = threadIdx.x * 32; i < n; i += NTHREADS * 32) {
        u32x4 o;
#pragma unroll
        for (int k = 0; k < 4; ++k) o[k] = pack8_i4(*(const f32x4*)(src + e0 + i + 8 * k), *(const f32x4*)(src + e0 + i + 8 * k + 4), scale);
        *(u32x4*)(dst + ((e0 + i) >> 1)) = o;
    }
}
__device__ __forceinline__ void convert_tables(const Params& p, int first, int stride) {
    for (int it = first; it < 1024; it += stride) {
        const int tsel = it >> 9; const size_t e0 = (size_t)(it & 511) * 32768;
        if (tsel) convert_chunk_i4(p.peer_v, p.ws + OFF_VT, e0, 32768, PEER_SV); else convert_chunk_i8(p.peer_u, p.ws + OFF_UT, e0, 32768, PEER_SU);
    }
}
__device__ __forceinline__ void phase0(const Params& p, LAS unsigned char* lds) {
    const int tid = threadIdx.x;
    float* ada = (float*)(p.ws + OFF_ADA);
    LAS float* lf = (LAS float*)lds;
    constexpr int N_ADA = 192, N_WIN = 52 * 16, N_WOUT = 256, N_WPQ = 256, N_SK = 4, N_BIAS = 1;
    constexpr int NITEMS = N_ADA + N_WIN + N_WOUT + N_WPQ + N_SK + N_BIAS;
    if (blockIdx.x < N_ADA) {
        {
            const int it = blockIdx.x;
            LAS float* sc = lf; LAS float* red = lf + 4096;
            for (int i = tid; i < 4096; i += NTHREADS) sc[i] = siluf(p.c[i]);
            __syncthreads();
            const int col = tid & 31, kg = tid >> 5, c0 = it * 32;
            float a0 = 0.f, a1 = 0.f, a2 = 0.f, a3 = 0.f;
            const float* w = p.w_ada + c0 + col;
#pragma unroll 8
            for (int j = 0; j < 64; ++j) { const int k = kg + 16 * j; const float wv = w[(size_t)k * 6144];
                a0 += sc[k] * wv; a1 += sc[1024 + k] * wv; a2 += sc[2048 + k] * wv; a3 += sc[3072 + k] * wv; }
            red[(kg * 4 + 0) * 32 + col] = a0; red[(kg * 4 + 1) * 32 + col] = a1; red[(kg * 4 + 2) * 32 + col] = a2; red[(kg * 4 + 3) * 32 + col] = a3;
            __syncthreads();
            if (tid < 128) { const int b = tid >> 5, cc = tid & 31; float s = 0.f;
                for (int g = 0; g < 16; ++g) s += red[(g * 4 + b) * 32 + cc];
                ada[b * 6144 + c0 + cc] = s + p.b_ada[c0 + cc]; }
        }
        wg_signal((unsigned*)(p.ws + OFF_CTL), CNT_ADA);
        __syncthreads();
    }
    for (int item = N_ADA + ((blockIdx.x + gridDim.x - N_ADA) % gridDim.x); item < NITEMS; item += gridDim.x) {
        int it = item;
        it -= N_ADA;
        if (it < N_WIN) { transpose_tile<true>(p.w_in, 3280, (bf16_t*)(p.ws + OFF_WIN), (it >> 4) * 64, (it & 15) * 64, lf); continue; }
        it -= N_WIN;
        if (it < N_WOUT) { transpose_tile<false>(p.w_out, 1024, (bf16_t*)(p.ws + OFF_WOUT), (it >> 4) * 64, (it & 15) * 64, lf); continue; }
        it -= N_WOUT;
        if (it < N_WPQ) { transpose_tile<false>(p.w_peer_q, 1024, (bf16_t*)(p.ws + OFF_WPQ), (it >> 4) * 64, (it & 15) * 64, lf); continue; }
        it -= N_WPQ;

        if (it < N_SK) { convert_chunk(p.sub_keys, (bf16_t*)(p.ws + OFF_SK), (size_t)it * 32768, 32768); continue; }
        it -= N_SK;
        { float* bias = (float*)(p.ws + OFF_BIAS);
          for (int n = tid; n < NIN_PAD; n += NTHREADS) { const int s = inperm_src(n); bias[n] = s >= 0 ? p.b_in[s] : 0.f; } }
    }
}

__device__ __forceinline__ void norm_mod_rows(const float* X, const float* g, const float* ada, int sh_off, int sc_off, bf16_t* out) {
    const int wid = threadIdx.x >> 6, lane = threadIdx.x & 63;
    for (int row = (blockIdx.x * 8 + wid) * 2; row < NTOK; row += gridDim.x * 16) {
        const int b = row >> 12;
        f32x4 v[2][4]; float ss[2] = {0.f, 0.f};
#pragma unroll
        for (int rr = 0; rr < 2; ++rr)
#pragma unroll
            for (int j = 0; j < 4; ++j) v[rr][j] = *(const f32x4*)(X + (size_t)(row + rr) * 1024 + 4 * (lane + 64 * j));
#pragma unroll
        for (int rr = 0; rr < 2; ++rr)
#pragma unroll
            for (int j = 0; j < 4; ++j) ss[rr] += v[rr][j][0] * v[rr][j][0] + v[rr][j][1] * v[rr][j][1] + v[rr][j][2] * v[rr][j][2] + v[rr][j][3] * v[rr][j][3];
        ss[0] = wave_sum(ss[0]); ss[1] = wave_sum(ss[1]);
        const float rstd0 = rsqrtf(ss[0] * (1.f / 1024.f) + 1e-6f), rstd1 = rsqrtf(ss[1] * (1.f / 1024.f) + 1e-6f);
#pragma unroll
        for (int j = 0; j < 4; ++j) {
            const int c = 4 * (lane + 64 * j);
            const f32x4 gg = *(const f32x4*)(g + c), sc = *(const f32x4*)(ada + b * 6144 + sc_off + c), sh = *(const f32x4*)(ada + b * 6144 + sh_off + c);
#pragma unroll
            for (int rr = 0; rr < 2; ++rr) {
                const float rstd = rr ? rstd1 : rstd0;
                float h[4];
#pragma unroll
                for (int i = 0; i < 4; ++i) h[i] = (v[rr][j][i] * rstd * gg[i]) * (1.f + sc[i]) + sh[i];
                u32x2 o; o[0] = pack2(h[0], h[1]); o[1] = pack2(h[2], h[3]);
                *(u32x2*)(out + (size_t)(row + rr) * 1024 + c) = o;
            }
        }
    }
}

__device__ __forceinline__ bf16x8 lds_frag(const LAS bf16_t* base, int row, int stride, int kofs) { return *(const LAS bf16x8*)(base + row * stride + kofs); }

__device__ __forceinline__ void conv_silu8(const bf16_t* src, const float* cw  , int row, int tpos, int col, float scale, float (&o)[8]) {
    float acc[8];
#pragma unroll
    for (int i = 0; i < 8; ++i) acc[i] = 0.f;
#pragma unroll
    for (int j = 0; j < 4; ++j) {
        const int tt = tpos - 3 + j;
        if (tt >= 0) {
            const u32x4 xv = *(const u32x4*)(src + (size_t)(row - 3 + j) * 512 + col);
            const f32x4 w0 = *(const f32x4*)(cw + j * 1024), w1 = *(const f32x4*)(cw + j * 1024 + 4);
            acc[0] += w0[0] * lo16(xv[0]); acc[1] += w0[1] * hi16(xv[0]); acc[2] += w0[2] * lo16(xv[1]); acc[3] += w0[3] * hi16(xv[1]);
            acc[4] += w1[0] * lo16(xv[2]); acc[5] += w1[1] * hi16(xv[2]); acc[6] += w1[2] * lo16(xv[3]); acc[7] += w1[3] * hi16(xv[3]);
        }
    }
#pragma unroll
    for (int i = 0; i < 8; ++i) o[i] = siluf(acc[i]) * scale;
}

__device__ __forceinline__ void mlstm_passA(const Params& p, int task, LAS unsigned char* lds) {
    const int tid = opaque_tid(), wid = tid >> 6, lane = tid & 63;
    const int bh = task >> 6, c = task & 63, b = bh >> 2, h = bh & 3;
    const int row0 = b * SEQ + c * 64;
    const float* gates = (const float*)(p.ws + OFF_GATE);
    const bf16_t* MK = (const bf16_t*)(p.ws + OFF_MK); const bf16_t* MV = (const bf16_t*)(p.ws + OFF_MV);
    LAS bf16_t* KT = (LAS bf16_t*)lds;
    LAS bf16_t* VT = KT + 128 * 72;
    LAS float* sc = (LAS float*)(VT + 128 * 72);
    LAS float* lsg = sc; LAS float* ig = sc + 64; LAS float* wloc = sc + 128; LAS float* misc = sc + 192;
    if (tid < 64) {
        const float f = gates[(size_t)(row0 + tid) * 16 + 4 + h], iv = gates[(size_t)(row0 + tid) * 16 + h];
        const float bc = wave_scan_add(logsigmoidf_(f), lane);
        const float bl = __shfl(bc, 63);
        const float a = bl - bc + iv;
        const float m = wave_max(a);
        lsg[tid] = bc; ig[tid] = iv; wloc[tid] = __expf(a - m);
        if (tid == 0) { misc[0] = m; misc[1] = bl; }
    }
    __syncthreads();
    for (int pc = tid; pc < 1024; pc += NTHREADS) {
        const int s = pc >> 4, dg = pc & 15;
        float kk[8];
        conv_silu8(MK, p.conv_qk + 512 + h * 128 + dg * 8, row0 + s, c * 64 + s, h * 128 + dg * 8, 1.f, kk);
#pragma unroll
        for (int i = 0; i < 8; ++i) KT[(dg * 8 + i) * 72 + s] = f2bf(kk[i]);
        const u32x4 vv = *(const u32x4*)(MV + (size_t)(row0 + s) * 512 + h * 128 + dg * 8);
        const float w = wloc[s];
#pragma unroll
        for (int i = 0; i < 4; ++i) { VT[(dg * 8 + 2 * i) * 72 + s] = f2bf(lo16(vv[i]) * w); VT[(dg * 8 + 2 * i + 1) * 72 + s] = f2bf(hi16(vv[i]) * w); }
    }
    __syncthreads();
    {
        const int r = lane & 15, g = lane >> 4;
        bf16x8 a0 = lds_frag(VT, wid * 16 + r, 72, 8 * g), a1 = lds_frag(VT, wid * 16 + r, 72, 8 * g + 32);
        bf16_t* KV = (bf16_t*)(p.ws + OFF_KV) + (size_t)task * 16384;
#pragma unroll
        for (int dt = 0; dt < 8; ++dt) {
            f32x4 acc = {0.f, 0.f, 0.f, 0.f};
            acc = __builtin_amdgcn_mfma_f32_16x16x32_bf16(a0, lds_frag(KT, dt * 16 + r, 72, 8 * g), acc, 0, 0, 0);
            acc = __builtin_amdgcn_mfma_f32_16x16x32_bf16(a1, lds_frag(KT, dt * 16 + r, 72, 8 * g + 32), acc, 0, 0, 0);
#pragma unroll
            for (int j = 0; j < 4; ++j) KV[(wid * 16 + 4 * g + j) * 128 + dt * 16 + r] = f2bf_sw(acc[j]);
        }
    }
    if (tid < 128) {
        float s = 0.f;
        for (int i = 0; i < 64; ++i) s += wloc[i] * bf2f(KT[tid * 72 + i]);
        ((float*)(p.ws + OFF_KS))[(size_t)task * 128 + tid] = s;
    }
    if (tid == 0) { ((float*)(p.ws + OFF_MLOC))[task] = misc[0]; ((float*)(p.ws + OFF_BLAST))[task] = misc[1]; }
    __syncthreads();
}

__device__ __forceinline__ void mlstm_scan(const Params& p, int item, LAS unsigned char* lds) {
    const int tid = opaque_tid();
    const int bh = item >> 4, blk = item & 15;
    LAS float* dec = (LAS float*)lds; LAS float* inj = dec + 64;
    if (tid == 0) {
        const float* ML = (const float*)(p.ws + OFF_MLOC); const float* BL = (const float*)(p.ws + OFF_BLAST); float* M0 = (float*)(p.ws + OFF_M0);
        float m = 0.f;
        for (int c = 0; c < 64; ++c) {
            const float ml = ML[bh * 64 + c], bl = BL[bh * 64 + c];
            if (blk == 0) M0[bh * 64 + c] = m;
            const float mn = fmaxf(bl + m, ml);
            dec[c] = __expf(bl + m - mn); inj[c] = __expf(ml - mn); m = mn;
        }
    }
    __syncthreads();
    unsigned* KV = (unsigned*)(p.ws + OFF_KV) + (size_t)bh * 64 * 8192 + blk * 512 + tid;
    float s0 = 0.f, s1 = 0.f;
#pragma unroll 8
    for (int c = 0; c < 64; ++c) {
        const unsigned w = KV[(size_t)c * 8192];
        KV[(size_t)c * 8192] = pack2(s0, s1);
        s0 = dec[c] * s0 + inj[c] * lo16(w); s1 = dec[c] * s1 + inj[c] * hi16(w);
    }
    if (blk == 0 && tid < 128) {
        float* KS = (float*)(p.ws + OFF_KS) + (size_t)bh * 64 * 128 + tid;
        float s = 0.f;
        for (int c = 0; c < 64; ++c) { const float k = KS[c * 128]; KS[c * 128] = s; s = dec[c] * s + inj[c] * k; }
    }
    __syncthreads();
}

__device__ __forceinline__ void mlstm_passB(const Params& p, int task, LAS unsigned char* lds) {
    const int tid = opaque_tid(), wid = tid >> 6, lane = tid & 63;
    const int bh = task >> 6, c = task & 63, b = bh >> 2, h = bh & 3;
    const int row0 = b * SEQ + c * 64;
    const float* gates = (const float*)(p.ws + OFF_GATE);
    const bf16_t* MQ = (const bf16_t*)(p.ws + OFF_MQ); const bf16_t* MK = (const bf16_t*)(p.ws + OFF_MK);
    const bf16_t* MV = (const bf16_t*)(p.ws + OFF_MV); const bf16_t* MO = (const bf16_t*)(p.ws + OFF_MO);
    LAS bf16_t* Q = (LAS bf16_t*)lds;
    LAS bf16_t* K = Q + 64 * 136;
    LAS bf16_t* VT = K + 64 * 136;
    LAS bf16_t* C0 = VT + 128 * 72;
    LAS bf16_t* P = C0 + 128 * 136;
    LAS float* sc = (LAS float*)(P + 64 * 72);
    LAS float* bcum = sc; LAS float* ig = sc + 64; LAS float* cs = sc + 128; LAS float* rb = sc + 192; LAS float* wint = sc + 256;
    LAS float* emt = sc + 320; LAS float* rinv = sc + 384; LAS float* qn = sc + 448; LAS float* n0 = sc + 512; LAS float* rowpart = sc + 640;
    LAS float* H = (LAS float*)lds;
    if (tid < 64) {
        const float f = gates[(size_t)(row0 + tid) * 16 + 4 + h], iv = gates[(size_t)(row0 + tid) * 16 + h];
        const float m0 = ((const float*)(p.ws + OFF_M0))[task];
        const float sc_ = wave_scan_add(logsigmoidf_(f), lane);
        const float cst = iv - sc_;
        const float pm = wave_scan_max(cst, lane);
        const float m_intra = sc_ + pm, m_inter = sc_ + m0, mt = fmaxf(m_inter, m_intra);
        bcum[tid] = sc_; ig[tid] = iv; cs[tid] = cst; rb[tid] = sc_ - mt; wint[tid] = __expf(m_inter - mt); emt[tid] = __expf(-mt);
    }
    if (tid >= 64 && tid < 192) n0[tid - 64] = ((const float*)(p.ws + OFF_KS))[(size_t)task * 128 + tid - 64];
    for (int pc = tid; pc < 1024; pc += NTHREADS) {
        const int s = pc >> 4, dg = pc & 15;
        float qq[8], kk[8];
        conv_silu8(MQ, p.conv_qk + h * 128 + dg * 8, row0 + s, c * 64 + s, h * 128 + dg * 8, 0.08838834764831845f, qq);
        conv_silu8(MK, p.conv_qk + 512 + h * 128 + dg * 8, row0 + s, c * 64 + s, h * 128 + dg * 8, 1.f, kk);
        u32x4 qo, ko;
#pragma unroll
        for (int i = 0; i < 4; ++i) { qo[i] = pack2(qq[2 * i], qq[2 * i + 1]); ko[i] = pack2(kk[2 * i], kk[2 * i + 1]); }
        *(LAS u32x4*)(Q + s * 136 + dg * 8) = qo; *(LAS u32x4*)(K + s * 136 + dg * 8) = ko;
        const u32x4 vv = *(const u32x4*)(MV + (size_t)(row0 + s) * 512 + h * 128 + dg * 8);
#pragma unroll
        for (int i = 0; i < 4; ++i) { VT[(dg * 8 + 2 * i) * 72 + s] = (bf16_t)(vv[i] & 0xffffu); VT[(dg * 8 + 2 * i + 1) * 72 + s] = (bf16_t)(vv[i] >> 16); }
    }
    {
        const bf16_t* KV = (const bf16_t*)(p.ws + OFF_KV) + (size_t)task * 16384;
        for (int pc = tid; pc < 2048; pc += NTHREADS) { const int e = pc >> 4, dg = pc & 15;
            *(LAS u32x4*)(C0 + e * 136 + dg * 8) = *(const u32x4*)(KV + e * 128 + dg * 8); }
    }
    __syncthreads();
    const int r = lane & 15, g = lane >> 4;
    {
        const int t = tid >> 3, part = tid & 7; float s = 0.f;
#pragma unroll
        for (int i = 0; i < 16; ++i) s += bf2f(Q[t * 136 + part * 16 + i]) * n0[part * 16 + i];
        s = oct_sum(s);
        if (part == 0) qn[t] = s;
    }
    {
        const int rt = wid >> 1;
#pragma unroll
        for (int cc = 0; cc < 2; ++cc) {
            const int ct = 2 * (wid & 1) + cc;
            f32x4 acc = {0.f, 0.f, 0.f, 0.f};
#pragma unroll
            for (int ks = 0; ks < 4; ++ks)
                acc = __builtin_amdgcn_mfma_f32_16x16x32_bf16(lds_frag(Q, rt * 16 + r, 136, 8 * g + 32 * ks), lds_frag(K, ct * 16 + r, 136, 8 * g + 32 * ks), acc, 0, 0, 0);
            const int scol = ct * 16 + r; const float csv = cs[scol];
#pragma unroll
            for (int j = 0; j < 4; ++j) {
                const int t = rt * 16 + 4 * g + j;
                float pv = (scol <= t) ? acc[j] * __expf(rb[t] + csv) : 0.f;
                P[t * 72 + scol] = f2bf(pv);
                pv = row16_sum(pv);
                if (r == 0) rowpart[t * 4 + ct] = pv;
            }
        }
    }
    __syncthreads();
    if (tid < 64) {
        const float den = rowpart[tid * 4] + rowpart[tid * 4 + 1] + rowpart[tid * 4 + 2] + rowpart[tid * 4 + 3] + wint[tid] * qn[tid];
        rinv[tid] = 1.f / fmaxf(fabsf(den), emt[tid]);
    }
    f32x4 hacc[4];
    {
        const int rt = wid >> 1;
#pragma unroll
        for (int ee = 0; ee < 4; ++ee) {
            const int et = 4 * (wid & 1) + ee;
            f32x4 a1 = {0.f, 0.f, 0.f, 0.f}, a2 = {0.f, 0.f, 0.f, 0.f};
#pragma unroll
            for (int ks = 0; ks < 2; ++ks)
                a1 = __builtin_amdgcn_mfma_f32_16x16x32_bf16(lds_frag(P, rt * 16 + r, 72, 8 * g + 32 * ks), lds_frag(VT, et * 16 + r, 72, 8 * g + 32 * ks), a1, 0, 0, 0);
#pragma unroll
            for (int ks = 0; ks < 4; ++ks)
                a2 = __builtin_amdgcn_mfma_f32_16x16x32_bf16(lds_frag(Q, rt * 16 + r, 136, 8 * g + 32 * ks), lds_frag(C0, et * 16 + r, 136, 8 * g + 32 * ks), a2, 0, 0, 0);
#pragma unroll
            for (int j = 0; j < 4; ++j) { const int t = rt * 16 + 4 * g + j; hacc[ee][j] = a1[j] + wint[t] * a2[j]; }
        }
    }
    __syncthreads();
    {
        const int rt = wid >> 1;
#pragma unroll
        for (int ee = 0; ee < 4; ++ee) {
            const int et = 4 * (wid & 1) + ee;
#pragma unroll
            for (int j = 0; j < 4; ++j) { const int t = rt * 16 + 4 * g + j; H[t * 132 + et * 16 + r] = hacc[ee][j] * rinv[t]; }
        }
    }
    __syncthreads();
    {
        const int t = tid >> 3, part = tid & 7;
        float hv[16]; float ss = 0.f;
#pragma unroll
        for (int i = 0; i < 16; ++i) { hv[i] = H[t * 132 + part * 16 + i]; ss += hv[i] * hv[i]; }
        ss = oct_sum(ss);
        const float rstd = rsqrtf(ss * (1.f / 128.f) + 1e-6f);
        const int col = h * 128 + part * 16;
        const u32x4 m0v = *(const u32x4*)(MO + (size_t)(row0 + t) * 512 + col), m1v = *(const u32x4*)(MO + (size_t)(row0 + t) * 512 + col + 8);
        float mo[16];
#pragma unroll
        for (int i = 0; i < 4; ++i) { mo[2 * i] = lo16(m0v[i]); mo[2 * i + 1] = hi16(m0v[i]); mo[8 + 2 * i] = lo16(m1v[i]); mo[8 + 2 * i + 1] = hi16(m1v[i]); }
        float o[16];
#pragma unroll
        for (int i = 0; i < 16; ++i) o[i] = (hv[i] * rstd * p.out_norm_m[col + i]) * sigmoidf_(mo[i]);
        u32x4 o0, o1;
#pragma unroll
        for (int i = 0; i < 4; ++i) { o0[i] = pack2(o[2 * i], o[2 * i + 1]); o1[i] = pack2(o[8 + 2 * i], o[8 + 2 * i + 1]); }
        bf16_t* dst = (bf16_t*)(p.ws + OFF_ACT) + (size_t)(row0 + t) * 1024 + col;
        *(u32x4*)dst = o0; *(u32x4*)(dst + 8) = o1;
    }
    __syncthreads();
}

__device__ __forceinline__ unsigned f2sortable(float f) { const unsigned u = __float_as_uint(f); return (u & 0x80000000u) ? ~u : (u | 0x80000000u); }
#define CNT4(c0, c1, c2, c3, a, b, cc, d, thr) asm volatile( \
    "v_cmp_ge_u32 s[40:41], %4, %8\n\tv_cmp_ge_u32 s[42:43], %5, %8\n\tv_cmp_ge_u32 s[44:45], %6, %8\n\tv_cmp_ge_u32 s[46:47], %7, %8\n\t" \
    "v_addc_co_u32 %0, s[48:49], 0, %0, s[40:41]\n\tv_addc_co_u32 %1, s[50:51], 0, %1, s[42:43]\n\tv_addc_co_u32 %2, s[52:53], 0, %2, s[44:45]\n\tv_addc_co_u32 %3, s[54:55], 0, %3, s[46:47]" \
    : "+v"(c0), "+v"(c1), "+v"(c2), "+v"(c3) : "v"(a), "v"(b), "v"(cc), "v"(d), "v"(thr) \
    : "s40", "s41", "s42", "s43", "s44", "s45", "s46", "s47", "s48", "s49", "s50", "s51", "s52", "s53", "s54", "s55")
template <int NR>
__device__ __forceinline__ int count_geN(const unsigned (&u)[NR], unsigned thr) {
    int c0 = 0, c1 = 0, c2 = 0, c3 = 0;
#pragma unroll
    for (int j = 0; j < NR; j += 4) CNT4(c0, c1, c2, c3, u[j], u[j + 1], u[j + 2], u[j + 3], thr);
    return (c0 + c1) + (c2 + c3);
}
template <int NR>
__device__ __forceinline__ void select_topk(const LAS float* srow, LAS int* lq, int t, int n, int lane) {
    unsigned u[NR];
#pragma unroll
    for (int j = 0; j < NR; ++j) { const int key = lane + 64 * j; u[j] = (key <= t) ? ((f2sortable(srow[key]) & 0xFFFFF000u) | (unsigned)(4095 - key)) : 0u; }
    unsigned tau = 1u;
    if (n > 256) {
        tau = 0u;
        for (int bit = 31; bit >= 0; --bit) {
            const unsigned cand = tau | (1u << bit);
            const int cnt = wave_sum_i32_uniform(count_geN<NR>(u, cand));
            if (cnt >= 256) { tau = cand; if (cnt == 256) break; }
        }
    }
    const int c = count_geN<NR>(u, tau);
    int pre = c;
#pragma unroll
    for (int o = 1; o < 64; o <<= 1) { const int v = __shfl_up(pre, o); if (lane >= o) pre += v; }
    int pos = pre - c;
    int keyv = lane;
#pragma unroll
    for (int j = 0; j < NR; ++j) {
        const bool sel = u[j] >= tau;
        const int slot = sel ? pos : (256 + lane);
        lq[slot] = keyv;
        pos += sel ? 1 : 0; keyv += 64;
    }
}
__device__ __forceinline__ unsigned wave_max_u32(unsigned v) {
    v = max(v, (unsigned)__builtin_amdgcn_update_dpp(0, (int)v, 0xB1, 0xF, 0xF, true)); v = max(v, (unsigned)__builtin_amdgcn_update_dpp(0, (int)v, 0x4E, 0xF, 0xF, true));
    v = max(v, (unsigned)__builtin_amdgcn_update_dpp(0, (int)v, 0x141, 0xF, 0xF, true)); v = max(v, (unsigned)__builtin_amdgcn_update_dpp(0, (int)v, 0x140, 0xF, 0xF, true));
    return max(max((unsigned)__builtin_amdgcn_readlane((int)v, 0), (unsigned)__builtin_amdgcn_readlane((int)v, 16)), max((unsigned)__builtin_amdgcn_readlane((int)v, 32), (unsigned)__builtin_amdgcn_readlane((int)v, 48)));
}
template <int NR>
__device__ __forceinline__ void select_topk2(LAS float* srow, LAS unsigned* buf, LAS int* lq, int t, int n, int lane) {
    unsigned u[NR];
#pragma unroll
    for (int j = 0; j < NR; ++j) { const int key = lane + 64 * j; u[j] = (key <= t) ? ((f2sortable(srow[key]) & 0xFFFFF000u) | (unsigned)(4095 - key)) : 0u; }
    unsigned mx = 0u;
#pragma unroll
    for (int j = 0; j < NR; ++j) mx = max(mx, u[j]);
    mx = wave_max_u32(mx);
    unsigned tau = 0u; int bit = 31, G = n, lc = 0;
    {
        unsigned th = mx & 0xFF800000u;
#pragma unroll 1
        for (int s6 = 0; s6 < 6; ++s6) {
            const int lcnt = count_geN<NR>(u, th);
            const int cnt = wave_sum_i32_uniform(lcnt);
            if (cnt >= 256) { tau = th; bit = 22; G = cnt; lc = lcnt; break; }
            if (th < 0x00800000u) break;
            th -= 0x00800000u;
        }
    }
    while (G > 512 && bit >= 0) {
        const unsigned cand = tau | (1u << bit);
        const int lcnt = count_geN<NR>(u, cand);
        const int cnt = wave_sum_i32_uniform(lcnt);
        if (cnt >= 256) { tau = cand; G = cnt; lc = lcnt; }
        --bit;
    }
    {
        int pre = lc;
#pragma unroll
        for (int o = 1; o < 64; o <<= 1) { const int v = __shfl_up(pre, o); if (lane >= o) pre += v; }
        int pos = pre - lc;
#pragma unroll
        for (int j = 0; j < NR; ++j) {
            const bool sel = u[j] >= tau;
            buf[sel ? pos : (512 + lane)] = u[j];
            pos += sel ? 1 : 0;
        }
    }
    unsigned c[8];
#pragma unroll
    for (int j = 0; j < 8; ++j) c[j] = (lane + 64 * j < G) ? buf[lane + 64 * j] : 0u;
    while (G > 256 && bit >= 0) {
        const unsigned cand = tau | (1u << bit);
        int cnt = 0;
#pragma unroll
        for (int j = 0; j < 8; ++j) cnt += __builtin_popcountll(__builtin_amdgcn_ballot_w64(c[j] >= cand));
        if (cnt >= 256) { tau = cand; G = cnt; }
        --bit;
    }
    {
        const int lc2 = count_geN<8>(c, tau);
        int pre = lc2;
#pragma unroll
        for (int o = 1; o < 64; o <<= 1) { const int v = __shfl_up(pre, o); if (lane >= o) pre += v; }
        int pos = pre - lc2;
#pragma unroll
        for (int j = 0; j < 8; ++j) {
            const bool sel = c[j] >= tau;
            lq[sel ? pos : (256 + lane)] = 4095 - (int)(c[j] & 4095u);
            pos += sel ? 1 : 0;
        }
    }
}
__device__ __forceinline__ void dsa_task(const Params& p, int task, LAS unsigned char* lds) {
    const int tid = opaque_tid(), wid = __builtin_amdgcn_readfirstlane(tid >> 6), lane = tid & 63;
    const int b = task >> 9, qg = task & 511, t0 = qg * 8, rowb = b * SEQ;
    const bf16_t* IQ = (const bf16_t*)(p.ws + OFF_IQ); const bf16_t* IK = (const bf16_t*)(p.ws + OFF_IK);
    const bf16_t* AQ = (const bf16_t*)(p.ws + OFF_AQ); const bf16_t* AK = (const bf16_t*)(p.ws + OFF_AK); const bf16_t* AV = (const bf16_t*)(p.ws + OFF_AV);
    const float* gates = (const float*)(p.ws + OFF_GATE);
    LAS float* scores = (LAS float*)lds;
    LAS int* lists = (LAS int*)(lds + 131072);
    const int ntile = (t0 + 8 + 31) >> 5;
#pragma unroll 1
    for (int rr0 = 0; rr0 < ((DSA_REP & 1) ? 2 : 1); ++rr0)
    {
        const int r = lane & 31, hh = lane >> 5;
        bf16x8 af[2][4]; float wv[2][4][4];
#pragma unroll
        for (int rt = 0; rt < 2; ++rt) {
            const size_t qrow = (size_t)(rowb + t0 + 4 * rt + (r >> 3));
#pragma unroll
            for (int ks = 0; ks < 4; ++ks) af[rt][ks] = *(const bf16x8*)(IQ + qrow * 512 + (r & 7) * 64 + 16 * ks + 8 * hh);
#pragma unroll
            for (int q4 = 0; q4 < 4; ++q4)
#pragma unroll
                for (int h4 = 0; h4 < 4; ++h4) wv[rt][q4][h4] = gates[(size_t)(rowb + t0 + 4 * rt + q4) * 16 + 8 + h4 + 4 * hh] * 0.04419417382415922f;
        }
        bf16x8 bfr[4], bnx[4];
        if (wid < ntile) {
#pragma unroll
            for (int ks = 0; ks < 4; ++ks) bfr[ks] = *(const bf16x8*)(IK + (size_t)(rowb + 32 * wid) * 64 + ks * 512 + lane * 8);
        }
        for (int kt = wid; kt < ntile; kt += 8) {
            if (kt + 8 < ntile) {
#pragma unroll
                for (int ks = 0; ks < 4; ++ks) bnx[ks] = *(const bf16x8*)(IK + (size_t)(rowb + 32 * (kt + 8)) * 64 + ks * 512 + lane * 8);
            }
            const int key = 32 * kt + r;
#pragma unroll
            for (int rt = 0; rt < 2; ++rt) {
                f32x16 acc;
#pragma unroll
                for (int i = 0; i < 16; ++i) acc[i] = 0.f;
#pragma unroll
                for (int ks = 0; ks < 4; ++ks) acc = __builtin_amdgcn_mfma_f32_32x32x16_bf16(af[rt][ks], bfr[ks], acc, 0, 0, 0);
                float part[4];
#pragma unroll
                for (int q4 = 0; q4 < 4; ++q4) {
                    part[q4] = 0.f;
#pragma unroll
                    for (int h4 = 0; h4 < 4; ++h4) part[q4] += fmaxf(acc[q4 * 4 + h4], 0.f) * wv[rt][q4][h4];
                }
                float tot[2];
#pragma unroll
                for (int i = 0; i < 2; ++i) { const u32x2 r_ = __builtin_amdgcn_permlane32_swap(__float_as_uint(part[i]), __float_as_uint(part[i + 2]), false, false); tot[i] = __uint_as_float(r_[0]) + __uint_as_float(r_[1]); }
#pragma unroll
                for (int i = 0; i < 2; ++i) { const int qq = 4 * rt + 2 * hh + i; scores[qq * 4096 + key] = (key <= t0 + qq) ? tot[i] : -INFINITY; }
            }
#pragma unroll
            for (int ks = 0; ks < 4; ++ks) bfr[ks] = bnx[ks];
        }
    }
    __syncthreads();
    const int qq = wid, t = t0 + qq, n = t + 1;
    const int nsel = n < 256 ? n : 256;
#pragma unroll 1
    for (int rr1 = 0; rr1 < ((DSA_REP & 2) ? 2 : 1); ++rr1)
    {
        LAS float* srow = scores + qq * 4096; LAS int* lq = lists + qq * 320; LAS unsigned* cbuf = (LAS unsigned*)(lds + 141312 + qq * 2304);
        const int nreg = (t >> 6) + 1;
        if (nreg <= 8) select_topk<8>(srow, lq, t, n, lane);
        else if (nreg <= 16) select_topk2<16>(srow, cbuf, lq, t, n, lane);
        else if (nreg <= 24) select_topk2<24>(srow, cbuf, lq, t, n, lane);
        else if (nreg <= 32) select_topk2<32>(srow, cbuf, lq, t, n, lane);
        else if (nreg <= 40) select_topk2<40>(srow, cbuf, lq, t, n, lane);
        else if (nreg <= 48) select_topk2<48>(srow, cbuf, lq, t, n, lane);
        else if (nreg <= 56) select_topk2<56>(srow, cbuf, lq, t, n, lane);
        else select_topk2<64>(srow, cbuf, lq, t, n, lane);
    }
    asm volatile("s_waitcnt lgkmcnt(0)" ::: "memory");
#pragma unroll 1
    for (int rr2 = 0; rr2 < ((DSA_REP & 4) ? 2 : 1); ++rr2) {
#pragma unroll 1
    for (int rr3 = 0; rr3 < ((DSA_REP & 8) ? 2 : 1); ++rr3)
    {
        const int r = lane & 15, g = lane >> 4;
        const size_t qrow = (size_t)(rowb + t);
        bf16x8 bq[2];
#pragma unroll
        for (int ks = 0; ks < 2; ++ks) {
            if (r < 8) bq[ks] = *(const bf16x8*)(AQ + qrow * 512 + r * 64 + 8 * g + 32 * ks);
            else { bq[ks] = (bf16x8){0, 0, 0, 0, 0, 0, 0, 0}; }
        }
        LAS float* Pl = scores + qq * 4096;
#pragma unroll 1
        for (int half = 0; half < 2; ++half) {
            bf16x8 a0[8], a1[8];
#pragma unroll
            for (int i = 0; i < 8; ++i) {
                const int jp = 16 * (half * 8 + i) + r;
                const int key = (jp < nsel) ? lists[qq * 320 + jp] : 0;
                a0[i] = *(const bf16x8*)(AK + (size_t)(rowb + key) * 64 + 8 * g); a1[i] = *(const bf16x8*)(AK + (size_t)(rowb + key) * 64 + 8 * g + 32);
            }
#pragma unroll
            for (int i = 0; i < 8; ++i) {
                const int kt = half * 8 + i;
                f32x4 acc = {0.f, 0.f, 0.f, 0.f};
                acc = __builtin_amdgcn_mfma_f32_16x16x32_bf16(a0[i], bq[0], acc, 0, 0, 0);
                acc = __builtin_amdgcn_mfma_f32_16x16x32_bf16(a1[i], bq[1], acc, 0, 0, 0);
                if (r < 8) *(LAS f32x4*)(Pl + r * 260 + 16 * kt + 4 * g) = acc * 0.125f;
            }
        }
        asm volatile("s_waitcnt lgkmcnt(0)" ::: "memory");
        const int hd = lane & 7, ch = lane >> 3;
        f32x4 pv[8];
        float mx = -INFINITY;
#pragma unroll
        for (int i = 0; i < 8; ++i) {
            pv[i] = *(const LAS f32x4*)(Pl + hd * 260 + ch * 32 + 4 * i);
#pragma unroll
            for (int j = 0; j < 4; ++j) if (ch * 32 + 4 * i + j < nsel) mx = fmaxf(mx, pv[i][j]);
        }
        mx = fmaxf(mx, dppf(mx, 0x128));
        mx = fmaxf(mx, xchg_f32<16>(mx, lane)); mx = fmaxf(mx, xchg_f32<32>(mx, lane));
        float sm = 0.f;
#pragma unroll
        for (int i = 0; i < 8; ++i)
#pragma unroll
            for (int j = 0; j < 4; ++j) { const float e = (ch * 32 + 4 * i + j < nsel) ? __expf(pv[i][j] - mx) : 0.f; pv[i][j] = e; sm += e; }
        sm += dppf(sm, 0x128); sm += xchg_f32<16>(sm, lane); sm += xchg_f32<32>(sm, lane);
        const float inv = __builtin_amdgcn_rcpf(sm);
        LAS bf16_t* Pt = (LAS bf16_t*)((LAS unsigned char*)Pl + 9216);
#pragma unroll
        for (int i = 0; i < 4; ++i) {
            u32x4 o;
            o[0] = pack2(pv[2 * i][0] * inv, pv[2 * i][1] * inv); o[1] = pack2(pv[2 * i][2] * inv, pv[2 * i][3] * inv);
            o[2] = pack2(pv[2 * i + 1][0] * inv, pv[2 * i + 1][1] * inv); o[3] = pack2(pv[2 * i + 1][2] * inv, pv[2 * i + 1][3] * inv);
            *(LAS u32x4*)(Pt + hd * 264 + ch * 32 + 8 * i) = o;
        }
    }
    asm volatile("s_waitcnt lgkmcnt(0)" ::: "memory");
#pragma unroll 1
    for (int rr4 = 0; rr4 < ((DSA_REP & 16) ? 2 : 1); ++rr4)
    {
        typedef short s16x4 __attribute__((ext_vector_type(4)));
        const int r = lane & 15, g = lane >> 4;
        LAS unsigned char* wb = (LAS unsigned char*)(scores + qq * 4096);
        const LAS bf16_t* Pt = (const LAS bf16_t*)(wb + 9216);
        const int nchunk = (nsel + 31) >> 5;
        const int kl = lane >> 3, dc = lane & 7;
        f32x4 acc[4];
#pragma unroll
        for (int ct = 0; ct < 4; ++ct) acc[ct] = (f32x4){0.f, 0.f, 0.f, 0.f};
        u32x4 vq[4], vn[4];
#pragma unroll
        for (int i = 0; i < 4; ++i) {
            const int jp = kl + 8 * i;
            const int key = (jp < nsel) ? lists[qq * 320 + jp] : 0;
            vq[i] = *(const u32x4*)(AV + (size_t)(rowb + key) * 64 + dc * 8);
        }
#pragma unroll 1
        for (int c = 0; c < nchunk; ++c) {
            LAS unsigned char* vb = wb + (c & 1) * 4608;
#pragma unroll
            for (int i = 0; i < 4; ++i) *(LAS u32x4*)(vb + (kl + 8 * i) * 144 + dc * 16) = vq[i];
            if (c + 1 < nchunk) {
#pragma unroll
                for (int i = 0; i < 4; ++i) {
                    const int jp = 32 * (c + 1) + kl + 8 * i;
                    const int key = (jp < nsel) ? lists[qq * 320 + jp] : 0;
                    vn[i] = *(const u32x4*)(AV + (size_t)(rowb + key) * 64 + dc * 8);
                }
            }
            bf16x8 a = *(const LAS bf16x8*)(Pt + (r & 7) * 264 + 32 * c + 8 * g);
            if (r >= 8) a = (bf16x8){0, 0, 0, 0, 0, 0, 0, 0};
#pragma unroll
            for (int ct = 0; ct < 4; ++ct) {
                LAS unsigned char* ba = vb + (8 * g + (r >> 2)) * 144 + (16 * ct + 4 * (r & 3)) * 2;
                const s16x4 b0 = __builtin_amdgcn_ds_read_tr16_b64_v4i16((LAS s16x4*)ba);
                const s16x4 b1 = __builtin_amdgcn_ds_read_tr16_b64_v4i16((LAS s16x4*)(ba + 4 * 144));
                bf16x8 bb; bb[0] = b0[0]; bb[1] = b0[1]; bb[2] = b0[2]; bb[3] = b0[3]; bb[4] = b1[0]; bb[5] = b1[1]; bb[6] = b1[2]; bb[7] = b1[3];
                acc[ct] = __builtin_amdgcn_mfma_f32_16x16x32_bf16(a, bb, acc[ct], 0, 0, 0);
            }
#pragma unroll
            for (int i = 0; i < 4; ++i) vq[i] = vn[i];
        }
        bf16_t* dst = (bf16_t*)(p.ws + OFF_ACT) + (size_t)(rowb + t) * 1024 + 512;
#pragma unroll
        for (int j = 0; j < 4; ++j) {
            float ss = acc[0][j] * acc[0][j] + acc[1][j] * acc[1][j] + acc[2][j] * acc[2][j] + acc[3][j] * acc[3][j];
            ss = row16_sum(ss);
            const float rstd = rsqrtf(ss * (1.f / 64.f) + 1e-6f);
            if (g < 2) {
                const int hd = 4 * g + j;
#pragma unroll
                for (int ct = 0; ct < 4; ++ct) dst[hd * 64 + 16 * ct + r] = f2bf(acc[ct][j] * rstd * p.out_norm_a[hd * 64 + 16 * ct + r]);
            }
        }
    }
    }
    __syncthreads();
}

__device__ __forceinline__ float sortable2f(unsigned s) { return __uint_as_float((s & 0x80000000u) ? (s ^ 0x80000000u) : ~s); }
#define CE_DESC(x, y) do { const unsigned mx_ = max(x, y), mn_ = min(x, y); (x) = mx_; (y) = mn_; } while (0)
template <int BASE, int N>
__device__ __forceinline__ void bitonic_sort16_desc(unsigned (&a)[N]) {
#pragma unroll
    for (int k = 2; k <= 16; k <<= 1) {
#pragma unroll
        for (int j = k >> 1; j > 0; j >>= 1) {
#pragma unroll
            for (int i = 0; i < 16; ++i) {
                const int l = i ^ j;
                if (l > i) {
                    if ((i & k) == 0) CE_DESC(a[BASE + i], a[BASE + l]);
                    else CE_DESC(a[BASE + l], a[BASE + i]);
                }
            }
        }
    }
}
template <int BASE, int N>
__device__ __forceinline__ void bitonic_merge16_desc(unsigned (&a)[N]) {
#pragma unroll
    for (int j = 8; j > 0; j >>= 1) {
#pragma unroll
        for (int i = 0; i < 16; ++i) { const int l = i ^ j; if (l > i) CE_DESC(a[BASE + i], a[BASE + l]); }
    }
}
template <int BA, int BB, int N>
__device__ __forceinline__ void top16_merge(unsigned (&a)[N]) {
#pragma unroll
    for (int i = 0; i < 16; ++i) a[BA + i] = max(a[BA + i], a[BB + 15 - i]);
    bitonic_merge16_desc<BA, N>(a);
}
__device__ __forceinline__ void top16_of_64(unsigned (&a)[64]) {
    bitonic_sort16_desc<0, 64>(a); bitonic_sort16_desc<16, 64>(a); bitonic_sort16_desc<32, 64>(a); bitonic_sort16_desc<48, 64>(a);
    top16_merge<0, 16, 64>(a); top16_merge<32, 48, 64>(a); top16_merge<0, 32, 64>(a);
}
__device__ __forceinline__ void peer_route(const Params& p, int task, LAS unsigned char* lds) {
    const int tid = opaque_tid(), wid = __builtin_amdgcn_readfirstlane(tid >> 6), lane = tid & 63;
    const int n0 = task * 32, head = wid;
    const int r = lane & 31, hh = lane >> 5;
    const bf16_t* QRY = (const bf16_t*)(p.ws + OFF_QRY); const bf16_t* SK = (const bf16_t*)(p.ws + OFF_SK);
    LAS unsigned* tkl = (LAS unsigned*)lds + wid * (32 * 64);
#pragma unroll 1
    for (int p2 = 0; p2 < 2; ++p2) {
        const int grp = head * 2 + p2;
        bf16x8 bq[4];
#pragma unroll
        for (int ks = 0; ks < 4; ++ks) bq[ks] = *(const bf16x8*)(QRY + (size_t)(n0 + r) * 1024 + grp * 64 + 16 * ks + 8 * hh);
        unsigned key[64];
#pragma unroll
        for (int kt = 0; kt < 4; ++kt) {
            f32x16 acc;
#pragma unroll
            for (int i = 0; i < 16; ++i) acc[i] = 0.f;
#pragma unroll
            for (int ks = 0; ks < 4; ++ks) {
                const bf16x8 a = *(const bf16x8*)(SK + (size_t)(grp * 128 + 32 * kt + r) * 64 + 16 * ks + 8 * hh);
                acc = __builtin_amdgcn_mfma_f32_32x32x16_bf16(a, bq[ks], acc, 0, 0, 0);
            }
#pragma unroll
            for (int reg = 0; reg < 16; ++reg) {
                const int idx = 32 * kt + (reg & 3) + 8 * (reg >> 2) + 4 * hh;
                key[kt * 16 + reg] = (f2sortable(acc[reg]) & ~0x7Fu) | (unsigned)(127 - idx);
            }
        }
        top16_of_64(key);
        unsigned mg[16];
#pragma unroll
        for (int i = 0; i < 16; ++i) mg[i] = max(key[i], xchg_u32<32>(key[15 - i], lane));
        bitonic_merge16_desc<0, 16>(mg);
#pragma unroll
        for (int k = 0; k < 16; ++k) tkl[(p2 * 16 + k) * 64 + lane] = mg[k];
    }
    float v1[16], v2[16];
#pragma unroll
    for (int k = 0; k < 16; ++k) { v1[k] = sortable2f(tkl[k * 64 + lane] & ~0x7Fu); v2[k] = sortable2f(tkl[(16 + k) * 64 + lane] & ~0x7Fu); }
    unsigned ck[64];
    {
        int ci = 0;
#pragma unroll
        for (int a = 0; a < 16; ++a) {
#pragma unroll
            for (int bb = 0; bb < 16 / (a + 1); ++bb) { ck[ci] = (f2sortable(v1[a] + v2[bb]) & ~0xFFu) | (unsigned)(255 - (16 * a + bb)); ++ci; }
        }
#pragma unroll
        for (int i = 50; i < 64; ++i) ck[i] = 0u;
    }
    top16_of_64(ck);
    float tv[16]; int te[16];
    float sum = 0.f;
#pragma unroll
    for (int k = 0; k < 16; ++k) {
        const int flat = 255 - (int)(ck[k] & 0xFFu);
        const int i1 = 127 - (int)(tkl[(flat >> 4) * 64 + lane] & 0x7Fu), i2 = 127 - (int)(tkl[(16 + (flat & 15)) * 64 + lane] & 0x7Fu);
        te[k] = i1 * 128 + i2;
        tv[k] = __expf(sortable2f(ck[k] & ~0xFFu) - sortable2f(ck[0] & ~0xFFu)); sum += tv[k];
    }
    const float inv = 1.f / sum;
    if (hh == 0) {
        int* EI = (int*)(p.ws + OFF_EIDX) + (size_t)(n0 + r) * 128 + head * 16;
#pragma unroll
        for (int q = 0; q < 4; ++q) { u32x4 o; o[0] = te[4 * q]; o[1] = te[4 * q + 1]; o[2] = te[4 * q + 2]; o[3] = te[4 * q + 3]; *(u32x4*)(EI + 4 * q) = o; }
    } else {
        float* GW = (float*)(p.ws + OFF_GW) + (size_t)(n0 + r) * 128 + head * 16;
#pragma unroll
        for (int q = 0; q < 4; ++q) { f32x4 o; o[0] = tv[4 * q] * inv; o[1] = tv[4 * q + 1] * inv; o[2] = tv[4 * q + 2] * inv; o[3] = tv[4 * q + 3] * inv; *(f32x4*)(GW + 4 * q) = o; }
    }
}

__device__ __forceinline__ float gelu_exact(float a) { return 0.5f * a * (1.f + erff(a * 0.70710678118654752440f)); }
__device__ __forceinline__ float gelu_as(float v) {
    const float av = fabsf(v), t = __builtin_amdgcn_rcpf(av * 0.2316418882f + 1.0f);
    float q = t * 0.5307027145f + (-0.7265760135f); q = q * t + 0.7107068705f; q = q * t + (-0.142248368f); q = q * t + 0.127414796f; q = q * t;
    const float e = __builtin_amdgcn_exp2f((v * v) * (-0.72134752044f));
    const float m = v * (q * e), rr = v - m;
    return v < 0.f ? m : rr;
}
__device__ __forceinline__ void dec16_fp8(const u32x4 w, float (&f)[16]) {
#pragma unroll
    for (int i = 0; i < 4; ++i) {
        const f32x2 lo = __builtin_amdgcn_cvt_pk_f32_fp8((int)w[i], false), hi = __builtin_amdgcn_cvt_pk_f32_fp8((int)w[i], true);
        f[4 * i] = lo[0]; f[4 * i + 1] = lo[1]; f[4 * i + 2] = hi[0]; f[4 * i + 3] = hi[1];
    }
}
__device__ __forceinline__ void sort_pairs128(int& k_lo, int& k_hi, float& g_lo, float& g_hi, int lane) {
#pragma unroll
    for (int size = 2; size <= 128; size <<= 1) {
#pragma unroll
        for (int stride = size >> 1; stride >= 1; stride >>= 1) {
            if (stride == 64) {
                const bool sw = k_hi < k_lo;
                const int ta = sw ? k_hi : k_lo, tb = sw ? k_lo : k_hi; const float ga = sw ? g_hi : g_lo, gb = sw ? g_lo : g_hi;
                k_lo = ta; k_hi = tb; g_lo = ga; g_hi = gb;
            } else {
                int p_lo, p_hi; float q_lo, q_hi;
                if (stride == 1) { p_lo = (int)xchg_u32<1>((unsigned)k_lo, lane); p_hi = (int)xchg_u32<1>((unsigned)k_hi, lane); q_lo = xchg_f32<1>(g_lo, lane); q_hi = xchg_f32<1>(g_hi, lane); }
                else if (stride == 2) { p_lo = (int)xchg_u32<2>((unsigned)k_lo, lane); p_hi = (int)xchg_u32<2>((unsigned)k_hi, lane); q_lo = xchg_f32<2>(g_lo, lane); q_hi = xchg_f32<2>(g_hi, lane); }
                else if (stride == 4) { p_lo = (int)xchg_u32<4>((unsigned)k_lo, lane); p_hi = (int)xchg_u32<4>((unsigned)k_hi, lane); q_lo = xchg_f32<4>(g_lo, lane); q_hi = xchg_f32<4>(g_hi, lane); }
                else if (stride == 8) { p_lo = (int)xchg_u32<8>((unsigned)k_lo, lane); p_hi = (int)xchg_u32<8>((unsigned)k_hi, lane); q_lo = xchg_f32<8>(g_lo, lane); q_hi = xchg_f32<8>(g_hi, lane); }
                else if (stride == 16) { p_lo = (int)xchg_u32<16>((unsigned)k_lo, lane); p_hi = (int)xchg_u32<16>((unsigned)k_hi, lane); q_lo = xchg_f32<16>(g_lo, lane); q_hi = xchg_f32<16>(g_hi, lane); }
                else { p_lo = (int)xchg_u32<32>((unsigned)k_lo, lane); p_hi = (int)xchg_u32<32>((unsigned)k_hi, lane); q_lo = xchg_f32<32>(g_lo, lane); q_hi = xchg_f32<32>(g_hi, lane); }
                const bool lower = (lane & stride) == 0;
                const bool asc_lo = (size >= 64) ? true : ((lane & size) == 0);
                const bool asc_hi = (size == 128) ? true : ((size == 64) ? false : ((lane & size) == 0));
                const bool min_lo = (lower == asc_lo), min_hi = (lower == asc_hi);
                const bool take_lo = min_lo ? (p_lo < k_lo) : (p_lo > k_lo);
                const bool take_hi = min_hi ? (p_hi < k_hi) : (p_hi > k_hi);
                k_lo = take_lo ? p_lo : k_lo; g_lo = take_lo ? q_lo : g_lo;
                k_hi = take_hi ? p_hi : k_hi; g_hi = take_hi ? q_hi : g_hi;
            }
        }
    }
}
__device__ __forceinline__ void peer_finish_row(const Params& p, const float* ada, int tok, int d0, const float (&acc)[16], bool do_store) {
    const int b = tok >> 12;
    float* orow = p.out + (size_t)tok * 1024 + d0;
    float xo[16]; float ss = 0.f;
#pragma unroll
    for (int q = 0; q < 4; ++q) {
        const f32x4 xv = *(const f32x4*)(orow + 4 * q), gv = *(const f32x4*)(ada + b * 6144 + 5120 + d0 + 4 * q);
#pragma unroll
        for (int i = 0; i < 4; ++i) { const float v = xv[i] + gv[i] * acc[q * 4 + i]; xo[q * 4 + i] = v; ss += v * v; }
    }
    ss = wave_sum(ss);
    const float rstd = rsqrtf(ss * (1.f / 1024.f) + 1e-6f);
#pragma unroll
    for (int q = 0; q < 4; ++q) {
        const f32x4 fg = *(const f32x4*)(p.final_g + d0 + 4 * q);
        f32x4 ov;
#pragma unroll
        for (int i = 0; i < 4; ++i) ov[i] = xo[q * 4 + i] * rstd * fg[i];
        if (do_store) *(f32x4*)(orow + 4 * q) = ov;
    }
}
struct PeTok { unsigned hq[4]; float ascale; int acc[16]; int csum; int k_lo, k_hi; float g_lo, g_hi; };
__device__ __forceinline__ void pe_tok_init(PeTok& t, const bf16_t* H2, const int* EI, const float* GW, int tok, int d0, int lane) {
    const u32x4 h0 = *(const u32x4*)(H2 + (size_t)tok * 1024 + d0), h1 = *(const u32x4*)(H2 + (size_t)tok * 1024 + d0 + 8);
    float hx[16];
#pragma unroll
    for (int i = 0; i < 4; ++i) { hx[2 * i] = lo16(h0[i]); hx[2 * i + 1] = hi16(h0[i]); hx[8 + 2 * i] = lo16(h1[i]); hx[8 + 2 * i + 1] = hi16(h1[i]); }
    float am = 0.f;
#pragma unroll
    for (int i = 0; i < 16; ++i) am = fmaxf(am, fabsf(hx[i]));
    am = fmaxf(wave_max_dpp(am), 1e-20f);
    const float hs = 127.f / am;
#pragma unroll
    for (int i = 0; i < 4; ++i) t.hq[i] = pack4_i8(hx[4 * i], hx[4 * i + 1], hx[4 * i + 2], hx[4 * i + 3], hs);
    t.ascale = am * (1.f / (127.f * PEER_SU));
#pragma unroll
    for (int i = 0; i < 16; ++i) t.acc[i] = 0;
    t.csum = 0;
    t.k_lo = EI[(size_t)tok * 128 + lane]; t.k_hi = EI[(size_t)tok * 128 + 64 + lane];
    t.g_lo = GW[(size_t)tok * 128 + lane]; t.g_hi = GW[(size_t)tok * 128 + 64 + lane];
    sort_pairs128(t.k_lo, t.k_hi, t.g_lo, t.g_hi, lane);
}
__device__ __forceinline__ void pe_tok_result(const PeTok& t, float (&acc)[16]) {
    const int coff = 8 * t.csum;
#pragma unroll
    for (int i = 0; i < 4; ++i)
#pragma unroll
        for (int j = 0; j < 4; ++j) acc[8 * (i >> 1) + 2 * j + (i & 1)] = (float)(t.acc[4 * i + j] - coff) * (1.f / (PEER_SC * PEER_SV));
}
typedef short s16x2 __attribute__((ext_vector_type(2)));
__device__ __forceinline__ int dot2_i16(unsigned a, int b, int c) { return __builtin_amdgcn_sdot2(__builtin_bit_cast(s16x2, a), __builtin_bit_cast(s16x2, b), c, false); }
__device__ __forceinline__ void pe_vgroup(PeTok& t, const u32x2 (&vv)[8], int base, int c0, int c1, int c2, int c3) {
    const int c01 = (c0 & 0xFFFF) | (c1 << 16), c23 = (c2 & 0xFFFF) | (c3 << 16);
    t.csum += c0 + c1 + c2 + c3;
#pragma unroll
    for (int i = 0; i < 4; ++i) {
        const unsigned w0 = (vv[base][i >> 1] >> (4 * (i & 1))) & 0x0F0F0F0Fu, w1 = (vv[base + 1][i >> 1] >> (4 * (i & 1))) & 0x0F0F0F0Fu;
        const unsigned w2_ = (vv[base + 2][i >> 1] >> (4 * (i & 1))) & 0x0F0F0F0Fu, w3 = (vv[base + 3][i >> 1] >> (4 * (i & 1))) & 0x0F0F0F0Fu;
        t.acc[4 * i + 0] = dot2_i16(__builtin_amdgcn_perm(w3, w2_, 0x0c040c00u), c23, dot2_i16(__builtin_amdgcn_perm(w1, w0, 0x0c040c00u), c01, t.acc[4 * i + 0]));
        t.acc[4 * i + 1] = dot2_i16(__builtin_amdgcn_perm(w3, w2_, 0x0c050c01u), c23, dot2_i16(__builtin_amdgcn_perm(w1, w0, 0x0c050c01u), c01, t.acc[4 * i + 1]));
        t.acc[4 * i + 2] = dot2_i16(__builtin_amdgcn_perm(w3, w2_, 0x0c060c02u), c23, dot2_i16(__builtin_amdgcn_perm(w1, w0, 0x0c060c02u), c01, t.acc[4 * i + 2]));
        t.acc[4 * i + 3] = dot2_i16(__builtin_amdgcn_perm(w3, w2_, 0x0c070c03u), c23, dot2_i16(__builtin_amdgcn_perm(w1, w0, 0x0c070c03u), c01, t.acc[4 * i + 3]));
    }
}
#ifndef PE_SYNC_MASK
#define PE_SYNC_MASK 31
#endif
__device__ __forceinline__ void peer_experts(const Params& p, bool do_store) {
    const int wid = threadIdx.x >> 6, lane = threadIdx.x & 63;
    const bf16_t* H2 = (const bf16_t*)(p.ws + OFF_ACT); const unsigned char* UT = p.ws + OFF_UT; const unsigned char* VT = p.ws + OFF_VT;
    const int* EI = (const int*)(p.ws + OFF_EIDX); const float* GW = (const float*)(p.ws + OFF_GW); const float* ada = (const float*)(p.ws + OFF_ADA);
    const int d0 = 16 * lane;
    const int stride = gridDim.x * 8;
    for (int tok0 = blockIdx.x * 8 + wid; tok0 < NTOK; tok0 += 4 * stride) {
        __syncthreads();
        int tk[4]; bool has[4];
#pragma unroll
        for (int i = 0; i < 4; ++i) { has[i] = (tok0 + i * stride) < NTOK; tk[i] = has[i] ? tok0 + i * stride : tok0; }
        PeTok T[4];
#pragma unroll
        for (int i = 0; i < 4; ++i) pe_tok_init(T[i], H2, EI, GW, tk[i], d0, lane);
        u32x4 uX[8], uY[8]; u32x2 vX[8], vY[8]; float gX[8], gY[8];
#define PE_ISSUE(UU, VV, GG, K0, A, B) do { _Pragma("unroll") for (int q = 0; q < 4; ++q) { \
            const unsigned ea_ = (unsigned)__builtin_amdgcn_readlane((K0) < 64 ? A.k_lo : A.k_hi, ((K0) + q) & 63), eb_ = (unsigned)__builtin_amdgcn_readlane((K0) < 64 ? B.k_lo : B.k_hi, ((K0) + q) & 63); \
            GG[q] = rlanef((K0) < 64 ? A.g_lo : A.g_hi, ((K0) + q) & 63); GG[4 + q] = rlanef((K0) < 64 ? B.g_lo : B.g_hi, ((K0) + q) & 63); \
            UU[q] = *(const u32x4*)(UT + (size_t)(ea_ * 1024u) + (unsigned)d0); VV[q] = *(const u32x2*)(VT + (size_t)(ea_ * 512u) + 8u * (unsigned)lane); \
            UU[4 + q] = *(const u32x4*)(UT + (size_t)(eb_ * 1024u) + (unsigned)d0); VV[4 + q] = *(const u32x2*)(VT + (size_t)(eb_ * 512u) + 8u * (unsigned)lane); } } while (0)
#define PE_COMPUTE(UU, VV, GG, A, B) do { \
            float sv[8]; \
            _Pragma("unroll") for (int q = 0; q < 8; ++q) { int d_ = 0; \
                _Pragma("unroll") for (int i = 0; i < 4; ++i) d_ = __builtin_amdgcn_sdot4((int)UU[q][i], (int)(q < 4 ? A.hq[i] : B.hq[i]), d_, false); \
                sv[q] = (float)d_ * (q < 4 ? A.ascale : B.ascale); } \
            float t4[4]; \
            _Pragma("unroll") for (int i = 0; i < 4; ++i) { const u32x2 r_ = __builtin_amdgcn_permlane32_swap(__float_as_uint(sv[i]), __float_as_uint(sv[i + 4]), false, false); t4[i] = __uint_as_float(r_[0]) + __uint_as_float(r_[1]); } \
            float w2[2]; \
            _Pragma("unroll") for (int i = 0; i < 2; ++i) { const u32x2 r_ = __builtin_amdgcn_permlane16_swap(__float_as_uint(t4[i]), __float_as_uint(t4[i + 2]), false, false); w2[i] = __uint_as_float(r_[0]) + __uint_as_float(r_[1]); } \
            _Pragma("unroll") for (int i = 0; i < 2; ++i) { w2[i] += dppf(w2[i], 0xB1); w2[i] += dppf(w2[i], 0x4E); w2[i] += dppf(w2[i], 0x141); w2[i] += dppf(w2[i], 0x140); } \
            float mine = 0.f, gmine = 0.f; \
            _Pragma("unroll") for (int q = 0; q < 8; ++q) { \
                const float tq = rlanef(w2[q & 1], 16 * (((q >> 1) & 1) + 2 * (q >> 2))); \
                mine = ((lane & 7) == q) ? tq : mine; gmine = ((lane & 7) == q) ? GG[q] : gmine; } \
            const float cmine = gmine * gelu_as(mine); \
            const int cqm = (int)fminf(fmaxf(rintf(cmine * PEER_SC), -16383.f), 16383.f);        \
            pe_vgroup(A, VV, 0, __builtin_amdgcn_readlane(cqm, 0), __builtin_amdgcn_readlane(cqm, 1), __builtin_amdgcn_readlane(cqm, 2), __builtin_amdgcn_readlane(cqm, 3)); \
            pe_vgroup(B, VV, 4, __builtin_amdgcn_readlane(cqm, 4), __builtin_amdgcn_readlane(cqm, 5), __builtin_amdgcn_readlane(cqm, 6), __builtin_amdgcn_readlane(cqm, 7)); } while (0)
        PE_ISSUE(uX, vX, gX, 0, T[0], T[1]);
#pragma unroll 1
        for (int k0 = 0; k0 < 128; k0 += 4) {
            if ((k0 & PE_SYNC_MASK) == 0 && k0) __syncthreads();
            PE_ISSUE(uY, vY, gY, k0, T[2], T[3]);
            PE_COMPUTE(uX, vX, gX, T[0], T[1]);
            if (k0 + 4 < 128) PE_ISSUE(uX, vX, gX, k0 + 4, T[0], T[1]);
            PE_COMPUTE(uY, vY, gY, T[2], T[3]);
        }
#undef PE_ISSUE
#undef PE_COMPUTE
        float acc[16];
#pragma unroll
        for (int i = 0; i < 4; ++i) { pe_tok_result(T[i], acc); peer_finish_row(p, ada, tk[i], d0, acc, do_store && has[i]); }
    }
}

enum { PH_PREP = 0, PH_GEMM_IN, PH_MIX, PH_GEMM_OUT, PH_H2, PH_GEMM_Q, PH_ROUTE, PH_EXPERT, PH_COUNT };

typedef const __attribute__((address_space(4))) Params* KParams;
__device__ __forceinline__ const Params& kparams() {
    auto q = __builtin_amdgcn_kernarg_segment_ptr();
    asm volatile("" : "+s"(q));
    return *(const Params*)q;
}
#ifndef PHMASK
#define PHMASK 0xFFFF
#endif
#ifndef REP_PHASE
#define REP_PHASE -1
#endif
#define PHASE_BEGIN(idx) if (((PHMASK >> (idx)) & 1) && ph_lo <= (idx) && (idx) < ph_hi) { for (int rep = 0; rep < ((idx) == REP_PHASE ? 2 : 1); ++rep) { if ((idx) != ph_lo || rep) xcd_barrier(bar); const Params& p = kparams(); const int G = gridDim.x; (void)G; const bool last_rep = (rep == ((idx) == REP_PHASE ? 1 : 0)); (void)last_rep;
#define PHASE_END } }

__global__ void __launch_bounds__(NTHREADS, 2) hymba_fwd(Params p_) {
    extern __shared__ __attribute__((aligned(16))) unsigned char smem_raw[];
    LAS unsigned char* lds = (LAS unsigned char*)smem_raw;
    volatile LAS unsigned* xbw = (volatile LAS unsigned*)(lds + LDS_BYTES - 16);
    if (threadIdx.x == 0) { xbw[0] = 0u; xbw[1] = 0u; xbw[2] = 0u; xbw[3] = 0u; }
    __syncthreads();
    XcdBarrier bar = xcd_barrier_post((unsigned*)(p_.ws + OFF_CTL), xbw);
    const int ph_lo = p_.ph_lo, ph_hi = p_.ph_hi;

    PHASE_BEGIN(PH_PREP)
        phase0(p, lds);
        wg_wait((unsigned*)(p.ws + OFF_CTL), CNT_ADA, 192u);
        norm_mod_rows(p.x, p.norm1_g, (const float*)(p.ws + OFF_ADA), 0, 1024, (bf16_t*)(p.ws + OFF_ACT));
    PHASE_END
    PHASE_BEGIN(PH_GEMM_IN)
        {   pg8::StaticOrder S; S.init(NTOK, 3072, G, blockIdx.x);
            EpiInMain E; E.ws = p.ws; E.bias = (const float*)(p.ws + OFF_BIAS);
            pg8::gemm_phase(lds, pg8::Gemm{(const bf16_t*)(p.ws + OFF_ACT), (const bf16_t*)(p.ws + OFF_WIN), NTOK, 3072, 1024}, S, E); }
        {   pg8::StaticOrder S; S.init(NTOK, 256, G, blockIdx.x);
            EpiInTail E; E.ws = p.ws; E.bias = (const float*)(p.ws + OFF_BIAS) + 3072;
            pg8::gemm_phase(lds, pg8::Gemm{(const bf16_t*)(p.ws + OFF_ACT), (const bf16_t*)(p.ws + OFF_WIN) + (size_t)3072 * 1024, NTOK, 256, 1024}, S, E); }
        if (G > 64) { if ((int)blockIdx.x >= 64) convert_tables(p, (int)blockIdx.x - 64, G - 64); }
        else convert_tables(p, (int)blockIdx.x, G);
    PHASE_END
    PHASE_BEGIN(PH_MIX)
        unsigned* ctl = (unsigned*)(p.ws + OFF_CTL);
        for (int t = blockIdx.x; t < 1024; t += G) mlstm_passA(p, t, lds);
        wg_signal(ctl, CNT_MLA);
        __syncthreads();
        for (int t = blockIdx.x; t < 2048; t += G) {
            const int rnd = t >> 8, w = t & 255; const int bsel = rnd >> 1; const int qgs = (rnd & 1) ? w : (511 - w);
            dsa_task(p, (bsel << 9) | qgs, lds); }
        wg_wait(ctl, CNT_MLA, (unsigned)G);
        for (int t = blockIdx.x; t < 256; t += G) mlstm_scan(p, t, lds);
        wg_signal(ctl, CNT_SCAN);
        wg_wait(ctl, CNT_SCAN, (unsigned)G);
        for (int t = blockIdx.x; t < 1024; t += G) mlstm_passB(p, t, lds);
    PHASE_END
    PHASE_BEGIN(PH_GEMM_OUT)
        {   pg8::StaticOrder S; S.init(NTOK, 1024, G, blockIdx.x);
            EpiOut E; E.x = p.x; E.ada = (const float*)(p.ws + OFF_ADA); E.out = p.out;
            pg8::gemm_phase(lds, pg8::Gemm{(const bf16_t*)(p.ws + OFF_ACT), (const bf16_t*)(p.ws + OFF_WOUT), NTOK, 1024, 1024}, S, E); }
    PHASE_END
    PHASE_BEGIN(PH_H2) norm_mod_rows(p.out, p.norm2_g, (const float*)(p.ws + OFF_ADA), 3072, 4096, (bf16_t*)(p.ws + OFF_ACT)); PHASE_END
    PHASE_BEGIN(PH_GEMM_Q)
        {   pg8::StaticOrder S; S.init(NTOK, 1024, G, blockIdx.x);
            EpiQry E; E.O = (bf16_t*)(p.ws + OFF_QRY);
            pg8::gemm_phase(lds, pg8::Gemm{(const bf16_t*)(p.ws + OFF_ACT), (const bf16_t*)(p.ws + OFF_WPQ), NTOK, 1024, 1024}, S, E); }
    PHASE_END
    PHASE_BEGIN(PH_ROUTE) for (int t = blockIdx.x; t < 512; t += G) peer_route(p, t, lds); PHASE_END
    PHASE_BEGIN(PH_EXPERT) peer_experts(p, last_rep); PHASE_END
}

extern "C" void kernel_launch(void* const* d_in, const int* in_sizes, int n_in, void* d_out, int out_size, void* d_ws, size_t ws_size, hipStream_t stream) {
    static int grid = 0;
    if (grid == 0) {
        int dev = 0, cus = 0, per_cu = 0;
        if (hipGetDevice(&dev) != hipSuccess || hipDeviceGetAttribute(&cus, hipDeviceAttributeMultiprocessorCount, dev) != hipSuccess) { fprintf(stderr, "kernel_launch: device query failed\n"); grid = -1; return; }
        if (hipFuncSetAttribute((const void*)hymba_fwd, hipFuncAttributeMaxDynamicSharedMemorySize, LDS_BYTES) != hipSuccess) { fprintf(stderr, "kernel_launch: hipFuncSetAttribute failed\n"); grid = -1; return; }
        if (hipOccupancyMaxActiveBlocksPerMultiprocessor(&per_cu, (const void*)hymba_fwd, NTHREADS, LDS_BYTES) != hipSuccess || per_cu < 1) { fprintf(stderr, "kernel_launch: occupancy query says %d blocks/CU\n", per_cu); }
        (void)hipGetLastError();
        grid = cus;
        if (ws_size < WS_END || n_in != 17) { fprintf(stderr, "kernel_launch: unexpected sizes (ws %zu, n_in %d)\n", ws_size, n_in); grid = -1; return; }
    }
    if (grid < 0) return;
    (void)hipMemsetAsync((char*)d_ws + OFF_CTL, 0, CTL_BYTES, stream);
    Params p{};
    p.x = (const float*)d_in[0]; p.c = (const float*)d_in[1]; p.w_ada = (const float*)d_in[2]; p.b_ada = (const float*)d_in[3]; p.norm1_g = (const float*)d_in[4];
    p.w_in = (const float*)d_in[5]; p.b_in = (const float*)d_in[6]; p.conv_qk = (const float*)d_in[7]; p.out_norm_m = (const float*)d_in[8]; p.out_norm_a = (const float*)d_in[9];
    p.w_out = (const float*)d_in[10]; p.norm2_g = (const float*)d_in[11]; p.w_peer_q = (const float*)d_in[12]; p.sub_keys = (const float*)d_in[13]; p.peer_u = (const float*)d_in[14];
    p.peer_v = (const float*)d_in[15]; p.final_g = (const float*)d_in[16];
    p.out = (float*)d_out; p.ws = (unsigned char*)d_ws; p.ph_lo = 0; p.ph_hi = PH_COUNT;
    void* args[] = {&p};
    hipError_t e = hipLaunchCooperativeKernel((const void*)hymba_fwd, dim3(grid), dim3(NTHREADS), args, LDS_BYTES, stream);
    if (e != hipSuccess) fprintf(stderr, "kernel_launch: cooperative launch failed: %s (grid %d)\n", hipGetErrorString(e), grid);
}
```

```cpp
#include <hip/hip_runtime.h>
#include <stdint.h>
#define REP_PHASE -1
#define DSA_REP 0
#include <cstdio>

#define LAS __attribute__((address_space(3)))
typedef unsigned short bf16_t;
typedef short bf16x8 __attribute__((ext_vector_type(8)));
typedef float f32x4 __attribute__((ext_vector_type(4)));
typedef float f32x2 __attribute__((ext_vector_type(2)));
typedef float f32x16 __attribute__((ext_vector_type(16)));
typedef unsigned u32x4 __attribute__((ext_vector_type(4)));
typedef unsigned u32x2 __attribute__((ext_vector_type(2)));

constexpr int NTOK = 16384, DM = 1024, SEQ = 4096;
constexpr int NIN_PAD = 3328;
constexpr int LDS_BYTES = 163840 - 64;
constexpr int NTHREADS = 512;

constexpr size_t MiB = 1024 * 1024;
constexpr size_t OFF_CTL = 0;
constexpr size_t CTL_BYTES = 16384;
constexpr size_t OFF_ADA = 64 * 1024;
constexpr size_t OFF_BIAS = 192 * 1024;
constexpr size_t OFF_SK = 256 * 1024;
constexpr size_t OFF_WIN = 512 * 1024;
constexpr size_t OFF_WOUT = 7 * MiB;
constexpr size_t OFF_WPQ = 9 * MiB;
constexpr size_t OFF_ACT = 11 * MiB;
constexpr size_t OFF_MQ = 43 * MiB;
constexpr size_t OFF_MK = 59 * MiB;
constexpr size_t OFF_MV = 75 * MiB;
constexpr size_t OFF_MO = 91 * MiB;
constexpr size_t OFF_AQ = 107 * MiB;
constexpr size_t OFF_IQ = 123 * MiB;
constexpr size_t OFF_AK = 139 * MiB;
constexpr size_t OFF_AV = 141 * MiB;
constexpr size_t OFF_IK = 143 * MiB;
constexpr size_t OFF_GATE = 145 * MiB;
constexpr size_t OFF_KV = 146 * MiB;
constexpr size_t OFF_KS = 178 * MiB;
constexpr size_t OFF_MLOC = 178 * MiB + 512 * 1024;
constexpr size_t OFF_BLAST = OFF_MLOC + 4096;
constexpr size_t OFF_M0 = OFF_BLAST + 4096;
constexpr size_t OFF_UT = 179 * MiB;
constexpr size_t OFF_VT = 195 * MiB;
constexpr size_t WS_END = 211 * MiB;
constexpr float PEER_SU = 812.8f;
constexpr float PEER_SV = 8.443f;
constexpr float PEER_SC = 2048.f;
constexpr size_t OFF_QRY = OFF_MQ;
constexpr size_t OFF_EIDX = OFF_MV;
constexpr size_t OFF_GW = OFF_MV + 8 * MiB;

struct Params {
    const float* x; const float* c; const float* w_ada; const float* b_ada; const float* norm1_g;
    const float* w_in; const float* b_in; const float* conv_qk; const float* out_norm_m; const float* out_norm_a;
    const float* w_out; const float* norm2_g; const float* w_peer_q; const float* sub_keys; const float* peer_u;
    const float* peer_v; const float* final_g;
    float* out; unsigned char* ws;
    int ph_lo, ph_hi;
};

__device__ __forceinline__ int opaque_tid() { int t = threadIdx.x; asm volatile("" : "+v"(t)); return t; }
__device__ __forceinline__ float bf2f(unsigned short b) { return __uint_as_float(((unsigned)b) << 16); }
__device__ __forceinline__ unsigned pack2(float lo, float hi) { unsigned r; asm("v_cvt_pk_bf16_f32 %0, %1, %2" : "=v"(r) : "v"(lo), "v"(hi)); return r; }
__device__ __forceinline__ unsigned short f2bf(float f) { return (unsigned short)(pack2(f, 0.f) & 0xffffu); }
__device__ __forceinline__ unsigned short f2bf_sw(float f) { unsigned u = __float_as_uint(f); u += 0x7FFFu + ((u >> 16) & 1u); return (unsigned short)(u >> 16); }
__device__ __forceinline__ float lo16(unsigned w) { return __uint_as_float(w << 16); }
__device__ __forceinline__ float hi16(unsigned w) { return __uint_as_float(w & 0xffff0000u); }
__device__ __forceinline__ float wave_sum_dpp(float v);
__device__ __forceinline__ float wave_sum(float v) { return wave_sum_dpp(v); }
__device__ __forceinline__ int wave_sum_i32_uniform(int v) {
    v += __builtin_amdgcn_update_dpp(0, v, 0xB1, 0xF, 0xF, true);
    v += __builtin_amdgcn_update_dpp(0, v, 0x4E, 0xF, 0xF, true);
    v += __builtin_amdgcn_update_dpp(0, v, 0x141, 0xF, 0xF, true);
    v += __builtin_amdgcn_update_dpp(0, v, 0x140, 0xF, 0xF, true);
    return __builtin_amdgcn_readlane(v, 0) + __builtin_amdgcn_readlane(v, 16) + __builtin_amdgcn_readlane(v, 32) + __builtin_amdgcn_readlane(v, 48);
}
__device__ __forceinline__ float wave_scan_add(float v, int lane) {
#pragma unroll
    for (int o = 1; o < 64; o <<= 1) { const float t = __shfl_up(v, o); if (lane >= o) v += t; }
    return v;
}
__device__ __forceinline__ float wave_scan_max(float v, int lane) {
#pragma unroll
    for (int o = 1; o < 64; o <<= 1) { const float t = __shfl_up(v, o); if (lane >= o) v = fmaxf(v, t); }
    return v;
}
__device__ __forceinline__ float wave_max(float v) {
#pragma unroll
    for (int o = 32; o >= 1; o >>= 1) v = fmaxf(v, __shfl_xor(v, o));
    return v;
}
#define dppf(v, ctrl) __uint_as_float((unsigned)__builtin_amdgcn_update_dpp(0, (int)__float_as_uint(v), (ctrl), 0xF, 0xF, true))
__device__ __forceinline__ float rlanef(float v, int l) { return __uint_as_float((unsigned)__builtin_amdgcn_readlane((int)__float_as_uint(v), l)); }
__device__ __forceinline__ float wave_sum_dpp(float v) {
    v += dppf(v, 0xB1); v += dppf(v, 0x4E); v += dppf(v, 0x141); v += dppf(v, 0x140);
    return (rlanef(v, 0) + rlanef(v, 16)) + (rlanef(v, 32) + rlanef(v, 48));
}
__device__ __forceinline__ float wave_max_dpp(float v) {
    v = fmaxf(v, dppf(v, 0xB1)); v = fmaxf(v, dppf(v, 0x4E)); v = fmaxf(v, dppf(v, 0x141)); v = fmaxf(v, dppf(v, 0x140));
    return fmaxf(fmaxf(rlanef(v, 0), rlanef(v, 16)), fmaxf(rlanef(v, 32), rlanef(v, 48)));
}
template <int STRIDE>
__device__ __forceinline__ unsigned xchg_u32(unsigned x, int lane) {
    if constexpr (STRIDE == 1) return (unsigned)__builtin_amdgcn_update_dpp(0, (int)x, 0xB1, 0xF, 0xF, true);
    else if constexpr (STRIDE == 2) return (unsigned)__builtin_amdgcn_update_dpp(0, (int)x, 0x4E, 0xF, 0xF, true);
    else if constexpr (STRIDE == 4) {
        const unsigned up = (unsigned)__builtin_amdgcn_update_dpp(0, (int)x, 0x104, 0xF, 0xF, true);
        const unsigned dn = (unsigned)__builtin_amdgcn_update_dpp(0, (int)x, 0x114, 0xF, 0xF, true);
        return (lane & 4) ? dn : up;
    }
    else if constexpr (STRIDE == 8) return (unsigned)__builtin_amdgcn_update_dpp(0, (int)x, 0x128, 0xF, 0xF, true);
    else if constexpr (STRIDE == 16) { const u32x2 r_ = __builtin_amdgcn_permlane16_swap(x, x, false, false); return (lane & 16) ? r_[0] : r_[1]; }
    else { const u32x2 r_ = __builtin_amdgcn_permlane32_swap(x, x, false, false); return (lane & 32) ? r_[0] : r_[1]; }
}
template <int STRIDE> __device__ __forceinline__ float xchg_f32(float x, int lane) { return __uint_as_float(xchg_u32<STRIDE>(__float_as_uint(x), lane)); }
__device__ __forceinline__ float row16_sum(float v) { v += dppf(v, 0xB1); v += dppf(v, 0x4E); v += dppf(v, 0x141); v += dppf(v, 0x140); return v; }
__device__ __forceinline__ float oct_sum(float v) { v += dppf(v, 0xB1); v += dppf(v, 0x4E); v += dppf(v, 0x141); return v; }
__device__ __forceinline__ float siluf(float x) { return x * __builtin_amdgcn_rcpf(1.f + __expf(-x)); }
__device__ __forceinline__ float sigmoidf_(float x) { return __builtin_amdgcn_rcpf(1.f + __expf(-x)); }
__device__ __forceinline__ float logsigmoidf_(float x) { return fminf(x, 0.f) - log1pf(__expf(-fabsf(x))); }

#define XB_TMO      128
#define XB_XCNT(j)  (256  + 64 * (j))
#define XB_XSUB(j)  (1280 + 64 * (j))
#define XB_XGEN(j)  (2304 + 64 * (j))
#define XB_TOP      3328
#define XB_TOPGEN   3392
#define XCD_BAR_WORDS 3456
#define XB_SPIN_CAP (1u << 22)
__device__ __forceinline__ unsigned xb_ld(unsigned* p)              { return __hip_atomic_load(p, __ATOMIC_RELAXED, __HIP_MEMORY_SCOPE_AGENT); }
__device__ __forceinline__ unsigned xb_add(unsigned* p, unsigned v) { return __hip_atomic_fetch_add(p, v, __ATOMIC_RELAXED, __HIP_MEMORY_SCOPE_AGENT); }
__device__ __forceinline__ unsigned xb_xcc_id() { return (unsigned)__builtin_amdgcn_s_getreg((3 << 11) | 20) & 0xFu; }
#define XB_SPIN(cond, bar) do { unsigned _sp = 0; while (cond) { __builtin_amdgcn_s_sleep(1); \
    if ((++_sp & 255u) == 0u) { if (xb_ld(&(bar)[XB_TMO])) break; if (_sp > XB_SPIN_CAP) { atomicAdd(&(bar)[XB_TMO], 1u); break; } } } } while (0)
struct XcdBarrier { unsigned* bar; unsigned x; volatile LAS unsigned* st; };
__device__ __forceinline__ XcdBarrier xcd_barrier_post(unsigned* bar, volatile LAS unsigned* st) {
    XcdBarrier b; b.bar = bar; b.x = xb_xcc_id(); b.st = st;
    if (threadIdx.x == 0) (void)xb_add(&bar[XB_XCNT(b.x)], 1u);
    return b;
}
__device__ __forceinline__ void xcd_barrier_complete(unsigned* bar, unsigned x, unsigned& nloc, unsigned& nx) {
    const unsigned G = gridDim.x * gridDim.y * gridDim.z;
    unsigned sum, cnt, mine, sp = 0u;
    for (;;) {
        sum = 0u; cnt = 0u; mine = 0u;
#pragma unroll
        for (unsigned j = 0; j < 16; ++j) { const unsigned c = xb_ld(&bar[XB_XCNT(j)]); sum += c; cnt += (c > 0u) ? 1u : 0u; mine = (j == x) ? c : mine; }
        if (sum == G) break;
        __builtin_amdgcn_s_sleep(1);
        if ((++sp & 255u) == 0u) { if (xb_ld(&bar[XB_TMO])) break; if (sp > XB_SPIN_CAP) { atomicAdd(&bar[XB_TMO], 1u); break; } }
    }
    nloc = mine > 0u ? mine : 1u; nx = cnt > 0u ? cnt : 1u;
}
__device__ __forceinline__ void xcd_barrier(const XcdBarrier& b) {
    asm volatile("s_waitcnt vmcnt(0)" ::: "memory");
    __syncthreads();
    if (threadIdx.x == 0) {
        unsigned* bar = b.bar;
        __builtin_amdgcn_s_waitcnt(0);
        unsigned nloc = b.st[0], nx = b.st[1];
        if (nloc == 0u) { xcd_barrier_complete(bar, b.x, nloc, nx); b.st[0] = nloc; b.st[1] = nx; }
        const unsigned old = xb_add(&bar[XB_XSUB(b.x)], 1u);
        const unsigned gen = old / nloc;
        if (old + 1u == (gen + 1u) * nloc) {
            __builtin_amdgcn_fence(__ATOMIC_RELEASE, "agent");
            asm volatile("s_waitcnt vmcnt(0)" ::: "memory");
            const unsigned og = xb_add(&bar[XB_TOP], 1u);
            const unsigned tg = og / nx;
            if (og + 1u == (tg + 1u) * nx) xb_add(&bar[XB_TOPGEN], 1u);
            else XB_SPIN(xb_ld(&bar[XB_TOPGEN]) == tg, bar);
            __builtin_amdgcn_fence(__ATOMIC_ACQUIRE, "agent");
            xb_add(&bar[XB_XGEN(b.x)], 1u);
            asm volatile("s_waitcnt vmcnt(0)" ::: "memory");
        } else {
            XB_SPIN(xb_ld(&bar[XB_XGEN(b.x)]) == gen, bar);
            __builtin_amdgcn_fence(__ATOMIC_ACQUIRE, "agent");
            asm volatile("s_waitcnt vmcnt(0)" ::: "memory");
        }
    }
    __syncthreads();
}

#define CNT_ADA  3600
#define CNT_MLA  3664
#define CNT_SCAN 3728
__device__ __forceinline__ void wg_signal(unsigned* ctl, int word) {
    asm volatile("s_waitcnt vmcnt(0)" ::: "memory");
    __syncthreads();
    if (threadIdx.x == 0) {
        __builtin_amdgcn_fence(__ATOMIC_RELEASE, "agent");
        asm volatile("s_waitcnt vmcnt(0)" ::: "memory");
        (void)xb_add(&ctl[word], 1u);
    }
}
__device__ __forceinline__ void wg_wait(unsigned* ctl, int word, unsigned need) {
    if (threadIdx.x == 0) {
        XB_SPIN(xb_ld(&ctl[word]) < need, ctl);
        __builtin_amdgcn_fence(__ATOMIC_ACQUIRE, "agent");
        asm volatile("s_waitcnt vmcnt(0)" ::: "memory");
    }
    __syncthreads();
}

namespace pg8 {
constexpr int BM = 256, BK = 64, HALF = 128, HTB = HALF * BK * 2, STAGE_BYTES = 8 * HTB, NXCD = 8, WGM = 8;
__host__ __device__ __forceinline__ int lds_byte(int r, int c) { const int st = (r >> 4) * 2 + (c >> 5), rr = r & 15, cc = c & 31, ob = rr * 64 + cc * 2; return st * 1024 + (ob ^ (((ob >> 9) & 1) << 5)); }
__host__ __device__ __forceinline__ void stage_rc(int b, int& R, int& C) { const int st = b / 1024, sb = b % 1024, swz = sb ^ (((sb >> 9) & 1) << 5); R = (st >> 1) * 16 + swz / 64; C = (st & 1) * 32 + (swz % 64) / 2; }
__host__ __device__ __forceinline__ int perm32(int rho) { const int n = rho >> 4, i = rho & 15; return 8 * (i >> 2) + 4 * n + (i & 3); }
struct Unit { int pm, pn; };
struct Gemm { const bf16_t* A; const bf16_t* Bt; int M, N, K; };
struct StaticOrder {
    int nM, nN, nwg, G, c;
    __host__ __device__ void init(int M, int N, int G_, int c_) { nM = M / BM; nN = N / BM; nwg = nM * nN; G = G_; c = c_; }
    __host__ __device__ bool next(int i, Unit& u) const {
        const long L = (long)i * G + c; if (L >= nwg) return false;
        int wgid = (int)L; { const int q = nwg / NXCD, r = nwg % NXCD, xcd = wgid % NXCD, off = wgid / NXCD; wgid = (xcd < r ? xcd * (q + 1) : r * (q + 1) + (xcd - r) * q) + off; }
        const int nig = WGM * nN, gid = wgid / nig, fm = gid * WGM, gsz = (nM - fm) < WGM ? (nM - fm) : WGM;
        u.pm = fm + ((wgid % nig) % gsz); u.pn = (wgid % nig) / gsz; return true;
    }
    __device__ __forceinline__ void a_ready(const Unit&) const {}
    __device__ __forceinline__ void done(const Unit&) const {}
};
__device__ __forceinline__ unsigned cvt_pk_bf16(float lo, float hi) { unsigned r; asm volatile("v_cvt_pk_bf16_f32 %0, %1, %2" : "=v"(r) : "v"(lo), "v"(hi)); return r; }

template <class Epi, class Sched>
__device__ __forceinline__ void gemm_phase(LAS unsigned char* lds, const Gemm g, const Sched& S, const Epi& E) {
    const int tid = threadIdx.x, wid = __builtin_amdgcn_readfirstlane(tid >> 6), lane = tid & 63, wr = wid >> 2, wc = wid & 3, fr = lane & 15, fq = lane >> 4;
    const int K = g.K, nt = K / BK;
    unsigned voffA[2], voffB[2];
#pragma unroll
    for (int i = 0; i < 2; ++i) { int R, C; stage_rc(tid * 16 + i * 8192, R, C); const int Rb = Epi::PERM ? ((R & ~31) + perm32(R & 31)) : R;
        voffA[i] = (unsigned)(R * K + C) * 2u; voffB[i] = (unsigned)(Rb * K + C) * 2u; }
    const size_t kstep = (size_t)(BK * 2);
    const size_t hstep = (size_t)HALF * K * 2;
    const size_t tstep = 2 * hstep;
    const unsigned ldsw = (unsigned)wid * 1024u;
    const int aoff = lds_byte(wr * 64 + fr, fq * 8), boff = lds_byte(wc * 32 + fr, fq * 8);
#define PG8_SA(b, h) (((b) * 2 + (h)) * HTB)
#define PG8_SB(b, h) ((4 + (b) * 2 + (h)) * HTB)
#define PG8_STAGE(bufoff, gbase, voff) do { _Pragma("unroll") for (int _i = 0; _i < 2; ++_i) \
        __builtin_amdgcn_global_load_lds((const unsigned*)((const char*)(gbase) + (voff)[_i]), (LAS unsigned*)(lds + (bufoff) + ldsw + _i * 8192), 16, 0, 0); } while (0)
#define PG8_LDA(dst, b, h) do { _Pragma("unroll") for (int m = 0; m < 4; ++m) _Pragma("unroll") for (int k = 0; k < 2; ++k) dst[m][k] = *(const LAS bf16x8*)(lds + PG8_SA(b, h) + aoff + m * 2048 + k * 1024); } while (0)
#define PG8_LDB(dst, b, h) do { _Pragma("unroll") for (int n = 0; n < 2; ++n) _Pragma("unroll") for (int k = 0; k < 2; ++k) dst[n][k] = *(const LAS bf16x8*)(lds + PG8_SB(b, h) + boff + n * 2048 + k * 1024); } while (0)
#define PG8_MMA(ai, bj, At, Bt) do { __builtin_amdgcn_s_setprio(1); _Pragma("unroll") for (int m = 0; m < 4; ++m) _Pragma("unroll") for (int n = 0; n < 2; ++n) _Pragma("unroll") for (int k = 0; k < 2; ++k) \
        acc[ai][bj][m][n] = __builtin_amdgcn_mfma_f32_16x16x32_bf16(Bt[n][k], At[m][k], acc[ai][bj][m][n], 0, 0, 0); __builtin_amdgcn_s_setprio(0); } while (0)
#define PG8_WAIT_V(n) asm volatile("s_waitcnt vmcnt(" #n ")" ::: "memory")
#define PG8_WAIT_L(n) asm volatile("s_waitcnt lgkmcnt(" #n ")" ::: "memory")
#define PG8_BAR __builtin_amdgcn_s_barrier()
#define PG8_SCHED __builtin_amdgcn_sched_barrier(0)
    Unit cur, nxt; int ui = 0;
    if (!S.next(0, cur)) return;
    f32x4 acc[2][2][4][2];
#pragma unroll
    for (int a = 0; a < 2; ++a)
#pragma unroll
        for (int b = 0; b < 2; ++b)
#pragma unroll
            for (int m = 0; m < 4; ++m)
#pragma unroll
                for (int n = 0; n < 2; ++n) acc[a][b][m][n] = (f32x4){0.f, 0.f, 0.f, 0.f};
    bf16x8 At[4][2], B0[2][2], B1[2][2];
    const char* cA = (const char*)g.A + (size_t)cur.pm * tstep; const char* cB = (const char*)g.Bt + (size_t)cur.pn * tstep;
    S.a_ready(cur);
    PG8_STAGE(PG8_SB(0, 0), cB, voffB); PG8_STAGE(PG8_SA(0, 0), cA, voffA); PG8_STAGE(PG8_SB(0, 1), cB + hstep, voffB); PG8_STAGE(PG8_SA(0, 1), cA + hstep, voffA);
    if (wr == 1) PG8_BAR;
    PG8_WAIT_V(4); PG8_BAR;
    PG8_STAGE(PG8_SB(1, 0), cB + kstep, voffB); PG8_STAGE(PG8_SA(1, 0), cA + kstep, voffA); PG8_STAGE(PG8_SB(1, 1), cB + hstep + kstep, voffB);
    PG8_WAIT_V(6); PG8_BAR;
    for (;;) {
        const bool has_next = S.next(ui + 1, nxt);
        const char* nA = has_next ? (const char*)g.A + (size_t)nxt.pm * tstep : cA; const char* nB = has_next ? (const char*)g.Bt + (size_t)nxt.pn * tstep : cB;
        for (int t = 0; t < nt; t += 2) {
            const bool last = (t == nt - 2);
            const char* a1 = cA + (size_t)(t + 1) * kstep;
            const char* a2 = last ? nA : cA + (size_t)(t + 2) * kstep; const char* b2 = last ? nB : cB + (size_t)(t + 2) * kstep;
            const char* a3 = a2 + kstep; const char* b3 = b2 + kstep;
            if (last && has_next) S.a_ready(nxt);
            PG8_LDB(B0, 0, 0); PG8_SCHED; PG8_LDA(At, 0, 0); PG8_STAGE(PG8_SA(1, 1), a1 + hstep, voffA);
            PG8_WAIT_L(8); PG8_BAR; PG8_WAIT_L(0); PG8_MMA(0, 0, At, B0); PG8_BAR; PG8_SCHED;
            PG8_LDB(B1, 0, 1); PG8_STAGE(PG8_SB(0, 0), b2, voffB);
            PG8_BAR; PG8_WAIT_L(0); PG8_MMA(0, 1, At, B1); PG8_BAR;
            PG8_LDA(At, 0, 1); PG8_STAGE(PG8_SA(0, 0), a2, voffA);
            PG8_BAR; PG8_WAIT_L(0); PG8_MMA(1, 0, At, B0); PG8_BAR; PG8_SCHED;
            PG8_STAGE(PG8_SB(0, 1), b2 + hstep, voffB);
            PG8_WAIT_V(6); PG8_BAR; PG8_MMA(1, 1, At, B1); PG8_BAR;
            PG8_LDB(B0, 1, 0); PG8_SCHED; PG8_LDA(At, 1, 0); PG8_STAGE(PG8_SA(0, 1), a2 + hstep, voffA);
            PG8_WAIT_L(8); PG8_BAR; PG8_WAIT_L(0); PG8_MMA(0, 0, At, B0); PG8_BAR; PG8_SCHED;
            PG8_LDB(B1, 1, 1); PG8_STAGE(PG8_SB(1, 0), b3, voffB);
            PG8_BAR; PG8_WAIT_L(0); PG8_MMA(0, 1, At, B1); PG8_BAR;
            PG8_LDA(At, 1, 1); PG8_STAGE(PG8_SA(1, 0), a3, voffA);
            PG8_BAR; PG8_WAIT_L(0); PG8_MMA(1, 0, At, B0); PG8_BAR; PG8_SCHED;
            PG8_STAGE(PG8_SB(1, 1), b3 + hstep, voffB);
            PG8_WAIT_V(6); PG8_BAR; PG8_MMA(1, 1, At, B1); PG8_BAR;
        }
        asm volatile("s_nop 15\n\ts_nop 15" ::: "memory");
        E(acc, cur, wr, wc, fr, fq); S.done(cur);
        if (!has_next) break;
#pragma unroll
        for (int a = 0; a < 2; ++a)
#pragma unroll
            for (int b = 0; b < 2; ++b)
#pragma unroll
                for (int m = 0; m < 4; ++m)
#pragma unroll
                    for (int n = 0; n < 2; ++n) acc[a][b][m][n] = (f32x4){0.f, 0.f, 0.f, 0.f};
        cur = nxt; cA = nA; cB = nB; ++ui;
    }
    PG8_WAIT_V(0);
    if (wr == 0) PG8_BAR;
    PG8_BAR;
#undef PG8_SA
#undef PG8_SB
#undef PG8_STAGE
#undef PG8_LDA
#undef PG8_LDB
#undef PG8_MMA
#undef PG8_WAIT_V
#undef PG8_WAIT_L
#undef PG8_BAR
#undef PG8_SCHED
}
}

struct EpiInMain {
    static constexpr bool PERM = true;
    unsigned char* ws; const float* bias;
    __device__ __forceinline__ void operator()(const f32x4 (&acc)[2][2][4][2], const pg8::Unit& u, int wr, int wc, int fr, int fq) const {
        const int row0 = u.pm * 256 + wr * 64 + fr;
        const int cl0 = wc * 32 + 8 * fq;
        bf16_t* base = (bf16_t*)(ws + OFF_MQ + (size_t)(u.pn >> 1) * (16 * MiB)) + (u.pn & 1) * 256 + cl0;
        const float* bp = bias + u.pn * 256 + cl0;
#pragma unroll
        for (int bj = 0; bj < 2; ++bj) {
            const f32x4 b0 = *(const f32x4*)(bp + bj * 128), b1 = *(const f32x4*)(bp + bj * 128 + 4);
#pragma unroll
            for (int ai = 0; ai < 2; ++ai)
#pragma unroll
                for (int m = 0; m < 4; ++m) {
                    const f32x4 v0 = acc[ai][bj][m][0] + b0, v1 = acc[ai][bj][m][1] + b1;
                    u32x4 o; o[0] = pg8::cvt_pk_bf16(v0[0], v0[1]); o[1] = pg8::cvt_pk_bf16(v0[2], v0[3]); o[2] = pg8::cvt_pk_bf16(v1[0], v1[1]); o[3] = pg8::cvt_pk_bf16(v1[2], v1[3]);
                    *(u32x4*)(base + (size_t)(row0 + ai * 128 + m * 16) * 512 + bj * 128) = o;
                }
        }
    }
};
struct EpiInTail {
    static constexpr bool PERM = true;
    unsigned char* ws; const float* bias;
    __device__ __forceinline__ void operator()(const f32x4 (&acc)[2][2][4][2], const pg8::Unit& u, int wr, int wc, int fr, int fq) const {
        const int row0 = u.pm * 256 + wr * 64 + fr;
        const int cl0 = wc * 32 + 8 * fq;
#pragma unroll
        for (int bj = 0; bj < 2; ++bj) {
            const int cl = bj * 128 + cl0;
            if (cl >= 208) continue;
            const f32x4 b0 = *(const f32x4*)(bias + cl), b1 = *(const f32x4*)(bias + cl + 4);
            if (cl < 192) {
                bf16_t* dst = (bf16_t*)(ws + OFF_AK + (size_t)(cl >> 6) * (2 * MiB)) + (cl & 63);
#pragma unroll
                for (int ai = 0; ai < 2; ++ai)
#pragma unroll
                    for (int m = 0; m < 4; ++m) {
                        const f32x4 v0 = acc[ai][bj][m][0] + b0, v1 = acc[ai][bj][m][1] + b1;
                        u32x4 o; o[0] = pg8::cvt_pk_bf16(v0[0], v0[1]); o[1] = pg8::cvt_pk_bf16(v0[2], v0[3]); o[2] = pg8::cvt_pk_bf16(v1[0], v1[1]); o[3] = pg8::cvt_pk_bf16(v1[2], v1[3]);
                        const int row = row0 + ai * 128 + m * 16;
                        if (cl < 128) *(u32x4*)(dst + (size_t)row * 64) = o;
                        else *(u32x4*)((bf16_t*)(ws + OFF_IK) + (size_t)(row >> 5) * 2048 + (((cl - 128) >> 3) * 32 + (row & 31)) * 8) = o;
                    }
            } else {
                float* dst = (float*)(ws + OFF_GATE) + (cl - 192);
#pragma unroll
                for (int ai = 0; ai < 2; ++ai)
#pragma unroll
                    for (int m = 0; m < 4; ++m) {
                        float* d = dst + (size_t)(row0 + ai * 128 + m * 16) * 16;
                        *(f32x4*)d = acc[ai][bj][m][0] + b0; *(f32x4*)(d + 4) = acc[ai][bj][m][1] + b1;
                    }
            }
        }
    }
};
struct EpiOut {
    static constexpr bool PERM = false;
    const float* x; const float* ada; float* out;
    __device__ __forceinline__ void operator()(const f32x4 (&acc)[2][2][4][2], const pg8::Unit& u, int wr, int wc, int fr, int fq) const {
        const int row0 = u.pm * 256 + wr * 64 + fr, col0 = u.pn * 256 + wc * 32 + 4 * fq;
        const int b = (u.pm * 256) >> 12;
        f32x4 gv[2][2];
#pragma unroll
        for (int bj = 0; bj < 2; ++bj)
#pragma unroll
            for (int n = 0; n < 2; ++n) gv[bj][n] = *(const f32x4*)(ada + b * 6144 + 2048 + col0 + bj * 128 + n * 16);
#pragma unroll
        for (int ai = 0; ai < 2; ++ai)
#pragma unroll
            for (int m = 0; m < 4; ++m) {
                const size_t ro = (size_t)(row0 + ai * 128 + m * 16) * 1024 + col0;
#pragma unroll
                for (int bj = 0; bj < 2; ++bj)
#pragma unroll
                    for (int n = 0; n < 2; ++n) {
                        const f32x4 xv = *(const f32x4*)(x + ro + bj * 128 + n * 16);
                        *(f32x4*)(out + ro + bj * 128 + n * 16) = xv + gv[bj][n] * acc[ai][bj][m][n];
                    }
            }
    }
};
struct EpiQry {
    static constexpr bool PERM = true;
    bf16_t* O;
    __device__ __forceinline__ void operator()(const f32x4 (&acc)[2][2][4][2], const pg8::Unit& u, int wr, int wc, int fr, int fq) const {
        const int row0 = u.pm * 256 + wr * 64 + fr, col0 = u.pn * 256 + wc * 32 + 8 * fq;
#pragma unroll
        for (int ai = 0; ai < 2; ++ai)
#pragma unroll
            for (int m = 0; m < 4; ++m) {
                bf16_t* rowp = O + (size_t)(row0 + ai * 128 + m * 16) * 1024 + col0;
#pragma unroll
                for (int bj = 0; bj < 2; ++bj) {
                    const f32x4 v0 = acc[ai][bj][m][0], v1 = acc[ai][bj][m][1];
                    u32x4 o; o[0] = pg8::cvt_pk_bf16(v0[0], v0[1]); o[1] = pg8::cvt_pk_bf16(v0[2], v0[3]); o[2] = pg8::cvt_pk_bf16(v1[0], v1[1]); o[3] = pg8::cvt_pk_bf16(v1[2], v1[3]);
                    *(u32x4*)(rowp + bj * 128) = o;
                }
            }
    }
};

__device__ __forceinline__ int inperm_src(int n) {
    if (n < 2048) return n;
    if (n < 2560) return 2056 + (n - 2048);
    if (n < 3072) return 2696 + (n - 2560);
    if (n < 3136) return 2568 + (n - 3072);
    if (n < 3200) return 2632 + (n - 3136);
    if (n < 3264) return 3208 + (n - 3200);
    if (n < 3268) return 2048 + (n - 3264);
    if (n < 3272) return 2052 + (n - 3268);
    if (n < 3280) return 3272 + (n - 3272);
    return -1;
}
template <bool PERMUTE>
__device__ __forceinline__ void transpose_tile(const float* src, int ld, bf16_t* dst, int n0, int k0, LAS float* t) {
    const int tid = threadIdx.x;
    for (int i = tid; i < 4096; i += NTHREADS) {
        const int kk = i >> 6, nn = i & 63;
        const int sc = PERMUTE ? inperm_src(n0 + nn) : (n0 + nn);
        t[kk * 65 + nn] = sc >= 0 ? src[(size_t)(k0 + kk) * ld + sc] : 0.f;
    }
    __syncthreads();
    for (int i = tid; i < 2048; i += NTHREADS) {
        const int nn = i >> 5, kp = (i & 31) * 2;
        ((unsigned*)dst)[((size_t)(n0 + nn) * 1024 + k0 + kp) >> 1] = pack2(t[kp * 65 + nn], t[(kp + 1) * 65 + nn]);
    }
    __syncthreads();
}
__device__ __forceinline__ void convert_chunk(const float* src, bf16_t* dst, size_t e0, int n) {
    for (int i = threadIdx.x * 8; i < n; i += NTHREADS * 8) {
        const f32x4 a = *(const f32x4*)(src + e0 + i), b = *(const f32x4*)(src + e0 + i + 4);
        u32x4 o; o[0] = pack2(a[0], a[1]); o[1] = pack2(a[2], a[3]); o[2] = pack2(b[0], b[1]); o[3] = pack2(b[2], b[3]);
        *(u32x4*)(dst + e0 + i) = o;
    }
}
__device__ __forceinline__ unsigned pack4_fp8(float a, float b, float c, float d) {
    a = fminf(fmaxf(a, -448.f), 448.f); b = fminf(fmaxf(b, -448.f), 448.f); c = fminf(fmaxf(c, -448.f), 448.f); d = fminf(fmaxf(d, -448.f), 448.f);
    int w = 0;
    w = __builtin_amdgcn_cvt_pk_fp8_f32(a, b, w, false);
    w = __builtin_amdgcn_cvt_pk_fp8_f32(c, d, w, true);
    return (unsigned)w;
}
__device__ __forceinline__ void convert_chunk_fp8(const float* src, unsigned char* dst, size_t e0, int n, float scale) {
    for (int i = threadIdx.x * 16; i < n; i += NTHREADS * 16) {
        const f32x4 a = *(const f32x4*)(src + e0 + i), b = *(const f32x4*)(src + e0 + i + 4), c = *(const f32x4*)(src + e0 + i + 8), d = *(const f32x4*)(src + e0 + i + 12);
        u32x4 o; o[0] = pack4_fp8(a[0] * scale, a[1] * scale, a[2] * scale, a[3] * scale); o[1] = pack4_fp8(b[0] * scale, b[1] * scale, b[2] * scale, b[3] * scale);
        o[2] = pack4_fp8(c[0] * scale, c[1] * scale, c[2] * scale, c[3] * scale); o[3] = pack4_fp8(d[0] * scale, d[1] * scale, d[2] * scale, d[3] * scale);
        *(u32x4*)(dst + e0 + i) = o;
    }
}
__device__ __forceinline__ unsigned pack8_fp4(const f32x4 a, const f32x4 b, float scale) {
    float v[8] = {a[0] * scale, a[1] * scale, a[2] * scale, a[3] * scale, b[0] * scale, b[1] * scale, b[2] * scale, b[3] * scale};
#pragma unroll
    for (int i = 0; i < 8; ++i) v[i] = fminf(fmaxf(v[i], -6.f), 6.f);
    unsigned w = 0;
    w = __builtin_amdgcn_cvt_scalef32_pk_fp4_f32(w, v[0], v[1], 1.0f, 0);
    w = __builtin_amdgcn_cvt_scalef32_pk_fp4_f32(w, v[2], v[3], 1.0f, 1);
    w = __builtin_amdgcn_cvt_scalef32_pk_fp4_f32(w, v[4], v[5], 1.0f, 2);
    w = __builtin_amdgcn_cvt_scalef32_pk_fp4_f32(w, v[6], v[7], 1.0f, 3);
    return w;
}
__device__ __forceinline__ void convert_chunk_fp4(const float* src, unsigned char* dst, size_t e0, int n, float scale) {
    for (int i = threadIdx.x * 32; i < n; i += NTHREADS * 32) {
        u32x4 o;
#pragma unroll
        for (int k = 0; k < 4; ++k) o[k] = pack8_fp4(*(const f32x4*)(src + e0 + i + 8 * k), *(const f32x4*)(src + e0 + i + 8 * k + 4), scale);
        *(u32x4*)(dst + ((e0 + i) >> 1)) = o;
    }
}
__device__ __forceinline__ unsigned pack4_i8(float a, float b, float c, float d, float scale) {
    const int ia = (int)fminf(fmaxf(rintf(a * scale), -127.f), 127.f), ib = (int)fminf(fmaxf(rintf(b * scale), -127.f), 127.f);
    const int ic = (int)fminf(fmaxf(rintf(c * scale), -127.f), 127.f), id = (int)fminf(fmaxf(rintf(d * scale), -127.f), 127.f);
    return (unsigned)(ia & 0xFF) | ((unsigned)(ib & 0xFF) << 8) | ((unsigned)(ic & 0xFF) << 16) | ((unsigned)(id & 0xFF) << 24);
}
__device__ __forceinline__ void convert_chunk_i8(const float* src, unsigned char* dst, size_t e0, int n, float scale) {
    for (int i = threadIdx.x * 16; i < n; i += NTHREADS * 16) {
        const f32x4 a = *(const f32x4*)(src + e0 + i), b = *(const f32x4*)(src + e0 + i + 4), c = *(const f32x4*)(src + e0 + i + 8), d = *(const f32x4*)(src + e0 + i + 12);
        u32x4 o; o[0] = pack4_i8(a[0], a[1], a[2], a[3], scale); o[1] = pack4_i8(b[0], b[1], b[2], b[3], scale); o[2] = pack4_i8(c[0], c[1], c[2], c[3], scale); o[3] = pack4_i8(d[0], d[1], d[2], d[3], scale);
        *(u32x4*)(dst + e0 + i) = o;
    }
}
__device__ __forceinline__ unsigned pack8_i4(const f32x4 a, const f32x4 b, float scale) {
    unsigned w = 0;
#pragma unroll
    for (int k = 0; k < 4; ++k) {
        const int qa = (int)fminf(fmaxf(rintf(a[k] * scale), -7.f), 7.f) + 8, qb = (int)fminf(fmaxf(rintf(b[k] * scale), -7.f), 7.f) + 8;
        w |= (unsigned)qa << (4 * k); w |= (unsigned)qb << (4 * (k + 4));
    }
    return w;
}
__device__ __forceinline__ void convert_chunk_i4(const float* src, unsigned char* dst, size_t e0, int n, float scale) {
    for (int i = threadIdx.x * 32; i < n; i += NTHREADS * 32) {
        u32x4 o;
#pragma unroll
        for (int k = 0; k < 4; ++k) o[k] = pack8_i4(*(const f32x4*)(src + e0 + i + 8 * k), *(const f32x4*)(src + e0 + i + 8 * k + 4), scale);
        *(u32x4*)(dst + ((e0 + i) >> 1)) = o;
    }
}
__device__ __forceinline__ void convert_tables(const Params& p, int first, int stride) {
    for (int it = first; it < 1024; it += stride) {
        const int tsel = it >> 9; const size_t e0 = (size_t)(it & 511) * 32768;
        if (tsel) convert_chunk_i4(p.peer_v, p.ws + OFF_VT, e0, 32768, PEER_SV); else convert_chunk_i8(p.peer_u, p.ws + OFF_UT, e0, 32768, PEER_SU);
    }
}
__device__ __forceinline__ void phase0(const Params& p, LAS unsigned char* lds) {
    const int tid = threadIdx.x;
    float* ada = (float*)(p.ws + OFF_ADA);
    LAS float* lf = (LAS float*)lds;
    constexpr int N_ADA = 192, N_WIN = 52 * 16, N_WOUT = 256, N_WPQ = 256, N_SK = 4, N_BIAS = 1;
    constexpr int NITEMS = N_ADA + N_WIN + N_WOUT + N_WPQ + N_SK + N_BIAS;
    if (blockIdx.x < N_ADA) {
        {
            const int it = blockIdx.x;
            LAS float* sc = lf; LAS float* red = lf + 4096;
            for (int i = tid; i < 4096; i += NTHREADS) sc[i] = siluf(p.c[i]);
            __syncthreads();
            const int col = tid & 31, kg = tid >> 5, c0 = it * 32;
            float a0 = 0.f, a1 = 0.f, a2 = 0.f, a3 = 0.f;
            const float* w = p.w_ada + c0 + col;
#pragma unroll 8
            for (int j = 0; j < 64; ++j) { const int k = kg + 16 * j; const float wv = w[(size_t)k * 6144];
                a0 += sc[k] * wv; a1 += sc[1024 + k] * wv; a2 += sc[2048 + k] * wv; a3 += sc[3072 + k] * wv; }
            red[(kg * 4 + 0) * 32 + col] = a0; red[(kg * 4 + 1) * 32 + col] = a1; red[(kg * 4 + 2) * 32 + col] = a2; red[(kg * 4 + 3) * 32 + col] = a3;
            __syncthreads();
            if (tid < 128) { const int b = tid >> 5, cc = tid & 31; float s = 0.f;
                for (int g = 0; g < 16; ++g) s += red[(g * 4 + b) * 32 + cc];
                ada[b * 6144 + c0 + cc] = s + p.b_ada[c0 + cc]; }
        }
        wg_signal((unsigned*)(p.ws + OFF_CTL), CNT_ADA);
        __syncthreads();
    }
    for (int item = N_ADA + ((blockIdx.x + gridDim.x - N_ADA) % gridDim.x); item < NITEMS; item += gridDim.x) {
        int it = item;
        it -= N_ADA;
        if (it < N_WIN) { transpose_tile<true>(p.w_in, 3280, (bf16_t*)(p.ws + OFF_WIN), (it >> 4) * 64, (it & 15) * 64, lf); continue; }
        it -= N_WIN;
        if (it < N_WOUT) { transpose_tile<false>(p.w_out, 1024, (bf16_t*)(p.ws + OFF_WOUT), (it >> 4) * 64, (it & 15) * 64, lf); continue; }
        it -= N_WOUT;
        if (it < N_WPQ) { transpose_tile<false>(p.w_peer_q, 1024, (bf16_t*)(p.ws + OFF_WPQ), (it >> 4) * 64, (it & 15) * 64, lf); continue; }
        it -= N_WPQ;

        if (it < N_SK) { convert_chunk(p.sub_keys, (bf16_t*)(p.ws + OFF_SK), (size_t)it * 32768, 32768); continue; }
        it -= N_SK;
        { float* bias = (float*)(p.ws + OFF_BIAS);
          for (int n = tid; n < NIN_PAD; n += NTHREADS) { const int s = inperm_src(n); bias[n] = s >= 0 ? p.b_in[s] : 0.f; } }
    }
}

__device__ __forceinline__ void norm_mod_rows(const float* X, const float* g, const float* ada, int sh_off, int sc_off, bf16_t* out) {
    const int wid = threadIdx.x >> 6, lane = threadIdx.x & 63;
    for (int row = (blockIdx.x * 8 + wid) * 2; row < NTOK; row += gridDim.x * 16) {
        const int b = row >> 12;
        f32x4 v[2][4]; float ss[2] = {0.f, 0.f};
#pragma unroll
        for (int rr = 0; rr < 2; ++rr)
#pragma unroll
            for (int j = 0; j < 4; ++j) v[rr][j] = *(const f32x4*)(X + (size_t)(row + rr) * 1024 + 4 * (lane + 64 * j));
#pragma unroll
        for (int rr = 0; rr < 2; ++rr)
#pragma unroll
            for (int j = 0; j < 4; ++j) ss[rr] += v[rr][j][0] * v[rr][j][0] + v[rr][j][1] * v[rr][j][1] + v[rr][j][2] * v[rr][j][2] + v[rr][j][3] * v[rr][j][3];
        ss[0] = wave_sum(ss[0]); ss[1] = wave_sum(ss[1]);
        const float rstd0 = rsqrtf(ss[0] * (1.f / 1024.f) + 1e-6f), rstd1 = rsqrtf(ss[1] * (1.f / 1024.f) + 1e-6f);
#pragma unroll
        for (int j = 0; j < 4; ++j) {
            const int c = 4 * (lane + 64 * j);
            const f32x4 gg = *(const f32x4*)(g + c), sc = *(const f32x4*)(ada + b * 6144 + sc_off + c), sh = *(const f32x4*)(ada + b * 6144 + sh_off + c);
#pragma unroll
            for (int rr = 0; rr < 2; ++rr) {
                const float rstd = rr ? rstd1 : rstd0;
                float h[4];
#pragma unroll
                for (int i = 0; i < 4; ++i) h[i] = (v[rr][j][i] * rstd * gg[i]) * (1.f + sc[i]) + sh[i];
                u32x2 o; o[0] = pack2(h[0], h[1]); o[1] = pack2(h[2], h[3]);
                *(u32x2*)(out + (size_t)(row + rr) * 1024 + c) = o;
            }
        }
    }
}

__device__ __forceinline__ bf16x8 lds_frag(const LAS bf16_t* base, int row, int stride, int kofs) { return *(const LAS bf16x8*)(base + row * stride + kofs); }

__device__ __forceinline__ void conv_silu8(const bf16_t* src, const float* cw  , int row, int tpos, int col, float scale, float (&o)[8]) {
    float acc[8];
#pragma unroll
    for (int i = 0; i < 8; ++i) acc[i] = 0.f;
#pragma unroll
    for (int j = 0; j < 4; ++j) {
        const int tt = tpos - 3 + j;
        if (tt >= 0) {
            const u32x4 xv = *(const u32x4*)(src + (size_t)(row - 3 + j) * 512 + col);
            const f32x4 w0 = *(const f32x4*)(cw + j * 1024), w1 = *(const f32x4*)(cw + j * 1024 + 4);
            acc[0] += w0[0] * lo16(xv[0]); acc[1] += w0[1] * hi16(xv[0]); acc[2] += w0[2] * lo16(xv[1]); acc[3] += w0[3] * hi16(xv[1]);
            acc[4] += w1[0] * lo16(xv[2]); acc[5] += w1[1] * hi16(xv[2]); acc[6] += w1[2] * lo16(xv[3]); acc[7] += w1[3] * hi16(xv[3]);
        }
    }
#pragma unroll
    for (int i = 0; i < 8; ++i) o[i] = siluf(acc[i]) * scale;
}

__device__ __forceinline__ void mlstm_passA(const Params& p, int task, LAS unsigned char* lds) {
    const int tid = opaque_tid(), wid = tid >> 6, lane = tid & 63;
    const int bh = task >> 6, c = task & 63, b = bh >> 2, h = bh & 3;
    const int row0 = b * SEQ + c * 64;
    const float* gates = (const float*)(p.ws + OFF_GATE);
    const bf16_t* MK = (const bf16_t*)(p.ws + OFF_MK); const bf16_t* MV = (const bf16_t*)(p.ws + OFF_MV);
    LAS bf16_t* KT = (LAS bf16_t*)lds;
    LAS bf16_t* VT = KT + 128 * 72;
    LAS float* sc = (LAS float*)(VT + 128 * 72);
    LAS float* lsg = sc; LAS float* ig = sc + 64; LAS float* wloc = sc + 128; LAS float* misc = sc + 192;
    if (tid < 64) {
        const float f = gates[(size_t)(row0 + tid) * 16 + 4 + h], iv = gates[(size_t)(row0 + tid) * 16 + h];
        const float bc = wave_scan_add(logsigmoidf_(f), lane);
        const float bl = __shfl(bc, 63);
        const float a = bl - bc + iv;
        const float m = wave_max(a);
        lsg[tid] = bc; ig[tid] = iv; wloc[tid] = __expf(a - m);
        if (tid == 0) { misc[0] = m; misc[1] = bl; }
    }
    __syncthreads();
    for (int pc = tid; pc < 1024; pc += NTHREADS) {
        const int s = pc >> 4, dg = pc & 15;
        float kk[8];
        conv_silu8(MK, p.conv_qk + 512 + h * 128 + dg * 8, row0 + s, c * 64 + s, h * 128 + dg * 8, 1.f, kk);
#pragma unroll
        for (int i = 0; i < 8; ++i) KT[(dg * 8 + i) * 72 + s] = f2bf(kk[i]);
        const u32x4 vv = *(const u32x4*)(MV + (size_t)(row0 + s) * 512 + h * 128 + dg * 8);
        const float w = wloc[s];
#pragma unroll
        for (int i = 0; i < 4; ++i) { VT[(dg * 8 + 2 * i) * 72 + s] = f2bf(lo16(vv[i]) * w); VT[(dg * 8 + 2 * i + 1) * 72 + s] = f2bf(hi16(vv[i]) * w); }
    }
    __syncthreads();
    {
        const int r = lane & 15, g = lane >> 4;
        bf16x8 a0 = lds_frag(VT, wid * 16 + r, 72, 8 * g), a1 = lds_frag(VT, wid * 16 + r, 72, 8 * g + 32);
        bf16_t* KV = (bf16_t*)(p.ws + OFF_KV) + (size_t)task * 16384;
#pragma unroll
        for (int dt = 0; dt < 8; ++dt) {
            f32x4 acc = {0.f, 0.f, 0.f, 0.f};
            acc = __builtin_amdgcn_mfma_f32_16x16x32_bf16(a0, lds_frag(KT, dt * 16 + r, 72, 8 * g), acc, 0, 0, 0);
            acc = __builtin_amdgcn_mfma_f32_16x16x32_bf16(a1, lds_frag(KT, dt * 16 + r, 72, 8 * g + 32), acc, 0, 0, 0);
#pragma unroll
            for (int j = 0; j < 4; ++j) KV[(wid * 16 + 4 * g + j) * 128 + dt * 16 + r] = f2bf_sw(acc[j]);
        }
    }
    if (tid < 128) {
        float s = 0.f;
        for (int i = 0; i < 64; ++i) s += wloc[i] * bf2f(KT[tid * 72 + i]);
        ((float*)(p.ws + OFF_KS))[(size_t)task * 128 + tid] = s;
    }
    if (tid == 0) { ((float*)(p.ws + OFF_MLOC))[task] = misc[0]; ((float*)(p.ws + OFF_BLAST))[task] = misc[1]; }
    __syncthreads();
}

__device__ __forceinline__ void mlstm_scan(const Params& p, int item, LAS unsigned char* lds) {
    const int tid = opaque_tid();
    const int bh = item >> 4, blk = item & 15;
    LAS float* dec = (LAS float*)lds; LAS float* inj = dec + 64;
    if (tid == 0) {
        const float* ML = (const float*)(p.ws + OFF_MLOC); const float* BL = (const float*)(p.ws + OFF_BLAST); float* M0 = (float*)(p.ws + OFF_M0);
        float m = 0.f;
        for (int c = 0; c < 64; ++c) {
            const float ml = ML[bh * 64 + c], bl = BL[bh * 64 + c];
            if (blk == 0) M0[bh * 64 + c] = m;
            const float mn = fmaxf(bl + m, ml);
            dec[c] = __expf(bl + m - mn); inj[c] = __expf(ml - mn); m = mn;
        }
    }
    __syncthreads();
    unsigned* KV = (unsigned*)(p.ws + OFF_KV) + (size_t)bh * 64 * 8192 + blk * 512 + tid;
    float s0 = 0.f, s1 = 0.f;
#pragma unroll 8
    for (int c = 0; c < 64; ++c) {
        const unsigned w = KV[(size_t)c * 8192];
        KV[(size_t)c * 8192] = pack2(s0, s1);
        s0 = dec[c] * s0 + inj[c] * lo16(w); s1 = dec[c] * s1 + inj[c] * hi16(w);
    }
    if (blk == 0 && tid < 128) {
        float* KS = (float*)(p.ws + OFF_KS) + (size_t)bh * 64 * 128 + tid;
        float s = 0.f;
        for (int c = 0; c < 64; ++c) { const float k = KS[c * 128]; KS[c * 128] = s; s = dec[c] * s + inj[c] * k; }
    }
    __syncthreads();
}

__device__ __forceinline__ void mlstm_passB(const Params& p, int task, LAS unsigned char* lds) {
    const int tid = opaque_tid(), wid = tid >> 6, lane = tid & 63;
    const int bh = task >> 6, c = task & 63, b = bh >> 2, h = bh & 3;
    const int row0 = b * SEQ + c * 64;
    const float* gates = (const float*)(p.ws + OFF_GATE);
    const bf16_t* MQ = (const bf16_t*)(p.ws + OFF_MQ); const bf16_t* MK = (const bf16_t*)(p.ws + OFF_MK);
    const bf16_t* MV = (const bf16_t*)(p.ws + OFF_MV); const bf16_t* MO = (const bf16_t*)(p.ws + OFF_MO);
    LAS bf16_t* Q = (LAS bf16_t*)lds;
    LAS bf16_t* K = Q + 64 * 136;
    LAS bf16_t* VT = K + 64 * 136;
    LAS bf16_t* C0 = VT + 128 * 72;
    LAS bf16_t* P = C0 + 128 * 136;
    LAS float* sc = (LAS float*)(P + 64 * 72);
    LAS float* bcum = sc; LAS float* ig = sc + 64; LAS float* cs = sc + 128; LAS float* rb = sc + 192; LAS float* wint = sc + 256;
    LAS float* emt = sc + 320; LAS float* rinv = sc + 384; LAS float* qn = sc + 448; LAS float* n0 = sc + 512; LAS float* rowpart = sc + 640;
    LAS float* H = (LAS float*)lds;
    if (tid < 64) {
        const float f = gates[(size_t)(row0 + tid) * 16 + 4 + h], iv = gates[(size_t)(row0 + tid) * 16 + h];
        const float m0 = ((const float*)(p.ws + OFF_M0))[task];
        const float sc_ = wave_scan_add(logsigmoidf_(f), lane);
        const float cst = iv - sc_;
        const float pm = wave_scan_max(cst, lane);
        const float m_intra = sc_ + pm, m_inter = sc_ + m0, mt = fmaxf(m_inter, m_intra);
        bcum[tid] = sc_; ig[tid] = iv; cs[tid] = cst; rb[tid] = sc_ - mt; wint[tid] = __expf(m_inter - mt); emt[tid] = __expf(-mt);
    }
    if (tid >= 64 && tid < 192) n0[tid - 64] = ((const float*)(p.ws + OFF_KS))[(size_t)task * 128 + tid - 64];
    for (int pc = tid; pc < 1024; pc += NTHREADS) {
        const int s = pc >> 4, dg = pc & 15;
        float qq[8], kk[8];
        conv_silu8(MQ, p.conv_qk + h * 128 + dg * 8, row0 + s, c * 64 + s, h * 128 + dg * 8, 0.08838834764831845f, qq);
        conv_silu8(MK, p.conv_qk + 512 + h * 128 + dg * 8, row0 + s, c * 64 + s, h * 128 + dg * 8, 1.f, kk);
        u32x4 qo, ko;
#pragma unroll
        for (int i = 0; i < 4; ++i) { qo[i] = pack2(qq[2 * i], qq[2 * i + 1]); ko[i] = pack2(kk[2 * i], kk[2 * i + 1]); }
        *(LAS u32x4*)(Q + s * 136 + dg * 8) = qo; *(LAS u32x4*)(K + s * 136 + dg * 8) = ko;
        const u32x4 vv = *(const u32x4*)(MV + (size_t)(row0 + s) * 512 + h * 128 + dg * 8);
#pragma unroll
        for (int i = 0; i < 4; ++i) { VT[(dg * 8 + 2 * i) * 72 + s] = (bf16_t)(vv[i] & 0xffffu); VT[(dg * 8 + 2 * i + 1) * 72 + s] = (bf16_t)(vv[i] >> 16); }
    }
    {
        const bf16_t* KV = (const bf16_t*)(p.ws + OFF_KV) + (size_t)task * 16384;
        for (int pc = tid; pc < 2048; pc += NTHREADS) { const int e = pc >> 4, dg = pc & 15;
            *(LAS u32x4*)(C0 + e * 136 + dg * 8) = *(const u32x4*)(KV + e * 128 + dg * 8); }
    }
    __syncthreads();
    const int r = lane & 15, g = lane >> 4;
    {
        const int t = tid >> 3, part = tid & 7; float s = 0.f;
#pragma unroll
        for (int i = 0; i < 16; ++i) s += bf2f(Q[t * 136 + part * 16 + i]) * n0[part * 16 + i];
        s = oct_sum(s);
        if (part == 0) qn[t] = s;
    }
    {
        const int rt = wid >> 1;
#pragma unroll
        for (int cc = 0; cc < 2; ++cc) {
            const int ct = 2 * (wid & 1) + cc;
            f32x4 acc = {0.f, 0.f, 0.f, 0.f};
#pragma unroll
            for (int ks = 0; ks < 4; ++ks)
                acc = __builtin_amdgcn_mfma_f32_16x16x32_bf16(lds_frag(Q, rt * 16 + r, 136, 8 * g + 32 * ks), lds_frag(K, ct * 16 + r, 136, 8 * g + 32 * ks), acc, 0, 0, 0);
            const int scol = ct * 16 + r; const float csv = cs[scol];
#pragma unroll
            for (int j = 0; j < 4; ++j) {
                const int t = rt * 16 + 4 * g + j;
                float pv = (scol <= t) ? acc[j] * __expf(rb[t] + csv) : 0.f;
                P[t * 72 + scol] = f2bf(pv);
                pv = row16_sum(pv);
                if (r == 0) rowpart[t * 4 + ct] = pv;
            }
        }
    }
    __syncthreads();
    if (tid < 64) {
        const float den = rowpart[tid * 4] + rowpart[tid * 4 + 1] + rowpart[tid * 4 + 2] + rowpart[tid * 4 + 3] + wint[tid] * qn[tid];
        rinv[tid] = 1.f / fmaxf(fabsf(den), emt[tid]);
    }
    f32x4 hacc[4];
    {
        const int rt = wid >> 1;
#pragma unroll
        for (int ee = 0; ee < 4; ++ee) {
            const int et = 4 * (wid & 1) + ee;
            f32x4 a1 = {0.f, 0.f, 0.f, 0.f}, a2 = {0.f, 0.f, 0.f, 0.f};
#pragma unroll
            for (int ks = 0; ks < 2; ++ks)
                a1 = __builtin_amdgcn_mfma_f32_16x16x32_bf16(lds_frag(P, rt * 16 + r, 72, 8 * g + 32 * ks), lds_frag(VT, et * 16 + r, 72, 8 * g + 32 * ks), a1, 0, 0, 0);
#pragma unroll
            for (int ks = 0; ks < 4; ++ks)
                a2 = __builtin_amdgcn_mfma_f32_16x16x32_bf16(lds_frag(Q, rt * 16 + r, 136, 8 * g + 32 * ks), lds_frag(C0, et * 16 + r, 136, 8 * g + 32 * ks), a2, 0, 0, 0);
#pragma unroll
            for (int j = 0; j < 4; ++j) { const int t = rt * 16 + 4 * g + j; hacc[ee][j] = a1[j] + wint[t] * a2[j]; }
        }
    }
    __syncthreads();
    {
        const int rt = wid >> 1;
#pragma unroll
        for (int ee = 0; ee < 4; ++ee) {
            const int et = 4 * (wid & 1) + ee;
#pragma unroll
            for (int j = 0; j < 4; ++j) { const int t = rt * 16 + 4 * g + j; H[t * 132 + et * 16 + r] = hacc[ee][j] * rinv[t]; }
        }
    }
    __syncthreads();
    {
        const int t = tid >> 3, part = tid & 7;
        float hv[16]; float ss = 0.f;
#pragma unroll
        for (int i = 0; i < 16; ++i) { hv[i] = H[t * 132 + part * 16 + i]; ss += hv[i] * hv[i]; }
        ss = oct_sum(ss);
        const float rstd = rsqrtf(ss * (1.f / 128.f) + 1e-6f);
        const int col = h * 128 + part * 16;
        const u32x4 m0v = *(const u32x4*)(MO + (size_t)(row0 + t) * 512 + col), m1v = *(const u32x4*)(MO + (size_t)(row0 + t) * 512 + col + 8);
        float mo[16];
#pragma unroll
        for (int i = 0; i < 4; ++i) { mo[2 * i] = lo16(m0v[i]); mo[2 * i + 1] = hi16(m0v[i]); mo[8 + 2 * i] = lo16(m1v[i]); mo[8 + 2 * i + 1] = hi16(m1v[i]); }
        float o[16];
#pragma unroll
        for (int i = 0; i < 16; ++i) o[i] = (hv[i] * rstd * p.out_norm_m[col + i]) * sigmoidf_(mo[i]);
        u32x4 o0, o1;
#pragma unroll
        for (int i = 0; i < 4; ++i) { o0[i] = pack2(o[2 * i], o[2 * i + 1]); o1[i] = pack2(o[8 + 2 * i], o[8 + 2 * i + 1]); }
        bf16_t* dst = (bf16_t*)(p.ws + OFF_ACT) + (size_t)(row0 + t) * 1024 + col;
        *(u32x4*)dst = o0; *(u32x4*)(dst + 8) = o1;
    }
    __syncthreads();
}

__device__ __forceinline__ unsigned f2sortable(float f) { const unsigned u = __float_as_uint(f); return (u & 0x80000000u) ? ~u : (u | 0x80000000u); }
#define CNT4(c0, c1, c2, c3, a, b, cc, d, thr) asm volatile( \
    "v_cmp_ge_u32 s[40:41], %4, %8\n\tv_cmp_ge_u32 s[42:43], %5, %8\n\tv_cmp_ge_u32 s[44:45], %6, %8\n\tv_cmp_ge_u32 s[46:47], %7, %8\n\t" \
    "v_addc_co_u32 %0, s[48:49], 0, %0, s[40:41]\n\tv_addc_co_u32 %1, s[50:51], 0, %1, s[42:43]\n\tv_addc_co_u32 %2, s[52:53], 0, %2, s[44:45]\n\tv_addc_co_u32 %3, s[54:55], 0, %3, s[46:47]" \
    : "+v"(c0), "+v"(c1), "+v"(c2), "+v"(c3) : "v"(a), "v"(b), "v"(cc), "v"(d), "v"(thr) \
    : "s40", "s41", "s42", "s43", "s44", "s45", "s46", "s47", "s48", "s49", "s50", "s51", "s52", "s53", "s54", "s55")
template <int NR>
__device__ __forceinline__ int count_geN(const unsigned (&u)[NR], unsigned thr) {
    int c0 = 0, c1 = 0, c2 = 0, c3 = 0;
#pragma unroll
    for (int j = 0; j < NR; j += 4) CNT4(c0, c1, c2, c3, u[j], u[j + 1], u[j + 2], u[j + 3], thr);
    return (c0 + c1) + (c2 + c3);
}
template <int NR>
__device__ __forceinline__ void select_topk(const LAS float* srow, LAS int* lq, int t, int n, int lane) {
    unsigned u[NR];
#pragma unroll
    for (int j = 0; j < NR; ++j) { const int key = lane + 64 * j; u[j] = (key <= t) ? ((f2sortable(srow[key]) & 0xFFFFF000u) | (unsigned)(4095 - key)) : 0u; }
    unsigned tau = 1u;
    if (n > 256) {
        tau = 0u;
        for (int bit = 31; bit >= 0; --bit) {
            const unsigned cand = tau | (1u << bit);
            const int cnt = wave_sum_i32_uniform(count_geN<NR>(u, cand));
            if (cnt >= 256) { tau = cand; if (cnt == 256) break; }
        }
    }
    const int c = count_geN<NR>(u, tau);
    int pre = c;
#pragma unroll
    for (int o = 1; o < 64; o <<= 1) { const int v = __shfl_up(pre, o); if (lane >= o) pre += v; }
    int pos = pre - c;
    int keyv = lane;
#pragma unroll
    for (int j = 0; j < NR; ++j) {
        const bool sel = u[j] >= tau;
        const int slot = sel ? pos : (256 + lane);
        lq[slot] = keyv;
        pos += sel ? 1 : 0; keyv += 64;
    }
}
__device__ __forceinline__ unsigned wave_max_u32(unsigned v) {
    v = max(v, (unsigned)__builtin_amdgcn_update_dpp(0, (int)v, 0xB1, 0xF, 0xF, true)); v = max(v, (unsigned)__builtin_amdgcn_update_dpp(0, (int)v, 0x4E, 0xF, 0xF, true));
    v = max(v, (unsigned)__builtin_amdgcn_update_dpp(0, (int)v, 0x141, 0xF, 0xF, true)); v = max(v, (unsigned)__builtin_amdgcn_update_dpp(0, (int)v, 0x140, 0xF, 0xF, true));
    return max(max((unsigned)__builtin_amdgcn_readlane((int)v, 0), (unsigned)__builtin_amdgcn_readlane((int)v, 16)), max((unsigned)__builtin_amdgcn_readlane((int)v, 32), (unsigned)__builtin_amdgcn_readlane((int)v, 48)));
}
template <int NR>
__device__ __forceinline__ void select_topk2(LAS float* srow, LAS unsigned* buf, LAS int* lq, int t, int n, int lane) {
    unsigned u[NR];
#pragma unroll
    for (int j = 0; j < NR; ++j) { const int key = lane + 64 * j; u[j] = (key <= t) ? ((f2sortable(srow[key]) & 0xFFFFF000u) | (unsigned)(4095 - key)) : 0u; }
    unsigned mx = 0u;
#pragma unroll
    for (int j = 0; j < NR; ++j) mx = max(mx, u[j]);
    mx = wave_max_u32(mx);
    unsigned tau = 0u; int bit = 31, G = n, lc = 0;
    {
        unsigned th = mx & 0xFF800000u;
#pragma unroll 1
        for (int s6 = 0; s6 < 6; ++s6) {
            const int lcnt = count_geN<NR>(u, th);
            const int cnt = wave_sum_i32_uniform(lcnt);
            if (cnt >= 256) { tau = th; bit = 22; G = cnt; lc = lcnt; break; }
            if (th < 0x00800000u) break;
            th -= 0x00800000u;
        }
    }
    while (G > 512 && bit >= 0) {
        const unsigned cand = tau | (1u << bit);
        const int lcnt = count_geN<NR>(u, cand);
        const int cnt = wave_sum_i32_uniform(lcnt);
        if (cnt >= 256) { tau = cand; G = cnt; lc = lcnt; }
        --bit;
    }
    {
        int pre = lc;
#pragma unroll
        for (int o = 1; o < 64; o <<= 1) { const int v = __shfl_up(pre, o); if (lane >= o) pre += v; }
        int pos = pre - lc;
#pragma unroll
        for (int j = 0; j < NR; ++j) {
            const bool sel = u[j] >= tau;
            buf[sel ? pos : (512 + lane)] = u[j];
            pos += sel ? 1 : 0;
        }
    }
    unsigned c[8];
#pragma unroll
    for (int j = 0; j < 8; ++j) c[j] = (lane + 64 * j < G) ? buf[lane + 64 * j] : 0u;
    while (G > 256 && bit >= 0) {
        const unsigned cand = tau | (1u << bit);
        int cnt = 0;
#pragma unroll
        for (int j = 0; j < 8; ++j) cnt += __builtin_popcountll(__builtin_amdgcn_ballot_w64(c[j] >= cand));
        if (cnt >= 256) { tau = cand; G = cnt; }
        --bit;
    }
    {
        const int lc2 = count_geN<8>(c, tau);
        int pre = lc2;
#pragma unroll
        for (int o = 1; o < 64; o <<= 1) { const int v = __shfl_up(pre, o); if (lane >= o) pre += v; }
        int pos = pre - lc2;
#pragma unroll
        for (int j = 0; j < 8; ++j) {
            const bool sel = c[j] >= tau;
            lq[sel ? pos : (256 + lane)] = 4095 - (int)(c[j] & 4095u);
            pos += sel ? 1 : 0;
        }
    }
}
__device__ __forceinline__ void dsa_task(const Params& p, int task, LAS unsigned char* lds) {
    const int tid = opaque_tid(), wid = __builtin_amdgcn_readfirstlane(tid >> 6), lane = tid & 63;
    const int b = task >> 9, qg = task & 511, t0 = qg * 8, rowb = b * SEQ;
    const bf16_t* IQ = (const bf16_t*)(p.ws + OFF_IQ); const bf16_t* IK = (const bf16_t*)(p.ws + OFF_IK);
    const bf16_t* AQ = (const bf16_t*)(p.ws + OFF_AQ); const bf16_t* AK = (const bf16_t*)(p.ws + OFF_AK); const bf16_t* AV = (const bf16_t*)(p.ws + OFF_AV);
    const float* gates = (const float*)(p.ws + OFF_GATE);
    LAS float* scores = (LAS float*)lds;
    LAS int* lists = (LAS int*)(lds + 131072);
    const int ntile = (t0 + 8 + 31) >> 5;
#pragma unroll 1
    for (int rr0 = 0; rr0 < ((DSA_REP & 1) ? 2 : 1); ++rr0)
    {
        const int r = lane & 31, hh = lane >> 5;
        bf16x8 af[2][4]; float wv[2][4][4];
#pragma unroll
        for (int rt = 0; rt < 2; ++rt) {
            const size_t qrow = (size_t)(rowb + t0 + 4 * rt + (r >> 3));
#pragma unroll
            for (int ks = 0; ks < 4; ++ks) af[rt][ks] = *(const bf16x8*)(IQ + qrow * 512 + (r & 7) * 64 + 16 * ks + 8 * hh);
#pragma unroll
            for (int q4 = 0; q4 < 4; ++q4)
#pragma unroll
                for (int h4 = 0; h4 < 4; ++h4) wv[rt][q4][h4] = gates[(size_t)(rowb + t0 + 4 * rt + q4) * 16 + 8 + h4 + 4 * hh] * 0.04419417382415922f;
        }
        bf16x8 bfr[4], bnx[4];
        if (wid < ntile) {
#pragma unroll
            for (int ks = 0; ks < 4; ++ks) bfr[ks] = *(const bf16x8*)(IK + (size_t)(rowb + 32 * wid) * 64 + ks * 512 + lane * 8);
        }
        for (int kt = wid; kt < ntile; kt += 8) {
            if (kt + 8 < ntile) {
#pragma unroll
                for (int ks = 0; ks < 4; ++ks) bnx[ks] = *(const bf16x8*)(IK + (size_t)(rowb + 32 * (kt + 8)) * 64 + ks * 512 + lane * 8);
            }
            const int key = 32 * kt + r;
#pragma unroll
            for (int rt = 0; rt < 2; ++rt) {
                f32x16 acc;
#pragma unroll
                for (int i = 0; i < 16; ++i) acc[i] = 0.f;
#pragma unroll
                for (int ks = 0; ks < 4; ++ks) acc = __builtin_amdgcn_mfma_f32_32x32x16_bf16(af[rt][ks], bfr[ks], acc, 0, 0, 0);
                float part[4];
#pragma unroll
                for (int q4 = 0; q4 < 4; ++q4) {
                    part[q4] = 0.f;
#pragma unroll
                    for (int h4 = 0; h4 < 4; ++h4) part[q4] += fmaxf(acc[q4 * 4 + h4], 0.f) * wv[rt][q4][h4];
                }
                float tot[2];
#pragma unroll
                for (int i = 0; i < 2; ++i) { const u32x2 r_ = __builtin_amdgcn_permlane32_swap(__float_as_uint(part[i]), __float_as_uint(part[i + 2]), false, false); tot[i] = __uint_as_float(r_[0]) + __uint_as_float(r_[1]); }
#pragma unroll
                for (int i = 0; i < 2; ++i) { const int qq = 4 * rt + 2 * hh + i; scores[qq * 4096 + key] = (key <= t0 + qq) ? tot[i] : -INFINITY; }
            }
#pragma unroll
            for (int ks = 0; ks < 4; ++ks) bfr[ks] = bnx[ks];
        }
    }
    __syncthreads();
    const int qq = wid, t = t0 + qq, n = t + 1;
    const int nsel = n < 256 ? n : 256;
#pragma unroll 1
    for (int rr1 = 0; rr1 < ((DSA_REP & 2) ? 2 : 1); ++rr1)
    {
        LAS float* srow = scores + qq * 4096; LAS int* lq = lists + qq * 320; LAS unsigned* cbuf = (LAS unsigned*)(lds + 141312 + qq * 2304);
        const int nreg = (t >> 6) + 1;
        if (nreg <= 8) select_topk<8>(srow, lq, t, n, lane);
        else if (nreg <= 16) select_topk2<16>(srow, cbuf, lq, t, n, lane);
        else if (nreg <= 24) select_topk2<24>(srow, cbuf, lq, t, n, lane);
        else if (nreg <= 32) select_topk2<32>(srow, cbuf, lq, t, n, lane);
        else if (nreg <= 40) select_topk2<40>(srow, cbuf, lq, t, n, lane);
        else if (nreg <= 48) select_topk2<48>(srow, cbuf, lq, t, n, lane);
        else if (nreg <= 56) select_topk2<56>(srow, cbuf, lq, t, n, lane);
        else select_topk2<64>(srow, cbuf, lq, t, n, lane);
    }
    asm volatile("s_waitcnt lgkmcnt(0)" ::: "memory");
#pragma unroll 1
    for (int rr2 = 0; rr2 < ((DSA_REP & 4) ? 2 : 1); ++rr2) {
#pragma unroll 1
    for (int rr3 = 0; rr3 < ((DSA_REP & 8) ? 2 : 1); ++rr3)
    {
        const int r = lane & 15, g = lane >> 4;
        const size_t qrow = (size_t)(rowb + t);
        bf16x8 bq[2];
#pragma unroll
        for (int ks = 0; ks < 2; ++ks) {
            if (r < 8) bq[ks] = *(const bf16x8*)(AQ + qrow * 512 + r * 64 + 8 * g + 32 * ks);
            else { bq[ks] = (bf16x8){0, 0, 0, 0, 0, 0, 0, 0}; }
        }
        LAS float* Pl = scores + qq * 4096;
        LAS unsigned char* ksA = lds + 141312 + qq * 2304;
        LAS unsigned char* ksB = (LAS unsigned char*)Pl + 13440;
        const int kl = lane >> 3, dc = lane & 7;
#pragma unroll 1
        for (int half = 0; half < 2; ++half) {
            u32x4 kr[16];
#pragma unroll
            for (int i = 0; i < 16; ++i) {
                const int jp = 16 * (half * 8 + (i >> 1)) + kl + 8 * (i & 1);
                const int key = (jp < nsel) ? lists[qq * 320 + jp] : 0;
                kr[i] = *(const u32x4*)(AK + (size_t)(rowb + key) * 64 + dc * 8);
            }
#pragma unroll
            for (int i = 0; i < 8; ++i) {
                const int kt = half * 8 + i;
                LAS unsigned char* ks_ = (i & 1) ? ksB : ksA;
                *(LAS u32x4*)(ks_ + kl * 144 + dc * 16) = kr[2 * i]; *(LAS u32x4*)(ks_ + (kl + 8) * 144 + dc * 16) = kr[2 * i + 1];
                const bf16x8 a0 = *(const LAS bf16x8*)(ks_ + r * 144 + 16 * g), a1 = *(const LAS bf16x8*)(ks_ + r * 144 + 64 + 16 * g);
                f32x4 acc = {0.f, 0.f, 0.f, 0.f};
                acc = __builtin_amdgcn_mfma_f32_16x16x32_bf16(a0, bq[0], acc, 0, 0, 0);
                acc = __builtin_amdgcn_mfma_f32_16x16x32_bf16(a1, bq[1], acc, 0, 0, 0);
                if (r < 8) *(LAS f32x4*)(Pl + r * 260 + 16 * kt + 4 * g) = acc * 0.125f;
            }
        }
        asm volatile("s_waitcnt lgkmcnt(0)" ::: "memory");
        const int hd = lane & 7, ch = lane >> 3;
        f32x4 pv[8];
        float mx = -INFINITY;
#pragma unroll
        for (int i = 0; i < 8; ++i) {
            pv[i] = *(const LAS f32x4*)(Pl + hd * 260 + ch * 32 + 4 * i);
#pragma unroll
            for (int j = 0; j < 4; ++j) if (ch * 32 + 4 * i + j < nsel) mx = fmaxf(mx, pv[i][j]);
        }
        mx = fmaxf(mx, dppf(mx, 0x128));
        mx = fmaxf(mx, xchg_f32<16>(mx, lane)); mx = fmaxf(mx, xchg_f32<32>(mx, lane));
        float sm = 0.f;
#pragma unroll
        for (int i = 0; i < 8; ++i)
#pragma unroll
            for (int j = 0; j < 4; ++j) { const float e = (ch * 32 + 4 * i + j < nsel) ? __expf(pv[i][j] - mx) : 0.f; pv[i][j] = e; sm += e; }
        sm += dppf(sm, 0x128); sm += xchg_f32<16>(sm, lane); sm += xchg_f32<32>(sm, lane);
        const float inv = __builtin_amdgcn_rcpf(sm);
        LAS bf16_t* Pt = (LAS bf16_t*)((LAS unsigned char*)Pl + 9216);
#pragma unroll
        for (int i = 0; i < 4; ++i) {
            u32x4 o;
            o[0] = pack2(pv[2 * i][0] * inv, pv[2 * i][1] * inv); o[1] = pack2(pv[2 * i][2] * inv, pv[2 * i][3] * inv);
            o[2] = pack2(pv[2 * i + 1][0] * inv, pv[2 * i + 1][1] * inv); o[3] = pack2(pv[2 * i + 1][2] * inv, pv[2 * i + 1][3] * inv);
            *(LAS u32x4*)(Pt + hd * 264 + ch * 32 + 8 * i) = o;
        }
    }
    asm volatile("s_waitcnt lgkmcnt(0)" ::: "memory");
#pragma unroll 1
    for (int rr4 = 0; rr4 < ((DSA_REP & 16) ? 2 : 1); ++rr4)
    {
        typedef short s16x4 __attribute__((ext_vector_type(4)));
        const int r = lane & 15, g = lane >> 4;
        LAS unsigned char* wb = (LAS unsigned char*)(scores + qq * 4096);
        const LAS bf16_t* Pt = (const LAS bf16_t*)(wb + 9216);
        const int nchunk = (nsel + 31) >> 5;
        const int kl = lane >> 3, dc = lane & 7;
        f32x4 acc[4];
#pragma unroll
        for (int ct = 0; ct < 4; ++ct) acc[ct] = (f32x4){0.f, 0.f, 0.f, 0.f};
        u32x4 vq[4], vn[4];
#pragma unroll
        for (int i = 0; i < 4; ++i) {
            const int jp = kl + 8 * i;
            const int key = (jp < nsel) ? lists[qq * 320 + jp] : 0;
            vq[i] = *(const u32x4*)(AV + (size_t)(rowb + key) * 64 + dc * 8);
        }
#pragma unroll 1
        for (int c = 0; c < nchunk; ++c) {
            LAS unsigned char* vb = wb + (c & 1) * 4608;
#pragma unroll
            for (int i = 0; i < 4; ++i) *(LAS u32x4*)(vb + (kl + 8 * i) * 144 + dc * 16) = vq[i];
            if (c + 1 < nchunk) {
#pragma unroll
                for (int i = 0; i < 4; ++i) {
                    const int jp = 32 * (c + 1) + kl + 8 * i;
                    const int key = (jp < nsel) ? lists[qq * 320 + jp] : 0;
                    vn[i] = *(const u32x4*)(AV + (size_t)(rowb + key) * 64 + dc * 8);
                }
            }
            bf16x8 a = *(const LAS bf16x8*)(Pt + (r & 7) * 264 + 32 * c + 8 * g);
            if (r >= 8) a = (bf16x8){0, 0, 0, 0, 0, 0, 0, 0};
#pragma unroll
            for (int ct = 0; ct < 4; ++ct) {
                LAS unsigned char* ba = vb + (8 * g + (r >> 2)) * 144 + (16 * ct + 4 * (r & 3)) * 2;
                const s16x4 b0 = __builtin_amdgcn_ds_read_tr16_b64_v4i16((LAS s16x4*)ba);
                const s16x4 b1 = __builtin_amdgcn_ds_read_tr16_b64_v4i16((LAS s16x4*)(ba + 4 * 144));
                bf16x8 bb; bb[0] = b0[0]; bb[1] = b0[1]; bb[2] = b0[2]; bb[3] = b0[3]; bb[4] = b1[0]; bb[5] = b1[1]; bb[6] = b1[2]; bb[7] = b1[3];
                acc[ct] = __builtin_amdgcn_mfma_f32_16x16x32_bf16(a, bb, acc[ct], 0, 0, 0);
            }
#pragma unroll
            for (int i = 0; i < 4; ++i) vq[i] = vn[i];
        }
        bf16_t* dst = (bf16_t*)(p.ws + OFF_ACT) + (size_t)(rowb + t) * 1024 + 512;
#pragma unroll
        for (int j = 0; j < 4; ++j) {
            float ss = acc[0][j] * acc[0][j] + acc[1][j] * acc[1][j] + acc[2][j] * acc[2][j] + acc[3][j] * acc[3][j];
            ss = row16_sum(ss);
            const float rstd = rsqrtf(ss * (1.f / 64.f) + 1e-6f);
            if (g < 2) {
                const int hd = 4 * g + j;
#pragma unroll
                for (int ct = 0; ct < 4; ++ct) dst[hd * 64 + 16 * ct + r] = f2bf(acc[ct][j] * rstd * p.out_norm_a[hd * 64 + 16 * ct + r]);
            }
        }
    }
    }
    __syncthreads();
}

__device__ __forceinline__ float sortable2f(unsigned s) { return __uint_as_float((s & 0x80000000u) ? (s ^ 0x80000000u) : ~s); }
#define CE_DESC(x, y) do { const unsigned mx_ = max(x, y), mn_ = min(x, y); (x) = mx_; (y) = mn_; } while (0)
template <int BASE, int N>
__device__ __forceinline__ void bitonic_sort16_desc(unsigned (&a)[N]) {
#pragma unroll
    for (int k = 2; k <= 16; k <<= 1) {
#pragma unroll
        for (int j = k >> 1; j > 0; j >>= 1) {
#pragma unroll
            for (int i = 0; i < 16; ++i) {
                const int l = i ^ j;
                if (l > i) {
                    if ((i & k) == 0) CE_DESC(a[BASE + i], a[BASE + l]);
                    else CE_DESC(a[BASE + l], a[BASE + i]);
                }
            }
        }
    }
}
template <int BASE, int N>
__device__ __forceinline__ void bitonic_merge16_desc(unsigned (&a)[N]) {
#pragma unroll
    for (int j = 8; j > 0; j >>= 1) {
#pragma unroll
        for (int i = 0; i < 16; ++i) { const int l = i ^ j; if (l > i) CE_DESC(a[BASE + i], a[BASE + l]); }
    }
}
template <int BA, int BB, int N>
__device__ __forceinline__ void top16_merge(unsigned (&a)[N]) {
#pragma unroll
    for (int i = 0; i < 16; ++i) a[BA + i] = max(a[BA + i], a[BB + 15 - i]);
    bitonic_merge16_desc<BA, N>(a);
}
__device__ __forceinline__ void top16_of_64(unsigned (&a)[64]) {
    bitonic_sort16_desc<0, 64>(a); bitonic_sort16_desc<16, 64>(a); bitonic_sort16_desc<32, 64>(a); bitonic_sort16_desc<48, 64>(a);
    top16_merge<0, 16, 64>(a); top16_merge<32, 48, 64>(a); top16_merge<0, 32, 64>(a);
}
__device__ __forceinline__ void peer_route(const Params& p, int task, LAS unsigned char* lds) {
    const int tid = opaque_tid(), wid = __builtin_amdgcn_readfirstlane(tid >> 6), lane = tid & 63;
    const int n0 = task * 32, head = wid;
    const int r = lane & 31, hh = lane >> 5;
    const bf16_t* QRY = (const bf16_t*)(p.ws + OFF_QRY); const bf16_t* SK = (const bf16_t*)(p.ws + OFF_SK);
    LAS unsigned* tkl = (LAS unsigned*)lds + wid * (32 * 64);
#pragma unroll 1
    for (int p2 = 0; p2 < 2; ++p2) {
        const int grp = head * 2 + p2;
        bf16x8 bq[4];
#pragma unroll
        for (int ks = 0; ks < 4; ++ks) bq[ks] = *(const bf16x8*)(QRY + (size_t)(n0 + r) * 1024 + grp * 64 + 16 * ks + 8 * hh);
        unsigned key[64];
#pragma unroll
        for (int kt = 0; kt < 4; ++kt) {
            f32x16 acc;
#pragma unroll
            for (int i = 0; i < 16; ++i) acc[i] = 0.f;
#pragma unroll
            for (int ks = 0; ks < 4; ++ks) {
                const bf16x8 a = *(const bf16x8*)(SK + (size_t)(grp * 128 + 32 * kt + r) * 64 + 16 * ks + 8 * hh);
                acc = __builtin_amdgcn_mfma_f32_32x32x16_bf16(a, bq[ks], acc, 0, 0, 0);
            }
#pragma unroll
            for (int reg = 0; reg < 16; ++reg) {
                const int idx = 32 * kt + (reg & 3) + 8 * (reg >> 2) + 4 * hh;
                key[kt * 16 + reg] = (f2sortable(acc[reg]) & ~0x7Fu) | (unsigned)(127 - idx);
            }
        }
        top16_of_64(key);
        unsigned mg[16];
#pragma unroll
        for (int i = 0; i < 16; ++i) mg[i] = max(key[i], xchg_u32<32>(key[15 - i], lane));
        bitonic_merge16_desc<0, 16>(mg);
#pragma unroll
        for (int k = 0; k < 16; ++k) tkl[(p2 * 16 + k) * 64 + lane] = mg[k];
    }
    float v1[16], v2[16];
#pragma unroll
    for (int k = 0; k < 16; ++k) { v1[k] = sortable2f(tkl[k * 64 + lane] & ~0x7Fu); v2[k] = sortable2f(tkl[(16 + k) * 64 + lane] & ~0x7Fu); }
    unsigned ck[64];
    {
        int ci = 0;
#pragma unroll
        for (int a = 0; a < 16; ++a) {
#pragma unroll
            for (int bb = 0; bb < 16 / (a + 1); ++bb) { ck[ci] = (f2sortable(v1[a] + v2[bb]) & ~0xFFu) | (unsigned)(255 - (16 * a + bb)); ++ci; }
        }
#pragma unroll
        for (int i = 50; i < 64; ++i) ck[i] = 0u;
    }
    top16_of_64(ck);
    float tv[16]; int te[16];
    float sum = 0.f;
#pragma unroll
    for (int k = 0; k < 16; ++k) {
        const int flat = 255 - (int)(ck[k] & 0xFFu);
        const int i1 = 127 - (int)(tkl[(flat >> 4) * 64 + lane] & 0x7Fu), i2 = 127 - (int)(tkl[(16 + (flat & 15)) * 64 + lane] & 0x7Fu);
        te[k] = i1 * 128 + i2;
        tv[k] = __expf(sortable2f(ck[k] & ~0xFFu) - sortable2f(ck[0] & ~0xFFu)); sum += tv[k];
    }
    const float inv = 1.f / sum;
    if (hh == 0) {
        int* EI = (int*)(p.ws + OFF_EIDX) + (size_t)(n0 + r) * 128 + head * 16;
#pragma unroll
        for (int q = 0; q < 4; ++q) { u32x4 o; o[0] = te[4 * q]; o[1] = te[4 * q + 1]; o[2] = te[4 * q + 2]; o[3] = te[4 * q + 3]; *(u32x4*)(EI + 4 * q) = o; }
    } else {
        float* GW = (float*)(p.ws + OFF_GW) + (size_t)(n0 + r) * 128 + head * 16;
#pragma unroll
        for (int q = 0; q < 4; ++q) { f32x4 o; o[0] = tv[4 * q] * inv; o[1] = tv[4 * q + 1] * inv; o[2] = tv[4 * q + 2] * inv; o[3] = tv[4 * q + 3] * inv; *(f32x4*)(GW + 4 * q) = o; }
    }
}

__device__ __forceinline__ float gelu_exact(float a) { return 0.5f * a * (1.f + erff(a * 0.70710678118654752440f)); }
__device__ __forceinline__ float gelu_as(float v) {
    const float av = fabsf(v), t = __builtin_amdgcn_rcpf(av * 0.2316418882f + 1.0f);
    float q = t * 0.5307027145f + (-0.7265760135f); q = q * t + 0.7107068705f; q = q * t + (-0.142248368f); q = q * t + 0.127414796f; q = q * t;
    const float e = __builtin_amdgcn_exp2f((v * v) * (-0.72134752044f));
    const float m = v * (q * e), rr = v - m;
    return v < 0.f ? m : rr;
}
__device__ __forceinline__ void dec16_fp8(const u32x4 w, float (&f)[16]) {
#pragma unroll
    for (int i = 0; i < 4; ++i) {
        const f32x2 lo = __builtin_amdgcn_cvt_pk_f32_fp8((int)w[i], false), hi = __builtin_amdgcn_cvt_pk_f32_fp8((int)w[i], true);
        f[4 * i] = lo[0]; f[4 * i + 1] = lo[1]; f[4 * i + 2] = hi[0]; f[4 * i + 3] = hi[1];
    }
}
__device__ __forceinline__ void sort_pairs128(int& k_lo, int& k_hi, float& g_lo, float& g_hi, int lane) {
#pragma unroll
    for (int size = 2; size <= 128; size <<= 1) {
#pragma unroll
        for (int stride = size >> 1; stride >= 1; stride >>= 1) {
            if (stride == 64) {
                const bool sw = k_hi < k_lo;
                const int ta = sw ? k_hi : k_lo, tb = sw ? k_lo : k_hi; const float ga = sw ? g_hi : g_lo, gb = sw ? g_lo : g_hi;
                k_lo = ta; k_hi = tb; g_lo = ga; g_hi = gb;
            } else {
                int p_lo, p_hi; float q_lo, q_hi;
                if (stride == 1) { p_lo = (int)xchg_u32<1>((unsigned)k_lo, lane); p_hi = (int)xchg_u32<1>((unsigned)k_hi, lane); q_lo = xchg_f32<1>(g_lo, lane); q_hi = xchg_f32<1>(g_hi, lane); }
                else if (stride == 2) { p_lo = (int)xchg_u32<2>((unsigned)k_lo, lane); p_hi = (int)xchg_u32<2>((unsigned)k_hi, lane); q_lo = xchg_f32<2>(g_lo, lane); q_hi = xchg_f32<2>(g_hi, lane); }
                else if (stride == 4) { p_lo = (int)xchg_u32<4>((unsigned)k_lo, lane); p_hi = (int)xchg_u32<4>((unsigned)k_hi, lane); q_lo = xchg_f32<4>(g_lo, lane); q_hi = xchg_f32<4>(g_hi, lane); }
                else if (stride == 8) { p_lo = (int)xchg_u32<8>((unsigned)k_lo, lane); p_hi = (int)xchg_u32<8>((unsigned)k_hi, lane); q_lo = xchg_f32<8>(g_lo, lane); q_hi = xchg_f32<8>(g_hi, lane); }
                else if (stride == 16) { p_lo = (int)xchg_u32<16>((unsigned)k_lo, lane); p_hi = (int)xchg_u32<16>((unsigned)k_hi, lane); q_lo = xchg_f32<16>(g_lo, lane); q_hi = xchg_f32<16>(g_hi, lane); }
                else { p_lo = (int)xchg_u32<32>((unsigned)k_lo, lane); p_hi = (int)xchg_u32<32>((unsigned)k_hi, lane); q_lo = xchg_f32<32>(g_lo, lane); q_hi = xchg_f32<32>(g_hi, lane); }
                const bool lower = (lane & stride) == 0;
                const bool asc_lo = (size >= 64) ? true : ((lane & size) == 0);
                const bool asc_hi = (size == 128) ? true : ((size == 64) ? false : ((lane & size) == 0));
                const bool min_lo = (lower == asc_lo), min_hi = (lower == asc_hi);
                const bool take_lo = min_lo ? (p_lo < k_lo) : (p_lo > k_lo);
                const bool take_hi = min_hi ? (p_hi < k_hi) : (p_hi > k_hi);
                k_lo = take_lo ? p_lo : k_lo; g_lo = take_lo ? q_lo : g_lo;
                k_hi = take_hi ? p_hi : k_hi; g_hi = take_hi ? q_hi : g_hi;
            }
        }
    }
}
__device__ __forceinline__ void peer_finish_row(const Params& p, const float* ada, int tok, int d0, const float (&acc)[16], bool do_store) {
    const int b = tok >> 12;
    float* orow = p.out + (size_t)tok * 1024 + d0;
    float xo[16]; float ss = 0.f;
#pragma unroll
    for (int q = 0; q < 4; ++q) {
        const f32x4 xv = *(const f32x4*)(orow + 4 * q), gv = *(const f32x4*)(ada + b * 6144 + 5120 + d0 + 4 * q);
#pragma unroll
        for (int i = 0; i < 4; ++i) { const float v = xv[i] + gv[i] * acc[q * 4 + i]; xo[q * 4 + i] = v; ss += v * v; }
    }
    ss = wave_sum(ss);
    const float rstd = rsqrtf(ss * (1.f / 1024.f) + 1e-6f);
#pragma unroll
    for (int q = 0; q < 4; ++q) {
        const f32x4 fg = *(const f32x4*)(p.final_g + d0 + 4 * q);
        f32x4 ov;
#pragma unroll
        for (int i = 0; i < 4; ++i) ov[i] = xo[q * 4 + i] * rstd * fg[i];
        if (do_store) *(f32x4*)(orow + 4 * q) = ov;
    }
}
struct PeTok { unsigned hq[4]; float ascale; int acc[16]; int csum; int k_lo, k_hi; };
__device__ __forceinline__ void pe_tok_init(PeTok& t, LAS float* gl, const bf16_t* H2, const int* EI, const float* GW, int tok, int d0, int lane) {
    const u32x4 h0 = *(const u32x4*)(H2 + (size_t)tok * 1024 + d0), h1 = *(const u32x4*)(H2 + (size_t)tok * 1024 + d0 + 8);
    float hx[16];
#pragma unroll
    for (int i = 0; i < 4; ++i) { hx[2 * i] = lo16(h0[i]); hx[2 * i + 1] = hi16(h0[i]); hx[8 + 2 * i] = lo16(h1[i]); hx[8 + 2 * i + 1] = hi16(h1[i]); }
    float am = 0.f;
#pragma unroll
    for (int i = 0; i < 16; ++i) am = fmaxf(am, fabsf(hx[i]));
    am = fmaxf(wave_max_dpp(am), 1e-20f);
    const float hs = 127.f / am;
#pragma unroll
    for (int i = 0; i < 4; ++i) t.hq[i] = pack4_i8(hx[4 * i], hx[4 * i + 1], hx[4 * i + 2], hx[4 * i + 3], hs);
    t.ascale = am * (1.f / (127.f * PEER_SU));
#pragma unroll
    for (int i = 0; i < 16; ++i) t.acc[i] = 0;
    t.csum = 0;
    t.k_lo = EI[(size_t)tok * 128 + lane]; t.k_hi = EI[(size_t)tok * 128 + 64 + lane];
    float g_lo = GW[(size_t)tok * 128 + lane], g_hi = GW[(size_t)tok * 128 + 64 + lane];
    sort_pairs128(t.k_lo, t.k_hi, g_lo, g_hi, lane);
    gl[lane] = g_lo; gl[64 + lane] = g_hi;
}
__device__ __forceinline__ void pe_tok_result(const PeTok& t, float (&acc)[16]) {
    const int coff = 8 * t.csum;
#pragma unroll
    for (int i = 0; i < 4; ++i)
#pragma unroll
        for (int j = 0; j < 4; ++j) acc[8 * (i >> 1) + 2 * j + (i & 1)] = (float)(t.acc[4 * i + j] - coff) * (1.f / (PEER_SC * PEER_SV));
}
typedef short s16x2 __attribute__((ext_vector_type(2)));
__device__ __forceinline__ int dot2_i16(unsigned a, int b, int c) { return __builtin_amdgcn_sdot2(__builtin_bit_cast(s16x2, a), __builtin_bit_cast(s16x2, b), c, false); }
__device__ __forceinline__ void pe_vgroup(PeTok& t, const u32x2 (&vv)[8], int base, int c0, int c1, int c2, int c3) {
    const int c01 = (c0 & 0xFFFF) | (c1 << 16), c23 = (c2 & 0xFFFF) | (c3 << 16);
    t.csum += c0 + c1 + c2 + c3;
#pragma unroll
    for (int i = 0; i < 4; ++i) {
        const unsigned w0 = (vv[base][i >> 1] >> (4 * (i & 1))) & 0x0F0F0F0Fu, w1 = (vv[base + 1][i >> 1] >> (4 * (i & 1))) & 0x0F0F0F0Fu;
        const unsigned w2_ = (vv[base + 2][i >> 1] >> (4 * (i & 1))) & 0x0F0F0F0Fu, w3 = (vv[base + 3][i >> 1] >> (4 * (i & 1))) & 0x0F0F0F0Fu;
        t.acc[4 * i + 0] = dot2_i16(__builtin_amdgcn_perm(w3, w2_, 0x0c040c00u), c23, dot2_i16(__builtin_amdgcn_perm(w1, w0, 0x0c040c00u), c01, t.acc[4 * i + 0]));
        t.acc[4 * i + 1] = dot2_i16(__builtin_amdgcn_perm(w3, w2_, 0x0c050c01u), c23, dot2_i16(__builtin_amdgcn_perm(w1, w0, 0x0c050c01u), c01, t.acc[4 * i + 1]));
        t.acc[4 * i + 2] = dot2_i16(__builtin_amdgcn_perm(w3, w2_, 0x0c060c02u), c23, dot2_i16(__builtin_amdgcn_perm(w1, w0, 0x0c060c02u), c01, t.acc[4 * i + 2]));
        t.acc[4 * i + 3] = dot2_i16(__builtin_amdgcn_perm(w3, w2_, 0x0c070c03u), c23, dot2_i16(__builtin_amdgcn_perm(w1, w0, 0x0c070c03u), c01, t.acc[4 * i + 3]));
    }
}
#ifndef PE_SYNC_MASK
#define PE_SYNC_MASK 31
#endif
__device__ __forceinline__ int dot4_z(unsigned a, unsigned b) { int d; asm("v_dot4_i32_i8 %0, %1, %2, 0" : "=v"(d) : "v"(a), "v"(b)); return d; }
#define DPPI(v, ctrl) __builtin_amdgcn_update_dpp(0, (v), (ctrl), 0xF, 0xF, true)
__device__ __forceinline__ void peer_experts(const Params& p, bool do_store, LAS unsigned char* lds) {
    const int wid = threadIdx.x >> 6, lane = threadIdx.x & 63;
    const bf16_t* H2 = (const bf16_t*)(p.ws + OFF_ACT); const unsigned char* UT = p.ws + OFF_UT; const unsigned char* VT = p.ws + OFF_VT;
    const int* EI = (const int*)(p.ws + OFF_EIDX); const float* GW = (const float*)(p.ws + OFF_GW); const float* ada = (const float*)(p.ws + OFF_ADA);
    const int d0 = 16 * lane;
    const unsigned uofs = 16u * (unsigned)lane, vofs = 8u * (unsigned)lane;
    const int stride = gridDim.x * 8;
    LAS float* gl = (LAS float*)lds + wid * 512;
    const LAS float* glane = gl + (lane >> 5) * 128 + 2 * ((lane >> 4) & 1) + (lane & 1);
    for (int tok0 = blockIdx.x * 8 + wid; tok0 < NTOK; tok0 += 4 * stride) {
        __syncthreads();
        int tk[4]; bool has[4];
#pragma unroll
        for (int i = 0; i < 4; ++i) { has[i] = (tok0 + i * stride) < NTOK; tk[i] = has[i] ? tok0 + i * stride : tok0; }
        PeTok T[4];
#pragma unroll
        for (int i = 0; i < 4; ++i) pe_tok_init(T[i], gl + i * 128, H2, EI, GW, tk[i], d0, lane);
        const float ascX = lane < 32 ? T[0].ascale : T[1].ascale, ascY = lane < 32 ? T[2].ascale : T[3].ascale;
        u32x4 uX[8], uY[8]; u32x2 vX[8], vY[8];
#define PE_ISSUE(UU, VV, K0, A, B) do { _Pragma("unroll") for (int q = 0; q < 4; ++q) { \
            const unsigned ea_ = (unsigned)__builtin_amdgcn_readlane((K0) < 64 ? A.k_lo : A.k_hi, ((K0) + q) & 63), eb_ = (unsigned)__builtin_amdgcn_readlane((K0) < 64 ? B.k_lo : B.k_hi, ((K0) + q) & 63); \
              \
            asm volatile("global_load_dwordx4 %0, %1, %2" : "=v"(UU[q]) : "v"(uofs), "s"(UT + (size_t)ea_ * 1024u)); \
            asm volatile("global_load_dwordx2 %0, %1, %2" : "=v"(VV[q]) : "v"(vofs), "s"(VT + (size_t)ea_ * 512u)); \
            asm volatile("global_load_dwordx4 %0, %1, %2" : "=v"(UU[4 + q]) : "v"(uofs), "s"(UT + (size_t)eb_ * 1024u)); \
            asm volatile("global_load_dwordx2 %0, %1, %2" : "=v"(VV[4 + q]) : "v"(vofs), "s"(VT + (size_t)eb_ * 512u)); } } while (0)
#define PE_WAIT(UU, VV, N) do { asm volatile("s_waitcnt vmcnt(" #N ")"); \
            _Pragma("unroll") for (int q = 0; q < 8; ++q) asm volatile("" : "+v"(UU[q]), "+v"(VV[q])); } while (0)
#define PE_COMPUTE(UU, VV, K0, TOKOFS, ASC, A, B) do { \
            const float gmine = glane[(TOKOFS) * 128 + (K0)]; \
            int sv[8]; \
            _Pragma("unroll") for (int q = 0; q < 8; ++q) { int d_ = dot4_z(UU[q][0], (q < 4 ? A.hq[0] : B.hq[0])); \
                _Pragma("unroll") for (int i = 1; i < 4; ++i) d_ = __builtin_amdgcn_sdot4((int)UU[q][i], (int)(q < 4 ? A.hq[i] : B.hq[i]), d_, false); \
                sv[q] = d_; } \
            int t4[4]; \
            _Pragma("unroll") for (int i = 0; i < 4; ++i) { const u32x2 r_ = __builtin_amdgcn_permlane32_swap((unsigned)sv[i], (unsigned)sv[i + 4], false, false); t4[i] = (int)r_[0] + (int)r_[1]; } \
            int w2[2]; \
            _Pragma("unroll") for (int i = 0; i < 2; ++i) { const u32x2 r_ = __builtin_amdgcn_permlane16_swap((unsigned)t4[i], (unsigned)t4[i + 2], false, false); w2[i] = (int)r_[0] + (int)r_[1]; } \
            _Pragma("unroll") for (int i = 0; i < 2; ++i) { w2[i] += DPPI(w2[i], 0xB1); w2[i] += DPPI(w2[i], 0x4E); w2[i] += DPPI(w2[i], 0x141); w2[i] += DPPI(w2[i], 0x140); } \
            const float mine = (float)((lane & 1) ? w2[1] : w2[0]) * (ASC); \
            const float cmine = gmine * gelu_as(mine); \
            const int cqm = (int)fminf(fmaxf(rintf(cmine * PEER_SC), -16383.f), 16383.f);        \
            pe_vgroup(A, VV, 0, __builtin_amdgcn_readlane(cqm, 0), __builtin_amdgcn_readlane(cqm, 1), __builtin_amdgcn_readlane(cqm, 16), __builtin_amdgcn_readlane(cqm, 17)); \
            pe_vgroup(B, VV, 4, __builtin_amdgcn_readlane(cqm, 32), __builtin_amdgcn_readlane(cqm, 33), __builtin_amdgcn_readlane(cqm, 48), __builtin_amdgcn_readlane(cqm, 49)); } while (0)
        PE_ISSUE(uX, vX, 0, T[0], T[1]);
#pragma unroll 1
        for (int k0 = 0; k0 < 128; k0 += 4) {
            if ((k0 & PE_SYNC_MASK) == 0 && k0) __syncthreads();
            PE_ISSUE(uY, vY, k0, T[2], T[3]);
            PE_WAIT(uX, vX, 16);
            PE_COMPUTE(uX, vX, k0, 0, ascX, T[0], T[1]);
            { const int kn = (k0 + 4 < 128) ? k0 + 4 : k0;
              PE_ISSUE(uX, vX, kn, T[0], T[1]); }
            PE_WAIT(uY, vY, 16);
            PE_COMPUTE(uY, vY, k0, 2, ascY, T[2], T[3]);
        }
        PE_WAIT(uX, vX, 0);
#undef PE_WAIT
#undef PE_ISSUE
#undef PE_COMPUTE
        float acc[16];
#pragma unroll
        for (int i = 0; i < 4; ++i) { pe_tok_result(T[i], acc); peer_finish_row(p, ada, tk[i], d0, acc, do_store && has[i]); }
    }
}

enum { PH_PREP = 0, PH_GEMM_IN, PH_MIX, PH_GEMM_OUT, PH_H2, PH_GEMM_Q, PH_ROUTE, PH_EXPERT, PH_COUNT };

typedef const __attribute__((address_space(4))) Params* KParams;
__device__ __forceinline__ const Params& kparams() {
    auto q = __builtin_amdgcn_kernarg_segment_ptr();
    asm volatile("" : "+s"(q));
    return *(const Params*)q;
}
#ifndef PHMASK
#define PHMASK 0xFFFF
#endif
#ifndef REP_PHASE
#define REP_PHASE -1
#endif
#define PHASE_BEGIN(idx) if (((PHMASK >> (idx)) & 1) && ph_lo <= (idx) && (idx) < ph_hi) { for (int rep = 0; rep < ((idx) == REP_PHASE ? 2 : 1); ++rep) { if ((idx) != ph_lo || rep) xcd_barrier(bar); const Params& p = kparams(); const int G = gridDim.x; (void)G; const bool last_rep = (rep == ((idx) == REP_PHASE ? 1 : 0)); (void)last_rep;
#define PHASE_END } }

__global__ void __launch_bounds__(NTHREADS, 2) hymba_fwd(Params p_) {
    extern __shared__ __attribute__((aligned(16))) unsigned char smem_raw[];
    LAS unsigned char* lds = (LAS unsigned char*)smem_raw;
    volatile LAS unsigned* xbw = (volatile LAS unsigned*)(lds + LDS_BYTES - 16);
    if (threadIdx.x == 0) { xbw[0] = 0u; xbw[1] = 0u; xbw[2] = 0u; xbw[3] = 0u; }
    __syncthreads();
    XcdBarrier bar = xcd_barrier_post((unsigned*)(p_.ws + OFF_CTL), xbw);
    const int ph_lo = p_.ph_lo, ph_hi = p_.ph_hi;

    PHASE_BEGIN(PH_PREP)
        phase0(p, lds);
        wg_wait((unsigned*)(p.ws + OFF_CTL), CNT_ADA, 192u);
        norm_mod_rows(p.x, p.norm1_g, (const float*)(p.ws + OFF_ADA), 0, 1024, (bf16_t*)(p.ws + OFF_ACT));
    PHASE_END
    PHASE_BEGIN(PH_GEMM_IN)
        {   pg8::StaticOrder S; S.init(NTOK, 3072, G, blockIdx.x);
            EpiInMain E; E.ws = p.ws; E.bias = (const float*)(p.ws + OFF_BIAS);
            pg8::gemm_phase(lds, pg8::Gemm{(const bf16_t*)(p.ws + OFF_ACT), (const bf16_t*)(p.ws + OFF_WIN), NTOK, 3072, 1024}, S, E); }
        {   pg8::StaticOrder S; S.init(NTOK, 256, G, blockIdx.x);
            EpiInTail E; E.ws = p.ws; E.bias = (const float*)(p.ws + OFF_BIAS) + 3072;
            pg8::gemm_phase(lds, pg8::Gemm{(const bf16_t*)(p.ws + OFF_ACT), (const bf16_t*)(p.ws + OFF_WIN) + (size_t)3072 * 1024, NTOK, 256, 1024}, S, E); }
        if (G > 64) { if ((int)blockIdx.x >= 64) convert_tables(p, (int)blockIdx.x - 64, G - 64); }
        else convert_tables(p, (int)blockIdx.x, G);
    PHASE_END
    PHASE_BEGIN(PH_MIX)
        unsigned* ctl = (unsigned*)(p.ws + OFF_CTL);
        for (int t = blockIdx.x; t < 1024; t += G) mlstm_passA(p, t, lds);
        wg_signal(ctl, CNT_MLA);
        __syncthreads();
        for (int t = blockIdx.x; t < 2048; t += G) {
            const int rnd = t >> 8, w = t & 255; const int bsel = rnd >> 1; const int qgs = (rnd & 1) ? w : (511 - w);
            dsa_task(p, (bsel << 9) | qgs, lds); }
        wg_wait(ctl, CNT_MLA, (unsigned)G);
        for (int t = blockIdx.x; t < 256; t += G) mlstm_scan(p, t, lds);
        wg_signal(ctl, CNT_SCAN);
        wg_wait(ctl, CNT_SCAN, (unsigned)G);
        for (int t = blockIdx.x; t < 1024; t += G) mlstm_passB(p, t, lds);
    PHASE_END
    PHASE_BEGIN(PH_GEMM_OUT)
        {   pg8::StaticOrder S; S.init(NTOK, 1024, G, blockIdx.x);
            EpiOut E; E.x = p.x; E.ada = (const float*)(p.ws + OFF_ADA); E.out = p.out;
            pg8::gemm_phase(lds, pg8::Gemm{(const bf16_t*)(p.ws + OFF_ACT), (const bf16_t*)(p.ws + OFF_WOUT), NTOK, 1024, 1024}, S, E); }
    PHASE_END
    PHASE_BEGIN(PH_H2) norm_mod_rows(p.out, p.norm2_g, (const float*)(p.ws + OFF_ADA), 3072, 4096, (bf16_t*)(p.ws + OFF_ACT)); PHASE_END
    PHASE_BEGIN(PH_GEMM_Q)
        {   pg8::StaticOrder S; S.init(NTOK, 1024, G, blockIdx.x);
            EpiQry E; E.O = (bf16_t*)(p.ws + OFF_QRY);
            pg8::gemm_phase(lds, pg8::Gemm{(const bf16_t*)(p.ws + OFF_ACT), (const bf16_t*)(p.ws + OFF_WPQ), NTOK, 1024, 1024}, S, E); }
    PHASE_END
    PHASE_BEGIN(PH_ROUTE) for (int t = blockIdx.x; t < 512; t += G) peer_route(p, t, lds); PHASE_END
    PHASE_BEGIN(PH_EXPERT) peer_experts(p, last_rep, lds); PHASE_END
}

extern "C" void kernel_launch(void* const* d_in, const int* in_sizes, int n_in, void* d_out, int out_size, void* d_ws, size_t ws_size, hipStream_t stream) {
    static int grid = 0;
    if (grid == 0) {
        int dev = 0, cus = 0, per_cu = 0;
        if (hipGetDevice(&dev) != hipSuccess || hipDeviceGetAttribute(&cus, hipDeviceAttributeMultiprocessorCount, dev) != hipSuccess) { fprintf(stderr, "kernel_launch: device query failed\n"); grid = -1; return; }
        if (hipFuncSetAttribute((const void*)hymba_fwd, hipFuncAttributeMaxDynamicSharedMemorySize, LDS_BYTES) != hipSuccess) { fprintf(stderr, "kernel_launch: hipFuncSetAttribute failed\n"); grid = -1; return; }
        if (hipOccupancyMaxActiveBlocksPerMultiprocessor(&per_cu, (const void*)hymba_fwd, NTHREADS, LDS_BYTES) != hipSuccess || per_cu < 1) { fprintf(stderr, "kernel_launch: occupancy query says %d blocks/CU\n", per_cu); }
        (void)hipGetLastError();
        grid = cus;
        if (ws_size < WS_END || n_in != 17) { fprintf(stderr, "kernel_launch: unexpected sizes (ws %zu, n_in %d)\n", ws_size, n_in); grid = -1; return; }
    }
    if (grid < 0) return;
    (void)hipMemsetAsync((char*)d_ws + OFF_CTL, 0, CTL_BYTES, stream);
    Params p{};
    p.x = (const float*)d_in[0]; p.c = (const float*)d_in[1]; p.w_ada = (const float*)d_in[2]; p.b_ada = (const float*)d_in[3]; p.norm1_g = (const float*)d_in[4];
    p.w_in = (const float*)d_in[5]; p.b_in = (const float*)d_in[6]; p.conv_qk = (const float*)d_in[7]; p.out_norm_m = (const float*)d_in[8]; p.out_norm_a = (const float*)d_in[9];
    p.w_out = (const float*)d_in[10]; p.norm2_g = (const float*)d_in[11]; p.w_peer_q = (const float*)d_in[12]; p.sub_keys = (const float*)d_in[13]; p.peer_u = (const float*)d_in[14];
    p.peer_v = (const float*)d_in[15]; p.final_g = (const float*)d_in[16];
    p.out = (float*)d_out; p.ws = (unsigned char*)d_ws; p.ph_lo = 0; p.ph_hi = PH_COUNT;
    void* args[] = {&p};
    hipError_t e = hipLaunchCooperativeKernel((const void*)hymba_fwd, dim3(grid), dim3(NTHREADS), args, LDS_BYTES, stream);
    if (e != hipSuccess) fprintf(stderr, "kernel_launch: cooperative launch failed: %s (grid %d)\n", hipGetErrorString(e), grid);
}
```

```cpp
#include <hip/hip_runtime.h>
#include <stdint.h>
#define REP_PHASE -1
#define DSA_REP 0
#include <cstdio>

#define LAS __attribute__((address_space(3)))
typedef unsigned short bf16_t;
typedef short bf16x8 __attribute__((ext_vector_type(8)));
typedef float f32x4 __attribute__((ext_vector_type(4)));
typedef float f32x2 __attribute__((ext_vector_type(2)));
typedef float f32x16 __attribute__((ext_vector_type(16)));
typedef unsigned u32x4 __attribute__((ext_vector_type(4)));
typedef unsigned u32x2 __attribute__((ext_vector_type(2)));

constexpr int NTOK = 16384, DM = 1024, SEQ = 4096;
constexpr int NIN_PAD = 3328;
constexpr int LDS_BYTES = 163840 - 64;
constexpr int NTHREADS = 512;

constexpr size_t MiB = 1024 * 1024;
constexpr size_t OFF_CTL = 0;
constexpr size_t CTL_BYTES = 16384;
constexpr size_t OFF_ADA = 64 * 1024;
constexpr size_t OFF_BIAS = 192 * 1024;
constexpr size_t OFF_SK = 256 * 1024;
constexpr size_t OFF_WIN = 512 * 1024;
constexpr size_t OFF_WOUT = 7 * MiB;
constexpr size_t OFF_WPQ = 9 * MiB;
constexpr size_t OFF_ACT = 11 * MiB;
constexpr size_t OFF_MQ = 43 * MiB;
constexpr size_t OFF_MK = 59 * MiB;
constexpr size_t OFF_MV = 75 * MiB;
constexpr size_t OFF_MO = 91 * MiB;
constexpr size_t OFF_AQ = 107 * MiB;
constexpr size_t OFF_IQ = 123 * MiB;
constexpr size_t OFF_AK = 139 * MiB;
constexpr size_t OFF_AV = 141 * MiB;
constexpr size_t OFF_IK = 143 * MiB;
constexpr size_t OFF_GATE = 145 * MiB;
constexpr size_t OFF_KV = 146 * MiB;
constexpr size_t OFF_KS = 178 * MiB;
constexpr size_t OFF_MLOC = 178 * MiB + 512 * 1024;
constexpr size_t OFF_BLAST = OFF_MLOC + 4096;
constexpr size_t OFF_M0 = OFF_BLAST + 4096;
constexpr size_t OFF_UT = 179 * MiB;
constexpr size_t OFF_VT = 195 * MiB;
constexpr size_t WS_END = 211 * MiB;
constexpr float PEER_SU = 95.52f;
constexpr float PEER_SV = 8.443f;
constexpr float PEER_SC = 2048.f;
constexpr size_t OFF_QRY = OFF_MQ;
constexpr size_t OFF_EIDX = OFF_MV;
constexpr size_t OFF_GW = OFF_MV + 8 * MiB;

struct Params {
    const float* x; const float* c; const float* w_ada; const float* b_ada; const float* norm1_g;
    const float* w_in; const float* b_in; const float* conv_qk; const float* out_norm_m; const float* out_norm_a;
    const float* w_out; const float* norm2_g; const float* w_peer_q; const float* sub_keys; const float* peer_u;
    const float* peer_v; const float* final_g;
    float* out; unsigned char* ws;
    int ph_lo, ph_hi;
};

__device__ __forceinline__ int opaque_tid() { int t = threadIdx.x; asm volatile("" : "+v"(t)); return t; }
__device__ __forceinline__ float bf2f(unsigned short b) { return __uint_as_float(((unsigned)b) << 16); }
__device__ __forceinline__ unsigned pack2(float lo, float hi) { unsigned r; asm("v_cvt_pk_bf16_f32 %0, %1, %2" : "=v"(r) : "v"(lo), "v"(hi)); return r; }
__device__ __forceinline__ unsigned short f2bf(float f) { return (unsigned short)(pack2(f, 0.f) & 0xffffu); }
__device__ __forceinline__ unsigned short f2bf_sw(float f) { unsigned u = __float_as_uint(f); u += 0x7FFFu + ((u >> 16) & 1u); return (unsigned short)(u >> 16); }
__device__ __forceinline__ float lo16(unsigned w) { return __uint_as_float(w << 16); }
__device__ __forceinline__ float hi16(unsigned w) { return __uint_as_float(w & 0xffff0000u); }
__device__ __forceinline__ float wave_sum_dpp(float v);
__device__ __forceinline__ float wave_sum(float v) { return wave_sum_dpp(v); }
__device__ __forceinline__ int wave_sum_i32_uniform(int v) {
    v += __builtin_amdgcn_update_dpp(0, v, 0xB1, 0xF, 0xF, true);
    v += __builtin_amdgcn_update_dpp(0, v, 0x4E, 0xF, 0xF, true);
    v += __builtin_amdgcn_update_dpp(0, v, 0x141, 0xF, 0xF, true);
    v += __builtin_amdgcn_update_dpp(0, v, 0x140, 0xF, 0xF, true);
    return __builtin_amdgcn_readlane(v, 0) + __builtin_amdgcn_readlane(v, 16) + __builtin_amdgcn_readlane(v, 32) + __builtin_amdgcn_readlane(v, 48);
}
__device__ __forceinline__ float wave_scan_add(float v, int lane) {
#pragma unroll
    for (int o = 1; o < 64; o <<= 1) { const float t = __shfl_up(v, o); if (lane >= o) v += t; }
    return v;
}
__device__ __forceinline__ float wave_scan_max(float v, int lane) {
#pragma unroll
    for (int o = 1; o < 64; o <<= 1) { const float t = __shfl_up(v, o); if (lane >= o) v = fmaxf(v, t); }
    return v;
}
__device__ __forceinline__ float wave_max(float v) {
#pragma unroll
    for (int o = 32; o >= 1; o >>= 1) v = fmaxf(v, __shfl_xor(v, o));
    return v;
}
#define dppf(v, ctrl) __uint_as_float((unsigned)__builtin_amdgcn_update_dpp(0, (int)__float_as_uint(v), (ctrl), 0xF, 0xF, true))
__device__ __forceinline__ float rlanef(float v, int l) { return __uint_as_float((unsigned)__builtin_amdgcn_readlane((int)__float_as_uint(v), l)); }
__device__ __forceinline__ float wave_sum_dpp(float v) {
    v += dppf(v, 0xB1); v += dppf(v, 0x4E); v += dppf(v, 0x141); v += dppf(v, 0x140);
    return (rlanef(v, 0) + rlanef(v, 16)) + (rlanef(v, 32) + rlanef(v, 48));
}
__device__ __forceinline__ float wave_max_dpp(float v) {
    v = fmaxf(v, dppf(v, 0xB1)); v = fmaxf(v, dppf(v, 0x4E)); v = fmaxf(v, dppf(v, 0x141)); v = fmaxf(v, dppf(v, 0x140));
    return fmaxf(fmaxf(rlanef(v, 0), rlanef(v, 16)), fmaxf(rlanef(v, 32), rlanef(v, 48)));
}
template <int STRIDE>
__device__ __forceinline__ unsigned xchg_u32(unsigned x, int lane) {
    if constexpr (STRIDE == 1) return (unsigned)__builtin_amdgcn_update_dpp(0, (int)x, 0xB1, 0xF, 0xF, true);
    else if constexpr (STRIDE == 2) return (unsigned)__builtin_amdgcn_update_dpp(0, (int)x, 0x4E, 0xF, 0xF, true);
    else if constexpr (STRIDE == 4) {
        const unsigned up = (unsigned)__builtin_amdgcn_update_dpp(0, (int)x, 0x104, 0xF, 0xF, true);
        const unsigned dn = (unsigned)__builtin_amdgcn_update_dpp(0, (int)x, 0x114, 0xF, 0xF, true);
        return (lane & 4) ? dn : up;
    }
    else if constexpr (STRIDE == 8) return (unsigned)__builtin_amdgcn_update_dpp(0, (int)x, 0x128, 0xF, 0xF, true);
    else if constexpr (STRIDE == 16) { const u32x2 r_ = __builtin_amdgcn_permlane16_swap(x, x, false, false); return (lane & 16) ? r_[0] : r_[1]; }
    else { const u32x2 r_ = __builtin_amdgcn_permlane32_swap(x, x, false, false); return (lane & 32) ? r_[0] : r_[1]; }
}
template <int STRIDE> __device__ __forceinline__ float xchg_f32(float x, int lane) { return __uint_as_float(xchg_u32<STRIDE>(__float_as_uint(x), lane)); }
__device__ __forceinline__ float row16_sum(float v) { v += dppf(v, 0xB1); v += dppf(v, 0x4E); v += dppf(v, 0x141); v += dppf(v, 0x140); return v; }
__device__ __forceinline__ float oct_sum(float v) { v += dppf(v, 0xB1); v += dppf(v, 0x4E); v += dppf(v, 0x141); return v; }
__device__ __forceinline__ float siluf(float x) { return x * __builtin_amdgcn_rcpf(1.f + __expf(-x)); }
__device__ __forceinline__ float sigmoidf_(float x) { return __builtin_amdgcn_rcpf(1.f + __expf(-x)); }
__device__ __forceinline__ float logsigmoidf_(float x) { return fminf(x, 0.f) - log1pf(__expf(-fabsf(x))); }

#define XB_TMO      128
#define XB_XCNT(j)  (256  + 64 * (j))
#define XB_XSUB(j)  (1280 + 64 * (j))
#define XB_XGEN(j)  (2304 + 64 * (j))
#define XB_TOP      3328
#define XB_TOPGEN   3392
#define XCD_BAR_WORDS 3456
#define XB_SPIN_CAP (1u << 22)
__device__ __forceinline__ unsigned xb_ld(unsigned* p)              { return __hip_atomic_load(p, __ATOMIC_RELAXED, __HIP_MEMORY_SCOPE_AGENT); }
__device__ __forceinline__ unsigned xb_add(unsigned* p, unsigned v) { return __hip_atomic_fetch_add(p, v, __ATOMIC_RELAXED, __HIP_MEMORY_SCOPE_AGENT); }
__device__ __forceinline__ unsigned xb_xcc_id() { return (unsigned)__builtin_amdgcn_s_getreg((3 << 11) | 20) & 0xFu; }
#define XB_SPIN(cond, bar) do { unsigned _sp = 0; while (cond) { __builtin_amdgcn_s_sleep(1); \
    if ((++_sp & 255u) == 0u) { if (xb_ld(&(bar)[XB_TMO])) break; if (_sp > XB_SPIN_CAP) { atomicAdd(&(bar)[XB_TMO], 1u); break; } } } } while (0)
struct XcdBarrier { unsigned* bar; unsigned x; volatile LAS unsigned* st; };
__device__ __forceinline__ XcdBarrier xcd_barrier_post(unsigned* bar, volatile LAS unsigned* st) {
    XcdBarrier b; b.bar = bar; b.x = xb_xcc_id(); b.st = st;
    if (threadIdx.x == 0) (void)xb_add(&bar[XB_XCNT(b.x)], 1u);
    return b;
}
__device__ __forceinline__ void xcd_barrier_complete(unsigned* bar, unsigned x, unsigned& nloc, unsigned& nx) {
    const unsigned G = gridDim.x * gridDim.y * gridDim.z;
    unsigned sum, cnt, mine, sp = 0u;
    for (;;) {
        sum = 0u; cnt = 0u; mine = 0u;
#pragma unroll
        for (unsigned j = 0; j < 16; ++j) { const unsigned c = xb_ld(&bar[XB_XCNT(j)]); sum += c; cnt += (c > 0u) ? 1u : 0u; mine = (j == x) ? c : mine; }
        if (sum == G) break;
        __builtin_amdgcn_s_sleep(1);
        if ((++sp & 255u) == 0u) { if (xb_ld(&bar[XB_TMO])) break; if (sp > XB_SPIN_CAP) { atomicAdd(&bar[XB_TMO], 1u); break; } }
    }
    nloc = mine > 0u ? mine : 1u; nx = cnt > 0u ? cnt : 1u;
}
__device__ __forceinline__ void xcd_barrier(const XcdBarrier& b) {
    asm volatile("s_waitcnt vmcnt(0)" ::: "memory");
    __syncthreads();
    if (threadIdx.x == 0) {
        unsigned* bar = b.bar;
        __builtin_amdgcn_s_waitcnt(0);
        unsigned nloc = b.st[0], nx = b.st[1];
        if (nloc == 0u) { xcd_barrier_complete(bar, b.x, nloc, nx); b.st[0] = nloc; b.st[1] = nx; }
        const unsigned old = xb_add(&bar[XB_XSUB(b.x)], 1u);
        const unsigned gen = old / nloc;
        if (old + 1u == (gen + 1u) * nloc) {
            __builtin_amdgcn_fence(__ATOMIC_RELEASE, "agent");
            asm volatile("s_waitcnt vmcnt(0)" ::: "memory");
            const unsigned og = xb_add(&bar[XB_TOP], 1u);
            const unsigned tg = og / nx;
            if (og + 1u == (tg + 1u) * nx) xb_add(&bar[XB_TOPGEN], 1u);
            else XB_SPIN(xb_ld(&bar[XB_TOPGEN]) == tg, bar);
            __builtin_amdgcn_fence(__ATOMIC_ACQUIRE, "agent");
            xb_add(&bar[XB_XGEN(b.x)], 1u);
            asm volatile("s_waitcnt vmcnt(0)" ::: "memory");
        } else {
            XB_SPIN(xb_ld(&bar[XB_XGEN(b.x)]) == gen, bar);
            __builtin_amdgcn_fence(__ATOMIC_ACQUIRE, "agent");
            asm volatile("s_waitcnt vmcnt(0)" ::: "memory");
        }
    }
    __syncthreads();
}

#define CNT_ADA  3600
#define CNT_MLA  3664
#define CNT_SCAN 3728
__device__ __forceinline__ void wg_signal(unsigned* ctl, int word) {
    asm volatile("s_waitcnt vmcnt(0)" ::: "memory");
    __syncthreads();
    if (threadIdx.x == 0) {
        __builtin_amdgcn_fence(__ATOMIC_RELEASE, "agent");
        asm volatile("s_waitcnt vmcnt(0)" ::: "memory");
        (void)xb_add(&ctl[word], 1u);
    }
}
__device__ __forceinline__ void wg_wait(unsigned* ctl, int word, unsigned need) {
    if (threadIdx.x == 0) {
        XB_SPIN(xb_ld(&ctl[word]) < need, ctl);
        __builtin_amdgcn_fence(__ATOMIC_ACQUIRE, "agent");
        asm volatile("s_waitcnt vmcnt(0)" ::: "memory");
    }
    __syncthreads();
}

namespace pg8 {
constexpr int BM = 256, BK = 64, HALF = 128, HTB = HALF * BK * 2, STAGE_BYTES = 8 * HTB, NXCD = 8, WGM = 8;
__host__ __device__ __forceinline__ int lds_byte(int r, int c) { const int st = (r >> 4) * 2 + (c >> 5), rr = r & 15, cc = c & 31, ob = rr * 64 + cc * 2; return st * 1024 + (ob ^ (((ob >> 9) & 1) << 5)); }
__host__ __device__ __forceinline__ void stage_rc(int b, int& R, int& C) { const int st = b / 1024, sb = b % 1024, swz = sb ^ (((sb >> 9) & 1) << 5); R = (st >> 1) * 16 + swz / 64; C = (st & 1) * 32 + (swz % 64) / 2; }
__host__ __device__ __forceinline__ int perm32(int rho) { const int n = rho >> 4, i = rho & 15; return 8 * (i >> 2) + 4 * n + (i & 3); }
struct Unit { int pm, pn; };
struct Gemm { const bf16_t* A; const bf16_t* Bt; int M, N, K; };
struct StaticOrder {
    int nM, nN, nwg, G, c;
    __host__ __device__ void init(int M, int N, int G_, int c_) { nM = M / BM; nN = N / BM; nwg = nM * nN; G = G_; c = c_; }
    __host__ __device__ bool next(int i, Unit& u) const {
        const long L = (long)i * G + c; if (L >= nwg) return false;
        int wgid = (int)L; { const int q = nwg / NXCD, r = nwg % NXCD, xcd = wgid % NXCD, off = wgid / NXCD; wgid = (xcd < r ? xcd * (q + 1) : r * (q + 1) + (xcd - r) * q) + off; }
        const int nig = WGM * nN, gid = wgid / nig, fm = gid * WGM, gsz = (nM - fm) < WGM ? (nM - fm) : WGM;
        u.pm = fm + ((wgid % nig) % gsz); u.pn = (wgid % nig) / gsz; return true;
    }
    __device__ __forceinline__ void a_ready(const Unit&) const {}
    __device__ __forceinline__ void done(const Unit&) const {}
};
__device__ __forceinline__ unsigned cvt_pk_bf16(float lo, float hi) { unsigned r; asm volatile("v_cvt_pk_bf16_f32 %0, %1, %2" : "=v"(r) : "v"(lo), "v"(hi)); return r; }

template <class Epi, class Sched>
__device__ __forceinline__ void gemm_phase(LAS unsigned char* lds, const Gemm g, const Sched& S, const Epi& E) {
    const int tid = threadIdx.x, wid = __builtin_amdgcn_readfirstlane(tid >> 6), lane = tid & 63, wr = wid >> 2, wc = wid & 3, fr = lane & 15, fq = lane >> 4;
    const int K = g.K, nt = K / BK;
    unsigned voffA[2], voffB[2];
#pragma unroll
    for (int i = 0; i < 2; ++i) { int R, C; stage_rc(tid * 16 + i * 8192, R, C); const int Rb = Epi::PERM ? ((R & ~31) + perm32(R & 31)) : R;
        voffA[i] = (unsigned)(R * K + C) * 2u; voffB[i] = (unsigned)(Rb * K + C) * 2u; }
    const size_t kstep = (size_t)(BK * 2);
    const size_t hstep = (size_t)HALF * K * 2;
    const size_t tstep = 2 * hstep;
    const unsigned ldsw = (unsigned)wid * 1024u;
    const int aoff = lds_byte(wr * 64 + fr, fq * 8), boff = lds_byte(wc * 32 + fr, fq * 8);
#define PG8_SA(b, h) (((b) * 2 + (h)) * HTB)
#define PG8_SB(b, h) ((4 + (b) * 2 + (h)) * HTB)
#define PG8_STAGE(bufoff, gbase, voff) do { _Pragma("unroll") for (int _i = 0; _i < 2; ++_i) \
        __builtin_amdgcn_global_load_lds((const unsigned*)((const char*)(gbase) + (voff)[_i]), (LAS unsigned*)(lds + (bufoff) + ldsw + _i * 8192), 16, 0, 0); } while (0)
#define PG8_LDA(dst, b, h) do { _Pragma("unroll") for (int m = 0; m < 4; ++m) _Pragma("unroll") for (int k = 0; k < 2; ++k) dst[m][k] = *(const LAS bf16x8*)(lds + PG8_SA(b, h) + aoff + m * 2048 + k * 1024); } while (0)
#define PG8_LDB(dst, b, h) do { _Pragma("unroll") for (int n = 0; n < 2; ++n) _Pragma("unroll") for (int k = 0; k < 2; ++k) dst[n][k] = *(const LAS bf16x8*)(lds + PG8_SB(b, h) + boff + n * 2048 + k * 1024); } while (0)
#define PG8_MMA(ai, bj, At, Bt) do { __builtin_amdgcn_s_setprio(1); _Pragma("unroll") for (int m = 0; m < 4; ++m) _Pragma("unroll") for (int n = 0; n < 2; ++n) _Pragma("unroll") for (int k = 0; k < 2; ++k) \
        acc[ai][bj][m][n] = __builtin_amdgcn_mfma_f32_16x16x32_bf16(Bt[n][k], At[m][k], acc[ai][bj][m][n], 0, 0, 0); __builtin_amdgcn_s_setprio(0); } while (0)
#define PG8_WAIT_V(n) asm volatile("s_waitcnt vmcnt(" #n ")" ::: "memory")
#define PG8_WAIT_L(n) asm volatile("s_waitcnt lgkmcnt(" #n ")" ::: "memory")
#define PG8_BAR __builtin_amdgcn_s_barrier()
#define PG8_SCHED __builtin_amdgcn_sched_barrier(0)
    Unit cur, nxt; int ui = 0;
    if (!S.next(0, cur)) return;
    f32x4 acc[2][2][4][2];
#pragma unroll
    for (int a = 0; a < 2; ++a)
#pragma unroll
        for (int b = 0; b < 2; ++b)
#pragma unroll
            for (int m = 0; m < 4; ++m)
#pragma unroll
                for (int n = 0; n < 2; ++n) acc[a][b][m][n] = (f32x4){0.f, 0.f, 0.f, 0.f};
    bf16x8 At[4][2], B0[2][2], B1[2][2];
    const char* cA = (const char*)g.A + (size_t)cur.pm * tstep; const char* cB = (const char*)g.Bt + (size_t)cur.pn * tstep;
    S.a_ready(cur);
    PG8_STAGE(PG8_SB(0, 0), cB, voffB); PG8_STAGE(PG8_SA(0, 0), cA, voffA); PG8_STAGE(PG8_SB(0, 1), cB + hstep, voffB); PG8_STAGE(PG8_SA(0, 1), cA + hstep, voffA);
    if (wr == 1) PG8_BAR;
    PG8_WAIT_V(4); PG8_BAR;
    PG8_STAGE(PG8_SB(1, 0), cB + kstep, voffB); PG8_STAGE(PG8_SA(1, 0), cA + kstep, voffA); PG8_STAGE(PG8_SB(1, 1), cB + hstep + kstep, voffB);
    PG8_WAIT_V(6); PG8_BAR;
    for (;;) {
        const bool has_next = S.next(ui + 1, nxt);
        const char* nA = has_next ? (const char*)g.A + (size_t)nxt.pm * tstep : cA; const char* nB = has_next ? (const char*)g.Bt + (size_t)nxt.pn * tstep : cB;
        for (int t = 0; t < nt; t += 2) {
            const bool last = (t == nt - 2);
            const char* a1 = cA + (size_t)(t + 1) * kstep;
            const char* a2 = last ? nA : cA + (size_t)(t + 2) * kstep; const char* b2 = last ? nB : cB + (size_t)(t + 2) * kstep;
            const char* a3 = a2 + kstep; const char* b3 = b2 + kstep;
            if (last && has_next) S.a_ready(nxt);
            PG8_LDB(B0, 0, 0); PG8_SCHED; PG8_LDA(At, 0, 0); PG8_STAGE(PG8_SA(1, 1), a1 + hstep, voffA);
            PG8_WAIT_L(8); PG8_BAR; PG8_WAIT_L(0); PG8_MMA(0, 0, At, B0); PG8_BAR; PG8_SCHED;
            PG8_LDB(B1, 0, 1); PG8_STAGE(PG8_SB(0, 0), b2, voffB);
            PG8_BAR; PG8_WAIT_L(0); PG8_MMA(0, 1, At, B1); PG8_BAR;
            PG8_LDA(At, 0, 1); PG8_STAGE(PG8_SA(0, 0), a2, voffA);
            PG8_BAR; PG8_WAIT_L(0); PG8_MMA(1, 0, At, B0); PG8_BAR; PG8_SCHED;
            PG8_STAGE(PG8_SB(0, 1), b2 + hstep, voffB);
            PG8_WAIT_V(6); PG8_BAR; PG8_MMA(1, 1, At, B1); PG8_BAR;
            PG8_LDB(B0, 1, 0); PG8_SCHED; PG8_LDA(At, 1, 0); PG8_STAGE(PG8_SA(0, 1), a2 + hstep, voffA);
            PG8_WAIT_L(8); PG8_BAR; PG8_WAIT_L(0); PG8_MMA(0, 0, At, B0); PG8_BAR; PG8_SCHED;
            PG8_LDB(B1, 1, 1); PG8_STAGE(PG8_SB(1, 0), b3, voffB);
            PG8_BAR; PG8_WAIT_L(0); PG8_MMA(0, 1, At, B1); PG8_BAR;
            PG8_LDA(At, 1, 1); PG8_STAGE(PG8_SA(1, 0), a3, voffA);
            PG8_BAR; PG8_WAIT_L(0); PG8_MMA(1, 0, At, B0); PG8_BAR; PG8_SCHED;
            PG8_STAGE(PG8_SB(1, 1), b3 + hstep, voffB);
            PG8_WAIT_V(6); PG8_BAR; PG8_MMA(1, 1, At, B1); PG8_BAR;
        }
        asm volatile("s_nop 15\n\ts_nop 15" ::: "memory");
        E(acc, cur, wr, wc, fr, fq); S.done(cur);
        if (!has_next) break;
#pragma unroll
        for (int a = 0; a < 2; ++a)
#pragma unroll
            for (int b = 0; b < 2; ++b)
#pragma unroll
                for (int m = 0; m < 4; ++m)
#pragma unroll
                    for (int n = 0; n < 2; ++n) acc[a][b][m][n] = (f32x4){0.f, 0.f, 0.f, 0.f};
        cur = nxt; cA = nA; cB = nB; ++ui;
    }
    PG8_WAIT_V(0);
    if (wr == 0) PG8_BAR;
    PG8_BAR;
#undef PG8_SA
#undef PG8_SB
#undef PG8_STAGE
#undef PG8_LDA
#undef PG8_LDB
#undef PG8_MMA
#undef PG8_WAIT_V
#undef PG8_WAIT_L
#undef PG8_BAR
#undef PG8_SCHED
}
}

struct EpiInMain {
    static constexpr bool PERM = true;
    unsigned char* ws; const float* bias;
    __device__ __forceinline__ void operator()(const f32x4 (&acc)[2][2][4][2], const pg8::Unit& u, int wr, int wc, int fr, int fq) const {
        const int row0 = u.pm * 256 + wr * 64 + fr;
        const int cl0 = wc * 32 + 8 * fq;
        bf16_t* base = (bf16_t*)(ws + OFF_MQ + (size_t)(u.pn >> 1) * (16 * MiB)) + (u.pn & 1) * 256 + cl0;
        const float* bp = bias + u.pn * 256 + cl0;
#pragma unroll
        for (int bj = 0; bj < 2; ++bj) {
            const f32x4 b0 = *(const f32x4*)(bp + bj * 128), b1 = *(const f32x4*)(bp + bj * 128 + 4);
#pragma unroll
            for (int ai = 0; ai < 2; ++ai)
#pragma unroll
                for (int m = 0; m < 4; ++m) {
                    const f32x4 v0 = acc[ai][bj][m][0] + b0, v1 = acc[ai][bj][m][1] + b1;
                    u32x4 o; o[0] = pg8::cvt_pk_bf16(v0[0], v0[1]); o[1] = pg8::cvt_pk_bf16(v0[2], v0[3]); o[2] = pg8::cvt_pk_bf16(v1[0], v1[1]); o[3] = pg8::cvt_pk_bf16(v1[2], v1[3]);
                    *(u32x4*)(base + (size_t)(row0 + ai * 128 + m * 16) * 512 + bj * 128) = o;
                }
        }
    }
};
struct EpiInTail {
    static constexpr bool PERM = true;
    unsigned char* ws; const float* bias;
    __device__ __forceinline__ void operator()(const f32x4 (&acc)[2][2][4][2], const pg8::Unit& u, int wr, int wc, int fr, int fq) const {
        const int row0 = u.pm * 256 + wr * 64 + fr;
        const int cl0 = wc * 32 + 8 * fq;
#pragma unroll
        for (int bj = 0; bj < 2; ++bj) {
            const int cl = bj * 128 + cl0;
            if (cl >= 208) continue;
            const f32x4 b0 = *(const f32x4*)(bias + cl), b1 = *(const f32x4*)(bias + cl + 4);
            if (cl < 192) {
                bf16_t* dst = (bf16_t*)(ws + OFF_AK + (size_t)(cl >> 6) * (2 * MiB)) + (cl & 63);
#pragma unroll
                for (int ai = 0; ai < 2; ++ai)
#pragma unroll
                    for (int m = 0; m < 4; ++m) {
                        const f32x4 v0 = acc[ai][bj][m][0] + b0, v1 = acc[ai][bj][m][1] + b1;
                        u32x4 o; o[0] = pg8::cvt_pk_bf16(v0[0], v0[1]); o[1] = pg8::cvt_pk_bf16(v0[2], v0[3]); o[2] = pg8::cvt_pk_bf16(v1[0], v1[1]); o[3] = pg8::cvt_pk_bf16(v1[2], v1[3]);
                        const int row = row0 + ai * 128 + m * 16;
                        if (cl < 128) *(u32x4*)(dst + (size_t)row * 64) = o;
                        else *(u32x4*)((bf16_t*)(ws + OFF_IK) + (size_t)(row >> 5) * 2048 + (((cl - 128) >> 3) * 32 + (row & 31)) * 8) = o;
                    }
            } else {
                float* dst = (float*)(ws + OFF_GATE) + (cl - 192);
#pragma unroll
                for (int ai = 0; ai < 2; ++ai)
#pragma unroll
                    for (int m = 0; m < 4; ++m) {
                        float* d = dst + (size_t)(row0 + ai * 128 + m * 16) * 16;
                        *(f32x4*)d = acc[ai][bj][m][0] + b0; *(f32x4*)(d + 4) = acc[ai][bj][m][1] + b1;
                    }
            }
        }
    }
};
struct EpiOut {
    static constexpr bool PERM = false;
    const float* x; const float* ada; float* out;
    __device__ __forceinline__ void operator()(const f32x4 (&acc)[2][2][4][2], const pg8::Unit& u, int wr, int wc, int fr, int fq) const {
        const int row0 = u.pm * 256 + wr * 64 + fr, col0 = u.pn * 256 + wc * 32 + 4 * fq;
        const int b = (u.pm * 256) >> 12;
        f32x4 gv[2][2];
#pragma unroll
        for (int bj = 0; bj < 2; ++bj)
#pragma unroll
            for (int n = 0; n < 2; ++n) gv[bj][n] = *(const f32x4*)(ada + b * 6144 + 2048 + col0 + bj * 128 + n * 16);
#pragma unroll
        for (int ai = 0; ai < 2; ++ai)
#pragma unroll
            for (int m = 0; m < 4; ++m) {
                const size_t ro = (size_t)(row0 + ai * 128 + m * 16) * 1024 + col0;
#pragma unroll
                for (int bj = 0; bj < 2; ++bj)
#pragma unroll
                    for (int n = 0; n < 2; ++n) {
                        const f32x4 xv = *(const f32x4*)(x + ro + bj * 128 + n * 16);
                        *(f32x4*)(out + ro + bj * 128 + n * 16) = xv + gv[bj][n] * acc[ai][bj][m][n];
                    }
            }
    }
};
struct EpiQry {
    static constexpr bool PERM = true;
    bf16_t* O;
    __device__ __forceinline__ void operator()(const f32x4 (&acc)[2][2][4][2], const pg8::Unit& u, int wr, int wc, int fr, int fq) const {
        const int row0 = u.pm * 256 + wr * 64 + fr, col0 = u.pn * 256 + wc * 32 + 8 * fq;
#pragma unroll
        for (int ai = 0; ai < 2; ++ai)
#pragma unroll
            for (int m = 0; m < 4; ++m) {
                bf16_t* rowp = O + (size_t)(row0 + ai * 128 + m * 16) * 1024 + col0;
#pragma unroll
                for (int bj = 0; bj < 2; ++bj) {
                    const f32x4 v0 = acc[ai][bj][m][0], v1 = acc[ai][bj][m][1];
                    u32x4 o; o[0] = pg8::cvt_pk_bf16(v0[0], v0[1]); o[1] = pg8::cvt_pk_bf16(v0[2], v0[3]); o[2] = pg8::cvt_pk_bf16(v1[0], v1[1]); o[3] = pg8::cvt_pk_bf16(v1[2], v1[3]);
                    *(u32x4*)(rowp + bj * 128) = o;
                }
            }
    }
};

__device__ __forceinline__ int inperm_src(int n) {
    if (n < 2048) return n;
    if (n < 2560) return 2056 + (n - 2048);
    if (n < 3072) return 2696 + (n - 2560);
    if (n < 3136) return 2568 + (n - 3072);
    if (n < 3200) return 2632 + (n - 3136);
    if (n < 3264) return 3208 + (n - 3200);
    if (n < 3268) return 2048 + (n - 3264);
    if (n < 3272) return 2052 + (n - 3268);
    if (n < 3280) return 3272 + (n - 3272);
    return -1;
}
template <bool PERMUTE>
__device__ __forceinline__ void transpose_tile(const float* src, int ld, bf16_t* dst, int n0, int k0, LAS float* t) {
    const int tid = threadIdx.x;
    for (int i = tid; i < 4096; i += NTHREADS) {
        const int kk = i >> 6, nn = i & 63;
        const int sc = PERMUTE ? inperm_src(n0 + nn) : (n0 + nn);
        t[kk * 65 + nn] = sc >= 0 ? src[(size_t)(k0 + kk) * ld + sc] : 0.f;
    }
    __syncthreads();
    for (int i = tid; i < 2048; i += NTHREADS) {
        const int nn = i >> 5, kp = (i & 31) * 2;
        ((unsigned*)dst)[((size_t)(n0 + nn) * 1024 + k0 + kp) >> 1] = pack2(t[kp * 65 + nn], t[(kp + 1) * 65 + nn]);
    }
    __syncthreads();
}
__device__ __forceinline__ void convert_chunk(const float* src, bf16_t* dst, size_t e0, int n) {
    for (int i = threadIdx.x * 8; i < n; i += NTHREADS * 8) {
        const f32x4 a = *(const f32x4*)(src + e0 + i), b = *(const f32x4*)(src + e0 + i + 4);
        u32x4 o; o[0] = pack2(a[0], a[1]); o[1] = pack2(a[2], a[3]); o[2] = pack2(b[0], b[1]); o[3] = pack2(b[2], b[3]);
        *(u32x4*)(dst + e0 + i) = o;
    }
}
__device__ __forceinline__ unsigned pack4_fp8(float a, float b, float c, float d) {
    a = fminf(fmaxf(a, -448.f), 448.f); b = fminf(fmaxf(b, -448.f), 448.f); c = fminf(fmaxf(c, -448.f), 448.f); d = fminf(fmaxf(d, -448.f), 448.f);
    int w = 0;
    w = __builtin_amdgcn_cvt_pk_fp8_f32(a, b, w, false);
    w = __builtin_amdgcn_cvt_pk_fp8_f32(c, d, w, true);
    return (unsigned)w;
}
__device__ __forceinline__ void convert_chunk_fp8(const float* src, unsigned char* dst, size_t e0, int n, float scale) {
    for (int i = threadIdx.x * 16; i < n; i += NTHREADS * 16) {
        const f32x4 a = *(const f32x4*)(src + e0 + i), b = *(const f32x4*)(src + e0 + i + 4), c = *(const f32x4*)(src + e0 + i + 8), d = *(const f32x4*)(src + e0 + i + 12);
        u32x4 o; o[0] = pack4_fp8(a[0] * scale, a[1] * scale, a[2] * scale, a[3] * scale); o[1] = pack4_fp8(b[0] * scale, b[1] * scale, b[2] * scale, b[3] * scale);
        o[2] = pack4_fp8(c[0] * scale, c[1] * scale, c[2] * scale, c[3] * scale); o[3] = pack4_fp8(d[0] * scale, d[1] * scale, d[2] * scale, d[3] * scale);
        *(u32x4*)(dst + e0 + i) = o;
    }
}
__device__ __forceinline__ unsigned pack8_fp4(const f32x4 a, const f32x4 b, float scale) {
    float v[8] = {a[0] * scale, a[1] * scale, a[2] * scale, a[3] * scale, b[0] * scale, b[1] * scale, b[2] * scale, b[3] * scale};
#pragma unroll
    for (int i = 0; i < 8; ++i) v[i] = fminf(fmaxf(v[i], -6.f), 6.f);
    unsigned w = 0;
    w = __builtin_amdgcn_cvt_scalef32_pk_fp4_f32(w, v[0], v[1], 1.0f, 0);
    w = __builtin_amdgcn_cvt_scalef32_pk_fp4_f32(w, v[2], v[3], 1.0f, 1);
    w = __builtin_amdgcn_cvt_scalef32_pk_fp4_f32(w, v[4], v[5], 1.0f, 2);
    w = __builtin_amdgcn_cvt_scalef32_pk_fp4_f32(w, v[6], v[7], 1.0f, 3);
    return w;
}
__device__ __forceinline__ void convert_chunk_fp4(const float* src, unsigned char* dst, size_t e0, int n, float scale) {
    for (int i = threadIdx.x * 32; i < n; i += NTHREADS * 32) {
        u32x4 o;
#pragma unroll
        for (int k = 0; k < 4; ++k) o[k] = pack8_fp4(*(const f32x4*)(src + e0 + i + 8 * k), *(const f32x4*)(src + e0 + i + 8 * k + 4), scale);
        *(u32x4*)(dst + ((e0 + i) >> 1)) = o;
    }
}
__device__ __forceinline__ unsigned pack4_i8(float a, float b, float c, float d, float scale) {
    const int ia = (int)fminf(fmaxf(rintf(a * scale), -127.f), 127.f), ib = (int)fminf(fmaxf(rintf(b * scale), -127.f), 127.f);
    const int ic = (int)fminf(fmaxf(rintf(c * scale), -127.f), 127.f), id = (int)fminf(fmaxf(rintf(d * scale), -127.f), 127.f);
    return (unsigned)(ia & 0xFF) | ((unsigned)(ib & 0xFF) << 8) | ((unsigned)(ic & 0xFF) << 16) | ((unsigned)(id & 0xFF) << 24);
}
__device__ __forceinline__ void convert_chunk_i8(const float* src, unsigned char* dst, size_t e0, int n, float scale) {
    for (int i = threadIdx.x * 16; i < n; i += NTHREADS * 16) {
        const f32x4 a = *(const f32x4*)(src + e0 + i), b = *(const f32x4*)(src + e0 + i + 4), c = *(const f32x4*)(src + e0 + i + 8), d = *(const f32x4*)(src + e0 + i + 12);
        u32x4 o; o[0] = pack4_i8(a[0], a[1], a[2], a[3], scale); o[1] = pack4_i8(b[0], b[1], b[2], b[3], scale); o[2] = pack4_i8(c[0], c[1], c[2], c[3], scale); o[3] = pack4_i8(d[0], d[1], d[2], d[3], scale);
        *(u32x4*)(dst + e0 + i) = o;
    }
}
template <int OFS>
__device__ __forceinline__ unsigned pack8_i4(const f32x4 a, const f32x4 b, float scale) {
    unsigned w = 0;
#pragma unroll
    for (int k = 0; k < 4; ++k) {
        const int qa = ((int)fminf(fmaxf(rintf(a[k] * scale), -7.f), 7.f) + OFS) & 15, qb = ((int)fminf(fmaxf(rintf(b[k] * scale), -7.f), 7.f) + OFS) & 15;
        w |= (unsigned)qa << (4 * k); w |= (unsigned)qb << (4 * (k + 4));
    }
    return w;
}
template <int OFS>
__device__ __forceinline__ void convert_chunk_i4(const float* src, unsigned char* dst, size_t e0, int n, float scale) {
    for (int i = threadIdx.x * 32; i < n; i += NTHREADS * 32) {
        u32x4 o;
#pragma unroll
        for (int k = 0; k < 4; ++k) o[k] = pack8_i4<OFS>(*(const f32x4*)(src + e0 + i + 8 * k), *(const f32x4*)(src + e0 + i + 8 * k + 4), scale);
        *(u32x4*)(dst + ((e0 + i) >> 1)) = o;
    }
}
__device__ __forceinline__ void convert_tables(const Params& p, int first, int stride) {
    for (int it = first; it < 1024; it += stride) {
        const int tsel = it >> 9; const size_t e0 = (size_t)(it & 511) * 32768;
        if (tsel) convert_chunk_i4<8>(p.peer_v, p.ws + OFF_VT, e0, 32768, PEER_SV); else convert_chunk_i4<0>(p.peer_u, p.ws + OFF_UT, e0, 32768, PEER_SU);
    }
}
__device__ __forceinline__ void phase0(const Params& p, LAS unsigned char* lds) {
    const int tid = threadIdx.x;
    float* ada = (float*)(p.ws + OFF_ADA);
    LAS float* lf = (LAS float*)lds;
    constexpr int N_ADA = 192, N_WIN = 52 * 16, N_WOUT = 256, N_WPQ = 256, N_SK = 4, N_BIAS = 1;
    constexpr int NITEMS = N_ADA + N_WIN + N_WOUT + N_WPQ + N_SK + N_BIAS;
    if (blockIdx.x < N_ADA) {
        {
            const int it = blockIdx.x;
            LAS float* sc = lf; LAS float* red = lf + 4096;
            for (int i = tid; i < 4096; i += NTHREADS) sc[i] = siluf(p.c[i]);
            __syncthreads();
            const int col = tid & 31, kg = tid >> 5, c0 = it * 32;
            float a0 = 0.f, a1 = 0.f, a2 = 0.f, a3 = 0.f;
            const float* w = p.w_ada + c0 + col;
#pragma unroll 8
            for (int j = 0; j < 64; ++j) { const int k = kg + 16 * j; const float wv = w[(size_t)k * 6144];
                a0 += sc[k] * wv; a1 += sc[1024 + k] * wv; a2 += sc[2048 + k] * wv; a3 += sc[3072 + k] * wv; }
            red[(kg * 4 + 0) * 32 + col] = a0; red[(kg * 4 + 1) * 32 + col] = a1; red[(kg * 4 + 2) * 32 + col] = a2; red[(kg * 4 + 3) * 32 + col] = a3;
            __syncthreads();
            if (tid < 128) { const int b = tid >> 5, cc = tid & 31; float s = 0.f;
                for (int g = 0; g < 16; ++g) s += red[(g * 4 + b) * 32 + cc];
                ada[b * 6144 + c0 + cc] = s + p.b_ada[c0 + cc]; }
        }
        wg_signal((unsigned*)(p.ws + OFF_CTL), CNT_ADA);
        __syncthreads();
    }
    for (int item = N_ADA + ((blockIdx.x + gridDim.x - N_ADA) % gridDim.x); item < NITEMS; item += gridDim.x) {
        int it = item;
        it -= N_ADA;
        if (it < N_WIN) { transpose_tile<true>(p.w_in, 3280, (bf16_t*)(p.ws + OFF_WIN), (it >> 4) * 64, (it & 15) * 64, lf); continue; }
        it -= N_WIN;
        if (it < N_WOUT) { transpose_tile<false>(p.w_out, 1024, (bf16_t*)(p.ws + OFF_WOUT), (it >> 4) * 64, (it & 15) * 64, lf); continue; }
        it -= N_WOUT;
        if (it < N_WPQ) { transpose_tile<false>(p.w_peer_q, 1024, (bf16_t*)(p.ws + OFF_WPQ), (it >> 4) * 64, (it & 15) * 64, lf); continue; }
        it -= N_WPQ;

        if (it < N_SK) { convert_chunk(p.sub_keys, (bf16_t*)(p.ws + OFF_SK), (size_t)it * 32768, 32768); continue; }
        it -= N_SK;
        { float* bias = (float*)(p.ws + OFF_BIAS);
          for (int n = tid; n < NIN_PAD; n += NTHREADS) { const int s = inperm_src(n); bias[n] = s >= 0 ? p.b_in[s] : 0.f; } }
    }
}

__device__ __forceinline__ void norm_mod_rows(const float* X, const float* g, const float* ada, int sh_off, int sc_off, bf16_t* out) {
    const int wid = threadIdx.x >> 6, lane = threadIdx.x & 63;
    for (int row = (blockIdx.x * 8 + wid) * 2; row < NTOK; row += gridDim.x * 16) {
        const int b = row >> 12;
        f32x4 v[2][4]; float ss[2] = {0.f, 0.f};
#pragma unroll
        for (int rr = 0; rr < 2; ++rr)
#pragma unroll
            for (int j = 0; j < 4; ++j) v[rr][j] = *(const f32x4*)(X + (size_t)(row + rr) * 1024 + 4 * (lane + 64 * j));
#pragma unroll
        for (int rr = 0; rr < 2; ++rr)
#pragma unroll
            for (int j = 0; j < 4; ++j) ss[rr] += v[rr][j][0] * v[rr][j][0] + v[rr][j][1] * v[rr][j][1] + v[rr][j][2] * v[rr][j][2] + v[rr][j][3] * v[rr][j][3];
        ss[0] = wave_sum(ss[0]); ss[1] = wave_sum(ss[1]);
        const float rstd0 = rsqrtf(ss[0] * (1.f / 1024.f) + 1e-6f), rstd1 = rsqrtf(ss[1] * (1.f / 1024.f) + 1e-6f);
#pragma unroll
        for (int j = 0; j < 4; ++j) {
            const int c = 4 * (lane + 64 * j);
            const f32x4 gg = *(const f32x4*)(g + c), sc = *(const f32x4*)(ada + b * 6144 + sc_off + c), sh = *(const f32x4*)(ada + b * 6144 + sh_off + c);
#pragma unroll
            for (int rr = 0; rr < 2; ++rr) {
                const float rstd = rr ? rstd1 : rstd0;
                float h[4];
#pragma unroll
                for (int i = 0; i < 4; ++i) h[i] = (v[rr][j][i] * rstd * gg[i]) * (1.f + sc[i]) + sh[i];
                u32x2 o; o[0] = pack2(h[0], h[1]); o[1] = pack2(h[2], h[3]);
                *(u32x2*)(out + (size_t)(row + rr) * 1024 + c) = o;
            }
        }
    }
}

__device__ __forceinline__ bf16x8 lds_frag(const LAS bf16_t* base, int row, int stride, int kofs) { return *(const LAS bf16x8*)(base + row * stride + kofs); }

__device__ __forceinline__ void conv_silu8(const bf16_t* src, const float* cw  , int row, int tpos, int col, float scale, float (&o)[8]) {
    float acc[8];
#pragma unroll
    for (int i = 0; i < 8; ++i) acc[i] = 0.f;
#pragma unroll
    for (int j = 0; j < 4; ++j) {
        const int tt = tpos - 3 + j;
        if (tt >= 0) {
            const u32x4 xv = *(const u32x4*)(src + (size_t)(row - 3 + j) * 512 + col);
            const f32x4 w0 = *(const f32x4*)(cw + j * 1024), w1 = *(const f32x4*)(cw + j * 1024 + 4);
            acc[0] += w0[0] * lo16(xv[0]); acc[1] += w0[1] * hi16(xv[0]); acc[2] += w0[2] * lo16(xv[1]); acc[3] += w0[3] * hi16(xv[1]);
            acc[4] += w1[0] * lo16(xv[2]); acc[5] += w1[1] * hi16(xv[2]); acc[6] += w1[2] * lo16(xv[3]); acc[7] += w1[3] * hi16(xv[3]);
        }
    }
#pragma unroll
    for (int i = 0; i < 8; ++i) o[i] = siluf(acc[i]) * scale;
}

__device__ __forceinline__ void mlstm_passA(const Params& p, int task, LAS unsigned char* lds) {
    const int tid = opaque_tid(), wid = tid >> 6, lane = tid & 63;
    const int bh = task >> 6, c = task & 63, b = bh >> 2, h = bh & 3;
    const int row0 = b * SEQ + c * 64;
    const float* gates = (const float*)(p.ws + OFF_GATE);
    const bf16_t* MK = (const bf16_t*)(p.ws + OFF_MK); const bf16_t* MV = (const bf16_t*)(p.ws + OFF_MV);
    LAS bf16_t* KT = (LAS bf16_t*)lds;
    LAS bf16_t* VT = KT + 128 * 72;
    LAS float* sc = (LAS float*)(VT + 128 * 72);
    LAS float* lsg = sc; LAS float* ig = sc + 64; LAS float* wloc = sc + 128; LAS float* misc = sc + 192;
    if (tid < 64) {
        const float f = gates[(size_t)(row0 + tid) * 16 + 4 + h], iv = gates[(size_t)(row0 + tid) * 16 + h];
        const float bc = wave_scan_add(logsigmoidf_(f), lane);
        const float bl = __shfl(bc, 63);
        const float a = bl - bc + iv;
        const float m = wave_max(a);
        lsg[tid] = bc; ig[tid] = iv; wloc[tid] = __expf(a - m);
        if (tid == 0) { misc[0] = m; misc[1] = bl; }
    }
    __syncthreads();
    for (int pc = tid; pc < 1024; pc += NTHREADS) {
        const int s = pc >> 4, dg = pc & 15;
        float kk[8];
        conv_silu8(MK, p.conv_qk + 512 + h * 128 + dg * 8, row0 + s, c * 64 + s, h * 128 + dg * 8, 1.f, kk);
#pragma unroll
        for (int i = 0; i < 8; ++i) KT[(dg * 8 + i) * 72 + s] = f2bf(kk[i]);
        const u32x4 vv = *(const u32x4*)(MV + (size_t)(row0 + s) * 512 + h * 128 + dg * 8);
        const float w = wloc[s];
#pragma unroll
        for (int i = 0; i < 4; ++i) { VT[(dg * 8 + 2 * i) * 72 + s] = f2bf(lo16(vv[i]) * w); VT[(dg * 8 + 2 * i + 1) * 72 + s] = f2bf(hi16(vv[i]) * w); }
    }
    __syncthreads();
    {
        const int r = lane & 15, g = lane >> 4;
        bf16x8 a0 = lds_frag(VT, wid * 16 + r, 72, 8 * g), a1 = lds_frag(VT, wid * 16 + r, 72, 8 * g + 32);
        bf16_t* KV = (bf16_t*)(p.ws + OFF_KV) + (size_t)task * 16384;
#pragma unroll
        for (int dt = 0; dt < 8; ++dt) {
            f32x4 acc = {0.f, 0.f, 0.f, 0.f};
            acc = __builtin_amdgcn_mfma_f32_16x16x32_bf16(a0, lds_frag(KT, dt * 16 + r, 72, 8 * g), acc, 0, 0, 0);
            acc = __builtin_amdgcn_mfma_f32_16x16x32_bf16(a1, lds_frag(KT, dt * 16 + r, 72, 8 * g + 32), acc, 0, 0, 0);
#pragma unroll
            for (int j = 0; j < 4; ++j) KV[(wid * 16 + 4 * g + j) * 128 + dt * 16 + r] = f2bf_sw(acc[j]);
        }
    }
    if (tid < 128) {
        float s = 0.f;
        for (int i = 0; i < 64; ++i) s += wloc[i] * bf2f(KT[tid * 72 + i]);
        ((float*)(p.ws + OFF_KS))[(size_t)task * 128 + tid] = s;
    }
    if (tid == 0) { ((float*)(p.ws + OFF_MLOC))[task] = misc[0]; ((float*)(p.ws + OFF_BLAST))[task] = misc[1]; }
    __syncthreads();
}

__device__ __forceinline__ void mlstm_scan(const Params& p, int item, LAS unsigned char* lds) {
    const int tid = opaque_tid();
    const int bh = item >> 4, blk = item & 15;
    LAS float* dec = (LAS float*)lds; LAS float* inj = dec + 64;
    if (tid == 0) {
        const float* ML = (const float*)(p.ws + OFF_MLOC); const float* BL = (const float*)(p.ws + OFF_BLAST); float* M0 = (float*)(p.ws + OFF_M0);
        float m = 0.f;
        for (int c = 0; c < 64; ++c) {
            const float ml = ML[bh * 64 + c], bl = BL[bh * 64 + c];
            if (blk == 0) M0[bh * 64 + c] = m;
            const float mn = fmaxf(bl + m, ml);
            dec[c] = __expf(bl + m - mn); inj[c] = __expf(ml - mn); m = mn;
        }
    }
    __syncthreads();
    unsigned* KV = (unsigned*)(p.ws + OFF_KV) + (size_t)bh * 64 * 8192 + blk * 512 + tid;
    float s0 = 0.f, s1 = 0.f;
#pragma unroll 8
    for (int c = 0; c < 64; ++c) {
        const unsigned w = KV[(size_t)c * 8192];
        KV[(size_t)c * 8192] = pack2(s0, s1);
        s0 = dec[c] * s0 + inj[c] * lo16(w); s1 = dec[c] * s1 + inj[c] * hi16(w);
    }
    if (blk == 0 && tid < 128) {
        float* KS = (float*)(p.ws + OFF_KS) + (size_t)bh * 64 * 128 + tid;
        float s = 0.f;
        for (int c = 0; c < 64; ++c) { const float k = KS[c * 128]; KS[c * 128] = s; s = dec[c] * s + inj[c] * k; }
    }
    __syncthreads();
}

__device__ __forceinline__ void mlstm_passB(const Params& p, int task, LAS unsigned char* lds) {
    const int tid = opaque_tid(), wid = tid >> 6, lane = tid & 63;
    const int bh = task >> 6, c = task & 63, b = bh >> 2, h = bh & 3;
    const int row0 = b * SEQ + c * 64;
    const float* gates = (const float*)(p.ws + OFF_GATE);
    const bf16_t* MQ = (const bf16_t*)(p.ws + OFF_MQ); const bf16_t* MK = (const bf16_t*)(p.ws + OFF_MK);
    const bf16_t* MV = (const bf16_t*)(p.ws + OFF_MV); const bf16_t* MO = (const bf16_t*)(p.ws + OFF_MO);
    LAS bf16_t* Q = (LAS bf16_t*)lds;
    LAS bf16_t* K = Q + 64 * 136;
    LAS bf16_t* VT = K + 64 * 136;
    LAS bf16_t* C0 = VT + 128 * 72;
    LAS bf16_t* P = C0 + 128 * 136;
    LAS float* sc = (LAS float*)(P + 64 * 72);
    LAS float* bcum = sc; LAS float* ig = sc + 64; LAS float* cs = sc + 128; LAS float* rb = sc + 192; LAS float* wint = sc + 256;
    LAS float* emt = sc + 320; LAS float* rinv = sc + 384; LAS float* qn = sc + 448; LAS float* n0 = sc + 512; LAS float* rowpart = sc + 640;
    LAS float* H = (LAS float*)lds;
    if (tid < 64) {
        const float f = gates[(size_t)(row0 + tid) * 16 + 4 + h], iv = gates[(size_t)(row0 + tid) * 16 + h];
        const float m0 = ((const float*)(p.ws + OFF_M0))[task];
        const float sc_ = wave_scan_add(logsigmoidf_(f), lane);
        const float cst = iv - sc_;
        const float pm = wave_scan_max(cst, lane);
        const float m_intra = sc_ + pm, m_inter = sc_ + m0, mt = fmaxf(m_inter, m_intra);
        bcum[tid] = sc_; ig[tid] = iv; cs[tid] = cst; rb[tid] = sc_ - mt; wint[tid] = __expf(m_inter - mt); emt[tid] = __expf(-mt);
    }
    if (tid >= 64 && tid < 192) n0[tid - 64] = ((const float*)(p.ws + OFF_KS))[(size_t)task * 128 + tid - 64];
    for (int pc = tid; pc < 1024; pc += NTHREADS) {
        const int s = pc >> 4, dg = pc & 15;
        float qq[8], kk[8];
        conv_silu8(MQ, p.conv_qk + h * 128 + dg * 8, row0 + s, c * 64 + s, h * 128 + dg * 8, 0.08838834764831845f, qq);
        conv_silu8(MK, p.conv_qk + 512 + h * 128 + dg * 8, row0 + s, c * 64 + s, h * 128 + dg * 8, 1.f, kk);
        u32x4 qo, ko;
#pragma unroll
        for (int i = 0; i < 4; ++i) { qo[i] = pack2(qq[2 * i], qq[2 * i + 1]); ko[i] = pack2(kk[2 * i], kk[2 * i + 1]); }
        *(LAS u32x4*)(Q + s * 136 + dg * 8) = qo; *(LAS u32x4*)(K + s * 136 + dg * 8) = ko;
        const u32x4 vv = *(const u32x4*)(MV + (size_t)(row0 + s) * 512 + h * 128 + dg * 8);
#pragma unroll
        for (int i = 0; i < 4; ++i) { VT[(dg * 8 + 2 * i) * 72 + s] = (bf16_t)(vv[i] & 0xffffu); VT[(dg * 8 + 2 * i + 1) * 72 + s] = (bf16_t)(vv[i] >> 16); }
    }
    {
        const bf16_t* KV = (const bf16_t*)(p.ws + OFF_KV) + (size_t)task * 16384;
        for (int pc = tid; pc < 2048; pc += NTHREADS) { const int e = pc >> 4, dg = pc & 15;
            *(LAS u32x4*)(C0 + e * 136 + dg * 8) = *(const u32x4*)(KV + e * 128 + dg * 8); }
    }
    __syncthreads();
    const int r = lane & 15, g = lane >> 4;
    {
        const int t = tid >> 3, part = tid & 7; float s = 0.f;
#pragma unroll
        for (int i = 0; i < 16; ++i) s += bf2f(Q[t * 136 + part * 16 + i]) * n0[part * 16 + i];
        s = oct_sum(s);
        if (part == 0) qn[t] = s;
    }
    {
        const int rt = wid >> 1;
#pragma unroll
        for (int cc = 0; cc < 2; ++cc) {
            const int ct = 2 * (wid & 1) + cc;
            f32x4 acc = {0.f, 0.f, 0.f, 0.f};
#pragma unroll
            for (int ks = 0; ks < 4; ++ks)
                acc = __builtin_amdgcn_mfma_f32_16x16x32_bf16(lds_frag(Q, rt * 16 + r, 136, 8 * g + 32 * ks), lds_frag(K, ct * 16 + r, 136, 8 * g + 32 * ks), acc, 0, 0, 0);
            const int scol = ct * 16 + r; const float csv = cs[scol];
#pragma unroll
            for (int j = 0; j < 4; ++j) {
                const int t = rt * 16 + 4 * g + j;
                float pv = (scol <= t) ? acc[j] * __expf(rb[t] + csv) : 0.f;
                P[t * 72 + scol] = f2bf(pv);
                pv = row16_sum(pv);
                if (r == 0) rowpart[t * 4 + ct] = pv;
            }
        }
    }
    __syncthreads();
    if (tid < 64) {
        const float den = rowpart[tid * 4] + rowpart[tid * 4 + 1] + rowpart[tid * 4 + 2] + rowpart[tid * 4 + 3] + wint[tid] * qn[tid];
        rinv[tid] = 1.f / fmaxf(fabsf(den), emt[tid]);
    }
    f32x4 hacc[4];
    {
        const int rt = wid >> 1;
#pragma unroll
        for (int ee = 0; ee < 4; ++ee) {
            const int et = 4 * (wid & 1) + ee;
            f32x4 a1 = {0.f, 0.f, 0.f, 0.f}, a2 = {0.f, 0.f, 0.f, 0.f};
#pragma unroll
            for (int ks = 0; ks < 2; ++ks)
                a1 = __builtin_amdgcn_mfma_f32_16x16x32_bf16(lds_frag(P, rt * 16 + r, 72, 8 * g + 32 * ks), lds_frag(VT, et * 16 + r, 72, 8 * g + 32 * ks), a1, 0, 0, 0);
#pragma unroll
            for (int ks = 0; ks < 4; ++ks)
                a2 = __builtin_amdgcn_mfma_f32_16x16x32_bf16(lds_frag(Q, rt * 16 + r, 136, 8 * g + 32 * ks), lds_frag(C0, et * 16 + r, 136, 8 * g + 32 * ks), a2, 0, 0, 0);
#pragma unroll
            for (int j = 0; j < 4; ++j) { const int t = rt * 16 + 4 * g + j; hacc[ee][j] = a1[j] + wint[t] * a2[j]; }
        }
    }
    __syncthreads();
    {
        const int rt = wid >> 1;
#pragma unroll
        for (int ee = 0; ee < 4; ++ee) {
            const int et = 4 * (wid & 1) + ee;
#pragma unroll
            for (int j = 0; j < 4; ++j) { const int t = rt * 16 + 4 * g + j; H[t * 132 + et * 16 + r] = hacc[ee][j] * rinv[t]; }
        }
    }
    __syncthreads();
    {
        const int t = tid >> 3, part = tid & 7;
        float hv[16]; float ss = 0.f;
#pragma unroll
        for (int i = 0; i < 16; ++i) { hv[i] = H[t * 132 + part * 16 + i]; ss += hv[i] * hv[i]; }
        ss = oct_sum(ss);
        const float rstd = rsqrtf(ss * (1.f / 128.f) + 1e-6f);
        const int col = h * 128 + part * 16;
        const u32x4 m0v = *(const u32x4*)(MO + (size_t)(row0 + t) * 512 + col), m1v = *(const u32x4*)(MO + (size_t)(row0 + t) * 512 + col + 8);
        float mo[16];
#pragma unroll
        for (int i = 0; i < 4; ++i) { mo[2 * i] = lo16(m0v[i]); mo[2 * i + 1] = hi16(m0v[i]); mo[8 + 2 * i] = lo16(m1v[i]); mo[8 + 2 * i + 1] = hi16(m1v[i]); }
        float o[16];
#pragma unroll
        for (int i = 0; i < 16; ++i) o[i] = (hv[i] * rstd * p.out_norm_m[col + i]) * sigmoidf_(mo[i]);
        u32x4 o0, o1;
#pragma unroll
        for (int i = 0; i < 4; ++i) { o0[i] = pack2(o[2 * i], o[2 * i + 1]); o1[i] = pack2(o[8 + 2 * i], o[8 + 2 * i + 1]); }
        bf16_t* dst = (bf16_t*)(p.ws + OFF_ACT) + (size_t)(row0 + t) * 1024 + col;
        *(u32x4*)dst = o0; *(u32x4*)(dst + 8) = o1;
    }
    __syncthreads();
}

__device__ __forceinline__ unsigned f2sortable(float f) { const unsigned u = __float_as_uint(f); return (u & 0x80000000u) ? ~u : (u | 0x80000000u); }
#define CNT4(c0, c1, c2, c3, a, b, cc, d, thr) asm volatile( \
    "v_cmp_ge_u32 s[40:41], %4, %8\n\tv_cmp_ge_u32 s[42:43], %5, %8\n\tv_cmp_ge_u32 s[44:45], %6, %8\n\tv_cmp_ge_u32 s[46:47], %7, %8\n\t" \
    "v_addc_co_u32 %0, s[48:49], 0, %0, s[40:41]\n\tv_addc_co_u32 %1, s[50:51], 0, %1, s[42:43]\n\tv_addc_co_u32 %2, s[52:53], 0, %2, s[44:45]\n\tv_addc_co_u32 %3, s[54:55], 0, %3, s[46:47]" \
    : "+v"(c0), "+v"(c1), "+v"(c2), "+v"(c3) : "v"(a), "v"(b), "v"(cc), "v"(d), "v"(thr) \
    : "s40", "s41", "s42", "s43", "s44", "s45", "s46", "s47", "s48", "s49", "s50", "s51", "s52", "s53", "s54", "s55")
template <int NR>
__device__ __forceinline__ int count_geN(const unsigned (&u)[NR], unsigned thr) {
    int c0 = 0, c1 = 0, c2 = 0, c3 = 0;
#pragma unroll
    for (int j = 0; j < NR; j += 4) CNT4(c0, c1, c2, c3, u[j], u[j + 1], u[j + 2], u[j + 3], thr);
    return (c0 + c1) + (c2 + c3);
}
template <int NR>
__device__ __forceinline__ void select_topk(const LAS float* srow, LAS int* lq, int t, int n, int lane) {
    unsigned u[NR];
#pragma unroll
    for (int j = 0; j < NR; ++j) { const int key = lane + 64 * j; u[j] = (key <= t) ? ((f2sortable(srow[key]) & 0xFFFFF000u) | (unsigned)(4095 - key)) : 0u; }
    unsigned tau = 1u;
    if (n > 256) {
        tau = 0u;
        for (int bit = 31; bit >= 0; --bit) {
            const unsigned cand = tau | (1u << bit);
            const int cnt = wave_sum_i32_uniform(count_geN<NR>(u, cand));
            if (cnt >= 256) { tau = cand; if (cnt == 256) break; }
        }
    }
    const int c = count_geN<NR>(u, tau);
    int pre = c;
#pragma unroll
    for (int o = 1; o < 64; o <<= 1) { const int v = __shfl_up(pre, o); if (lane >= o) pre += v; }
    int pos = pre - c;
    int keyv = lane;
#pragma unroll
    for (int j = 0; j < NR; ++j) {
        const bool sel = u[j] >= tau;
        const int slot = sel ? pos : (256 + lane);
        lq[slot] = keyv;
        pos += sel ? 1 : 0; keyv += 64;
    }
}
__device__ __forceinline__ unsigned wave_max_u32(unsigned v) {
    v = max(v, (unsigned)__builtin_amdgcn_update_dpp(0, (int)v, 0xB1, 0xF, 0xF, true)); v = max(v, (unsigned)__builtin_amdgcn_update_dpp(0, (int)v, 0x4E, 0xF, 0xF, true));
    v = max(v, (unsigned)__builtin_amdgcn_update_dpp(0, (int)v, 0x141, 0xF, 0xF, true)); v = max(v, (unsigned)__builtin_amdgcn_update_dpp(0, (int)v, 0x140, 0xF, 0xF, true));
    return max(max((unsigned)__builtin_amdgcn_readlane((int)v, 0), (unsigned)__builtin_amdgcn_readlane((int)v, 16)), max((unsigned)__builtin_amdgcn_readlane((int)v, 32), (unsigned)__builtin_amdgcn_readlane((int)v, 48)));
}
template <int NR>
__device__ __forceinline__ void select_topk2(LAS float* srow, LAS unsigned* buf, LAS int* lq, int t, int n, int lane) {
    unsigned u[NR];
#pragma unroll
    for (int j = 0; j < NR; ++j) { const int key = lane + 64 * j; u[j] = (key <= t) ? ((f2sortable(srow[key]) & 0xFFFFF000u) | (unsigned)(4095 - key)) : 0u; }
    unsigned mx = 0u;
#pragma unroll
    for (int j = 0; j < NR; ++j) mx = max(mx, u[j]);
    mx = wave_max_u32(mx);
    unsigned tau = 0u; int bit = 31, G = n, lc = 0;
    {
        unsigned th = mx & 0xFF800000u;
#pragma unroll 1
        for (int s6 = 0; s6 < 6; ++s6) {
            const int lcnt = count_geN<NR>(u, th);
            const int cnt = wave_sum_i32_uniform(lcnt);
            if (cnt >= 256) { tau = th; bit = 22; G = cnt; lc = lcnt; break; }
            if (th < 0x00800000u) break;
            th -= 0x00800000u;
        }
    }
    while (G > 512 && bit >= 0) {
        const unsigned cand = tau | (1u << bit);
        const int lcnt = count_geN<NR>(u, cand);
        const int cnt = wave_sum_i32_uniform(lcnt);
        if (cnt >= 256) { tau = cand; G = cnt; lc = lcnt; }
        --bit;
    }
    {
        int pre = lc;
#pragma unroll
        for (int o = 1; o < 64; o <<= 1) { const int v = __shfl_up(pre, o); if (lane >= o) pre += v; }
        int pos = pre - lc;
#pragma unroll
        for (int j = 0; j < NR; ++j) {
            const bool sel = u[j] >= tau;
            buf[sel ? pos : (512 + lane)] = u[j];
            pos += sel ? 1 : 0;
        }
    }
    unsigned c[8];
#pragma unroll
    for (int j = 0; j < 8; ++j) c[j] = (lane + 64 * j < G) ? buf[lane + 64 * j] : 0u;
    while (G > 256 && bit >= 0) {
        const unsigned cand = tau | (1u << bit);
        int cnt = 0;
#pragma unroll
        for (int j = 0; j < 8; ++j) cnt += __builtin_popcountll(__builtin_amdgcn_ballot_w64(c[j] >= cand));
        if (cnt >= 256) { tau = cand; G = cnt; }
        --bit;
    }
    {
        const int lc2 = count_geN<8>(c, tau);
        int pre = lc2;
#pragma unroll
        for (int o = 1; o < 64; o <<= 1) { const int v = __shfl_up(pre, o); if (lane >= o) pre += v; }
        int pos = pre - lc2;
#pragma unroll
        for (int j = 0; j < 8; ++j) {
            const bool sel = c[j] >= tau;
            lq[sel ? pos : (256 + lane)] = 4095 - (int)(c[j] & 4095u);
            pos += sel ? 1 : 0;
        }
    }
}
__device__ __forceinline__ void dsa_task(const Params& p, int task, LAS unsigned char* lds) {
    const int tid = opaque_tid(), wid = __builtin_amdgcn_readfirstlane(tid >> 6), lane = tid & 63;
    const int b = task >> 9, qg = task & 511, t0 = qg * 8, rowb = b * SEQ;
    const bf16_t* IQ = (const bf16_t*)(p.ws + OFF_IQ); const bf16_t* IK = (const bf16_t*)(p.ws + OFF_IK);
    const bf16_t* AQ = (const bf16_t*)(p.ws + OFF_AQ); const bf16_t* AK = (const bf16_t*)(p.ws + OFF_AK); const bf16_t* AV = (const bf16_t*)(p.ws + OFF_AV);
    const float* gates = (const float*)(p.ws + OFF_GATE);
    LAS float* scores = (LAS float*)lds;
    LAS int* lists = (LAS int*)(lds + 131072);
    const int ntile = (t0 + 8 + 31) >> 5;
#pragma unroll 1
    for (int rr0 = 0; rr0 < ((DSA_REP & 1) ? 2 : 1); ++rr0)
    {
        const int r = lane & 31, hh = lane >> 5;
        bf16x8 af[2][4]; float wv[2][4][4];
#pragma unroll
        for (int rt = 0; rt < 2; ++rt) {
            const size_t qrow = (size_t)(rowb + t0 + 4 * rt + (r >> 3));
#pragma unroll
            for (int ks = 0; ks < 4; ++ks) af[rt][ks] = *(const bf16x8*)(IQ + qrow * 512 + (r & 7) * 64 + 16 * ks + 8 * hh);
#pragma unroll
            for (int q4 = 0; q4 < 4; ++q4)
#pragma unroll
                for (int h4 = 0; h4 < 4; ++h4) wv[rt][q4][h4] = gates[(size_t)(rowb + t0 + 4 * rt + q4) * 16 + 8 + h4 + 4 * hh] * 0.04419417382415922f;
        }
        bf16x8 bfr[4], bnx[4];
        if (wid < ntile) {
#pragma unroll
            for (int ks = 0; ks < 4; ++ks) bfr[ks] = *(const bf16x8*)(IK + (size_t)(rowb + 32 * wid) * 64 + ks * 512 + lane * 8);
        }
        for (int kt = wid; kt < ntile; kt += 8) {
            if (kt + 8 < ntile) {
#pragma unroll
                for (int ks = 0; ks < 4; ++ks) bnx[ks] = *(const bf16x8*)(IK + (size_t)(rowb + 32 * (kt + 8)) * 64 + ks * 512 + lane * 8);
            }
            const int key = 32 * kt + r;
#pragma unroll
            for (int rt = 0; rt < 2; ++rt) {
                f32x16 acc;
#pragma unroll
                for (int i = 0; i < 16; ++i) acc[i] = 0.f;
#pragma unroll
                for (int ks = 0; ks < 4; ++ks) acc = __builtin_amdgcn_mfma_f32_32x32x16_bf16(af[rt][ks], bfr[ks], acc, 0, 0, 0);
                float part[4];
#pragma unroll
                for (int q4 = 0; q4 < 4; ++q4) {
                    part[q4] = 0.f;
#pragma unroll
                    for (int h4 = 0; h4 < 4; ++h4) part[q4] += fmaxf(acc[q4 * 4 + h4], 0.f) * wv[rt][q4][h4];
                }
                float tot[2];
#pragma unroll
                for (int i = 0; i < 2; ++i) { const u32x2 r_ = __builtin_amdgcn_permlane32_swap(__float_as_uint(part[i]), __float_as_uint(part[i + 2]), false, false); tot[i] = __uint_as_float(r_[0]) + __uint_as_float(r_[1]); }
#pragma unroll
                for (int i = 0; i < 2; ++i) { const int qq = 4 * rt + 2 * hh + i; scores[qq * 4096 + key] = (key <= t0 + qq) ? tot[i] : -INFINITY; }
            }
#pragma unroll
            for (int ks = 0; ks < 4; ++ks) bfr[ks] = bnx[ks];
        }
    }
    __syncthreads();
    const int qq = wid, t = t0 + qq, n = t + 1;
    const int nsel = n < 256 ? n : 256;
#pragma unroll 1
    for (int rr1 = 0; rr1 < ((DSA_REP & 2) ? 2 : 1); ++rr1)
    {
        LAS float* srow = scores + qq * 4096; LAS int* lq = lists + qq * 320; LAS unsigned* cbuf = (LAS unsigned*)(lds + 141312 + qq * 2304);
        const int nreg = (t >> 6) + 1;
        if (nreg <= 8) select_topk<8>(srow, lq, t, n, lane);
        else if (nreg <= 16) select_topk2<16>(srow, cbuf, lq, t, n, lane);
        else if (nreg <= 24) select_topk2<24>(srow, cbuf, lq, t, n, lane);
        else if (nreg <= 32) select_topk2<32>(srow, cbuf, lq, t, n, lane);
        else if (nreg <= 40) select_topk2<40>(srow, cbuf, lq, t, n, lane);
        else if (nreg <= 48) select_topk2<48>(srow, cbuf, lq, t, n, lane);
        else if (nreg <= 56) select_topk2<56>(srow, cbuf, lq, t, n, lane);
        else select_topk2<64>(srow, cbuf, lq, t, n, lane);
    }
    asm volatile("s_waitcnt lgkmcnt(0)" ::: "memory");
#pragma unroll 1
    for (int rr2 = 0; rr2 < ((DSA_REP & 4) ? 2 : 1); ++rr2) {
#pragma unroll 1
    for (int rr3 = 0; rr3 < ((DSA_REP & 8) ? 2 : 1); ++rr3)
    {
        const int r = lane & 15, g = lane >> 4;
        const size_t qrow = (size_t)(rowb + t);
        bf16x8 bq[2];
#pragma unroll
        for (int ks = 0; ks < 2; ++ks) {
            if (r < 8) bq[ks] = *(const bf16x8*)(AQ + qrow * 512 + r * 64 + 8 * g + 32 * ks);
            else { bq[ks] = (bf16x8){0, 0, 0, 0, 0, 0, 0, 0}; }
        }
        LAS float* Pl = scores + qq * 4096;
        LAS unsigned char* ksA = lds + 141312 + qq * 2304;
        LAS unsigned char* ksB = (LAS unsigned char*)Pl + 13440;
        const int kl = lane >> 3, dc = lane & 7;
#pragma unroll 1
        for (int half = 0; half < 2; ++half) {
            u32x4 kr[16];
#pragma unroll
            for (int i = 0; i < 16; ++i) {
                const int jp = 16 * (half * 8 + (i >> 1)) + kl + 8 * (i & 1);
                const int key = (jp < nsel) ? lists[qq * 320 + jp] : 0;
                kr[i] = *(const u32x4*)(AK + (size_t)(rowb + key) * 64 + dc * 8);
            }
#pragma unroll
            for (int i = 0; i < 8; ++i) {
                const int kt = half * 8 + i;
                LAS unsigned char* ks_ = (i & 1) ? ksB : ksA;
                *(LAS u32x4*)(ks_ + kl * 144 + dc * 16) = kr[2 * i]; *(LAS u32x4*)(ks_ + (kl + 8) * 144 + dc * 16) = kr[2 * i + 1];
                const bf16x8 a0 = *(const LAS bf16x8*)(ks_ + r * 144 + 16 * g), a1 = *(const LAS bf16x8*)(ks_ + r * 144 + 64 + 16 * g);
                f32x4 acc = {0.f, 0.f, 0.f, 0.f};
                acc = __builtin_amdgcn_mfma_f32_16x16x32_bf16(a0, bq[0], acc, 0, 0, 0);
                acc = __builtin_amdgcn_mfma_f32_16x16x32_bf16(a1, bq[1], acc, 0, 0, 0);
                if (r < 8) *(LAS f32x4*)(Pl + r * 260 + 16 * kt + 4 * g) = acc * 0.125f;
            }
        }
        asm volatile("s_waitcnt lgkmcnt(0)" ::: "memory");
        const int hd = lane & 7, ch = lane >> 3;
        f32x4 pv[8];
        float mx = -INFINITY;
#pragma unroll
        for (int i = 0; i < 8; ++i) {
            pv[i] = *(const LAS f32x4*)(Pl + hd * 260 + ch * 32 + 4 * i);
#pragma unroll
            for (int j = 0; j < 4; ++j) if (ch * 32 + 4 * i + j < nsel) mx = fmaxf(mx, pv[i][j]);
        }
        mx = fmaxf(mx, dppf(mx, 0x128));
        mx = fmaxf(mx, xchg_f32<16>(mx, lane)); mx = fmaxf(mx, xchg_f32<32>(mx, lane));
        float sm = 0.f;
#pragma unroll
        for (int i = 0; i < 8; ++i)
#pragma unroll
            for (int j = 0; j < 4; ++j) { const float e = (ch * 32 + 4 * i + j < nsel) ? __expf(pv[i][j] - mx) : 0.f; pv[i][j] = e; sm += e; }
        sm += dppf(sm, 0x128); sm += xchg_f32<16>(sm, lane); sm += xchg_f32<32>(sm, lane);
        const float inv = __builtin_amdgcn_rcpf(sm);
        LAS bf16_t* Pt = (LAS bf16_t*)((LAS unsigned char*)Pl + 9216);
#pragma unroll
        for (int i = 0; i < 4; ++i) {
            u32x4 o;
            o[0] = pack2(pv[2 * i][0] * inv, pv[2 * i][1] * inv); o[1] = pack2(pv[2 * i][2] * inv, pv[2 * i][3] * inv);
            o[2] = pack2(pv[2 * i + 1][0] * inv, pv[2 * i + 1][1] * inv); o[3] = pack2(pv[2 * i + 1][2] * inv, pv[2 * i + 1][3] * inv);
            *(LAS u32x4*)(Pt + hd * 264 + ch * 32 + 8 * i) = o;
        }
    }
    asm volatile("s_waitcnt lgkmcnt(0)" ::: "memory");
#pragma unroll 1
    for (int rr4 = 0; rr4 < ((DSA_REP & 16) ? 2 : 1); ++rr4)
    {
        typedef short s16x4 __attribute__((ext_vector_type(4)));
        const int r = lane & 15, g = lane >> 4;
        LAS unsigned char* wb = (LAS unsigned char*)(scores + qq * 4096);
        const LAS bf16_t* Pt = (const LAS bf16_t*)(wb + 9216);
        const int nchunk = (nsel + 31) >> 5;
        const int kl = lane >> 3, dc = lane & 7;
        f32x4 acc[4];
#pragma unroll
        for (int ct = 0; ct < 4; ++ct) acc[ct] = (f32x4){0.f, 0.f, 0.f, 0.f};
        u32x4 vq[4], vn[4];
#pragma unroll
        for (int i = 0; i < 4; ++i) {
            const int jp = kl + 8 * i;
            const int key = (jp < nsel) ? lists[qq * 320 + jp] : 0;
            vq[i] = *(const u32x4*)(AV + (size_t)(rowb + key) * 64 + dc * 8);
        }
#pragma unroll 1
        for (int c = 0; c < nchunk; ++c) {
            LAS unsigned char* vb = wb + (c & 1) * 4608;
#pragma unroll
            for (int i = 0; i < 4; ++i) *(LAS u32x4*)(vb + (kl + 8 * i) * 144 + dc * 16) = vq[i];
            if (c + 1 < nchunk) {
#pragma unroll
                for (int i = 0; i < 4; ++i) {
                    const int jp = 32 * (c + 1) + kl + 8 * i;
                    const int key = (jp < nsel) ? lists[qq * 320 + jp] : 0;
                    vn[i] = *(const u32x4*)(AV + (size_t)(rowb + key) * 64 + dc * 8);
                }
            }
            bf16x8 a = *(const LAS bf16x8*)(Pt + (r & 7) * 264 + 32 * c + 8 * g);
            if (r >= 8) a = (bf16x8){0, 0, 0, 0, 0, 0, 0, 0};
#pragma unroll
            for (int ct = 0; ct < 4; ++ct) {
                LAS unsigned char* ba = vb + (8 * g + (r >> 2)) * 144 + (16 * ct + 4 * (r & 3)) * 2;
                const s16x4 b0 = __builtin_amdgcn_ds_read_tr16_b64_v4i16((LAS s16x4*)ba);
                const s16x4 b1 = __builtin_amdgcn_ds_read_tr16_b64_v4i16((LAS s16x4*)(ba + 4 * 144));
                bf16x8 bb; bb[0] = b0[0]; bb[1] = b0[1]; bb[2] = b0[2]; bb[3] = b0[3]; bb[4] = b1[0]; bb[5] = b1[1]; bb[6] = b1[2]; bb[7] = b1[3];
                acc[ct] = __builtin_amdgcn_mfma_f32_16x16x32_bf16(a, bb, acc[ct], 0, 0, 0);
            }
#pragma unroll
            for (int i = 0; i < 4; ++i) vq[i] = vn[i];
        }
        bf16_t* dst = (bf16_t*)(p.ws + OFF_ACT) + (size_t)(rowb + t) * 1024 + 512;
#pragma unroll
        for (int j = 0; j < 4; ++j) {
            float ss = acc[0][j] * acc[0][j] + acc[1][j] * acc[1][j] + acc[2][j] * acc[2][j] + acc[3][j] * acc[3][j];
            ss = row16_sum(ss);
            const float rstd = rsqrtf(ss * (1.f / 64.f) + 1e-6f);
            if (g < 2) {
                const int hd = 4 * g + j;
#pragma unroll
                for (int ct = 0; ct < 4; ++ct) dst[hd * 64 + 16 * ct + r] = f2bf(acc[ct][j] * rstd * p.out_norm_a[hd * 64 + 16 * ct + r]);
            }
        }
    }
    }
    __syncthreads();
}

__device__ __forceinline__ float sortable2f(unsigned s) { return __uint_as_float((s & 0x80000000u) ? (s ^ 0x80000000u) : ~s); }
#define CE_DESC(x, y) do { const unsigned mx_ = max(x, y), mn_ = min(x, y); (x) = mx_; (y) = mn_; } while (0)
template <int BASE, int N>
__device__ __forceinline__ void bitonic_sort16_desc(unsigned (&a)[N]) {
#pragma unroll
    for (int k = 2; k <= 16; k <<= 1) {
#pragma unroll
        for (int j = k >> 1; j > 0; j >>= 1) {
#pragma unroll
            for (int i = 0; i < 16; ++i) {
                const int l = i ^ j;
                if (l > i) {
                    if ((i & k) == 0) CE_DESC(a[BASE + i], a[BASE + l]);
                    else CE_DESC(a[BASE + l], a[BASE + i]);
                }
            }
        }
    }
}
template <int BASE, int N>
__device__ __forceinline__ void bitonic_merge16_desc(unsigned (&a)[N]) {
#pragma unroll
    for (int j = 8; j > 0; j >>= 1) {
#pragma unroll
        for (int i = 0; i < 16; ++i) { const int l = i ^ j; if (l > i) CE_DESC(a[BASE + i], a[BASE + l]); }
    }
}
template <int BA, int BB, int N>
__device__ __forceinline__ void top16_merge(unsigned (&a)[N]) {
#pragma unroll
    for (int i = 0; i < 16; ++i) a[BA + i] = max(a[BA + i], a[BB + 15 - i]);
    bitonic_merge16_desc<BA, N>(a);
}
__device__ __forceinline__ void top16_of_64(unsigned (&a)[64]) {
    bitonic_sort16_desc<0, 64>(a); bitonic_sort16_desc<16, 64>(a); bitonic_sort16_desc<32, 64>(a); bitonic_sort16_desc<48, 64>(a);
    top16_merge<0, 16, 64>(a); top16_merge<32, 48, 64>(a); top16_merge<0, 32, 64>(a);
}
__device__ __forceinline__ void peer_route(const Params& p, int task, LAS unsigned char* lds) {
    const int tid = opaque_tid(), wid = __builtin_amdgcn_readfirstlane(tid >> 6), lane = tid & 63;
    const int n0 = task * 32, head = wid;
    const int r = lane & 31, hh = lane >> 5;
    const bf16_t* QRY = (const bf16_t*)(p.ws + OFF_QRY); const bf16_t* SK = (const bf16_t*)(p.ws + OFF_SK);
    LAS unsigned* tkl = (LAS unsigned*)lds + wid * (32 * 64);
#pragma unroll 1
    for (int p2 = 0; p2 < 2; ++p2) {
        const int grp = head * 2 + p2;
        bf16x8 bq[4];
#pragma unroll
        for (int ks = 0; ks < 4; ++ks) bq[ks] = *(const bf16x8*)(QRY + (size_t)(n0 + r) * 1024 + grp * 64 + 16 * ks + 8 * hh);
        unsigned key[64];
#pragma unroll
        for (int kt = 0; kt < 4; ++kt) {
            f32x16 acc;
#pragma unroll
            for (int i = 0; i < 16; ++i) acc[i] = 0.f;
#pragma unroll
            for (int ks = 0; ks < 4; ++ks) {
                const bf16x8 a = *(const bf16x8*)(SK + (size_t)(grp * 128 + 32 * kt + r) * 64 + 16 * ks + 8 * hh);
                acc = __builtin_amdgcn_mfma_f32_32x32x16_bf16(a, bq[ks], acc, 0, 0, 0);
            }
#pragma unroll
            for (int reg = 0; reg < 16; ++reg) {
                const int idx = 32 * kt + (reg & 3) + 8 * (reg >> 2) + 4 * hh;
                key[kt * 16 + reg] = (f2sortable(acc[reg]) & ~0x7Fu) | (unsigned)(127 - idx);
            }
        }
        top16_of_64(key);
        unsigned mg[16];
#pragma unroll
        for (int i = 0; i < 16; ++i) mg[i] = max(key[i], xchg_u32<32>(key[15 - i], lane));
        bitonic_merge16_desc<0, 16>(mg);
#pragma unroll
        for (int k = 0; k < 16; ++k) tkl[(p2 * 16 + k) * 64 + lane] = mg[k];
    }
    float v1[16], v2[16];
#pragma unroll
    for (int k = 0; k < 16; ++k) { v1[k] = sortable2f(tkl[k * 64 + lane] & ~0x7Fu); v2[k] = sortable2f(tkl[(16 + k) * 64 + lane] & ~0x7Fu); }
    unsigned ck[64];
    {
        int ci = 0;
#pragma unroll
        for (int a = 0; a < 16; ++a) {
#pragma unroll
            for (int bb = 0; bb < 16 / (a + 1); ++bb) { ck[ci] = (f2sortable(v1[a] + v2[bb]) & ~0xFFu) | (unsigned)(255 - (16 * a + bb)); ++ci; }
        }
#pragma unroll
        for (int i = 50; i < 64; ++i) ck[i] = 0u;
    }
    top16_of_64(ck);
    float tv[16]; int te[16];
    float sum = 0.f;
#pragma unroll
    for (int k = 0; k < 16; ++k) {
        const int flat = 255 - (int)(ck[k] & 0xFFu);
        const int i1 = 127 - (int)(tkl[(flat >> 4) * 64 + lane] & 0x7Fu), i2 = 127 - (int)(tkl[(16 + (flat & 15)) * 64 + lane] & 0x7Fu);
        te[k] = i1 * 128 + i2;
        tv[k] = __expf(sortable2f(ck[k] & ~0xFFu) - sortable2f(ck[0] & ~0xFFu)); sum += tv[k];
    }
    const float inv = 1.f / sum;
    if (hh == 0) {
        int* EI = (int*)(p.ws + OFF_EIDX) + (size_t)(n0 + r) * 128 + head * 16;
#pragma unroll
        for (int q = 0; q < 4; ++q) { u32x4 o; o[0] = te[4 * q]; o[1] = te[4 * q + 1]; o[2] = te[4 * q + 2]; o[3] = te[4 * q + 3]; *(u32x4*)(EI + 4 * q) = o; }
    } else {
        float* GW = (float*)(p.ws + OFF_GW) + (size_t)(n0 + r) * 128 + head * 16;
#pragma unroll
        for (int q = 0; q < 4; ++q) { f32x4 o; o[0] = tv[4 * q] * inv; o[1] = tv[4 * q + 1] * inv; o[2] = tv[4 * q + 2] * inv; o[3] = tv[4 * q + 3] * inv; *(f32x4*)(GW + 4 * q) = o; }
    }
}

__device__ __forceinline__ float gelu_exact(float a) { return 0.5f * a * (1.f + erff(a * 0.70710678118654752440f)); }
__device__ __forceinline__ float gelu_as(float v) {
    const float av = fabsf(v), t = __builtin_amdgcn_rcpf(av * 0.2316418882f + 1.0f);
    float q = t * 0.5307027145f + (-0.7265760135f); q = q * t + 0.7107068705f; q = q * t + (-0.142248368f); q = q * t + 0.127414796f; q = q * t;
    const float e = __builtin_amdgcn_exp2f((v * v) * (-0.72134752044f));
    const float m = v * (q * e), rr = v - m;
    return v < 0.f ? m : rr;
}
__device__ __forceinline__ void dec16_fp8(const u32x4 w, float (&f)[16]) {
#pragma unroll
    for (int i = 0; i < 4; ++i) {
        const f32x2 lo = __builtin_amdgcn_cvt_pk_f32_fp8((int)w[i], false), hi = __builtin_amdgcn_cvt_pk_f32_fp8((int)w[i], true);
        f[4 * i] = lo[0]; f[4 * i + 1] = lo[1]; f[4 * i + 2] = hi[0]; f[4 * i + 3] = hi[1];
    }
}
__device__ __forceinline__ void sort_pairs128(int& k_lo, int& k_hi, float& g_lo, float& g_hi, int lane) {
#pragma unroll
    for (int size = 2; size <= 128; size <<= 1) {
#pragma unroll
        for (int stride = size >> 1; stride >= 1; stride >>= 1) {
            if (stride == 64) {
                const bool sw = k_hi < k_lo;
                const int ta = sw ? k_hi : k_lo, tb = sw ? k_lo : k_hi; const float ga = sw ? g_hi : g_lo, gb = sw ? g_lo : g_hi;
                k_lo = ta; k_hi = tb; g_lo = ga; g_hi = gb;
            } else {
                int p_lo, p_hi; float q_lo, q_hi;
                if (stride == 1) { p_lo = (int)xchg_u32<1>((unsigned)k_lo, lane); p_hi = (int)xchg_u32<1>((unsigned)k_hi, lane); q_lo = xchg_f32<1>(g_lo, lane); q_hi = xchg_f32<1>(g_hi, lane); }
                else if (stride == 2) { p_lo = (int)xchg_u32<2>((unsigned)k_lo, lane); p_hi = (int)xchg_u32<2>((unsigned)k_hi, lane); q_lo = xchg_f32<2>(g_lo, lane); q_hi = xchg_f32<2>(g_hi, lane); }
                else if (stride == 4) { p_lo = (int)xchg_u32<4>((unsigned)k_lo, lane); p_hi = (int)xchg_u32<4>((unsigned)k_hi, lane); q_lo = xchg_f32<4>(g_lo, lane); q_hi = xchg_f32<4>(g_hi, lane); }
                else if (stride == 8) { p_lo = (int)xchg_u32<8>((unsigned)k_lo, lane); p_hi = (int)xchg_u32<8>((unsigned)k_hi, lane); q_lo = xchg_f32<8>(g_lo, lane); q_hi = xchg_f32<8>(g_hi, lane); }
                else if (stride == 16) { p_lo = (int)xchg_u32<16>((unsigned)k_lo, lane); p_hi = (int)xchg_u32<16>((unsigned)k_hi, lane); q_lo = xchg_f32<16>(g_lo, lane); q_hi = xchg_f32<16>(g_hi, lane); }
                else { p_lo = (int)xchg_u32<32>((unsigned)k_lo, lane); p_hi = (int)xchg_u32<32>((unsigned)k_hi, lane); q_lo = xchg_f32<32>(g_lo, lane); q_hi = xchg_f32<32>(g_hi, lane); }
                const bool lower = (lane & stride) == 0;
                const bool asc_lo = (size >= 64) ? true : ((lane & size) == 0);
                const bool asc_hi = (size == 128) ? true : ((size == 64) ? false : ((lane & size) == 0));
                const bool min_lo = (lower == asc_lo), min_hi = (lower == asc_hi);
                const bool take_lo = min_lo ? (p_lo < k_lo) : (p_lo > k_lo);
                const bool take_hi = min_hi ? (p_hi < k_hi) : (p_hi > k_hi);
                k_lo = take_lo ? p_lo : k_lo; g_lo = take_lo ? q_lo : g_lo;
                k_hi = take_hi ? p_hi : k_hi; g_hi = take_hi ? q_hi : g_hi;
            }
        }
    }
}
__device__ __forceinline__ void peer_finish_row(const Params& p, const float* ada, int tok, int d0, const float (&acc)[16], bool do_store) {
    const int b = tok >> 12;
    float* orow = p.out + (size_t)tok * 1024 + d0;
    float xo[16]; float ss = 0.f;
#pragma unroll
    for (int q = 0; q < 4; ++q) {
        const f32x4 xv = *(const f32x4*)(orow + 4 * q), gv = *(const f32x4*)(ada + b * 6144 + 5120 + d0 + 4 * q);
#pragma unroll
        for (int i = 0; i < 4; ++i) { const float v = xv[i] + gv[i] * acc[q * 4 + i]; xo[q * 4 + i] = v; ss += v * v; }
    }
    ss = wave_sum(ss);
    const float rstd = rsqrtf(ss * (1.f / 1024.f) + 1e-6f);
#pragma unroll
    for (int q = 0; q < 4; ++q) {
        const f32x4 fg = *(const f32x4*)(p.final_g + d0 + 4 * q);
        f32x4 ov;
#pragma unroll
        for (int i = 0; i < 4; ++i) ov[i] = xo[q * 4 + i] * rstd * fg[i];
        if (do_store) *(f32x4*)(orow + 4 * q) = ov;
    }
}
struct PeTok { unsigned hhi[2], hlo[2]; float ascale; int acc[16]; };
__device__ __forceinline__ void pe_tok_init(PeTok& t, LAS int* el, LAS float* gl, const bf16_t* H2, const int* EI, const float* GW, int tok, int d0, int lane) {
    const u32x4 h0 = *(const u32x4*)(H2 + (size_t)tok * 1024 + d0), h1 = *(const u32x4*)(H2 + (size_t)tok * 1024 + d0 + 8);
    float hx[16];
#pragma unroll
    for (int i = 0; i < 4; ++i) { hx[2 * i] = lo16(h0[i]); hx[2 * i + 1] = hi16(h0[i]); hx[8 + 2 * i] = lo16(h1[i]); hx[8 + 2 * i + 1] = hi16(h1[i]); }
    float am = 0.f;
#pragma unroll
    for (int i = 0; i < 16; ++i) am = fmaxf(am, fabsf(hx[i]));
    am = fmaxf(wave_max_dpp(am), 1e-20f);
    const float hs = 119.f / am;
#pragma unroll
    for (int w = 0; w < 2; ++w) {
        unsigned ph = 0u, pl = 0u;
#pragma unroll
        for (int e = 0; e < 8; ++e) {
            const int q = (int)rintf(hx[8 * w + e] * hs);
            const int lo = ((q + 8) & 15) - 8, hi = (q - lo) >> 4;
            pl |= (unsigned)(lo & 15) << (4 * e); ph |= (unsigned)(hi & 15) << (4 * e);
        }
        t.hhi[w] = ph; t.hlo[w] = pl;
    }
    t.ascale = am * (1.f / (119.f * PEER_SU));
#pragma unroll
    for (int i = 0; i < 16; ++i) t.acc[i] = 0;
    int k_lo = EI[(size_t)tok * 128 + lane], k_hi = EI[(size_t)tok * 128 + 64 + lane];
    float g_lo = GW[(size_t)tok * 128 + lane], g_hi = GW[(size_t)tok * 128 + 64 + lane];
    sort_pairs128(k_lo, k_hi, g_lo, g_hi, lane);
    el[lane] = k_lo; el[64 + lane] = k_hi; gl[lane] = g_lo; gl[64 + lane] = g_hi;
}
__device__ __forceinline__ void pe_tok_result(const PeTok& t, int csum, float (&acc)[16]) {
    const int coff = 8 * csum;
#pragma unroll
    for (int w = 0; w < 2; ++w) {
        int A[8];
        A[7] = t.acc[8 * w + 4 + 3];
#pragma unroll
        for (int e = 6; e >= 0; --e) A[e] = ((e & 1) ? t.acc[8 * w + 4 + (e >> 1)] : t.acc[8 * w + (e >> 1)]) - 16 * A[e + 1];
#pragma unroll
        for (int e = 0; e < 8; ++e) acc[8 * w + e] = (float)(A[e] - coff) * (1.f / (PEER_SC * PEER_SV));
    }
}
typedef short s16x2 __attribute__((ext_vector_type(2)));
__device__ __forceinline__ int dot2_i16(unsigned a, int b, int c) { return __builtin_amdgcn_sdot2(__builtin_bit_cast(s16x2, a), __builtin_bit_cast(s16x2, b), c, false); }
__device__ __forceinline__ void pe_vgroup(PeTok& t, const u32x2 (&vv)[8], int base, int c01, int c23) {
#pragma unroll
    for (int i = 0; i < 4; ++i) {
        const unsigned w0 = vv[base][i >> 1] >> (4 * (i & 1)), w1 = vv[base + 1][i >> 1] >> (4 * (i & 1));
        const unsigned w2_ = vv[base + 2][i >> 1] >> (4 * (i & 1)), w3 = vv[base + 3][i >> 1] >> (4 * (i & 1));
        t.acc[4 * i + 0] = dot2_i16(__builtin_amdgcn_perm(w3, w2_, 0x0c040c00u), c23, dot2_i16(__builtin_amdgcn_perm(w1, w0, 0x0c040c00u), c01, t.acc[4 * i + 0]));
        t.acc[4 * i + 1] = dot2_i16(__builtin_amdgcn_perm(w3, w2_, 0x0c050c01u), c23, dot2_i16(__builtin_amdgcn_perm(w1, w0, 0x0c050c01u), c01, t.acc[4 * i + 1]));
        t.acc[4 * i + 2] = dot2_i16(__builtin_amdgcn_perm(w3, w2_, 0x0c060c02u), c23, dot2_i16(__builtin_amdgcn_perm(w1, w0, 0x0c060c02u), c01, t.acc[4 * i + 2]));
        t.acc[4 * i + 3] = dot2_i16(__builtin_amdgcn_perm(w3, w2_, 0x0c070c03u), c23, dot2_i16(__builtin_amdgcn_perm(w1, w0, 0x0c070c03u), c01, t.acc[4 * i + 3]));
    }
}
#ifndef PE_SYNC_MASK
#define PE_SYNC_MASK 31
#endif
__device__ __forceinline__ int dot8_z(unsigned a, unsigned b) { int d; asm("v_dot8_i32_i4 %0, %1, %2, 0" : "=v"(d) : "v"(a), "v"(b)); return d; }
#define DPPI(v, ctrl) __builtin_amdgcn_update_dpp(0, (v), (ctrl), 0xF, 0xF, true)
__device__ __forceinline__ void peer_experts(const Params& p, bool do_store, LAS unsigned char* lds) {
    const int wid = threadIdx.x >> 6, lane = threadIdx.x & 63;
    const bf16_t* H2 = (const bf16_t*)(p.ws + OFF_ACT); const unsigned char* UT = p.ws + OFF_UT; const unsigned char* VT = p.ws + OFF_VT;
    const int* EI = (const int*)(p.ws + OFF_EIDX); const float* GW = (const float*)(p.ws + OFF_GW); const float* ada = (const float*)(p.ws + OFF_ADA);
    const int d0 = 16 * lane;
    const unsigned uofs = 16u * (unsigned)lane, vofs = 8u * (unsigned)lane;
    const int stride = gridDim.x * 8;
    LAS int* el = (LAS int*)lds + wid * 1024;
    LAS float* gl = (LAS float*)(el + 512);
    const LAS float* glane = gl + (lane >> 5) * 128 + 2 * ((lane >> 4) & 1) + (lane & 1);
    for (int tok0 = blockIdx.x * 8 + wid; tok0 < NTOK; tok0 += 4 * stride) {
        __syncthreads();
        int tk[4]; bool has[4];
#pragma unroll
        for (int i = 0; i < 4; ++i) { has[i] = (tok0 + i * stride) < NTOK; tk[i] = has[i] ? tok0 + i * stride : tok0; }
        PeTok T[4];
#pragma unroll
        for (int i = 0; i < 4; ++i) pe_tok_init(T[i], el + i * 128, gl + i * 128, H2, EI, GW, tk[i], d0, lane);
        const float ascX = lane < 32 ? T[0].ascale : T[1].ascale, ascY = lane < 32 ? T[2].ascale : T[3].ascale;
        int csX = 0, csY = 0;
        u32x2 uX[8], uY[8], vX[8], vY[8];
#define PE_ISSUE(UU, VV, EA, EB) do { _Pragma("unroll") for (int q = 0; q < 8; ++q) { \
            const unsigned off_ = ((q < 4 ? EA[q & 3] : EB[q & 3]) << 9) | vofs; \
            asm volatile("global_load_dwordx2 %0, %1, %2" : "=v"(UU[q]) : "v"(off_), "s"(UT)); \
            asm volatile("global_load_dwordx2 %0, %1, %2" : "=v"(VV[q]) : "v"(off_), "s"(VT)); } } while (0)
#define PE_WAIT(UU, VV, N) do { asm volatile("s_waitcnt vmcnt(" #N ")"); \
            _Pragma("unroll") for (int q = 0; q < 8; ++q) asm volatile("" : "+v"(UU[q]), "+v"(VV[q])); } while (0)
#define PE_COMPUTE(UU, VV, GM, CS, ASC, A, B) do { \
            int sv[8]; \
            _Pragma("unroll") for (int q = 0; q < 8; ++q) { \
                const int dh_ = __builtin_amdgcn_sdot8((int)UU[q][1], (int)(q < 4 ? A.hhi[1] : B.hhi[1]), dot8_z(UU[q][0], (q < 4 ? A.hhi[0] : B.hhi[0])), false); \
                const int dl_ = __builtin_amdgcn_sdot8((int)UU[q][1], (int)(q < 4 ? A.hlo[1] : B.hlo[1]), dot8_z(UU[q][0], (q < 4 ? A.hlo[0] : B.hlo[0])), false); \
                sv[q] = (dh_ << 4) + dl_; } \
            int t4[4]; \
            _Pragma("unroll") for (int i = 0; i < 4; ++i) { const u32x2 r_ = __builtin_amdgcn_permlane32_swap((unsigned)sv[i], (unsigned)sv[i + 4], false, false); t4[i] = (int)r_[0] + (int)r_[1]; } \
            int w2[2]; \
            _Pragma("unroll") for (int i = 0; i < 2; ++i) { const u32x2 r_ = __builtin_amdgcn_permlane16_swap((unsigned)t4[i], (unsigned)t4[i + 2], false, false); w2[i] = (int)r_[0] + (int)r_[1]; } \
            _Pragma("unroll") for (int i = 0; i < 2; ++i) { w2[i] += DPPI(w2[i], 0xB1); w2[i] += DPPI(w2[i], 0x4E); w2[i] += DPPI(w2[i], 0x141); w2[i] += DPPI(w2[i], 0x140); } \
            const float mine = (float)((lane & 1) ? w2[1] : w2[0]) * (ASC); \
            const float cmine = (GM) * gelu_as(mine); \
            const int cqm = (int)fminf(fmaxf(rintf(cmine * PEER_SC), -16383.f), 16383.f);        \
            CS += cqm; \
              \
            const int pk_ = (int)__builtin_amdgcn_perm((unsigned)DPPI(cqm, 0xB1), (unsigned)cqm, 0x05040100u); \
            pe_vgroup(A, VV, 0, __builtin_amdgcn_readlane(pk_, 0), __builtin_amdgcn_readlane(pk_, 16)); \
            pe_vgroup(B, VV, 4, __builtin_amdgcn_readlane(pk_, 32), __builtin_amdgcn_readlane(pk_, 48)); } while (0)
        const LAS u32x4* el4 = (const LAS u32x4*)el;
        u32x4 eA = el4[0], eB = el4[32], eC = el4[64], eD = el4[96];
        float gXn = glane[0], gYn = glane[256];
        PE_ISSUE(uX, vX, eA, eB);
#pragma unroll 1
        for (int k0 = 0; k0 < 128; k0 += 4) {
            if ((k0 & PE_SYNC_MASK) == 0 && k0) __syncthreads();
            const int kn = (k0 + 4 < 128) ? k0 + 4 : k0;
            PE_ISSUE(uY, vY, eC, eD);
            const float gX = gXn; gXn = glane[kn]; eA = el4[kn >> 2]; eB = el4[32 + (kn >> 2)];
            PE_WAIT(uX, vX, 16);
            PE_COMPUTE(uX, vX, gX, csX, ascX, T[0], T[1]);
            PE_ISSUE(uX, vX, eA, eB);
            const float gY = gYn; gYn = glane[256 + kn]; eC = el4[64 + (kn >> 2)]; eD = el4[96 + (kn >> 2)];
            PE_WAIT(uY, vY, 16);
            PE_COMPUTE(uY, vY, gY, csY, ascY, T[2], T[3]);
        }
        PE_WAIT(uX, vX, 0);
#undef PE_WAIT
#undef PE_ISSUE
#undef PE_COMPUTE
        const int cs[4] = { __builtin_amdgcn_readlane(csX, 0) + __builtin_amdgcn_readlane(csX, 1) + __builtin_amdgcn_readlane(csX, 16) + __builtin_amdgcn_readlane(csX, 17),
                            __builtin_amdgcn_readlane(csX, 32) + __builtin_amdgcn_readlane(csX, 33) + __builtin_amdgcn_readlane(csX, 48) + __builtin_amdgcn_readlane(csX, 49),
                            __builtin_amdgcn_readlane(csY, 0) + __builtin_amdgcn_readlane(csY, 1) + __builtin_amdgcn_readlane(csY, 16) + __builtin_amdgcn_readlane(csY, 17),
                            __builtin_amdgcn_readlane(csY, 32) + __builtin_amdgcn_readlane(csY, 33) + __builtin_amdgcn_readlane(csY, 48) + __builtin_amdgcn_readlane(csY, 49) };
        float acc[16];
#pragma unroll
        for (int i = 0; i < 4; ++i) { pe_tok_result(T[i], cs[i], acc); peer_finish_row(p, ada, tk[i], d0, acc, do_store && has[i]); }
    }
}

enum { PH_PREP = 0, PH_GEMM_IN, PH_MIX, PH_GEMM_OUT, PH_H2, PH_GEMM_Q, PH_ROUTE, PH_EXPERT, PH_COUNT };

typedef const __attribute__((address_space(4))) Params* KParams;
__device__ __forceinline__ const Params& kparams() {
    auto q = __builtin_amdgcn_kernarg_segment_ptr();
    asm volatile("" : "+s"(q));
    return *(const Params*)q;
}
#ifndef PHMASK
#define PHMASK 0xFFFF
#endif
#ifndef REP_PHASE
#define REP_PHASE -1
#endif
#define PHASE_BEGIN(idx) if (((PHMASK >> (idx)) & 1) && ph_lo <= (idx) && (idx) < ph_hi) { for (int rep = 0; rep < ((idx) == REP_PHASE ? 2 : 1); ++rep) { if ((idx) != ph_lo || rep) xcd_barrier(bar); const Params& p = kparams(); const int G = gridDim.x; (void)G; const bool last_rep = (rep == ((idx) == REP_PHASE ? 1 : 0)); (void)last_rep;
#define PHASE_END } }

__global__ void __launch_bounds__(NTHREADS, 2) hymba_fwd(Params p_) {
    extern __shared__ __attribute__((aligned(16))) unsigned char smem_raw[];
    LAS unsigned char* lds = (LAS unsigned char*)smem_raw;
    volatile LAS unsigned* xbw = (volatile LAS unsigned*)(lds + LDS_BYTES - 16);
    if (threadIdx.x == 0) { xbw[0] = 0u; xbw[1] = 0u; xbw[2] = 0u; xbw[3] = 0u; }
    __syncthreads();
    XcdBarrier bar = xcd_barrier_post((unsigned*)(p_.ws + OFF_CTL), xbw);
    const int ph_lo = p_.ph_lo, ph_hi = p_.ph_hi;

    PHASE_BEGIN(PH_PREP)
        phase0(p, lds);
        wg_wait((unsigned*)(p.ws + OFF_CTL), CNT_ADA, 192u);
        norm_mod_rows(p.x, p.norm1_g, (const float*)(p.ws + OFF_ADA), 0, 1024, (bf16_t*)(p.ws + OFF_ACT));
    PHASE_END
    PHASE_BEGIN(PH_GEMM_IN)
        {   pg8::StaticOrder S; S.init(NTOK, 3072, G, blockIdx.x);
            EpiInMain E; E.ws = p.ws; E.bias = (const float*)(p.ws + OFF_BIAS);
            pg8::gemm_phase(lds, pg8::Gemm{(const bf16_t*)(p.ws + OFF_ACT), (const bf16_t*)(p.ws + OFF_WIN), NTOK, 3072, 1024}, S, E); }
        {   pg8::StaticOrder S; S.init(NTOK, 256, G, blockIdx.x);
            EpiInTail E; E.ws = p.ws; E.bias = (const float*)(p.ws + OFF_BIAS) + 3072;
            pg8::gemm_phase(lds, pg8::Gemm{(const bf16_t*)(p.ws + OFF_ACT), (const bf16_t*)(p.ws + OFF_WIN) + (size_t)3072 * 1024, NTOK, 256, 1024}, S, E); }
        if (G > 64) { if ((int)blockIdx.x >= 64) convert_tables(p, (int)blockIdx.x - 64, G - 64); }
        else convert_tables(p, (int)blockIdx.x, G);
    PHASE_END
    PHASE_BEGIN(PH_MIX)
        unsigned* ctl = (unsigned*)(p.ws + OFF_CTL);
        for (int t = blockIdx.x; t < 1024; t += G) mlstm_passA(p, t, lds);
        wg_signal(ctl, CNT_MLA);
        __syncthreads();
        for (int t = blockIdx.x; t < 2048; t += G) {
            const int rnd = t >> 8, w = t & 255; const int bsel = rnd >> 1; const int qgs = (rnd & 1) ? w : (511 - w);
            dsa_task(p, (bsel << 9) | qgs, lds); }
        wg_wait(ctl, CNT_MLA, (unsigned)G);
        for (int t = blockIdx.x; t < 256; t += G) mlstm_scan(p, t, lds);
        wg_signal(ctl, CNT_SCAN);
        wg_wait(ctl, CNT_SCAN, (unsigned)G);
        for (int t = blockIdx.x; t < 1024; t += G) mlstm_passB(p, t, lds);
    PHASE_END
    PHASE_BEGIN(PH_GEMM_OUT)
        {   pg8::StaticOrder S; S.init(NTOK, 1024, G, blockIdx.x);
            EpiOut E; E.x = p.x; E.ada = (const float*)(p.ws + OFF_ADA); E.out = p.out;
            pg8::gemm_phase(lds, pg8::Gemm{(const bf16_t*)(p.ws + OFF_ACT), (const bf16_t*)(p.ws + OFF_WOUT), NTOK, 1024, 1024}, S, E); }
    PHASE_END
    PHASE_BEGIN(PH_H2) norm_mod_rows(p.out, p.norm2_g, (const float*)(p.ws + OFF_ADA), 3072, 4096, (bf16_t*)(p.ws + OFF_ACT)); PHASE_END
    PHASE_BEGIN(PH_GEMM_Q)
        {   pg8::StaticOrder S; S.init(NTOK, 1024, G, blockIdx.x);
            EpiQry E; E.O = (bf16_t*)(p.ws + OFF_QRY);
            pg8::gemm_phase(lds, pg8::Gemm{(const bf16_t*)(p.ws + OFF_ACT), (const bf16_t*)(p.ws + OFF_WPQ), NTOK, 1024, 1024}, S, E); }
    PHASE_END
    PHASE_BEGIN(PH_ROUTE) for (int t = blockIdx.x; t < 512; t += G) peer_route(p, t, lds); PHASE_END
    PHASE_BEGIN(PH_EXPERT) peer_experts(p, last_rep, lds); PHASE_END
}

extern "C" void kernel_launch(void* const* d_in, const int* in_sizes, int n_in, void* d_out, int out_size, void* d_ws, size_t ws_size, hipStream_t stream) {
    static int grid = 0;
    if (grid == 0) {
        int dev = 0, cus = 0, per_cu = 0;
        if (hipGetDevice(&dev) != hipSuccess || hipDeviceGetAttribute(&cus, hipDeviceAttributeMultiprocessorCount, dev) != hipSuccess) { fprintf(stderr, "kernel_launch: device query failed\n"); grid = -1; return; }
        if (hipFuncSetAttribute((const void*)hymba_fwd, hipFuncAttributeMaxDynamicSharedMemorySize, LDS_BYTES) != hipSuccess) { fprintf(stderr, "kernel_launch: hipFuncSetAttribute failed\n"); grid = -1; return; }
        if (hipOccupancyMaxActiveBlocksPerMultiprocessor(&per_cu, (const void*)hymba_fwd, NTHREADS, LDS_BYTES) != hipSuccess || per_cu < 1) { fprintf(stderr, "kernel_launch: occupancy query says %d blocks/CU\n", per_cu); }
        (void)hipGetLastError();
        grid = cus;
        if (ws_size < WS_END || n_in != 17) { fprintf(stderr, "kernel_launch: unexpected sizes (ws %zu, n_in %d)\n", ws_size, n_in); grid = -1; return; }
    }
    if (grid < 0) return;
    (void)hipMemsetAsync((char*)d_ws + OFF_CTL, 0, CTL_BYTES, stream);
    Params p{};
    p.x = (const float*)d_in[0]; p.c = (const float*)d_in[1]; p.w_ada = (const float*)d_in[2]; p.b_ada = (const float*)d_in[3]; p.norm1_g = (const float*)d_in[4];
    p.w_in = (const float*)d_in[5]; p.b_in = (const float*)d_in[6]; p.conv_qk = (const float*)d_in[7]; p.out_norm_m = (const float*)d_in[8]; p.out_norm_a = (const float*)d_in[9];
    p.w_out = (const float*)d_in[10]; p.norm2_g = (const float*)d_in[11]; p.w_peer_q = (const float*)d_in[12]; p.sub_keys = (const float*)d_in[13]; p.peer_u = (const float*)d_in[14];
    p.peer_v = (const float*)d_in[15]; p.final_g = (const float*)d_in[16];
    p.out = (float*)d_out; p.ws = (unsigned char*)d_ws; p.ph_lo = 0; p.ph_hi = PH_COUNT;
    void* args[] = {&p};
    hipError_t e = hipLaunchCooperativeKernel((const void*)hymba_fwd, dim3(grid), dim3(NTHREADS), args, LDS_BYTES, stream);
    if (e != hipSuccess) fprintf(stderr, "kernel_launch: cooperative launch failed: %s (grid %d)\n", hipGetErrorString(e), grid);
}
```

```cpp
#include <hip/hip_runtime.h>
#include <type_traits>
#include <stdint.h>
#define REP_PHASE -1
#define DSA_REP 0
#include <cstdio>

#define LAS __attribute__((address_space(3)))
typedef unsigned short bf16_t;
typedef short bf16x8 __attribute__((ext_vector_type(8)));
typedef float f32x4 __attribute__((ext_vector_type(4)));
typedef float f32x2 __attribute__((ext_vector_type(2)));
typedef float f32x16 __attribute__((ext_vector_type(16)));
typedef unsigned u32x4 __attribute__((ext_vector_type(4)));
typedef unsigned u32x2 __attribute__((ext_vector_type(2)));

constexpr int NTOK = 16384, DM = 1024, SEQ = 4096;
constexpr int NIN_PAD = 3328;
constexpr int LDS_BYTES = 163840 - 64;
constexpr int NTHREADS = 512;

constexpr size_t MiB = 1024 * 1024;
constexpr size_t OFF_CTL = 0;
constexpr size_t CTL_BYTES = 16384;
constexpr size_t OFF_ADA = 64 * 1024;
constexpr size_t OFF_BIAS = 192 * 1024;
constexpr size_t OFF_SK = 256 * 1024;
constexpr size_t OFF_WIN = 512 * 1024;
constexpr size_t OFF_WOUT = 7 * MiB;
constexpr size_t OFF_WPQ = 9 * MiB;
constexpr size_t OFF_ACT = 11 * MiB;
constexpr size_t OFF_MQ = 43 * MiB;
constexpr size_t OFF_MK = 59 * MiB;
constexpr size_t OFF_MV = 75 * MiB;
constexpr size_t OFF_MO = 91 * MiB;
constexpr size_t OFF_AQ = 107 * MiB;
constexpr size_t OFF_IQ = 123 * MiB;
constexpr size_t OFF_AK = 139 * MiB;
constexpr size_t OFF_AV = 141 * MiB;
constexpr size_t OFF_IK = 143 * MiB;
constexpr size_t OFF_GATE = 145 * MiB;
constexpr size_t OFF_KV = 146 * MiB;
constexpr size_t OFF_KS = 178 * MiB;
constexpr size_t OFF_MLOC = 178 * MiB + 512 * 1024;
constexpr size_t OFF_BLAST = OFF_MLOC + 4096;
constexpr size_t OFF_M0 = OFF_BLAST + 4096;
constexpr size_t OFF_UT = 179 * MiB;
constexpr size_t OFF_VT = 195 * MiB;
constexpr size_t WS_END = 211 * MiB;
constexpr float PEER_SU = 95.52f;
constexpr float PEER_SV = 8.443f;
constexpr float PEER_SC = 2048.f;
constexpr size_t OFF_QRY = OFF_MQ;
constexpr size_t OFF_EIDX = OFF_MV;
constexpr size_t OFF_GW = OFF_MV + 8 * MiB;

struct Params {
    const float* x; const float* c; const float* w_ada; const float* b_ada; const float* norm1_g;
    const float* w_in; const float* b_in; const float* conv_qk; const float* out_norm_m; const float* out_norm_a;
    const float* w_out; const float* norm2_g; const float* w_peer_q; const float* sub_keys; const float* peer_u;
    const float* peer_v; const float* final_g;
    float* out; unsigned char* ws;
    int ph_lo, ph_hi;
};

__device__ __forceinline__ int opaque_tid() { int t = threadIdx.x; asm volatile("" : "+v"(t)); return t; }
__device__ __forceinline__ float bf2f(unsigned short b) { return __uint_as_float(((unsigned)b) << 16); }
__device__ __forceinline__ unsigned pack2(float lo, float hi) { unsigned r; asm("v_cvt_pk_bf16_f32 %0, %1, %2" : "=v"(r) : "v"(lo), "v"(hi)); return r; }
__device__ __forceinline__ unsigned short f2bf(float f) { return (unsigned short)(pack2(f, 0.f) & 0xffffu); }
__device__ __forceinline__ unsigned short f2bf_sw(float f) { unsigned u = __float_as_uint(f); u += 0x7FFFu + ((u >> 16) & 1u); return (unsigned short)(u >> 16); }
__device__ __forceinline__ float lo16(unsigned w) { return __uint_as_float(w << 16); }
__device__ __forceinline__ float hi16(unsigned w) { return __uint_as_float(w & 0xffff0000u); }
__device__ __forceinline__ float wave_sum_dpp(float v);
__device__ __forceinline__ float wave_sum(float v) { return wave_sum_dpp(v); }
__device__ __forceinline__ int wave_sum_i32_uniform(int v) {
    v += __builtin_amdgcn_update_dpp(0, v, 0xB1, 0xF, 0xF, true);
    v += __builtin_amdgcn_update_dpp(0, v, 0x4E, 0xF, 0xF, true);
    v += __builtin_amdgcn_update_dpp(0, v, 0x141, 0xF, 0xF, true);
    v += __builtin_amdgcn_update_dpp(0, v, 0x140, 0xF, 0xF, true);
    return __builtin_amdgcn_readlane(v, 0) + __builtin_amdgcn_readlane(v, 16) + __builtin_amdgcn_readlane(v, 32) + __builtin_amdgcn_readlane(v, 48);
}
__device__ __forceinline__ int wave_iscan_i32(int v) {
    v += __builtin_amdgcn_update_dpp(0, v, 0x111, 0xF, 0xF, true);
    v += __builtin_amdgcn_update_dpp(0, v, 0x112, 0xF, 0xF, true);
    v += __builtin_amdgcn_update_dpp(0, v, 0x114, 0xF, 0xF, true);
    v += __builtin_amdgcn_update_dpp(0, v, 0x118, 0xF, 0xF, true);
    v += __builtin_amdgcn_update_dpp(0, v, 0x142, 0xA, 0xF, false);
    v += __builtin_amdgcn_update_dpp(0, v, 0x143, 0xC, 0xF, false);
    return v;
}
#define dppf_m(ident, v, ctrl, rmask) __uint_as_float((unsigned)__builtin_amdgcn_update_dpp((int)__float_as_uint(ident), (int)__float_as_uint(v), (ctrl), (rmask), 0xF, false))
__device__ __forceinline__ float wave_scan_add(float v, int lane) {
    v += dppf_m(0.f, v, 0x111, 0xF); v += dppf_m(0.f, v, 0x112, 0xF); v += dppf_m(0.f, v, 0x114, 0xF); v += dppf_m(0.f, v, 0x118, 0xF);
    v += dppf_m(0.f, v, 0x142, 0xA); v += dppf_m(0.f, v, 0x143, 0xC);
    return v;
}
__device__ __forceinline__ float wave_scan_max(float v, int lane) {
    const float ni = -INFINITY;
    v = fmaxf(v, dppf_m(ni, v, 0x111, 0xF)); v = fmaxf(v, dppf_m(ni, v, 0x112, 0xF)); v = fmaxf(v, dppf_m(ni, v, 0x114, 0xF)); v = fmaxf(v, dppf_m(ni, v, 0x118, 0xF));
    v = fmaxf(v, dppf_m(ni, v, 0x142, 0xA)); v = fmaxf(v, dppf_m(ni, v, 0x143, 0xC));
    return v;
}
__device__ __forceinline__ float wave_max(float v) {
#pragma unroll
    for (int o = 32; o >= 1; o >>= 1) v = fmaxf(v, __shfl_xor(v, o));
    return v;
}
#define dppf(v, ctrl) __uint_as_float((unsigned)__builtin_amdgcn_update_dpp(0, (int)__float_as_uint(v), (ctrl), 0xF, 0xF, true))
__device__ __forceinline__ float rlanef(float v, int l) { return __uint_as_float((unsigned)__builtin_amdgcn_readlane((int)__float_as_uint(v), l)); }
__device__ __forceinline__ float wave_sum_dpp(float v) {
    v += dppf(v, 0xB1); v += dppf(v, 0x4E); v += dppf(v, 0x141); v += dppf(v, 0x140);
    return (rlanef(v, 0) + rlanef(v, 16)) + (rlanef(v, 32) + rlanef(v, 48));
}
__device__ __forceinline__ float wave_max_dpp(float v) {
    v = fmaxf(v, dppf(v, 0xB1)); v = fmaxf(v, dppf(v, 0x4E)); v = fmaxf(v, dppf(v, 0x141)); v = fmaxf(v, dppf(v, 0x140));
    return fmaxf(fmaxf(rlanef(v, 0), rlanef(v, 16)), fmaxf(rlanef(v, 32), rlanef(v, 48)));
}
template <int STRIDE>
__device__ __forceinline__ unsigned xchg_u32(unsigned x, int lane) {
    if constexpr (STRIDE == 1) return (unsigned)__builtin_amdgcn_update_dpp(0, (int)x, 0xB1, 0xF, 0xF, true);
    else if constexpr (STRIDE == 2) return (unsigned)__builtin_amdgcn_update_dpp(0, (int)x, 0x4E, 0xF, 0xF, true);
    else if constexpr (STRIDE == 4) {
        const unsigned up = (unsigned)__builtin_amdgcn_update_dpp(0, (int)x, 0x104, 0xF, 0xF, true);
        const unsigned dn = (unsigned)__builtin_amdgcn_update_dpp(0, (int)x, 0x114, 0xF, 0xF, true);
        return (lane & 4) ? dn : up;
    }
    else if constexpr (STRIDE == 8) return (unsigned)__builtin_amdgcn_update_dpp(0, (int)x, 0x128, 0xF, 0xF, true);
    else if constexpr (STRIDE == 16) { const u32x2 r_ = __builtin_amdgcn_permlane16_swap(x, x, false, false); return (lane & 16) ? r_[0] : r_[1]; }
    else { const u32x2 r_ = __builtin_amdgcn_permlane32_swap(x, x, false, false); return (lane & 32) ? r_[0] : r_[1]; }
}
template <int STRIDE> __device__ __forceinline__ float xchg_f32(float x, int lane) { return __uint_as_float(xchg_u32<STRIDE>(__float_as_uint(x), lane)); }
template <int STRIDE> __device__ __forceinline__ float xsum_f32(float x) {
    const u32x2 r_ = STRIDE == 16 ? __builtin_amdgcn_permlane16_swap(__float_as_uint(x), __float_as_uint(x), false, false) : __builtin_amdgcn_permlane32_swap(__float_as_uint(x), __float_as_uint(x), false, false);
    return __uint_as_float(r_[0]) + __uint_as_float(r_[1]); }
template <int STRIDE> __device__ __forceinline__ float xmax_f32(float x) {
    const u32x2 r_ = STRIDE == 16 ? __builtin_amdgcn_permlane16_swap(__float_as_uint(x), __float_as_uint(x), false, false) : __builtin_amdgcn_permlane32_swap(__float_as_uint(x), __float_as_uint(x), false, false);
    float m; asm("v_max_f32 %0, %1, %2" : "=v"(m) : "v"(r_[0]), "v"(r_[1])); return m; }
__device__ __forceinline__ float row16_sum(float v) { v += dppf(v, 0xB1); v += dppf(v, 0x4E); v += dppf(v, 0x141); v += dppf(v, 0x140); return v; }
__device__ __forceinline__ float oct_sum(float v) { v += dppf(v, 0xB1); v += dppf(v, 0x4E); v += dppf(v, 0x141); return v; }
__device__ __forceinline__ float siluf(float x) { return x * __builtin_amdgcn_rcpf(1.f + __expf(-x)); }
__device__ __forceinline__ float sigmoidf_(float x) { return __builtin_amdgcn_rcpf(1.f + __expf(-x)); }
__device__ __forceinline__ float logsigmoidf_(float x) { return fminf(x, 0.f) - log1pf(__expf(-fabsf(x))); }

#define XB_TMO      128
#define XB_XCNT(j)  (256  + 64 * (j))
#define XB_XSUB(j)  (1280 + 64 * (j))
#define XB_XGEN(j)  (2304 + 64 * (j))
#define XB_TOP      3328
#define XB_TOPGEN   3392
#define XCD_BAR_WORDS 3456
#define XB_SPIN_CAP (1u << 22)
__device__ __forceinline__ unsigned xb_ld(unsigned* p)              { return __hip_atomic_load(p, __ATOMIC_RELAXED, __HIP_MEMORY_SCOPE_AGENT); }
__device__ __forceinline__ unsigned xb_add(unsigned* p, unsigned v) { return __hip_atomic_fetch_add(p, v, __ATOMIC_RELAXED, __HIP_MEMORY_SCOPE_AGENT); }
__device__ __forceinline__ unsigned xb_xcc_id() { return (unsigned)__builtin_amdgcn_s_getreg((3 << 11) | 20) & 0xFu; }
#define XB_SPIN(cond, bar) do { unsigned _sp = 0; while (cond) { __builtin_amdgcn_s_sleep(1); \
    if ((++_sp & 255u) == 0u) { if (xb_ld(&(bar)[XB_TMO])) break; if (_sp > XB_SPIN_CAP) { atomicAdd(&(bar)[XB_TMO], 1u); break; } } } } while (0)
struct XcdBarrier { unsigned* bar; unsigned x; volatile LAS unsigned* st; };
__device__ __forceinline__ XcdBarrier xcd_barrier_post(unsigned* bar, volatile LAS unsigned* st) {
    XcdBarrier b; b.bar = bar; b.x = xb_xcc_id(); b.st = st;
    if (threadIdx.x == 0) (void)xb_add(&bar[XB_XCNT(b.x)], 1u);
    return b;
}
__device__ __forceinline__ void xcd_barrier_complete(unsigned* bar, unsigned x, unsigned& nloc, unsigned& nx) {
    const unsigned G = gridDim.x * gridDim.y * gridDim.z;
    unsigned sum, cnt, mine, sp = 0u;
    for (;;) {
        sum = 0u; cnt = 0u; mine = 0u;
#pragma unroll
        for (unsigned j = 0; j < 16; ++j) { const unsigned c = xb_ld(&bar[XB_XCNT(j)]); sum += c; cnt += (c > 0u) ? 1u : 0u; mine = (j == x) ? c : mine; }
        if (sum == G) break;
        __builtin_amdgcn_s_sleep(1);
        if ((++sp & 255u) == 0u) { if (xb_ld(&bar[XB_TMO])) break; if (sp > XB_SPIN_CAP) { atomicAdd(&bar[XB_TMO], 1u); break; } }
    }
    nloc = mine > 0u ? mine : 1u; nx = cnt > 0u ? cnt : 1u;
}
__device__ __forceinline__ void xcd_barrier(const XcdBarrier& b) {
    asm volatile("s_waitcnt vmcnt(0)" ::: "memory");
    __syncthreads();
    if (threadIdx.x == 0) {
        unsigned* bar = b.bar;
        __builtin_amdgcn_s_waitcnt(0);
        unsigned nloc = b.st[0], nx = b.st[1];
        if (nloc == 0u) { xcd_barrier_complete(bar, b.x, nloc, nx); b.st[0] = nloc; b.st[1] = nx; }
        const unsigned old = xb_add(&bar[XB_XSUB(b.x)], 1u);
        const unsigned gen = old / nloc;
        if (old + 1u == (gen + 1u) * nloc) {
            __builtin_amdgcn_fence(__ATOMIC_RELEASE, "agent");
            asm volatile("s_waitcnt vmcnt(0)" ::: "memory");
            const unsigned og = xb_add(&bar[XB_TOP], 1u);
            const unsigned tg = og / nx;
            if (og + 1u == (tg + 1u) * nx) xb_add(&bar[XB_TOPGEN], 1u);
            else XB_SPIN(xb_ld(&bar[XB_TOPGEN]) == tg, bar);
            __builtin_amdgcn_fence(__ATOMIC_ACQUIRE, "agent");
            xb_add(&bar[XB_XGEN(b.x)], 1u);
            asm volatile("s_waitcnt vmcnt(0)" ::: "memory");
        } else {
            XB_SPIN(xb_ld(&bar[XB_XGEN(b.x)]) == gen, bar);
            __builtin_amdgcn_fence(__ATOMIC_ACQUIRE, "agent");
            asm volatile("s_waitcnt vmcnt(0)" ::: "memory");
        }
    }
    __syncthreads();
}

#define CNT_ADA  3600
#define CNT_MLA  3664
#define CNT_SCAN 3728
__device__ __forceinline__ void wg_signal(unsigned* ctl, int word) {
    asm volatile("s_waitcnt vmcnt(0)" ::: "memory");
    __syncthreads();
    if (threadIdx.x == 0) {
        __builtin_amdgcn_fence(__ATOMIC_RELEASE, "agent");
        asm volatile("s_waitcnt vmcnt(0)" ::: "memory");
        (void)xb_add(&ctl[word], 1u);
    }
}
__device__ __forceinline__ void wg_wait(unsigned* ctl, int word, unsigned need) {
    if (threadIdx.x == 0) {
        XB_SPIN(xb_ld(&ctl[word]) < need, ctl);
        __builtin_amdgcn_fence(__ATOMIC_ACQUIRE, "agent");
        asm volatile("s_waitcnt vmcnt(0)" ::: "memory");
    }
    __syncthreads();
}

namespace pg8 {
constexpr int BM = 256, BK = 64, HALF = 128, HTB = HALF * BK * 2, STAGE_BYTES = 8 * HTB, NXCD = 8, WGM = 8;
__host__ __device__ __forceinline__ int lds_byte(int r, int c) { const int st = (r >> 4) * 2 + (c >> 5), rr = r & 15, cc = c & 31, ob = rr * 64 + cc * 2; return st * 1024 + (ob ^ (((ob >> 9) & 1) << 5)); }
__host__ __device__ __forceinline__ void stage_rc(int b, int& R, int& C) { const int st = b / 1024, sb = b % 1024, swz = sb ^ (((sb >> 9) & 1) << 5); R = (st >> 1) * 16 + swz / 64; C = (st & 1) * 32 + (swz % 64) / 2; }
__host__ __device__ __forceinline__ int perm32(int rho) { const int n = rho >> 4, i = rho & 15; return 8 * (i >> 2) + 4 * n + (i & 3); }
struct Unit { int pm, pn; };
struct Gemm { const bf16_t* A; const bf16_t* Bt; int M, N, K; };
struct StaticOrder {
    int nM, nN, nwg, G, c;
    __host__ __device__ void init(int M, int N, int G_, int c_) { nM = M / BM; nN = N / BM; nwg = nM * nN; G = G_; c = c_; }
    __host__ __device__ bool next(int i, Unit& u) const {
        const long L = (long)i * G + c; if (L >= nwg) return false;
        int wgid = (int)L; { const int q = nwg / NXCD, r = nwg % NXCD, xcd = wgid % NXCD, off = wgid / NXCD; wgid = (xcd < r ? xcd * (q + 1) : r * (q + 1) + (xcd - r) * q) + off; }
        const int nig = WGM * nN, gid = wgid / nig, fm = gid * WGM, gsz = (nM - fm) < WGM ? (nM - fm) : WGM;
        u.pm = fm + ((wgid % nig) % gsz); u.pn = (wgid % nig) / gsz; return true;
    }
    __device__ __forceinline__ void a_ready(const Unit&) const {}
    __device__ __forceinline__ void done(const Unit&) const {}
};
__device__ __forceinline__ unsigned cvt_pk_bf16(float lo, float hi) { unsigned r; asm volatile("v_cvt_pk_bf16_f32 %0, %1, %2" : "=v"(r) : "v"(lo), "v"(hi)); return r; }

template <class Epi, class Sched>
__device__ __forceinline__ void gemm_phase(LAS unsigned char* lds, const Gemm g, const Sched& S, const Epi& E) {
    const int tid = threadIdx.x, wid = __builtin_amdgcn_readfirstlane(tid >> 6), lane = tid & 63, wr = wid >> 2, wc = wid & 3, fr = lane & 15, fq = lane >> 4;
    const int K = g.K, nt = K / BK;
    unsigned voffA[2], voffB[2];
#pragma unroll
    for (int i = 0; i < 2; ++i) { int R, C; stage_rc(tid * 16 + i * 8192, R, C); const int Rb = Epi::PERM ? ((R & ~31) + perm32(R & 31)) : R;
        voffA[i] = (unsigned)(R * K + C) * 2u; voffB[i] = (unsigned)(Rb * K + C) * 2u; }
    const size_t kstep = (size_t)(BK * 2);
    const size_t hstep = (size_t)HALF * K * 2;
    const size_t tstep = 2 * hstep;
    const unsigned ldsw = (unsigned)wid * 1024u;
    const int aoff = lds_byte(wr * 64 + fr, fq * 8), boff = lds_byte(wc * 32 + fr, fq * 8);
#define PG8_SA(b, h) (((b) * 2 + (h)) * HTB)
#define PG8_SB(b, h) ((4 + (b) * 2 + (h)) * HTB)
#define PG8_STAGE(bufoff, gbase, voff) do { _Pragma("unroll") for (int _i = 0; _i < 2; ++_i) \
        __builtin_amdgcn_global_load_lds((const unsigned*)((const char*)(gbase) + (voff)[_i]), (LAS unsigned*)(lds + (bufoff) + ldsw + _i * 8192), 16, 0, 0); } while (0)
#define PG8_LDA(dst, b, h) do { _Pragma("unroll") for (int m = 0; m < 4; ++m) _Pragma("unroll") for (int k = 0; k < 2; ++k) dst[m][k] = *(const LAS bf16x8*)(lds + PG8_SA(b, h) + aoff + m * 2048 + k * 1024); } while (0)
#define PG8_LDB(dst, b, h) do { _Pragma("unroll") for (int n = 0; n < 2; ++n) _Pragma("unroll") for (int k = 0; k < 2; ++k) dst[n][k] = *(const LAS bf16x8*)(lds + PG8_SB(b, h) + boff + n * 2048 + k * 1024); } while (0)
#define PG8_MMA(ai, bj, At, Bt) do { __builtin_amdgcn_s_setprio(1); _Pragma("unroll") for (int m = 0; m < 4; ++m) _Pragma("unroll") for (int n = 0; n < 2; ++n) _Pragma("unroll") for (int k = 0; k < 2; ++k) \
        acc[ai][bj][m][n] = __builtin_amdgcn_mfma_f32_16x16x32_bf16(Bt[n][k], At[m][k], acc[ai][bj][m][n], 0, 0, 0); __builtin_amdgcn_s_setprio(0); } while (0)
#define PG8_WAIT_V(n) asm volatile("s_waitcnt vmcnt(" #n ")" ::: "memory")
#define PG8_WAIT_L(n) asm volatile("s_waitcnt lgkmcnt(" #n ")" ::: "memory")
#define PG8_BAR __builtin_amdgcn_s_barrier()
#define PG8_SCHED __builtin_amdgcn_sched_barrier(0)
    Unit cur, nxt; int ui = 0;
    if (!S.next(0, cur)) return;
    f32x4 acc[2][2][4][2];
#pragma unroll
    for (int a = 0; a < 2; ++a)
#pragma unroll
        for (int b = 0; b < 2; ++b)
#pragma unroll
            for (int m = 0; m < 4; ++m)
#pragma unroll
                for (int n = 0; n < 2; ++n) acc[a][b][m][n] = (f32x4){0.f, 0.f, 0.f, 0.f};
    bf16x8 At[4][2], B0[2][2], B1[2][2];
    const char* cA = (const char*)g.A + (size_t)cur.pm * tstep; const char* cB = (const char*)g.Bt + (size_t)cur.pn * tstep;
    S.a_ready(cur);
    PG8_STAGE(PG8_SB(0, 0), cB, voffB); PG8_STAGE(PG8_SA(0, 0), cA, voffA); PG8_STAGE(PG8_SB(0, 1), cB + hstep, voffB); PG8_STAGE(PG8_SA(0, 1), cA + hstep, voffA);
    if (wr == 1) PG8_BAR;
    PG8_WAIT_V(4); PG8_BAR;
    PG8_STAGE(PG8_SB(1, 0), cB + kstep, voffB); PG8_STAGE(PG8_SA(1, 0), cA + kstep, voffA); PG8_STAGE(PG8_SB(1, 1), cB + hstep + kstep, voffB);
    PG8_WAIT_V(6); PG8_BAR;
    for (;;) {
        const bool has_next = S.next(ui + 1, nxt);
        const char* nA = has_next ? (const char*)g.A + (size_t)nxt.pm * tstep : cA; const char* nB = has_next ? (const char*)g.Bt + (size_t)nxt.pn * tstep : cB;
        for (int t = 0; t < nt; t += 2) {
            const bool last = (t == nt - 2);
            const char* a1 = cA + (size_t)(t + 1) * kstep;
            const char* a2 = last ? nA : cA + (size_t)(t + 2) * kstep; const char* b2 = last ? nB : cB + (size_t)(t + 2) * kstep;
            const char* a3 = a2 + kstep; const char* b3 = b2 + kstep;
            if (last && has_next) S.a_ready(nxt);
            PG8_LDB(B0, 0, 0); PG8_SCHED; PG8_LDA(At, 0, 0); PG8_STAGE(PG8_SA(1, 1), a1 + hstep, voffA);
            PG8_WAIT_L(8); PG8_BAR; PG8_WAIT_L(0); PG8_MMA(0, 0, At, B0); PG8_BAR; PG8_SCHED;
            PG8_LDB(B1, 0, 1); PG8_STAGE(PG8_SB(0, 0), b2, voffB);
            PG8_BAR; PG8_WAIT_L(0); PG8_MMA(0, 1, At, B1); PG8_BAR;
            PG8_LDA(At, 0, 1); PG8_STAGE(PG8_SA(0, 0), a2, voffA);
            PG8_BAR; PG8_WAIT_L(0); PG8_MMA(1, 0, At, B0); PG8_BAR; PG8_SCHED;
            PG8_STAGE(PG8_SB(0, 1), b2 + hstep, voffB);
            PG8_WAIT_V(6); PG8_BAR; PG8_MMA(1, 1, At, B1); PG8_BAR;
            PG8_LDB(B0, 1, 0); PG8_SCHED; PG8_LDA(At, 1, 0); PG8_STAGE(PG8_SA(0, 1), a2 + hstep, voffA);
            PG8_WAIT_L(8); PG8_BAR; PG8_WAIT_L(0); PG8_MMA(0, 0, At, B0); PG8_BAR; PG8_SCHED;
            PG8_LDB(B1, 1, 1); PG8_STAGE(PG8_SB(1, 0), b3, voffB);
            PG8_BAR; PG8_WAIT_L(0); PG8_MMA(0, 1, At, B1); PG8_BAR;
            PG8_LDA(At, 1, 1); PG8_STAGE(PG8_SA(1, 0), a3, voffA);
            PG8_BAR; PG8_WAIT_L(0); PG8_MMA(1, 0, At, B0); PG8_BAR; PG8_SCHED;
            PG8_STAGE(PG8_SB(1, 1), b3 + hstep, voffB);
            PG8_WAIT_V(6); PG8_BAR; PG8_MMA(1, 1, At, B1); PG8_BAR;
        }
        asm volatile("s_nop 15\n\ts_nop 15" ::: "memory");
        E(acc, cur, wr, wc, fr, fq); S.done(cur);
        if (!has_next) break;
#pragma unroll
        for (int a = 0; a < 2; ++a)
#pragma unroll
            for (int b = 0; b < 2; ++b)
#pragma unroll
                for (int m = 0; m < 4; ++m)
#pragma unroll
                    for (int n = 0; n < 2; ++n) acc[a][b][m][n] = (f32x4){0.f, 0.f, 0.f, 0.f};
        cur = nxt; cA = nA; cB = nB; ++ui;
    }
    PG8_WAIT_V(0);
    if (wr == 0) PG8_BAR;
    PG8_BAR;
#undef PG8_SA
#undef PG8_SB
#undef PG8_STAGE
#undef PG8_LDA
#undef PG8_LDB
#undef PG8_MMA
#undef PG8_WAIT_V
#undef PG8_WAIT_L
#undef PG8_BAR
#undef PG8_SCHED
}
}

struct EpiInMain {
    static constexpr bool PERM = true;
    unsigned char* ws; const float* bias;
    __device__ __forceinline__ void operator()(const f32x4 (&acc)[2][2][4][2], const pg8::Unit& u, int wr, int wc, int fr, int fq) const {
        const int row0 = u.pm * 256 + wr * 64 + fr;
        const int cl0 = wc * 32 + 8 * fq;
        bf16_t* base = (bf16_t*)(ws + OFF_MQ + (size_t)(u.pn >> 1) * (16 * MiB)) + (u.pn & 1) * 256 + cl0;
        const float* bp = bias + u.pn * 256 + cl0;
        f32x4 bb[2][2];
#pragma unroll
        for (int bj = 0; bj < 2; ++bj) { bb[bj][0] = *(const f32x4*)(bp + bj * 128); bb[bj][1] = *(const f32x4*)(bp + bj * 128 + 4); }
#pragma unroll
        for (int bj = 0; bj < 2; ++bj) {
            const f32x4 b0 = bb[bj][0], b1 = bb[bj][1];
#pragma unroll
            for (int ai = 0; ai < 2; ++ai)
#pragma unroll
                for (int m = 0; m < 4; ++m) {
                    const f32x4 v0 = acc[ai][bj][m][0] + b0, v1 = acc[ai][bj][m][1] + b1;
                    u32x4 o; o[0] = pg8::cvt_pk_bf16(v0[0], v0[1]); o[1] = pg8::cvt_pk_bf16(v0[2], v0[3]); o[2] = pg8::cvt_pk_bf16(v1[0], v1[1]); o[3] = pg8::cvt_pk_bf16(v1[2], v1[3]);
                    *(u32x4*)(base + (size_t)(row0 + ai * 128 + m * 16) * 512 + bj * 128) = o;
                }
        }
    }
};
struct EpiInTail {
    static constexpr bool PERM = true;
    unsigned char* ws; const float* bias;
    __device__ __forceinline__ void operator()(const f32x4 (&acc)[2][2][4][2], const pg8::Unit& u, int wr, int wc, int fr, int fq) const {
        const int row0 = u.pm * 256 + wr * 64 + fr;
        const int cl0 = wc * 32 + 8 * fq;
#pragma unroll
        for (int bj = 0; bj < 2; ++bj) {
            const int cl = bj * 128 + cl0;
            if (cl >= 208) continue;
            const f32x4 b0 = *(const f32x4*)(bias + cl), b1 = *(const f32x4*)(bias + cl + 4);
            if (cl < 192) {
                bf16_t* dst = (bf16_t*)(ws + OFF_AK + (size_t)(cl >> 6) * (2 * MiB)) + (cl & 63);
#pragma unroll
                for (int ai = 0; ai < 2; ++ai)
#pragma unroll
                    for (int m = 0; m < 4; ++m) {
                        const f32x4 v0 = acc[ai][bj][m][0] + b0, v1 = acc[ai][bj][m][1] + b1;
                        u32x4 o; o[0] = pg8::cvt_pk_bf16(v0[0], v0[1]); o[1] = pg8::cvt_pk_bf16(v0[2], v0[3]); o[2] = pg8::cvt_pk_bf16(v1[0], v1[1]); o[3] = pg8::cvt_pk_bf16(v1[2], v1[3]);
                        const int row = row0 + ai * 128 + m * 16;
                        if (cl < 128) *(u32x4*)(dst + (size_t)row * 64) = o;
                        else *(u32x4*)((bf16_t*)(ws + OFF_IK) + (size_t)(row >> 5) * 2048 + (((cl - 128) >> 3) * 32 + (row & 31)) * 8) = o;
                    }
            } else {
                float* dst = (float*)(ws + OFF_GATE) + (cl - 192);
#pragma unroll
                for (int ai = 0; ai < 2; ++ai)
#pragma unroll
                    for (int m = 0; m < 4; ++m) {
                        float* d = dst + (size_t)(row0 + ai * 128 + m * 16) * 16;
                        *(f32x4*)d = acc[ai][bj][m][0] + b0; *(f32x4*)(d + 4) = acc[ai][bj][m][1] + b1;
                    }
            }
        }
    }
};
struct EpiOut {
    static constexpr bool PERM = false;
    const float* x; const float* ada; float* out;
    __device__ __forceinline__ void operator()(const f32x4 (&acc)[2][2][4][2], const pg8::Unit& u, int wr, int wc, int fr, int fq) const {
        const int row0 = u.pm * 256 + wr * 64 + fr, col0 = u.pn * 256 + wc * 32 + 4 * fq;
        const int b = (u.pm * 256) >> 12;
        f32x4 gv[2][2];
#pragma unroll
        for (int bj = 0; bj < 2; ++bj)
#pragma unroll
            for (int n = 0; n < 2; ++n) gv[bj][n] = *(const f32x4*)(ada + b * 6144 + 2048 + col0 + bj * 128 + n * 16);
#pragma unroll
        for (int ai = 0; ai < 2; ++ai) {
            f32x4 xv[4][2][2];
#pragma unroll
            for (int m = 0; m < 4; ++m)
#pragma unroll
                for (int bj = 0; bj < 2; ++bj)
#pragma unroll
                    for (int n = 0; n < 2; ++n) xv[m][bj][n] = *(const f32x4*)(x + (size_t)(row0 + ai * 128 + m * 16) * 1024 + col0 + bj * 128 + n * 16);
#pragma unroll
            for (int m = 0; m < 4; ++m) {
                const size_t ro = (size_t)(row0 + ai * 128 + m * 16) * 1024 + col0;
#pragma unroll
                for (int bj = 0; bj < 2; ++bj)
#pragma unroll
                    for (int n = 0; n < 2; ++n) *(f32x4*)(out + ro + bj * 128 + n * 16) = xv[m][bj][n] + gv[bj][n] * acc[ai][bj][m][n];
            }
        }
    }
};
struct EpiQry {
    static constexpr bool PERM = true;
    bf16_t* O;
    __device__ __forceinline__ void operator()(const f32x4 (&acc)[2][2][4][2], const pg8::Unit& u, int wr, int wc, int fr, int fq) const {
        const int row0 = u.pm * 256 + wr * 64 + fr, col0 = u.pn * 256 + wc * 32 + 8 * fq;
#pragma unroll
        for (int ai = 0; ai < 2; ++ai)
#pragma unroll
            for (int m = 0; m < 4; ++m) {
                bf16_t* rowp = O + (size_t)(row0 + ai * 128 + m * 16) * 1024 + col0;
#pragma unroll
                for (int bj = 0; bj < 2; ++bj) {
                    const f32x4 v0 = acc[ai][bj][m][0], v1 = acc[ai][bj][m][1];
                    u32x4 o; o[0] = pg8::cvt_pk_bf16(v0[0], v0[1]); o[1] = pg8::cvt_pk_bf16(v0[2], v0[3]); o[2] = pg8::cvt_pk_bf16(v1[0], v1[1]); o[3] = pg8::cvt_pk_bf16(v1[2], v1[3]);
                    *(u32x4*)(rowp + bj * 128) = o;
                }
            }
    }
};

__device__ __forceinline__ int inperm_src(int n) {
    if (n < 2048) return n;
    if (n < 2560) return 2056 + (n - 2048);
    if (n < 3072) return 2696 + (n - 2560);
    if (n < 3136) return 2568 + (n - 3072);
    if (n < 3200) return 2632 + (n - 3136);
    if (n < 3264) return 3208 + (n - 3200);
    if (n < 3268) return 2048 + (n - 3264);
    if (n < 3272) return 2052 + (n - 3268);
    if (n < 3280) return 3272 + (n - 3272);
    return -1;
}
template <bool PERMUTE>
__device__ __forceinline__ void transpose_strip(const float* src, int ld, bf16_t* dst, int n0, int k0, LAS float* t) {
    const int tid = threadIdx.x;
    const int nn = tid & 63, kq = tid >> 6;
    const int sc = PERMUTE ? inperm_src(n0 + nn) : (n0 + nn);
    float v[32];
    const int scc = sc >= 0 ? sc : 0;
#pragma unroll
    for (int j = 0; j < 32; ++j) v[j] = src[(size_t)(k0 + kq + 8 * j) * ld + scc];
#pragma unroll
    for (int j = 0; j < 32; ++j) v[j] = sc >= 0 ? v[j] : 0.f;
#pragma unroll
    for (int j = 0; j < 32; ++j) t[(kq + 8 * j) * 65 + nn] = v[j];
    __syncthreads();
    for (int i = tid; i < 8192; i += NTHREADS) {
        const int n2 = i >> 7, kp = (i & 127) * 2;
        ((unsigned*)dst)[((size_t)(n0 + n2) * 1024 + k0 + kp) >> 1] = pack2(t[kp * 65 + n2], t[(kp + 1) * 65 + n2]);
    }
    __syncthreads();
}
__device__ __forceinline__ void convert_chunk(const float* src, bf16_t* dst, size_t e0, int n) {
    for (int i = threadIdx.x * 8; i < n; i += NTHREADS * 8) {
        const f32x4 a = *(const f32x4*)(src + e0 + i), b = *(const f32x4*)(src + e0 + i + 4);
        u32x4 o; o[0] = pack2(a[0], a[1]); o[1] = pack2(a[2], a[3]); o[2] = pack2(b[0], b[1]); o[3] = pack2(b[2], b[3]);
        *(u32x4*)(dst + e0 + i) = o;
    }
}
__device__ __forceinline__ unsigned pack4_fp8(float a, float b, float c, float d) {
    a = fminf(fmaxf(a, -448.f), 448.f); b = fminf(fmaxf(b, -448.f), 448.f); c = fminf(fmaxf(c, -448.f), 448.f); d = fminf(fmaxf(d, -448.f), 448.f);
    int w = 0;
    w = __builtin_amdgcn_cvt_pk_fp8_f32(a, b, w, false);
    w = __builtin_amdgcn_cvt_pk_fp8_f32(c, d, w, true);
    return (unsigned)w;
}
__device__ __forceinline__ void convert_chunk_fp8(const float* src, unsigned char* dst, size_t e0, int n, float scale) {
    for (int i = threadIdx.x * 16; i < n; i += NTHREADS * 16) {
        const f32x4 a = *(const f32x4*)(src + e0 + i), b = *(const f32x4*)(src + e0 + i + 4), c = *(const f32x4*)(src + e0 + i + 8), d = *(const f32x4*)(src + e0 + i + 12);
        u32x4 o; o[0] = pack4_fp8(a[0] * scale, a[1] * scale, a[2] * scale, a[3] * scale); o[1] = pack4_fp8(b[0] * scale, b[1] * scale, b[2] * scale, b[3] * scale);
        o[2] = pack4_fp8(c[0] * scale, c[1] * scale, c[2] * scale, c[3] * scale); o[3] = pack4_fp8(d[0] * scale, d[1] * scale, d[2] * scale, d[3] * scale);
        *(u32x4*)(dst + e0 + i) = o;
    }
}
__device__ __forceinline__ unsigned pack8_fp4(const f32x4 a, const f32x4 b, float scale) {
    float v[8] = {a[0] * scale, a[1] * scale, a[2] * scale, a[3] * scale, b[0] * scale, b[1] * scale, b[2] * scale, b[3] * scale};
#pragma unroll
    for (int i = 0; i < 8; ++i) v[i] = fminf(fmaxf(v[i], -6.f), 6.f);
    unsigned w = 0;
    w = __builtin_amdgcn_cvt_scalef32_pk_fp4_f32(w, v[0], v[1], 1.0f, 0);
    w = __builtin_amdgcn_cvt_scalef32_pk_fp4_f32(w, v[2], v[3], 1.0f, 1);
    w = __builtin_amdgcn_cvt_scalef32_pk_fp4_f32(w, v[4], v[5], 1.0f, 2);
    w = __builtin_amdgcn_cvt_scalef32_pk_fp4_f32(w, v[6], v[7], 1.0f, 3);
    return w;
}
__device__ __forceinline__ void convert_chunk_fp4(const float* src, unsigned char* dst, size_t e0, int n, float scale) {
    for (int i = threadIdx.x * 32; i < n; i += NTHREADS * 32) {
        u32x4 o;
#pragma unroll
        for (int k = 0; k < 4; ++k) o[k] = pack8_fp4(*(const f32x4*)(src + e0 + i + 8 * k), *(const f32x4*)(src + e0 + i + 8 * k + 4), scale);
        *(u32x4*)(dst + ((e0 + i) >> 1)) = o;
    }
}
__device__ __forceinline__ unsigned pack4_i8(float a, float b, float c, float d, float scale) {
    const int ia = (int)fminf(fmaxf(rintf(a * scale), -127.f), 127.f), ib = (int)fminf(fmaxf(rintf(b * scale), -127.f), 127.f);
    const int ic = (int)fminf(fmaxf(rintf(c * scale), -127.f), 127.f), id = (int)fminf(fmaxf(rintf(d * scale), -127.f), 127.f);
    return (unsigned)(ia & 0xFF) | ((unsigned)(ib & 0xFF) << 8) | ((unsigned)(ic & 0xFF) << 16) | ((unsigned)(id & 0xFF) << 24);
}
__device__ __forceinline__ void convert_chunk_i8(const float* src, unsigned char* dst, size_t e0, int n, float scale) {
    for (int i = threadIdx.x * 16; i < n; i += NTHREADS * 16) {
        const f32x4 a = *(const f32x4*)(src + e0 + i), b = *(const f32x4*)(src + e0 + i + 4), c = *(const f32x4*)(src + e0 + i + 8), d = *(const f32x4*)(src + e0 + i + 12);
        u32x4 o; o[0] = pack4_i8(a[0], a[1], a[2], a[3], scale); o[1] = pack4_i8(b[0], b[1], b[2], b[3], scale); o[2] = pack4_i8(c[0], c[1], c[2], c[3], scale); o[3] = pack4_i8(d[0], d[1], d[2], d[3], scale);
        *(u32x4*)(dst + e0 + i) = o;
    }
}
template <int OFS>
__device__ __forceinline__ unsigned pack8_i4(const f32x4 a, const f32x4 b, float scale) {
    unsigned w = 0;
#pragma unroll
    for (int k = 0; k < 4; ++k) {
        const int ofs = (k == 3) ? 0 : OFS;
        const int qa = ((int)fminf(fmaxf(rintf(a[k] * scale), -7.f), 7.f) + ofs) & 15, qb = ((int)fminf(fmaxf(rintf(b[k] * scale), -7.f), 7.f) + ofs) & 15;
        w |= (unsigned)qa << (4 * k); w |= (unsigned)qb << (4 * (k + 4));
    }
    return w;
}
template <int OFS>
__device__ __forceinline__ void convert_chunk_i4(const float* src, unsigned char* dst, size_t e0, int n, float scale) {
    for (int i = threadIdx.x * 32; i < n; i += NTHREADS * 32) {
        u32x4 o;
#pragma unroll
        for (int k = 0; k < 4; ++k) o[k] = pack8_i4<OFS>(*(const f32x4*)(src + e0 + i + 8 * k), *(const f32x4*)(src + e0 + i + 8 * k + 4), scale);
        *(u32x4*)(dst + ((e0 + i) >> 1)) = o;
    }
}
__device__ __forceinline__ void convert_tables(const Params& p, int first, int stride) {
    for (int it = first; it < 1024; it += stride) {
        const int tsel = it >> 9; const size_t e0 = (size_t)(it & 511) * 32768;
        if (tsel) convert_chunk_i4<8>(p.peer_v, p.ws + OFF_VT, e0, 32768, PEER_SV); else convert_chunk_i4<0>(p.peer_u, p.ws + OFF_UT, e0, 32768, PEER_SU);
    }
}
__device__ __forceinline__ void phase0(const Params& p, LAS unsigned char* lds) {
    const int tid = threadIdx.x;
    float* ada = (float*)(p.ws + OFF_ADA);
    LAS float* lf = (LAS float*)lds;
    constexpr int N_ADA = 192, N_WIN = 52 * 4, N_WOUT = 64, N_WPQ = 64, N_SK = 4, N_BIAS = 1;
    constexpr int NITEMS = N_ADA + N_WIN + N_WOUT + N_WPQ + N_SK + N_BIAS;
    if (blockIdx.x < N_ADA) {
        {
            const int it = blockIdx.x;
            LAS float* sc = lf; LAS float* red = lf + 4096;
            for (int i = tid; i < 4096; i += NTHREADS) sc[i] = siluf(p.c[i]);
            __syncthreads();
            const int c4 = tid & 7, kg = tid >> 3, c0 = it * 32;
            f32x4 a0 = {0.f, 0.f, 0.f, 0.f}, a1 = a0, a2 = a0, a3 = a0;
            const float* w = p.w_ada + c0 + 4 * c4;
            f32x4 wv[16];
#pragma unroll
            for (int j = 0; j < 16; ++j) wv[j] = *(const f32x4*)(w + (size_t)(kg + 64 * j) * 6144);
#pragma unroll
            for (int j = 0; j < 16; ++j) { const int k = kg + 64 * j;
                a0 += sc[k] * wv[j]; a1 += sc[1024 + k] * wv[j]; a2 += sc[2048 + k] * wv[j]; a3 += sc[3072 + k] * wv[j]; }
            *(LAS f32x4*)(red + (kg * 4 + 0) * 32 + 4 * c4) = a0; *(LAS f32x4*)(red + (kg * 4 + 1) * 32 + 4 * c4) = a1;
            *(LAS f32x4*)(red + (kg * 4 + 2) * 32 + 4 * c4) = a2; *(LAS f32x4*)(red + (kg * 4 + 3) * 32 + 4 * c4) = a3;
            __syncthreads();
            if (tid < 128) { const int b = tid >> 5, cc = tid & 31; float s = 0.f;
                for (int g = 0; g < 64; ++g) s += red[(g * 4 + b) * 32 + cc];
                ada[b * 6144 + c0 + cc] = s + p.b_ada[c0 + cc]; }
        }
        wg_signal((unsigned*)(p.ws + OFF_CTL), CNT_ADA);
        __syncthreads();
    }
    for (int item = N_ADA + ((blockIdx.x + gridDim.x - N_ADA) % gridDim.x); item < NITEMS; item += gridDim.x) {
        int it = item;
        it -= N_ADA;
        if (it < N_WIN) { transpose_strip<true>(p.w_in, 3280, (bf16_t*)(p.ws + OFF_WIN), (it >> 2) * 64, (it & 3) * 256, lf); continue; }
        it -= N_WIN;
        if (it < N_WOUT) { transpose_strip<false>(p.w_out, 1024, (bf16_t*)(p.ws + OFF_WOUT), (it >> 2) * 64, (it & 3) * 256, lf); continue; }
        it -= N_WOUT;
        if (it < N_WPQ) { transpose_strip<false>(p.w_peer_q, 1024, (bf16_t*)(p.ws + OFF_WPQ), (it >> 2) * 64, (it & 3) * 256, lf); continue; }
        it -= N_WPQ;

        if (it < N_SK) { convert_chunk(p.sub_keys, (bf16_t*)(p.ws + OFF_SK), (size_t)it * 32768, 32768); continue; }
        it -= N_SK;
        { float* bias = (float*)(p.ws + OFF_BIAS);
          for (int n = tid; n < NIN_PAD; n += NTHREADS) { const int s = inperm_src(n); bias[n] = s >= 0 ? p.b_in[s] : 0.f; } }
    }
}

__device__ __forceinline__ void norm_mod_rows(const float* X, const float* g, const float* ada, int sh_off, int sc_off, bf16_t* out) {
    const int wid = threadIdx.x >> 6, lane = threadIdx.x & 63;
    for (int row = (blockIdx.x * 8 + wid) * 2; row < NTOK; row += gridDim.x * 16) {
        const int b = row >> 12;
        f32x4 v[2][4]; float ss[2] = {0.f, 0.f};
#pragma unroll
        for (int rr = 0; rr < 2; ++rr)
#pragma unroll
            for (int j = 0; j < 4; ++j) v[rr][j] = *(const f32x4*)(X + (size_t)(row + rr) * 1024 + 4 * (lane + 64 * j));
#pragma unroll
        for (int rr = 0; rr < 2; ++rr)
#pragma unroll
            for (int j = 0; j < 4; ++j) ss[rr] += v[rr][j][0] * v[rr][j][0] + v[rr][j][1] * v[rr][j][1] + v[rr][j][2] * v[rr][j][2] + v[rr][j][3] * v[rr][j][3];
        ss[0] = wave_sum(ss[0]); ss[1] = wave_sum(ss[1]);
        const float rstd0 = rsqrtf(ss[0] * (1.f / 1024.f) + 1e-6f), rstd1 = rsqrtf(ss[1] * (1.f / 1024.f) + 1e-6f);
#pragma unroll
        for (int j = 0; j < 4; ++j) {
            const int c = 4 * (lane + 64 * j);
            const f32x4 gg = *(const f32x4*)(g + c), sc = *(const f32x4*)(ada + b * 6144 + sc_off + c), sh = *(const f32x4*)(ada + b * 6144 + sh_off + c);
#pragma unroll
            for (int rr = 0; rr < 2; ++rr) {
                const float rstd = rr ? rstd1 : rstd0;
                float h[4];
#pragma unroll
                for (int i = 0; i < 4; ++i) h[i] = (v[rr][j][i] * rstd * gg[i]) * (1.f + sc[i]) + sh[i];
                u32x2 o; o[0] = pack2(h[0], h[1]); o[1] = pack2(h[2], h[3]);
                *(u32x2*)(out + (size_t)(row + rr) * 1024 + c) = o;
            }
        }
    }
}

__device__ __forceinline__ bf16x8 lds_frag(const LAS bf16_t* base, int row, int stride, int kofs) { return *(const LAS bf16x8*)(base + row * stride + kofs); }

__device__ __forceinline__ void conv_silu8(const bf16_t* src, const float* cw  , int row, int tpos, int col, float scale, float (&o)[8]) {
    float acc[8];
#pragma unroll
    for (int i = 0; i < 8; ++i) acc[i] = 0.f;
#pragma unroll
    for (int j = 0; j < 4; ++j) {
        const bool ok = (tpos - 3 + j) >= 0;
        u32x4 xv = *(const u32x4*)(src + (size_t)(ok ? row - 3 + j : row) * 512 + col);
        xv[0] = ok ? xv[0] : 0u; xv[1] = ok ? xv[1] : 0u; xv[2] = ok ? xv[2] : 0u; xv[3] = ok ? xv[3] : 0u;
        const f32x4 w0 = *(const f32x4*)(cw + j * 1024), w1 = *(const f32x4*)(cw + j * 1024 + 4);
        acc[0] += w0[0] * lo16(xv[0]); acc[1] += w0[1] * hi16(xv[0]); acc[2] += w0[2] * lo16(xv[1]); acc[3] += w0[3] * hi16(xv[1]);
        acc[4] += w1[0] * lo16(xv[2]); acc[5] += w1[1] * hi16(xv[2]); acc[6] += w1[2] * lo16(xv[3]); acc[7] += w1[3] * hi16(xv[3]);
    }
#pragma unroll
    for (int i = 0; i < 8; ++i) o[i] = siluf(acc[i]) * scale;
}

__device__ __forceinline__ void mlstm_passA(const Params& p, int task, LAS unsigned char* lds) {
    const int tid = opaque_tid(), wid = tid >> 6, lane = tid & 63;
    const int bh = task >> 6, c = task & 63, b = bh >> 2, h = bh & 3;
    const int row0 = b * SEQ + c * 64;
    const float* gates = (const float*)(p.ws + OFF_GATE);
    const bf16_t* MK = (const bf16_t*)(p.ws + OFF_MK); const bf16_t* MV = (const bf16_t*)(p.ws + OFF_MV);
    LAS bf16_t* KT = (LAS bf16_t*)lds;
    LAS bf16_t* VT = KT + 128 * 72;
    LAS float* sc = (LAS float*)(VT + 128 * 72);
    LAS float* lsg = sc; LAS float* ig = sc + 64; LAS float* wloc = sc + 128; LAS float* misc = sc + 192;
    if (tid < 64) {
        const float f = gates[(size_t)(row0 + tid) * 16 + 4 + h], iv = gates[(size_t)(row0 + tid) * 16 + h];
        const float bc = wave_scan_add(logsigmoidf_(f), lane);
        const float bl = rlanef(bc, 63);
        const float a = bl - bc + iv;
        const float m = wave_max_dpp(a);
        lsg[tid] = bc; ig[tid] = iv; wloc[tid] = __expf(a - m);
        if (tid == 0) { misc[0] = m; misc[1] = bl; }
    }
    __syncthreads();
    for (int pc = tid; pc < 1024; pc += NTHREADS) {
        const int s = pc >> 4, dg = pc & 15;
        float kk[8];
        conv_silu8(MK, p.conv_qk + 512 + h * 128 + dg * 8, row0 + s, c * 64 + s, h * 128 + dg * 8, 1.f, kk);
#pragma unroll
        for (int i = 0; i < 8; ++i) KT[(dg * 8 + i) * 72 + s] = f2bf(kk[i]);
        const u32x4 vv = *(const u32x4*)(MV + (size_t)(row0 + s) * 512 + h * 128 + dg * 8);
        const float w = wloc[s];
#pragma unroll
        for (int i = 0; i < 4; ++i) { VT[(dg * 8 + 2 * i) * 72 + s] = f2bf(lo16(vv[i]) * w); VT[(dg * 8 + 2 * i + 1) * 72 + s] = f2bf(hi16(vv[i]) * w); }
    }
    __syncthreads();
    {
        const int r = lane & 15, g = lane >> 4;
        bf16x8 a0 = lds_frag(VT, wid * 16 + r, 72, 8 * g), a1 = lds_frag(VT, wid * 16 + r, 72, 8 * g + 32);
        bf16_t* KV = (bf16_t*)(p.ws + OFF_KV) + (size_t)task * 16384;
#pragma unroll
        for (int dt = 0; dt < 8; ++dt) {
            f32x4 acc = {0.f, 0.f, 0.f, 0.f};
            acc = __builtin_amdgcn_mfma_f32_16x16x32_bf16(lds_frag(KT, dt * 16 + r, 72, 8 * g), a0, acc, 0, 0, 0);
            acc = __builtin_amdgcn_mfma_f32_16x16x32_bf16(lds_frag(KT, dt * 16 + r, 72, 8 * g + 32), a1, acc, 0, 0, 0);
#pragma unroll
            for (int j = 0; j < 4; ++j) acc[j] = __builtin_canonicalizef(acc[j]);
            { u32x2 o; o[0] = pack2(acc[0], acc[1]); o[1] = pack2(acc[2], acc[3]); *(u32x2*)(KV + (wid * 16 + r) * 128 + dt * 16 + 4 * g) = o; }
        }
    }
    if (tid < 128) {
        float s = 0.f;
        for (int i = 0; i < 64; ++i) s += wloc[i] * bf2f(KT[tid * 72 + i]);
        ((float*)(p.ws + OFF_KS))[(size_t)task * 128 + tid] = s;
    }
    if (tid == 0) { ((float*)(p.ws + OFF_MLOC))[task] = misc[0]; ((float*)(p.ws + OFF_BLAST))[task] = misc[1]; }
    __syncthreads();
}

__device__ __forceinline__ void conv_silu8_pre(const u32x4 (&xr)[4], const float* cw, int tpos, float scale, float (&o)[8]) {
    float acc[8];
#pragma unroll
    for (int i = 0; i < 8; ++i) acc[i] = 0.f;
#pragma unroll
    for (int j = 0; j < 4; ++j) {
        const bool ok = (tpos - 3 + j) >= 0;
        u32x4 xv = xr[j];
        xv[0] = ok ? xv[0] : 0u; xv[1] = ok ? xv[1] : 0u; xv[2] = ok ? xv[2] : 0u; xv[3] = ok ? xv[3] : 0u;
        const f32x4 w0 = *(const f32x4*)(cw + j * 1024), w1 = *(const f32x4*)(cw + j * 1024 + 4);
        acc[0] += w0[0] * lo16(xv[0]); acc[1] += w0[1] * hi16(xv[0]); acc[2] += w0[2] * lo16(xv[1]); acc[3] += w0[3] * hi16(xv[1]);
        acc[4] += w1[0] * lo16(xv[2]); acc[5] += w1[1] * hi16(xv[2]); acc[6] += w1[2] * lo16(xv[3]); acc[7] += w1[3] * hi16(xv[3]);
    }
#pragma unroll
    for (int i = 0; i < 8; ++i) o[i] = siluf(acc[i]) * scale;
}
struct PaPre { u32x4 xk[4][4], vv[4]; float f, iv; };
__device__ __forceinline__ void pa_prefetch(const Params& p, int task0, int task1, PaPre& S) {
    const int tid = opaque_tid();
    const float* gates = (const float*)(p.ws + OFF_GATE);
    const bf16_t* MK = (const bf16_t*)(p.ws + OFF_MK); const bf16_t* MV = (const bf16_t*)(p.ws + OFF_MV);
#pragma unroll
    for (int it = 0; it < 4; ++it) {
        const int pc = tid + it * NTHREADS;
        const int ti = pc >> 10, task = ti ? task1 : task0, s = (pc >> 4) & 63, dg = pc & 15;
        const int bh = task >> 6, c = task & 63, b = bh >> 2, h = bh & 3, row0 = b * SEQ + c * 64;
        const int row = row0 + s, tpos = c * 64 + s, col = h * 128 + dg * 8;
#pragma unroll
        for (int j = 0; j < 4; ++j) {
            const bool ok = (tpos - 3 + j) >= 0;
            S.xk[it][j] = *(const u32x4*)(MK + (size_t)(ok ? row - 3 + j : row) * 512 + col);
        }
        S.vv[it] = *(const u32x4*)(MV + (size_t)row * 512 + col);
    }
    {
        const int ti = (tid >> 6) & 1, task = ti ? task1 : task0, ln = tid & 63;
        const int bh = task >> 6, c = task & 63, b = bh >> 2, h = bh & 3, row0 = b * SEQ + c * 64;
        S.f = gates[(size_t)(row0 + ln) * 16 + 4 + h]; S.iv = gates[(size_t)(row0 + ln) * 16 + h];
    }
}
__device__ __forceinline__ void mlstm_passA2(const Params& p, int task0, int task1, LAS unsigned char* lds, PaPre& S, int next0, int next1) {
    const int tid = opaque_tid(), wid = tid >> 6, lane = tid & 63;
    const float* gates = (const float*)(p.ws + OFF_GATE);
    const bf16_t* MK = (const bf16_t*)(p.ws + OFF_MK); const bf16_t* MV = (const bf16_t*)(p.ws + OFF_MV);
    if (tid < 128) {
        const int ti = tid >> 6, task = ti ? task1 : task0;
        const int bh = task >> 6, c = task & 63, b = bh >> 2, h = bh & 3, row0 = b * SEQ + c * 64;
        LAS float* sc = (LAS float*)(lds + ti * 40960 + 2 * 128 * 72 * 2);
        const float f = S.f, iv = S.iv;
        const float bc = wave_scan_add(logsigmoidf_(f), lane);
        const float bl = rlanef(bc, 63);
        const float a = bl - bc + iv;
        const float m = wave_max_dpp(a);
        sc[lane] = bc; sc[64 + lane] = iv; sc[128 + lane] = __expf(a - m);
        if (lane == 0) { sc[192] = m; sc[193] = bl; }
    }
    __syncthreads();
#pragma unroll
    for (int it = 0; it < 4; ++it) {
        const int pc = tid + it * NTHREADS;
        const int ti = pc >> 10, task = ti ? task1 : task0, s = (pc >> 4) & 63, dg = pc & 15;
        const int bh = task >> 6, c = task & 63, b = bh >> 2, h = bh & 3, row0 = b * SEQ + c * 64;
        LAS bf16_t* KT = (LAS bf16_t*)(lds + ti * 40960); LAS bf16_t* VT = KT + 128 * 72;
        const LAS float* wloc = (const LAS float*)(lds + ti * 40960 + 2 * 128 * 72 * 2) + 128;
        float kk[8];
        conv_silu8_pre(S.xk[it], p.conv_qk + 512 + h * 128 + dg * 8, c * 64 + s, 1.f, kk);
#pragma unroll
        for (int i = 0; i < 8; ++i) KT[(dg * 8 + i) * 72 + s] = f2bf(kk[i]);
        const u32x4 vv = S.vv[it];
        const float w = wloc[s];
#pragma unroll
        for (int i = 0; i < 4; ++i) { VT[(dg * 8 + 2 * i) * 72 + s] = f2bf(lo16(vv[i]) * w); VT[(dg * 8 + 2 * i + 1) * 72 + s] = f2bf(hi16(vv[i]) * w); }
    }
    __syncthreads();
#pragma unroll
    for (int ti = 0; ti < 2; ++ti) {
        const int task = ti ? task1 : task0;
        const LAS bf16_t* KT = (const LAS bf16_t*)(lds + ti * 40960); const LAS bf16_t* VT = KT + 128 * 72;
        const int r = lane & 15, g = lane >> 4;
        bf16x8 a0 = lds_frag(VT, wid * 16 + r, 72, 8 * g), a1 = lds_frag(VT, wid * 16 + r, 72, 8 * g + 32);
        bf16_t* KV = (bf16_t*)(p.ws + OFF_KV) + (size_t)task * 16384;
#pragma unroll
        for (int dt = 0; dt < 8; ++dt) {
            f32x4 acc = {0.f, 0.f, 0.f, 0.f};
            acc = __builtin_amdgcn_mfma_f32_16x16x32_bf16(lds_frag(KT, dt * 16 + r, 72, 8 * g), a0, acc, 0, 0, 0);
            acc = __builtin_amdgcn_mfma_f32_16x16x32_bf16(lds_frag(KT, dt * 16 + r, 72, 8 * g + 32), a1, acc, 0, 0, 0);
#pragma unroll
            for (int j = 0; j < 4; ++j) acc[j] = __builtin_canonicalizef(acc[j]);
            { u32x2 o; o[0] = pack2(acc[0], acc[1]); o[1] = pack2(acc[2], acc[3]); *(u32x2*)(KV + (wid * 16 + r) * 128 + dt * 16 + 4 * g) = o; }
        }
    }
    if (tid < 256) {
        const int ti = tid >> 7, d = tid & 127, task = ti ? task1 : task0;
        const LAS bf16_t* KT = (const LAS bf16_t*)(lds + ti * 40960);
        const LAS float* sc = (const LAS float*)(lds + ti * 40960 + 2 * 128 * 72 * 2);
        float sum = 0.f;
#pragma unroll
        for (int i8 = 0; i8 < 8; ++i8) {
            const u32x4 kq = *(const LAS u32x4*)(KT + d * 72 + 8 * i8);
            const f32x4 w0 = *(const LAS f32x4*)(sc + 128 + 8 * i8), w1 = *(const LAS f32x4*)(sc + 132 + 8 * i8);
            sum += w0[0] * lo16(kq[0]); sum += w0[1] * hi16(kq[0]); sum += w0[2] * lo16(kq[1]); sum += w0[3] * hi16(kq[1]);
            sum += w1[0] * lo16(kq[2]); sum += w1[1] * hi16(kq[2]); sum += w1[2] * lo16(kq[3]); sum += w1[3] * hi16(kq[3]);
        }
        ((float*)(p.ws + OFF_KS))[(size_t)task * 128 + d] = sum;
        if (d == 0) { ((float*)(p.ws + OFF_MLOC))[task] = sc[192]; ((float*)(p.ws + OFF_BLAST))[task] = sc[193]; }
    }
    if (next0 >= 0) pa_prefetch(p, next0, next1, S);
    asm volatile("s_waitcnt lgkmcnt(0)" ::: "memory");
    __builtin_amdgcn_s_barrier();
}

__device__ __forceinline__ void mlstm_scan(const Params& p, int item, LAS unsigned char* lds) {
    const int tid = opaque_tid();
    const int bh = item >> 4, blk = item & 15;
    LAS float* dec = (LAS float*)lds; LAS float* inj = dec + 64;
    if (tid < 64) {
        const float* ML = (const float*)(p.ws + OFF_MLOC); const float* BL = (const float*)(p.ws + OFF_BLAST); float* M0 = (float*)(p.ws + OFF_M0);
        const float ml = ML[bh * 64 + tid], bl = BL[bh * 64 + tid];
        float A = bl, B = ml;
#define MP_STEP(ctrl, rmask) do { const float Ae = dppf_m(0.f, A, ctrl, rmask), Be = dppf_m(-INFINITY, B, ctrl, rmask); B = fmaxf(Be + A, B); A = Ae + A; } while (0)
        MP_STEP(0x111, 0xF); MP_STEP(0x112, 0xF); MP_STEP(0x114, 0xF); MP_STEP(0x118, 0xF); MP_STEP(0x142, 0xA); MP_STEP(0x143, 0xC);
        const float mn = fmaxf(A, B);
        const float m = dppf_m(0.f, mn, 0x138, 0xF);
        if (blk == 0) M0[bh * 64 + tid] = m;
        dec[tid] = __expf(bl + m - mn); inj[tid] = __expf(ml - mn);
    }
    unsigned* KV = (unsigned*)(p.ws + OFF_KV) + (size_t)bh * 64 * 8192 + blk * 512 + tid;
    unsigned w[64];
#pragma unroll
    for (int c = 0; c < 64; ++c) w[c] = KV[(size_t)c * 8192];
    const bool ks_own = (blk == 0 && tid < 128);
    float* KS = (float*)(p.ws + OFF_KS) + (size_t)bh * 64 * 128 + (ks_own ? tid : 0);
    __syncthreads();
    float s0 = 0.f, s1 = 0.f;
#pragma unroll
    for (int c = 0; c < 64; ++c) {
        KV[(size_t)c * 8192] = pack2(s0, s1);
        s0 = dec[c] * s0 + inj[c] * lo16(w[c]); s1 = dec[c] * s1 + inj[c] * hi16(w[c]);
    }
    if (ks_own) {
        float k[64];
#pragma unroll
        for (int c = 0; c < 64; ++c) k[c] = KS[c * 128];
        float sk = 0.f;
#pragma unroll
        for (int c = 0; c < 64; ++c) { KS[c * 128] = sk; sk = dec[c] * sk + inj[c] * k[c]; }
    }
    __syncthreads();
}

struct PbPre { u32x4 xq[2][4], xk[2][4], vv[2], kv[4]; float f, iv, m0, n0; };
__device__ __forceinline__ void pb_prefetch(const Params& p, int task, PbPre& S) {
    const int tid = opaque_tid();
    const int bh = task >> 6, c = task & 63, b = bh >> 2, h = bh & 3;
    const int row0 = b * SEQ + c * 64;
    const float* gates = (const float*)(p.ws + OFF_GATE);
    const bf16_t* MQ = (const bf16_t*)(p.ws + OFF_MQ); const bf16_t* MK = (const bf16_t*)(p.ws + OFF_MK); const bf16_t* MV = (const bf16_t*)(p.ws + OFF_MV);
#pragma unroll
    for (int it = 0; it < 2; ++it) {
        const int pc = tid + it * NTHREADS; const int s = pc >> 4, dg = pc & 15;
        const int row = row0 + s, tpos = c * 64 + s, col = h * 128 + dg * 8;
#pragma unroll
        for (int j = 0; j < 4; ++j) {
            const bool ok = (tpos - 3 + j) >= 0;
            const size_t ro = (size_t)(ok ? row - 3 + j : row) * 512 + col;
            S.xq[it][j] = *(const u32x4*)(MQ + ro); S.xk[it][j] = *(const u32x4*)(MK + ro);
        }
        S.vv[it] = *(const u32x4*)(MV + (size_t)row * 512 + col);
    }
    const bf16_t* KV = (const bf16_t*)(p.ws + OFF_KV) + (size_t)task * 16384;
#pragma unroll
    for (int it = 0; it < 4; ++it) { const int pc = tid + it * NTHREADS; const int e = pc >> 4, dg = pc & 15; S.kv[it] = *(const u32x4*)(KV + e * 128 + dg * 8); }
    const int tr = tid & 63, tn = (tid - 64) & 127;
    S.f = gates[(size_t)(row0 + tr) * 16 + 4 + h]; S.iv = gates[(size_t)(row0 + tr) * 16 + h];
    S.m0 = ((const float*)(p.ws + OFF_M0))[task]; S.n0 = ((const float*)(p.ws + OFF_KS))[(size_t)task * 128 + tn];
}
__device__ __forceinline__ void mlstm_passB(const Params& p, int task, LAS unsigned char* lds, PbPre& S, int next_task) {
    const int tid = opaque_tid(), wid = tid >> 6, lane = tid & 63;
    const int bh = task >> 6, c = task & 63, b = bh >> 2, h = bh & 3;
    const int row0 = b * SEQ + c * 64;
    const float* gates = (const float*)(p.ws + OFF_GATE);
    const bf16_t* MQ = (const bf16_t*)(p.ws + OFF_MQ); const bf16_t* MK = (const bf16_t*)(p.ws + OFF_MK);
    const bf16_t* MV = (const bf16_t*)(p.ws + OFF_MV); const bf16_t* MO = (const bf16_t*)(p.ws + OFF_MO);
    LAS bf16_t* Q = (LAS bf16_t*)lds;
    LAS bf16_t* K = Q + 64 * 136;
    LAS bf16_t* VT = K + 64 * 136;
    LAS bf16_t* C0 = VT + 128 * 72;
    LAS bf16_t* P = C0 + 128 * 136;
    LAS float* sc = (LAS float*)(P + 64 * 72);
    LAS float* bcum = sc; LAS float* ig = sc + 64; LAS float* cs = sc + 128; LAS float* rb = sc + 192; LAS float* wint = sc + 256;
    LAS float* emt = sc + 320; LAS float* rinv = sc + 384; LAS float* qn = sc + 448; LAS float* n0 = sc + 512; LAS float* rowpart = sc + 640;
    LAS float* H = (LAS float*)lds;
    if (tid < 64) {
        const float f = S.f, iv = S.iv;
        const float m0 = S.m0;
        const float sc_ = wave_scan_add(logsigmoidf_(f), lane);
        const float cst = iv - sc_;
        const float pm = wave_scan_max(cst, lane);
        const float m_intra = sc_ + pm, m_inter = sc_ + m0, mt = fmaxf(m_inter, m_intra);
        bcum[tid] = sc_; ig[tid] = iv; cs[tid] = cst; rb[tid] = sc_ - mt; wint[tid] = __expf(m_inter - mt); emt[tid] = __expf(-mt);
    }
    if (tid >= 64 && tid < 192) n0[tid - 64] = S.n0;
#pragma unroll
    for (int it = 0; it < 2; ++it) {
        const int pc = tid + it * NTHREADS;
        const int s = pc >> 4, dg = pc & 15;
        float qq[8], kk[8];
        conv_silu8_pre(S.xq[it], p.conv_qk + h * 128 + dg * 8, c * 64 + s, 0.08838834764831845f, qq);
        conv_silu8_pre(S.xk[it], p.conv_qk + 512 + h * 128 + dg * 8, c * 64 + s, 1.f, kk);
        u32x4 qo, ko;
#pragma unroll
        for (int i = 0; i < 4; ++i) { qo[i] = pack2(qq[2 * i], qq[2 * i + 1]); ko[i] = pack2(kk[2 * i], kk[2 * i + 1]); }
        *(LAS u32x4*)(Q + s * 136 + dg * 8) = qo; *(LAS u32x4*)(K + s * 136 + dg * 8) = ko;
        const u32x4 vv = S.vv[it];
#pragma unroll
        for (int i = 0; i < 4; ++i) { VT[(dg * 8 + 2 * i) * 72 + s] = (bf16_t)(vv[i] & 0xffffu); VT[(dg * 8 + 2 * i + 1) * 72 + s] = (bf16_t)(vv[i] >> 16); }
    }
#pragma unroll
    for (int it = 0; it < 4; ++it) { const int pc = tid + it * NTHREADS; const int e = pc >> 4, dg = pc & 15; *(LAS u32x4*)(C0 + e * 136 + dg * 8) = S.kv[it]; }
    __syncthreads();
    const int r = lane & 15, g = lane >> 4;
    {
        const int t = tid >> 3, part = tid & 7; float s = 0.f;
#pragma unroll
        for (int i = 0; i < 16; ++i) s += bf2f(Q[t * 136 + part * 16 + i]) * n0[part * 16 + i];
        s = oct_sum(s);
        if (part == 0) qn[t] = s;
    }
    {
        const int rt = wid >> 1;
#pragma unroll
        for (int cc = 0; cc < 2; ++cc) {
            const int ct = 2 * (wid & 1) + cc;
            f32x4 acc = {0.f, 0.f, 0.f, 0.f};
#pragma unroll
            for (int ks = 0; ks < 4; ++ks)
                acc = __builtin_amdgcn_mfma_f32_16x16x32_bf16(lds_frag(Q, rt * 16 + r, 136, 8 * g + 32 * ks), lds_frag(K, ct * 16 + r, 136, 8 * g + 32 * ks), acc, 0, 0, 0);
            const int scol = ct * 16 + r; const float csv = cs[scol];
#pragma unroll
            for (int j = 0; j < 4; ++j) {
                const int t = rt * 16 + 4 * g + j;
                float pv = (scol <= t) ? acc[j] * __expf(rb[t] + csv) : 0.f;
                P[t * 72 + scol] = f2bf(pv);
                pv = row16_sum(pv);
                if (r == 0) rowpart[t * 4 + ct] = pv;
            }
        }
    }
    __syncthreads();
    if (tid < 64) {
        const float den = rowpart[tid * 4] + rowpart[tid * 4 + 1] + rowpart[tid * 4 + 2] + rowpart[tid * 4 + 3] + wint[tid] * qn[tid];
        rinv[tid] = 1.f / fmaxf(fabsf(den), emt[tid]);
    }
    f32x4 hacc[4];
    {
        const int rt = wid >> 1;
#pragma unroll
        for (int ee = 0; ee < 4; ++ee) {
            const int et = 4 * (wid & 1) + ee;
            f32x4 a1 = {0.f, 0.f, 0.f, 0.f}, a2 = {0.f, 0.f, 0.f, 0.f};
#pragma unroll
            for (int ks = 0; ks < 2; ++ks)
                a1 = __builtin_amdgcn_mfma_f32_16x16x32_bf16(lds_frag(P, rt * 16 + r, 72, 8 * g + 32 * ks), lds_frag(VT, et * 16 + r, 72, 8 * g + 32 * ks), a1, 0, 0, 0);
#pragma unroll
            for (int ks = 0; ks < 4; ++ks)
                a2 = __builtin_amdgcn_mfma_f32_16x16x32_bf16(lds_frag(Q, rt * 16 + r, 136, 8 * g + 32 * ks), lds_frag(C0, et * 16 + r, 136, 8 * g + 32 * ks), a2, 0, 0, 0);
#pragma unroll
            for (int j = 0; j < 4; ++j) { const int t = rt * 16 + 4 * g + j; hacc[ee][j] = a1[j] + wint[t] * a2[j]; }
        }
    }
    __syncthreads();
    {
        const int rt = wid >> 1;
#pragma unroll
        for (int ee = 0; ee < 4; ++ee) {
            const int et = 4 * (wid & 1) + ee;
#pragma unroll
            for (int j = 0; j < 4; ++j) { const int t = rt * 16 + 4 * g + j; H[t * 132 + et * 16 + r] = hacc[ee][j] * rinv[t]; }
        }
    }
    __syncthreads();
    {
        const int t = tid >> 3, part = tid & 7;
        float hv[16]; float ss = 0.f;
#pragma unroll
        for (int i = 0; i < 16; ++i) { hv[i] = H[t * 132 + part * 16 + i]; ss += hv[i] * hv[i]; }
        ss = oct_sum(ss);
        const float rstd = rsqrtf(ss * (1.f / 128.f) + 1e-6f);
        const int col = h * 128 + part * 16;
        const u32x4 m0v = *(const u32x4*)(MO + (size_t)(row0 + t) * 512 + col), m1v = *(const u32x4*)(MO + (size_t)(row0 + t) * 512 + col + 8);
        float mo[16];
#pragma unroll
        for (int i = 0; i < 4; ++i) { mo[2 * i] = lo16(m0v[i]); mo[2 * i + 1] = hi16(m0v[i]); mo[8 + 2 * i] = lo16(m1v[i]); mo[8 + 2 * i + 1] = hi16(m1v[i]); }
        float o[16];
#pragma unroll
        for (int i = 0; i < 16; ++i) o[i] = (hv[i] * rstd * p.out_norm_m[col + i]) * sigmoidf_(mo[i]);
        u32x4 o0, o1;
#pragma unroll
        for (int i = 0; i < 4; ++i) { o0[i] = pack2(o[2 * i], o[2 * i + 1]); o1[i] = pack2(o[8 + 2 * i], o[8 + 2 * i + 1]); }
        bf16_t* dst = (bf16_t*)(p.ws + OFF_ACT) + (size_t)(row0 + t) * 1024 + col;
        *(u32x4*)dst = o0; *(u32x4*)(dst + 8) = o1;
    }
    if (next_task >= 0) pb_prefetch(p, next_task, S);
    asm volatile("s_waitcnt lgkmcnt(0)" ::: "memory");
    __builtin_amdgcn_s_barrier();
}

__device__ __forceinline__ unsigned f2sortable(float f) { const unsigned u = __float_as_uint(f); return u ^ ((unsigned)((int)u >> 31) | 0x80000000u); }
#define CNT4(c0, c1, c2, c3, a, b, cc, d, thr) asm volatile( \
    "v_cmp_ge_u32 s[40:41], %4, %8\n\tv_cmp_ge_u32 s[42:43], %5, %8\n\tv_cmp_ge_u32 s[44:45], %6, %8\n\tv_cmp_ge_u32 s[46:47], %7, %8\n\t" \
    "v_addc_co_u32 %0, s[48:49], 0, %0, s[40:41]\n\tv_addc_co_u32 %1, s[50:51], 0, %1, s[42:43]\n\tv_addc_co_u32 %2, s[52:53], 0, %2, s[44:45]\n\tv_addc_co_u32 %3, s[54:55], 0, %3, s[46:47]" \
    : "+v"(c0), "+v"(c1), "+v"(c2), "+v"(c3) : "v"(a), "v"(b), "v"(cc), "v"(d), "v"(thr) \
    : "s40", "s41", "s42", "s43", "s44", "s45", "s46", "s47", "s48", "s49", "s50", "s51", "s52", "s53", "s54", "s55")
template <int NR>
__device__ __forceinline__ int count_geN(const unsigned (&u)[NR], unsigned thr) {
    int c0 = 0, c1 = 0, c2 = 0, c3 = 0;
#pragma unroll
    for (int j = 0; j < NR; j += 4) CNT4(c0, c1, c2, c3, u[j], u[j + 1], u[j + 2], u[j + 3], thr);
    return (c0 + c1) + (c2 + c3);
}
#define COMPACT4(pos4, dump4, thr, k0, k1, k2, k3, d0, d1, d2, d3) do { unsigned i0_, i1_, i2_, i3_, x0_, x1_; asm volatile( \
    "v_cmp_ge_u32 s[40:41], %[K0], %[T]\n\tv_cmp_ge_u32 s[42:43], %[K1], %[T]\n\tv_cmp_ge_u32 s[44:45], %[K2], %[T]\n\tv_cmp_ge_u32 s[46:47], %[K3], %[T]\n\t" \
    "v_cndmask_b32_e64 %[I0], 0, 4, s[40:41]\n\tv_cndmask_b32_e64 %[I1], 0, 4, s[42:43]\n\tv_cndmask_b32_e64 %[I2], 0, 4, s[44:45]\n\tv_cndmask_b32_e64 %[I3], 0, 4, s[46:47]\n\t" \
    "v_cndmask_b32_e64 %[X0], %[DU], %[P], s[40:41]\n\tv_add_u32 %[P], %[P], %[I0]\n\tds_write_b32 %[X0], %[D0]\n\t" \
    "v_cndmask_b32_e64 %[X1], %[DU], %[P], s[42:43]\n\tv_add_u32 %[P], %[P], %[I1]\n\tds_write_b32 %[X1], %[D1]\n\t" \
    "v_cndmask_b32_e64 %[X0], %[DU], %[P], s[44:45]\n\tv_add_u32 %[P], %[P], %[I2]\n\tds_write_b32 %[X0], %[D2]\n\t" \
    "v_cndmask_b32_e64 %[X1], %[DU], %[P], s[46:47]\n\tv_add_u32 %[P], %[P], %[I3]\n\tds_write_b32 %[X1], %[D3]" \
    : [P] "+v"(pos4), [I0] "=&v"(i0_), [I1] "=&v"(i1_), [I2] "=&v"(i2_), [I3] "=&v"(i3_), [X0] "=&v"(x0_), [X1] "=&v"(x1_) \
    : [K0] "v"(k0), [K1] "v"(k1), [K2] "v"(k2), [K3] "v"(k3), [D0] "v"(d0), [D1] "v"(d1), [D2] "v"(d2), [D3] "v"(d3), [T] "v"(thr), [DU] "v"(dump4) \
    : "s40", "s41", "s42", "s43", "s44", "s45", "s46", "s47", "memory"); } while (0)
template <int NR>
__device__ __forceinline__ void select_topk(const LAS float* srow, LAS int* lq, int t, int n, int lane, int rowb) {
    unsigned u[NR];
#pragma unroll
    for (int j = 0; j < NR; ++j) {
        const int key = lane + 64 * j; const unsigned kv = ((f2sortable(srow[key]) & 0xFFFFF000u) | (unsigned)(63 - lane)) | (unsigned)((63 - j) << 6);
        u[j] = (j < NR - 8 || key <= t) ? kv : 0u; }
    unsigned tau = 1u;
    if (n > 256) {
        tau = 0u;
        for (int bit = 31; bit >= 0; --bit) {
            const unsigned cand = tau | (1u << bit);
            const int cnt = wave_sum_i32_uniform(count_geN<NR>(u, cand));
            if (cnt >= 256) { tau = cand; if (cnt == 256) break; }
        }
    }
    const int c = count_geN<NR>(u, tau);
    const int pre = wave_iscan_i32(c);
    int pos = pre - c;
    int keyv = (rowb + lane) << 7;
#pragma unroll
    for (int j = 0; j < NR; ++j) {
        const bool sel = u[j] >= tau;
        const int slot = sel ? pos : (256 + lane);
        lq[slot] = keyv;
        pos += sel ? 1 : 0; keyv += 64 << 7;
    }
}
__device__ __forceinline__ unsigned wave_max_u32(unsigned v) {
    v = max(v, (unsigned)__builtin_amdgcn_update_dpp(0, (int)v, 0xB1, 0xF, 0xF, true)); v = max(v, (unsigned)__builtin_amdgcn_update_dpp(0, (int)v, 0x4E, 0xF, 0xF, true));
    v = max(v, (unsigned)__builtin_amdgcn_update_dpp(0, (int)v, 0x141, 0xF, 0xF, true)); v = max(v, (unsigned)__builtin_amdgcn_update_dpp(0, (int)v, 0x140, 0xF, 0xF, true));
    return max(max((unsigned)__builtin_amdgcn_readlane((int)v, 0), (unsigned)__builtin_amdgcn_readlane((int)v, 16)), max((unsigned)__builtin_amdgcn_readlane((int)v, 32), (unsigned)__builtin_amdgcn_readlane((int)v, 48)));
}
template <int NR>
__device__ __forceinline__ void select_topk2(LAS float* srow, LAS unsigned* buf, LAS int* lq, int t, int n, int lane, int rowb) {
    unsigned u[NR];
#pragma unroll
    for (int j = 0; j < NR; ++j) {
        const int key = lane + 64 * j; const unsigned kv = ((f2sortable(srow[key]) & 0xFFFFF000u) | (unsigned)(63 - lane)) | (unsigned)((63 - j) << 6);
        u[j] = (j < NR - 8 || key <= t) ? kv : 0u; }
    unsigned mx = 0u;
#pragma unroll
    for (int j = 0; j < NR; ++j) mx = max(mx, u[j]);
    mx = wave_max_u32(mx);
    unsigned tau = 0u; int bit = 31, G = n, lc = 0;
    {
        unsigned th = mx & 0xFF800000u;
#pragma unroll 1
        for (int s6 = 0; s6 < 6; ++s6) {
            const int lcnt = count_geN<NR>(u, th);
            const int cnt = wave_sum_i32_uniform(lcnt);
            if (cnt >= 256) { tau = th; bit = 22; G = cnt; lc = lcnt; break; }
            if (th < 0x00800000u) break;
            th -= 0x00800000u;
        }
    }
    while (G > 512 && bit >= 0) {
        const unsigned cand = tau | (1u << bit);
        const int lcnt = count_geN<NR>(u, cand);
        const int cnt = wave_sum_i32_uniform(lcnt);
        if (cnt >= 256) { tau = cand; G = cnt; lc = lcnt; }
        --bit;
    }
    {
        const int pre = wave_iscan_i32(lc);
        const unsigned bufa = (unsigned)(__UINTPTR_TYPE__)buf;
        unsigned pos4 = bufa + 4u * (unsigned)(pre - lc); const unsigned dump4 = bufa + 4u * (unsigned)(512 + lane);
#pragma unroll
        for (int j = 0; j < NR; j += 4) COMPACT4(pos4, dump4, tau, u[j], u[j + 1], u[j + 2], u[j + 3], u[j], u[j + 1], u[j + 2], u[j + 3]);
    }
    unsigned c[8];
#pragma unroll
    for (int j = 0; j < 8; ++j) { const unsigned cv = buf[lane + 64 * j]; c[j] = (lane + 64 * j < G) ? cv : 0u; }
    while (G > 256 && bit >= 0) {
        const unsigned cand = tau | (1u << bit);
        int cnt = 0;
#pragma unroll
        for (int j = 0; j < 8; ++j) cnt += __builtin_popcountll(__builtin_amdgcn_ballot_w64(c[j] >= cand));
        if (cnt >= 256) { tau = cand; G = cnt; }
        --bit;
    }
    {
        const int lc2 = count_geN<8>(c, tau);
        const int pre = wave_iscan_i32(lc2);
        const unsigned lqa = (unsigned)(__UINTPTR_TYPE__)lq;
        unsigned pos4 = lqa + 4u * (unsigned)(pre - lc2); const unsigned dump4 = lqa + 4u * (unsigned)(256 + lane);
        const unsigned kx = 0x7FF80u | ((unsigned)rowb << 7);
        unsigned d[8];
#pragma unroll
        for (int j = 0; j < 8; ++j) d[j] = ((c[j] << 7) & 0x7FF80u) ^ kx;
        COMPACT4(pos4, dump4, tau, c[0], c[1], c[2], c[3], d[0], d[1], d[2], d[3]);
        COMPACT4(pos4, dump4, tau, c[4], c[5], c[6], c[7], d[4], d[5], d[6], d[7]);
    }
}
struct DsaPre { bf16x8 af[2][4]; f32x4 wq[2][4]; bf16x8 kb[4][4]; };
__device__ __forceinline__ void dsa_prefetch(const Params& p, int task, DsaPre& S) {
    const int tid = opaque_tid(), wid = __builtin_amdgcn_readfirstlane(tid >> 6), lane = tid & 63;
    const int b = task >> 9, qg = task & 511, t0 = qg * 8, rowb = b * SEQ;
    const bf16_t* IQ = (const bf16_t*)(p.ws + OFF_IQ); const bf16_t* IK = (const bf16_t*)(p.ws + OFF_IK);
    const float* gates = (const float*)(p.ws + OFF_GATE);
    const int ntile = (t0 + 8 + 31) >> 5;
    const int r = lane & 31, hh = lane >> 5;
#pragma unroll
    for (int rt = 0; rt < 2; ++rt) {
        const size_t qrow = (size_t)(rowb + t0 + 4 * rt + (r >> 3));
#pragma unroll
        for (int ks = 0; ks < 4; ++ks) S.af[rt][ks] = *(const bf16x8*)(IQ + qrow * 512 + (r & 7) * 64 + 16 * ks + 8 * hh);
#pragma unroll
        for (int q4 = 0; q4 < 4; ++q4) S.wq[rt][q4] = *(const f32x4*)(gates + (size_t)(rowb + t0 + 4 * rt + q4) * 16 + 8 + 4 * hh);
    }
#pragma unroll
    for (int d = 0; d < 4; ++d) {
        if (wid + 8 * d < ntile) {
#pragma unroll
            for (int ks = 0; ks < 4; ++ks) S.kb[d][ks] = *(const bf16x8*)(IK + (size_t)(rowb + 32 * (wid + 8 * d)) * 64 + ks * 512 + lane * 8);
        }
    }
}
__device__ __forceinline__ void dsa_task(const Params& p, int task, LAS unsigned char* lds, DsaPre& S, int next_task) {
    const int tid = opaque_tid(), wid = __builtin_amdgcn_readfirstlane(tid >> 6), lane = tid & 63;
    const int b = task >> 9, qg = task & 511, t0 = qg * 8, rowb = b * SEQ;
    const bf16_t* IQ = (const bf16_t*)(p.ws + OFF_IQ); const bf16_t* IK = (const bf16_t*)(p.ws + OFF_IK);
    const bf16_t* AQ = (const bf16_t*)(p.ws + OFF_AQ); const bf16_t* AK = (const bf16_t*)(p.ws + OFF_AK); const bf16_t* AV = (const bf16_t*)(p.ws + OFF_AV);
    const float* gates = (const float*)(p.ws + OFF_GATE);
    LAS float* scores = (LAS float*)lds;
    LAS int* lists = (LAS int*)(lds + 131072);
    const int ntile = (t0 + 8 + 31) >> 5;
#pragma unroll 1
    for (int rr0 = 0; rr0 < ((DSA_REP & 1) ? 2 : 1); ++rr0)
    {
        const int r = lane & 31, hh = lane >> 5;
        bf16x8 (&af)[2][4] = S.af; float wv[2][4][4];
#pragma unroll
        for (int rt = 0; rt < 2; ++rt)
#pragma unroll
            for (int q4 = 0; q4 < 4; ++q4)
#pragma unroll
                for (int h4 = 0; h4 < 4; ++h4) wv[rt][q4][h4] = S.wq[rt][q4][h4] * 0.04419417382415922f;
        constexpr int IDX_PF = 4;
        bf16x8 (&kb)[IDX_PF][4] = S.kb;
#pragma unroll 1
        for (int kt0 = wid; kt0 < ntile; kt0 += 8 * IDX_PF) {
#pragma unroll
            for (int d = 0; d < IDX_PF; ++d) {
                const int kt = kt0 + 8 * d;
                if (kt < ntile) {
                    const int key = 32 * kt + r;
                    f32x16 acc2[2];
#pragma unroll
                    for (int i = 0; i < 16; ++i) { acc2[0][i] = 0.f; acc2[1][i] = 0.f; }
#pragma unroll
                    for (int ks = 0; ks < 4; ++ks) {
                        acc2[0] = __builtin_amdgcn_mfma_f32_32x32x16_bf16(af[0][ks], kb[d][ks], acc2[0], 0, 0, 0);
                        acc2[1] = __builtin_amdgcn_mfma_f32_32x32x16_bf16(af[1][ks], kb[d][ks], acc2[1], 0, 0, 0);
                    }
#pragma unroll
                    for (int rt = 0; rt < 2; ++rt) {
                        float part[4];
#pragma unroll
                        for (int q4 = 0; q4 < 4; ++q4) {
                            part[q4] = 0.f;
#pragma unroll
                            for (int h4 = 0; h4 < 4; ++h4)
                                part[q4] += __int_as_float(max(__float_as_int(acc2[rt][q4 * 4 + h4]), 0)) * wv[rt][q4][h4];
                        }
                        float tot[2];
#pragma unroll
                        for (int i = 0; i < 2; ++i) { const u32x2 r_ = __builtin_amdgcn_permlane32_swap(__float_as_uint(part[i]), __float_as_uint(part[i + 2]), false, false); tot[i] = __uint_as_float(r_[0]) + __uint_as_float(r_[1]); }
#pragma unroll
                        for (int i = 0; i < 2; ++i) { const int qq = 4 * rt + 2 * hh + i; scores[qq * 4096 + key] = tot[i]; }
                    }
                    if (kt + 8 * IDX_PF < ntile) {
#pragma unroll
                        for (int ks = 0; ks < 4; ++ks) kb[d][ks] = *(const bf16x8*)(IK + (size_t)(rowb + 32 * (kt + 8 * IDX_PF)) * 64 + ks * 512 + lane * 8);
                    }
                }
            }
        }
    }
    __syncthreads();
    const int qq = wid, t = t0 + qq, n = t + 1;
    const int nsel_rt = n < 256 ? n : 256;
#pragma unroll 1
    for (int rr1 = 0; rr1 < ((DSA_REP & 2) ? 2 : 1); ++rr1)
    {
        LAS float* srow = scores + qq * 4096; LAS int* lq = lists + qq * 320; LAS unsigned* cbuf = (LAS unsigned*)(lds + 141312 + qq * 2304);
        const int nreg = (t >> 6) + 1;
        if (nreg <= 8) select_topk<8>(srow, lq, t, n, lane, rowb);
        else if (nreg <= 16) select_topk2<16>(srow, cbuf, lq, t, n, lane, rowb);
        else if (nreg <= 24) select_topk2<24>(srow, cbuf, lq, t, n, lane, rowb);
        else if (nreg <= 32) select_topk2<32>(srow, cbuf, lq, t, n, lane, rowb);
        else if (nreg <= 40) select_topk2<40>(srow, cbuf, lq, t, n, lane, rowb);
        else if (nreg <= 48) select_topk2<48>(srow, cbuf, lq, t, n, lane, rowb);
        else if (nreg <= 56) select_topk2<56>(srow, cbuf, lq, t, n, lane, rowb);
        else select_topk2<64>(srow, cbuf, lq, t, n, lane, rowb);
    }
    asm volatile("s_waitcnt lgkmcnt(0)" ::: "memory");
    auto attention = [&](auto full_tag) {
    const int nsel = decltype(full_tag)::value ? 256 : nsel_rt;
#pragma unroll 1
    for (int rr2 = 0; rr2 < ((DSA_REP & 4) ? 2 : 1); ++rr2) {
    float sm_inv = 1.f;
    f32x4 gnv[4];
#pragma unroll
    for (int ct = 0; ct < 4; ++ct) gnv[ct] = *(const f32x4*)(p.out_norm_a + (lane & 7) * 64 + 4 * (lane >> 4) + 16 * ct);
    u32x4 vq[4];
    const LAS int* lrow = lists + qq * 320 + (lane >> 3); asm volatile("" : "+v"(lrow));
#pragma unroll 1
    for (int rr3 = 0; rr3 < ((DSA_REP & 8) ? 2 : 1); ++rr3)
    {
        const int r = lane & 15, g = lane >> 4;
        const size_t qrow = (size_t)(rowb + t);
        bf16x8 bq[2];
#pragma unroll
        for (int ks = 0; ks < 2; ++ks) {
            bq[ks] = *(const bf16x8*)(AQ + qrow * 512 + (r & 7) * 64 + 8 * g + 32 * ks);
        }
        LAS float* Pl = scores + qq * 4096;
        LAS unsigned char* ksA = lds + 141312 + qq * 2304;
        LAS unsigned char* ksB = (LAS unsigned char*)Pl + 13440;
        const int kl = lane >> 3, dc = lane & 7;
#pragma unroll 1
        for (int half = 0; half < 2; ++half) {
            u32x4 kr[16];
#pragma unroll
            for (int i = 0; i < 16; ++i) {
                const int jp = 16 * (half * 8 + (i >> 1)) + kl + 8 * (i & 1);
                const int lk = lists[qq * 320 + jp]; const int ko = (jp < nsel) ? lk : (rowb << 7);
                kr[i] = *(const u32x4*)((const unsigned char*)AK + (unsigned)(ko + dc * 16));
            }
            bf16x8 fa0, fa1;
            *(LAS u32x4*)(ksA + kl * 144 + dc * 16) = kr[0]; *(LAS u32x4*)(ksA + (kl + 8) * 144 + dc * 16) = kr[1];
            fa0 = *(const LAS bf16x8*)(ksA + r * 144 + 16 * g); fa1 = *(const LAS bf16x8*)(ksA + r * 144 + 64 + 16 * g);
#pragma unroll
            for (int i = 0; i < 8; ++i) {
                const int kt = half * 8 + i;
                bf16x8 fn0 = fa0, fn1 = fa1;
                if (i + 1 < 8) {
                    LAS unsigned char* ks_ = ((i + 1) & 1) ? ksB : ksA;
                    *(LAS u32x4*)(ks_ + kl * 144 + dc * 16) = kr[2 * i + 2]; *(LAS u32x4*)(ks_ + (kl + 8) * 144 + dc * 16) = kr[2 * i + 3];
                    fn0 = *(const LAS bf16x8*)(ks_ + r * 144 + 16 * g); fn1 = *(const LAS bf16x8*)(ks_ + r * 144 + 64 + 16 * g);
                }
                f32x4 acc = {0.f, 0.f, 0.f, 0.f};
                acc = __builtin_amdgcn_mfma_f32_16x16x32_bf16(fa0, bq[0], acc, 0, 0, 0);
                acc = __builtin_amdgcn_mfma_f32_16x16x32_bf16(fa1, bq[1], acc, 0, 0, 0);
                if (r < 8) *(LAS f32x4*)(Pl + r * 260 + 16 * kt + 4 * g) = acc;
                fa0 = fn0; fa1 = fn1;
            }
        }
#pragma unroll
        for (int i = 0; i < 4; ++i) {
            const int jp = kl + 8 * i;
            const int lk = lrow[8 * i]; const int ko = (jp < nsel) ? lk : (rowb << 7);
            vq[i] = *(const u32x4*)((const unsigned char*)AV + (unsigned)(ko + dc * 16));
        }
        asm volatile("s_waitcnt lgkmcnt(0)" ::: "memory");
        const int hd = lane & 7, ch = lane >> 3;
        f32x4 pv[8];
        float mx = -INFINITY;
#pragma unroll
        for (int i = 0; i < 8; ++i) {
            pv[i] = *(const LAS f32x4*)(Pl + hd * 260 + ch * 32 + 4 * i);
#pragma unroll
            for (int j = 0; j < 4; ++j) if (ch * 32 + 4 * i + j < nsel) mx = fmaxf(mx, pv[i][j]);
        }
        mx = fmaxf(mx, dppf(mx, 0x128));
        mx = xmax_f32<16>(mx); mx = xmax_f32<32>(mx);
        const float nmxc = -mx * 0.18033688011112042f;
        typedef float f32x2 __attribute__((ext_vector_type(2)));
        f32x2 sm2 = {0.f, 0.f};
#pragma unroll
        for (int i = 0; i < 8; ++i) {
#pragma unroll
            for (int j = 0; j < 4; ++j) { const float e = (ch * 32 + 4 * i + j < nsel) ? __builtin_amdgcn_exp2f(__builtin_fmaf(pv[i][j], 0.18033688011112042f, nmxc)) : 0.f; pv[i][j] = e; }
            sm2 += (f32x2){pv[i][0], pv[i][1]}; sm2 += (f32x2){pv[i][2], pv[i][3]};
        }
        float sm = sm2[0] + sm2[1];
        sm += dppf(sm, 0x128); sm = xsum_f32<16>(sm); sm = xsum_f32<32>(sm);
        sm_inv = __builtin_amdgcn_rcpf(sm);
        LAS bf16_t* Pt = (LAS bf16_t*)((LAS unsigned char*)Pl + 9216);
#pragma unroll
        for (int i = 0; i < 4; ++i) {
            u32x4 o;
            o[0] = pack2(pv[2 * i][0], pv[2 * i][1]); o[1] = pack2(pv[2 * i][2], pv[2 * i][3]);
            o[2] = pack2(pv[2 * i + 1][0], pv[2 * i + 1][1]); o[3] = pack2(pv[2 * i + 1][2], pv[2 * i + 1][3]);
            *(LAS u32x4*)(Pt + hd * 264 + ch * 32 + 8 * i) = o;
        }
    }
    asm volatile("s_waitcnt lgkmcnt(0)" ::: "memory");
#pragma unroll 1
    for (int rr4 = 0; rr4 < ((DSA_REP & 16) ? 2 : 1); ++rr4)
    {
        typedef short s16x4 __attribute__((ext_vector_type(4)));
        const int r = lane & 15, g = lane >> 4;
        LAS unsigned char* wb = (LAS unsigned char*)(scores + qq * 4096);
        const LAS bf16_t* Pt = (const LAS bf16_t*)(wb + 9216);
        const int nchunk = (nsel + 31) >> 5;
        const int kl = lane >> 3, dc = lane & 7;
        f32x4 acc[4];
#pragma unroll
        for (int ct = 0; ct < 4; ++ct) acc[ct] = (f32x4){0.f, 0.f, 0.f, 0.f};
        u32x4 vn[4];
#pragma unroll 1
        for (int c = 0; c < nchunk; ++c) {
            LAS unsigned char* vb = wb + (c & 1) * 4608;
#pragma unroll
            for (int i = 0; i < 4; ++i) *(LAS u32x4*)(vb + (kl + 8 * i) * 144 + dc * 16) = vq[i];
            if (c + 1 < nchunk) {
#pragma unroll
                for (int i = 0; i < 4; ++i) {
                    const int jp = 32 * (c + 1) + kl + 8 * i;
                    const int lk = lrow[32 * (c + 1) + 8 * i]; const int ko = (jp < nsel) ? lk : (rowb << 7);
                    vn[i] = *(const u32x4*)((const unsigned char*)AV + (unsigned)(ko + dc * 16));
                }
            }
            bf16x8 a = *(const LAS bf16x8*)(Pt + (r & 7) * 264 + 32 * c + 8 * g);
#pragma unroll
            for (int ct = 0; ct < 4; ++ct) {
                LAS unsigned char* ba = vb + (8 * g + (r >> 2)) * 144 + (16 * ct + 4 * (r & 3)) * 2;
                const s16x4 b0 = __builtin_amdgcn_ds_read_tr16_b64_v4i16((LAS s16x4*)ba);
                const s16x4 b1 = __builtin_amdgcn_ds_read_tr16_b64_v4i16((LAS s16x4*)(ba + 4 * 144));
                bf16x8 bb; bb[0] = b0[0]; bb[1] = b0[1]; bb[2] = b0[2]; bb[3] = b0[3]; bb[4] = b1[0]; bb[5] = b1[1]; bb[6] = b1[2]; bb[7] = b1[3];
                acc[ct] = __builtin_amdgcn_mfma_f32_16x16x32_bf16(bb, a, acc[ct], 0, 0, 0);
            }
#pragma unroll
            for (int i = 0; i < 4; ++i) vq[i] = vn[i];
        }
        float ss = 0.f;
#pragma unroll
        for (int ct = 0; ct < 4; ++ct)
#pragma unroll
            for (int j = 0; j < 4; ++j) ss += acc[ct][j] * acc[ct][j];
        ss = xsum_f32<16>(ss); ss = xsum_f32<32>(ss);
        const float rstd = sm_inv * rsqrtf(ss * (sm_inv * sm_inv) * (1.f / 64.f) + 1e-6f);
        if (r < 8) {
            bf16_t* dst = (bf16_t*)(p.ws + OFF_ACT) + (size_t)(rowb + t) * 1024 + 512 + r * 64 + 4 * g;
#pragma unroll
            for (int ct = 0; ct < 4; ++ct) {
                const f32x4 gv = gnv[ct];
                u32x2 o; o[0] = pack2(acc[ct][0] * rstd * gv[0], acc[ct][1] * rstd * gv[1]); o[1] = pack2(acc[ct][2] * rstd * gv[2], acc[ct][3] * rstd * gv[3]);
                *(u32x2*)(dst + 16 * ct) = o;
            }
        }
    }
    }
    };
    if (nsel_rt == 256) attention(std::true_type{}); else attention(std::false_type{});
    if (next_task >= 0) dsa_prefetch(p, next_task, S);
    asm volatile("s_waitcnt lgkmcnt(0)" ::: "memory");
    __builtin_amdgcn_s_barrier();
}

__device__ __forceinline__ float sortable2f(unsigned s) { return __uint_as_float((s & 0x80000000u) ? (s ^ 0x80000000u) : ~s); }
#define CE_DESC(x, y) do { const unsigned mx_ = max(x, y), mn_ = min(x, y); (x) = mx_; (y) = mn_; } while (0)
template <int BASE, int N>
__device__ __forceinline__ void bitonic_sort16_desc(unsigned (&a)[N]) {
    CE_DESC(a[BASE + 0], a[BASE + 13]); CE_DESC(a[BASE + 1], a[BASE + 12]); CE_DESC(a[BASE + 2], a[BASE + 15]); CE_DESC(a[BASE + 3], a[BASE + 14]); CE_DESC(a[BASE + 4], a[BASE + 8]); CE_DESC(a[BASE + 5], a[BASE + 6]); CE_DESC(a[BASE + 7], a[BASE + 11]); CE_DESC(a[BASE + 9], a[BASE + 10]);
    CE_DESC(a[BASE + 0], a[BASE + 5]); CE_DESC(a[BASE + 1], a[BASE + 7]); CE_DESC(a[BASE + 2], a[BASE + 9]); CE_DESC(a[BASE + 3], a[BASE + 4]); CE_DESC(a[BASE + 6], a[BASE + 13]); CE_DESC(a[BASE + 8], a[BASE + 14]); CE_DESC(a[BASE + 10], a[BASE + 15]); CE_DESC(a[BASE + 11], a[BASE + 12]);
    CE_DESC(a[BASE + 0], a[BASE + 1]); CE_DESC(a[BASE + 2], a[BASE + 3]); CE_DESC(a[BASE + 4], a[BASE + 5]); CE_DESC(a[BASE + 6], a[BASE + 8]); CE_DESC(a[BASE + 7], a[BASE + 9]); CE_DESC(a[BASE + 10], a[BASE + 11]); CE_DESC(a[BASE + 12], a[BASE + 13]); CE_DESC(a[BASE + 14], a[BASE + 15]);
    CE_DESC(a[BASE + 0], a[BASE + 2]); CE_DESC(a[BASE + 1], a[BASE + 3]); CE_DESC(a[BASE + 4], a[BASE + 10]); CE_DESC(a[BASE + 5], a[BASE + 11]); CE_DESC(a[BASE + 6], a[BASE + 7]); CE_DESC(a[BASE + 8], a[BASE + 9]); CE_DESC(a[BASE + 12], a[BASE + 14]); CE_DESC(a[BASE + 13], a[BASE + 15]);
    CE_DESC(a[BASE + 1], a[BASE + 2]); CE_DESC(a[BASE + 3], a[BASE + 12]); CE_DESC(a[BASE + 4], a[BASE + 6]); CE_DESC(a[BASE + 5], a[BASE + 7]); CE_DESC(a[BASE + 8], a[BASE + 10]); CE_DESC(a[BASE + 9], a[BASE + 11]); CE_DESC(a[BASE + 13], a[BASE + 14]);
    CE_DESC(a[BASE + 1], a[BASE + 4]); CE_DESC(a[BASE + 2], a[BASE + 6]); CE_DESC(a[BASE + 5], a[BASE + 8]); CE_DESC(a[BASE + 7], a[BASE + 10]); CE_DESC(a[BASE + 9], a[BASE + 13]); CE_DESC(a[BASE + 11], a[BASE + 14]);
    CE_DESC(a[BASE + 2], a[BASE + 4]); CE_DESC(a[BASE + 3], a[BASE + 6]); CE_DESC(a[BASE + 9], a[BASE + 12]); CE_DESC(a[BASE + 11], a[BASE + 13]);
    CE_DESC(a[BASE + 3], a[BASE + 5]); CE_DESC(a[BASE + 6], a[BASE + 8]); CE_DESC(a[BASE + 7], a[BASE + 9]); CE_DESC(a[BASE + 10], a[BASE + 12]);
    CE_DESC(a[BASE + 3], a[BASE + 4]); CE_DESC(a[BASE + 5], a[BASE + 6]); CE_DESC(a[BASE + 7], a[BASE + 8]); CE_DESC(a[BASE + 9], a[BASE + 10]); CE_DESC(a[BASE + 11], a[BASE + 12]);
    CE_DESC(a[BASE + 6], a[BASE + 7]); CE_DESC(a[BASE + 8], a[BASE + 9]);
}
template <int BASE, int N>
__device__ __forceinline__ void bitonic_merge16_desc(unsigned (&a)[N]) {
#pragma unroll
    for (int j = 8; j > 0; j >>= 1) {
#pragma unroll
        for (int i = 0; i < 16; ++i) { const int l = i ^ j; if (l > i) CE_DESC(a[BASE + i], a[BASE + l]); }
    }
}
template <int BA, int BB, int N>
__device__ __forceinline__ void top16_merge(unsigned (&a)[N]) {
#pragma unroll
    for (int i = 0; i < 16; ++i) a[BA + i] = max(a[BA + i], a[BB + 15 - i]);
    bitonic_merge16_desc<BA, N>(a);
}
__device__ __forceinline__ void top16_of_64(unsigned (&a)[64]) {
    bitonic_sort16_desc<0, 64>(a); bitonic_sort16_desc<16, 64>(a); bitonic_sort16_desc<32, 64>(a); bitonic_sort16_desc<48, 64>(a);
    top16_merge<0, 16, 64>(a); top16_merge<32, 48, 64>(a); top16_merge<0, 32, 64>(a);
}
__device__ __forceinline__ void peer_route(const Params& p, int task, LAS unsigned char* lds) {
    const int tid = opaque_tid(), wid = __builtin_amdgcn_readfirstlane(tid >> 6), lane = tid & 63;
    const int n0 = task * 32, head = wid;
    const int r = lane & 31, hh = lane >> 5;
    const bf16_t* QRY = (const bf16_t*)(p.ws + OFF_QRY); const bf16_t* SK = (const bf16_t*)(p.ws + OFF_SK);
    LAS unsigned* tkl = (LAS unsigned*)lds + wid * (32 * 64);
#pragma unroll 1
    for (int p2 = 0; p2 < 2; ++p2) {
        const int grp = head * 2 + p2;
        bf16x8 bq[4];
#pragma unroll
        for (int ks = 0; ks < 4; ++ks) bq[ks] = *(const bf16x8*)(QRY + (size_t)(n0 + r) * 1024 + grp * 64 + 16 * ks + 8 * hh);
        unsigned key[64];
#pragma unroll
        for (int kt = 0; kt < 4; ++kt) {
            f32x16 acc;
#pragma unroll
            for (int i = 0; i < 16; ++i) acc[i] = 0.f;
#pragma unroll
            for (int ks = 0; ks < 4; ++ks) {
                const bf16x8 a = *(const bf16x8*)(SK + (size_t)(grp * 128 + 32 * kt + r) * 64 + 16 * ks + 8 * hh);
                acc = __builtin_amdgcn_mfma_f32_32x32x16_bf16(a, bq[ks], acc, 0, 0, 0);
            }
#pragma unroll
            for (int reg = 0; reg < 16; ++reg) {
                const int idx = 32 * kt + (reg & 3) + 8 * (reg >> 2) + 4 * hh;
                key[kt * 16 + reg] = (f2sortable(acc[reg]) & ~0x7Fu) | (unsigned)(127 - idx);
            }
        }
        top16_of_64(key);
        unsigned mg[16];
#pragma unroll
        for (int i = 0; i < 16; ++i) mg[i] = max(key[i], xchg_u32<32>(key[15 - i], lane));
        bitonic_merge16_desc<0, 16>(mg);
#pragma unroll
        for (int k = 0; k < 16; ++k) tkl[(p2 * 16 + k) * 64 + lane] = mg[k];
    }
    float v1[16], v2[16];
#pragma unroll
    for (int k = 0; k < 16; ++k) { v1[k] = sortable2f(tkl[k * 64 + lane] & ~0x7Fu); v2[k] = sortable2f(tkl[(16 + k) * 64 + lane] & ~0x7Fu); }
    unsigned ck[64];
    {
        int ci = 0;
#pragma unroll
        for (int a = 0; a < 16; ++a) {
#pragma unroll
            for (int bb = 0; bb < 16 / (a + 1); ++bb) { ck[ci] = (f2sortable(v1[a] + v2[bb]) & ~0xFFu) | (unsigned)(255 - (16 * a + bb)); ++ci; }
        }
#pragma unroll
        for (int i = 50; i < 64; ++i) ck[i] = 0u;
    }
    top16_of_64(ck);
    float tv[16]; int te[16];
    float sum = 0.f;
#pragma unroll
    for (int k = 0; k < 16; ++k) {
        const int flat = 255 - (int)(ck[k] & 0xFFu);
        const int i1 = 127 - (int)(tkl[(flat >> 4) * 64 + lane] & 0x7Fu), i2 = 127 - (int)(tkl[(16 + (flat & 15)) * 64 + lane] & 0x7Fu);
        te[k] = i1 * 128 + i2;
        tv[k] = __expf(sortable2f(ck[k] & ~0xFFu) - sortable2f(ck[0] & ~0xFFu)); sum += tv[k];
    }
    const float inv = 1.f / sum;
    if (hh == 0) {
        int* EI = (int*)(p.ws + OFF_EIDX) + (size_t)(n0 + r) * 128 + head * 16;
#pragma unroll
        for (int q = 0; q < 4; ++q) { u32x4 o; o[0] = te[4 * q]; o[1] = te[4 * q + 1]; o[2] = te[4 * q + 2]; o[3] = te[4 * q + 3]; *(u32x4*)(EI + 4 * q) = o; }
    } else {
        float* GW = (float*)(p.ws + OFF_GW) + (size_t)(n0 + r) * 128 + head * 16;
#pragma unroll
        for (int q = 0; q < 4; ++q) { f32x4 o; o[0] = tv[4 * q] * inv; o[1] = tv[4 * q + 1] * inv; o[2] = tv[4 * q + 2] * inv; o[3] = tv[4 * q + 3] * inv; *(f32x4*)(GW + 4 * q) = o; }
    }
}

__device__ __forceinline__ float gelu_exact(float a) { return 0.5f * a * (1.f + erff(a * 0.70710678118654752440f)); }
__device__ __forceinline__ float gelu_as(float v) {
    const float av = fabsf(v), t = __builtin_amdgcn_rcpf(av * 0.2316418882f + 1.0f);
    float q = t * 0.5307027145f + (-0.7265760135f); q = q * t + 0.7107068705f; q = q * t + (-0.142248368f); q = q * t + 0.127414796f; q = q * t;
    const float e = __builtin_amdgcn_exp2f((v * v) * (-0.72134752044f));
    const float m = v * (q * e), rr = v - m;
    return v < 0.f ? m : rr;
}
__device__ __forceinline__ void dec16_fp8(const u32x4 w, float (&f)[16]) {
#pragma unroll
    for (int i = 0; i < 4; ++i) {
        const f32x2 lo = __builtin_amdgcn_cvt_pk_f32_fp8((int)w[i], false), hi = __builtin_amdgcn_cvt_pk_f32_fp8((int)w[i], true);
        f[4 * i] = lo[0]; f[4 * i + 1] = lo[1]; f[4 * i + 2] = hi[0]; f[4 * i + 3] = hi[1];
    }
}
__device__ __forceinline__ void sort_pairs128(int& k_lo, int& k_hi, float& g_lo, float& g_hi, int lane) {
#pragma unroll
    for (int size = 2; size <= 128; size <<= 1) {
#pragma unroll
        for (int stride = size >> 1; stride >= 1; stride >>= 1) {
            if (stride == 64) {
                const bool sw = k_hi < k_lo;
                const int ta = sw ? k_hi : k_lo, tb = sw ? k_lo : k_hi; const float ga = sw ? g_hi : g_lo, gb = sw ? g_lo : g_hi;
                k_lo = ta; k_hi = tb; g_lo = ga; g_hi = gb;
            } else {
                int p_lo, p_hi; float q_lo, q_hi;
                if (stride == 1) { p_lo = (int)xchg_u32<1>((unsigned)k_lo, lane); p_hi = (int)xchg_u32<1>((unsigned)k_hi, lane); q_lo = xchg_f32<1>(g_lo, lane); q_hi = xchg_f32<1>(g_hi, lane); }
                else if (stride == 2) { p_lo = (int)xchg_u32<2>((unsigned)k_lo, lane); p_hi = (int)xchg_u32<2>((unsigned)k_hi, lane); q_lo = xchg_f32<2>(g_lo, lane); q_hi = xchg_f32<2>(g_hi, lane); }
                else if (stride == 4) { p_lo = (int)xchg_u32<4>((unsigned)k_lo, lane); p_hi = (int)xchg_u32<4>((unsigned)k_hi, lane); q_lo = xchg_f32<4>(g_lo, lane); q_hi = xchg_f32<4>(g_hi, lane); }
                else if (stride == 8) { p_lo = (int)xchg_u32<8>((unsigned)k_lo, lane); p_hi = (int)xchg_u32<8>((unsigned)k_hi, lane); q_lo = xchg_f32<8>(g_lo, lane); q_hi = xchg_f32<8>(g_hi, lane); }
                else if (stride == 16) { p_lo = (int)xchg_u32<16>((unsigned)k_lo, lane); p_hi = (int)xchg_u32<16>((unsigned)k_hi, lane); q_lo = xchg_f32<16>(g_lo, lane); q_hi = xchg_f32<16>(g_hi, lane); }
                else { p_lo = (int)xchg_u32<32>((unsigned)k_lo, lane); p_hi = (int)xchg_u32<32>((unsigned)k_hi, lane); q_lo = xchg_f32<32>(g_lo, lane); q_hi = xchg_f32<32>(g_hi, lane); }
                const bool lower = (lane & stride) == 0;
                const bool asc_lo = (size >= 64) ? true : ((lane & size) == 0);
                const bool asc_hi = (size == 128) ? true : ((size == 64) ? false : ((lane & size) == 0));
                const bool min_lo = (lower == asc_lo), min_hi = (lower == asc_hi);
                const bool take_lo = min_lo ? (p_lo < k_lo) : (p_lo > k_lo);
                const bool take_hi = min_hi ? (p_hi < k_hi) : (p_hi > k_hi);
                k_lo = take_lo ? p_lo : k_lo; g_lo = take_lo ? q_lo : g_lo;
                k_hi = take_hi ? p_hi : k_hi; g_hi = take_hi ? q_hi : g_hi;
            }
        }
    }
}
__device__ __forceinline__ void sort_keys128(unsigned& k_lo, unsigned& k_hi, int lane) {
#pragma unroll
    for (int size = 2; size <= 128; size <<= 1) {
#pragma unroll
        for (int stride = size >> 1; stride >= 1; stride >>= 1) {
            if (stride == 64) {
                const unsigned mn = min(k_lo, k_hi), mx = max(k_lo, k_hi); k_lo = mn; k_hi = mx;
            } else {
                unsigned p_lo, p_hi;
                if (stride == 1) { p_lo = xchg_u32<1>(k_lo, lane); p_hi = xchg_u32<1>(k_hi, lane); }
                else if (stride == 2) { p_lo = xchg_u32<2>(k_lo, lane); p_hi = xchg_u32<2>(k_hi, lane); }
                else if (stride == 4) { p_lo = xchg_u32<4>(k_lo, lane); p_hi = xchg_u32<4>(k_hi, lane); }
                else if (stride == 8) { p_lo = xchg_u32<8>(k_lo, lane); p_hi = xchg_u32<8>(k_hi, lane); }
                else if (stride == 16) { p_lo = xchg_u32<16>(k_lo, lane); p_hi = xchg_u32<16>(k_hi, lane); }
                else { p_lo = xchg_u32<32>(k_lo, lane); p_hi = xchg_u32<32>(k_hi, lane); }
                const bool lower = (lane & stride) == 0;
                const bool asc_lo = (size >= 64) ? true : ((lane & size) == 0);
                const bool asc_hi = (size == 128) ? true : ((size == 64) ? false : ((lane & size) == 0));
                const bool min_lo = (lower == asc_lo), min_hi = (lower == asc_hi);
                k_lo = min_lo ? min(k_lo, p_lo) : max(k_lo, p_lo);
                k_hi = min_hi ? min(k_hi, p_hi) : max(k_hi, p_hi);
            }
        }
    }
}
__device__ __forceinline__ void peer_finish_row(const Params& p, const float* ada, int tok, int d0, const float (&acc)[16], bool do_store, const f32x4 (&xin)[4], const f32x4 (&gin)[4], const f32x4 (&fgin)[4]) {
    const int b = tok >> 12;
    float* orow = p.out + (size_t)tok * 1024 + d0;
    float xo[16]; float ss = 0.f;
#pragma unroll
    for (int q = 0; q < 4; ++q) {
        const f32x4 xv = xin[q], gv = gin[q];
#pragma unroll
        for (int i = 0; i < 4; ++i) { const float v = xv[i] + gv[i] * acc[q * 4 + i]; xo[q * 4 + i] = v; ss += v * v; }
    }
    ss = wave_sum(ss);
    const float rstd = rsqrtf(ss * (1.f / 1024.f) + 1e-6f);
#pragma unroll
    for (int q = 0; q < 4; ++q) {
        const f32x4 fg = fgin[q];
        f32x4 ov;
#pragma unroll
        for (int i = 0; i < 4; ++i) ov[i] = xo[q * 4 + i] * rstd * fg[i];
        if (do_store) *(f32x4*)(orow + 4 * q) = ov;
    }
}
__device__ __forceinline__ float pe_tok_prep(LAS u32x4* hp, LAS int* el, LAS float* gl, const bf16_t* H2, const int* EI, const float* GW, int tok, int d0, int lane) {
    const u32x4 h0 = *(const u32x4*)(H2 + (size_t)tok * 1024 + d0), h1 = *(const u32x4*)(H2 + (size_t)tok * 1024 + d0 + 8);
    float hx[16];
#pragma unroll
    for (int i = 0; i < 4; ++i) { hx[2 * i] = lo16(h0[i]); hx[2 * i + 1] = hi16(h0[i]); hx[8 + 2 * i] = lo16(h1[i]); hx[8 + 2 * i + 1] = hi16(h1[i]); }
    float am = 0.f;
#pragma unroll
    for (int i = 0; i < 16; ++i) am = fmaxf(am, fabsf(hx[i]));
    am = fmaxf(wave_max_dpp(am), 1e-20f);
    const float hs = 119.f / am;
    u32x4 pl4;
#pragma unroll
    for (int w = 0; w < 2; ++w) {
        unsigned ph = 0u, pl = 0u;
#pragma unroll
        for (int e = 0; e < 8; ++e) {
            const int q = (int)rintf(hx[8 * w + e] * hs);
            const int lo = ((q + 8) & 15) - 8, hi = (q - lo) >> 4;
            pl |= (unsigned)(lo & 15) << (4 * e); ph |= (unsigned)(hi & 15) << (4 * e);
        }
        pl4[w] = ph; pl4[2 + w] = pl;
    }
    hp[lane] = pl4;
    unsigned k_lo = ((unsigned)EI[(size_t)tok * 128 + lane] << 7) | (unsigned)lane, k_hi = ((unsigned)EI[(size_t)tok * 128 + 64 + lane] << 7) | (unsigned)(64 + lane);
    LAS float* gtmp = (LAS float*)el;
    gtmp[lane] = GW[(size_t)tok * 128 + lane]; gtmp[64 + lane] = GW[(size_t)tok * 128 + 64 + lane];
    sort_keys128(k_lo, k_hi, lane);
    const float g_lo = gtmp[k_lo & 127u], g_hi = gtmp[k_hi & 127u];
    asm volatile("s_waitcnt lgkmcnt(0)" ::: "memory");
    el[lane] = (int)(k_lo >> 7); el[64 + lane] = (int)(k_hi >> 7); gl[lane] = g_lo; gl[64 + lane] = g_hi;
    return am * (1.f / (119.f * PEER_SU));
}
__device__ __forceinline__ void pe_acc_result(const int (&ta)[16], int csum, float (&acc)[16]) {
    const int coff = 8 * csum;
#pragma unroll
    for (int ch = 0; ch < 4; ++ch) {
        const unsigned T0 = (unsigned)ta[4 * ch], T1 = (unsigned)ta[4 * ch + 1], T2 = (unsigned)ta[4 * ch + 2], T3 = (unsigned)ta[4 * ch + 3];
        const int A3 = (int)T3, A2 = (int)(T2 - 16u * T3), A1 = (int)(T1 - 16u * T2), A0 = (int)(T0 - 16u * T1);
        acc[4 * ch + 0] = (float)(A0 - coff) * (1.f / (PEER_SC * PEER_SV)); acc[4 * ch + 1] = (float)(A1 - coff) * (1.f / (PEER_SC * PEER_SV));
        acc[4 * ch + 2] = (float)(A2 - coff) * (1.f / (PEER_SC * PEER_SV)); acc[4 * ch + 3] = (float)A3 * (1.f / (PEER_SC * PEER_SV));
    }
}
typedef short s16x2 __attribute__((ext_vector_type(2)));
__device__ __forceinline__ int dot2_i16(s16x2 a, int b, int c) { return __builtin_amdgcn_sdot2(a, __builtin_bit_cast(s16x2, b), c, false); }
__device__ __forceinline__ void pe_vgroup(int (&ta)[16], const u32x2 (&vv)[8], int base, int c01, int c23) {
#pragma unroll
    for (int ch = 0; ch < 4; ++ch) {
        const unsigned sel = (ch & 1) ? 0x07060302u : 0x05040100u;
        const s16x2 p01 = __builtin_bit_cast(s16x2, __builtin_amdgcn_perm(vv[base + 1][ch >> 1], vv[base][ch >> 1], sel));
        const s16x2 p23 = __builtin_bit_cast(s16x2, __builtin_amdgcn_perm(vv[base + 3][ch >> 1], vv[base + 2][ch >> 1], sel));
        ta[4 * ch + 0] = dot2_i16(p23, c23, dot2_i16(p01, c01, ta[4 * ch + 0]));
        ta[4 * ch + 1] = dot2_i16(p23 >> 4, c23, dot2_i16(p01 >> 4, c01, ta[4 * ch + 1]));
        ta[4 * ch + 2] = dot2_i16(p23 >> 8, c23, dot2_i16(p01 >> 8, c01, ta[4 * ch + 2]));
        ta[4 * ch + 3] = dot2_i16(p23 >> 12, c23, dot2_i16(p01 >> 12, c01, ta[4 * ch + 3]));
    }
}
__device__ __forceinline__ int dot8_z(unsigned a, unsigned b) { int d; asm("v_dot8_i32_i4 %0, %1, %2, 0" : "=v"(d) : "v"(a), "v"(b)); return d; }
#define DPPI(v, ctrl) __builtin_amdgcn_update_dpp(0, (v), (ctrl), 0xF, 0xF, true)
__device__ __forceinline__ void peer_experts(const Params& p, bool do_store, LAS unsigned char* lds, bool local) {
    const int wid = threadIdx.x >> 6, lane = threadIdx.x & 63;
    const bf16_t* H2 = (const bf16_t*)(p.ws + OFF_ACT); const unsigned char* UT = p.ws + OFF_UT; const unsigned char* VT = p.ws + OFF_VT;
    const int* EI = (const int*)(p.ws + OFF_EIDX); const float* GW = (const float*)(p.ws + OFF_GW); const float* ada = (const float*)(p.ws + OFF_ADA);
    const int d0 = 16 * lane;
    const unsigned vofs = 8u * (unsigned)lane;
    const int stride = gridDim.x * 8;
    LAS int* el = (LAS int*)(lds + wid * 16384);
    LAS float* gl = (LAS float*)(el + 1024);
    LAS u32x4* hp = (LAS u32x4*)(el + 2048);
    const LAS u32x4* el4 = (const LAS u32x4*)el;
    const LAS float* glane = gl + (lane >> 5) * 128 + 2 * ((lane >> 4) & 1) + (lane & 1);
    const LAS u32x4* hlane = hp + lane;
    const int tbase = local ? (int)blockIdx.x * 64 + wid * 8 : (int)blockIdx.x * 8 + wid, tstep = local ? 1 : stride;
    for (int tok0 = tbase; tok0 < NTOK; tok0 += 8 * stride) {
        __syncthreads();
        int tk[8]; bool has[8];
#pragma unroll
        for (int i = 0; i < 8; ++i) { has[i] = (tok0 + i * tstep) < NTOK; tk[i] = has[i] ? tok0 + i * tstep : tok0; }
        float asc[4]; int cs[4] = {0, 0, 0, 0};
#pragma unroll
        for (int i = 0; i < 4; ++i) {
            const float a0 = pe_tok_prep(hp + (2 * i) * 64, el + (2 * i) * 128, gl + (2 * i) * 128, H2, EI, GW, tk[2 * i], d0, lane);
            const float a1 = pe_tok_prep(hp + (2 * i + 1) * 64, el + (2 * i + 1) * 128, gl + (2 * i + 1) * 128, H2, EI, GW, tk[2 * i + 1], d0, lane);
            asc[i] = lane < 32 ? a0 : a1;
        }
        int ta[8][16];
#pragma unroll
        for (int i = 0; i < 8; ++i)
#pragma unroll
            for (int j = 0; j < 16; ++j) ta[i][j] = 0;
        u32x2 uX[8], uY[8], vX[8], vY[8];
#define PE_ISSUE(UU, VV, EA, EB) do { _Pragma("unroll") for (int q = 0; q < 8; ++q) { \
            const unsigned off_ = ((q < 4 ? EA[q & 3] : EB[q & 3]) << 9) | vofs; \
            asm volatile("global_load_dwordx2 %0, %1, %2" : "=v"(UU[q]) : "v"(off_), "s"(UT)); \
            asm volatile("global_load_dwordx2 %0, %1, %2" : "=v"(VV[q]) : "v"(off_), "s"(VT)); } } while (0)
#define PE_WAIT(UU, VV, N) do { asm volatile("s_waitcnt vmcnt(" #N ")"); \
            _Pragma("unroll") for (int q = 0; q < 8; ++q) asm volatile("" : "+v"(UU[q]), "+v"(VV[q])); } while (0)
#define PE_COMPUTE(UU, VV, GM, HA, HB, PI) do { \
            int sv[8]; \
            _Pragma("unroll") for (int q = 0; q < 8; ++q) { \
                const int dh_ = __builtin_amdgcn_sdot8((int)UU[q][1], (int)(q < 4 ? HA[1] : HB[1]), dot8_z(UU[q][0], (q < 4 ? HA[0] : HB[0])), false); \
                const int dl_ = __builtin_amdgcn_sdot8((int)UU[q][1], (int)(q < 4 ? HA[3] : HB[3]), dot8_z(UU[q][0], (q < 4 ? HA[2] : HB[2])), false); \
                sv[q] = (dh_ << 4) + dl_; } \
            int t4[4]; \
            _Pragma("unroll") for (int i = 0; i < 4; ++i) { const u32x2 r_ = __builtin_amdgcn_permlane32_swap((unsigned)sv[i], (unsigned)sv[i + 4], false, false); t4[i] = (int)r_[0] + (int)r_[1]; } \
            int w2[2]; \
            _Pragma("unroll") for (int i = 0; i < 2; ++i) { const u32x2 r_ = __builtin_amdgcn_permlane16_swap((unsigned)t4[i], (unsigned)t4[i + 2], false, false); w2[i] = (int)r_[0] + (int)r_[1]; } \
            _Pragma("unroll") for (int i = 0; i < 2; ++i) { w2[i] += DPPI(w2[i], 0xB1); w2[i] += DPPI(w2[i], 0x4E); w2[i] += DPPI(w2[i], 0x141); w2[i] += DPPI(w2[i], 0x140); } \
            const float mine = (float)((lane & 1) ? w2[1] : w2[0]) * asc[PI]; \
            const float cmine = (GM) * gelu_as(mine); \
            const int cqm = (int)fminf(fmaxf(rintf(cmine * PEER_SC), -16383.f), 16383.f);        \
            cs[PI] += cqm; \
              \
            const int pk_ = (int)__builtin_amdgcn_perm((unsigned)DPPI(cqm, 0xB1), (unsigned)cqm, 0x05040100u); \
            pe_vgroup(ta[2 * (PI)], VV, 0, __builtin_amdgcn_readlane(pk_, 0), __builtin_amdgcn_readlane(pk_, 16)); \
            pe_vgroup(ta[2 * (PI) + 1], VV, 4, __builtin_amdgcn_readlane(pk_, 32), __builtin_amdgcn_readlane(pk_, 48)); } while (0)
#define PE_STEP(UI, VI, PN, KN, UC, VC, PC, KC) do { \
            { const u32x4 ea_ = el4[(2 * (PN)) * 32 + ((KN) >> 2)], eb_ = el4[(2 * (PN) + 1) * 32 + ((KN) >> 2)]; PE_ISSUE(UI, VI, ea_, eb_); } \
            const float g_ = glane[(PC) * 256 + (KC)]; \
            const u32x4 ha_ = hlane[(2 * (PC)) * 64], hb_ = hlane[(2 * (PC) + 1) * 64]; \
            PE_WAIT(UC, VC, 16); \
            PE_COMPUTE(UC, VC, g_, ha_, hb_, PC); } while (0)
        { const u32x4 ea_ = el4[0], eb_ = el4[32]; PE_ISSUE(uX, vX, ea_, eb_); }
#pragma unroll 1
        for (int k0 = 0; k0 < 128; k0 += 4) {
            if ((k0 & 31) == 0 && k0) __syncthreads();
            const int kn = (k0 + 4 < 128) ? k0 + 4 : k0;
            PE_STEP(uY, vY, 1, k0, uX, vX, 0, k0);
            PE_STEP(uX, vX, 2, k0, uY, vY, 1, k0);
            PE_STEP(uY, vY, 3, k0, uX, vX, 2, k0);
            PE_STEP(uX, vX, 0, kn, uY, vY, 3, k0);
        }
        PE_WAIT(uX, vX, 0);
#undef PE_STEP
#undef PE_WAIT
#undef PE_ISSUE
#undef PE_COMPUTE
        float acc[16];
        f32x4 xr[2][4];
#pragma unroll
        for (int k = 0; k < 2; ++k)
#pragma unroll
            for (int q = 0; q < 4; ++q) xr[k][q] = *(const f32x4*)(p.out + (size_t)tk[k] * 1024 + d0 + 4 * q);
        f32x4 fgv[4], gvr[2][4];
#pragma unroll
        for (int q = 0; q < 4; ++q) { fgv[q] = *(const f32x4*)(p.final_g + d0 + 4 * q); gvr[0][q] = *(const f32x4*)(ada + (tk[0] >> 12) * 6144 + 5120 + d0 + 4 * q); }
#pragma unroll
        for (int i = 0; i < 8; ++i) {
            const int l0 = (i & 1) ? 32 : 0;
            if (i + 1 < 8) {
#pragma unroll
                for (int q = 0; q < 4; ++q) gvr[(i + 1) & 1][q] = *(const f32x4*)(ada + (tk[i + 1] >> 12) * 6144 + 5120 + d0 + 4 * q);
            }
            const int csum = __builtin_amdgcn_readlane(cs[i >> 1], l0) + __builtin_amdgcn_readlane(cs[i >> 1], l0 + 1) + __builtin_amdgcn_readlane(cs[i >> 1], l0 + 16) + __builtin_amdgcn_readlane(cs[i >> 1], l0 + 17);
            pe_acc_result(ta[i], csum, acc); peer_finish_row(p, ada, tk[i], d0, acc, do_store && has[i], xr[i & 1], gvr[i & 1], fgv);
            if (i + 2 < 8) {
#pragma unroll
                for (int q = 0; q < 4; ++q) xr[i & 1][q] = *(const f32x4*)(p.out + (size_t)tk[i + 2] * 1024 + d0 + 4 * q);
            }
        }
    }
}

enum { PH_PREP = 0, PH_GEMM_IN, PH_MIX, PH_GEMM_OUT, PH_H2, PH_GEMM_Q, PH_ROUTE, PH_EXPERT, PH_COUNT };

typedef const __attribute__((address_space(4))) Params* KParams;
__device__ __forceinline__ const Params& kparams() {
    auto q = __builtin_amdgcn_kernarg_segment_ptr();
    asm volatile("" : "+s"(q));
    return *(const Params*)q;
}
#ifndef PHMASK
#define PHMASK 0xFFFF
#endif
#ifndef REP_PHASE
#define REP_PHASE -1
#endif
#define PHASE_BEGIN(idx) if (((PHMASK >> (idx)) & 1) && ph_lo <= (idx) && (idx) < ph_hi) { for (int rep = 0; rep < ((idx) == REP_PHASE ? 2 : 1); ++rep) { if ((idx) != ph_lo || rep) xcd_barrier(bar); const Params& p = kparams(); const int G = gridDim.x; (void)G; const bool last_rep = (rep == ((idx) == REP_PHASE ? 1 : 0)); (void)last_rep;
#define PHASE_END } }

__global__ void __launch_bounds__(NTHREADS, 2) hymba_fwd(Params p_) {
    extern __shared__ __attribute__((aligned(16))) unsigned char smem_raw[];
    LAS unsigned char* lds = (LAS unsigned char*)smem_raw;
    volatile LAS unsigned* xbw = (volatile LAS unsigned*)(lds + LDS_BYTES - 16);
    if (threadIdx.x == 0) { xbw[0] = 0u; xbw[1] = 0u; xbw[2] = 0u; xbw[3] = 0u; }
    __syncthreads();
    XcdBarrier bar = xcd_barrier_post((unsigned*)(p_.ws + OFF_CTL), xbw);
    const int ph_lo = p_.ph_lo, ph_hi = p_.ph_hi;

    PHASE_BEGIN(PH_PREP)
        phase0(p, lds);
        wg_wait((unsigned*)(p.ws + OFF_CTL), CNT_ADA, 192u);
        norm_mod_rows(p.x, p.norm1_g, (const float*)(p.ws + OFF_ADA), 0, 1024, (bf16_t*)(p.ws + OFF_ACT));
    PHASE_END
    PHASE_BEGIN(PH_GEMM_IN)
        {   pg8::StaticOrder S; S.init(NTOK, 3072, G, blockIdx.x);
            EpiInMain E; E.ws = p.ws; E.bias = (const float*)(p.ws + OFF_BIAS);
            pg8::gemm_phase(lds, pg8::Gemm{(const bf16_t*)(p.ws + OFF_ACT), (const bf16_t*)(p.ws + OFF_WIN), NTOK, 3072, 1024}, S, E); }
        {   pg8::StaticOrder S; S.init(NTOK, 256, G, blockIdx.x);
            EpiInTail E; E.ws = p.ws; E.bias = (const float*)(p.ws + OFF_BIAS) + 3072;
            pg8::gemm_phase(lds, pg8::Gemm{(const bf16_t*)(p.ws + OFF_ACT), (const bf16_t*)(p.ws + OFF_WIN) + (size_t)3072 * 1024, NTOK, 256, 1024}, S, E); }
        if (G > 64) { if ((int)blockIdx.x >= 64) convert_tables(p, (int)blockIdx.x - 64, G - 64); }
        else convert_tables(p, (int)blockIdx.x, G);
    PHASE_END
    PHASE_BEGIN(PH_MIX)
        unsigned* ctl = (unsigned*)(p.ws + OFF_CTL);
        {   PaPre A;
            int t = blockIdx.x;
            if (t + G < 1024) pa_prefetch(p, t, t + G, A);
            for (; t < 1024; t += 2 * G) {
                if (t + G < 1024) { const int tn = t + 2 * G; const bool nx = tn + G < 1024; mlstm_passA2(p, t, t + G, lds, A, nx ? tn : -1, nx ? tn + G : -1); }
                else mlstm_passA(p, t, lds);
            }
        }
        __syncthreads();
        {
            auto dsa_map = [](int t) { const int rnd = t >> 8, w = t & 255; const int bsel = rnd >> 1; const int qgs = (rnd & 1) ? w : (511 - w); return (bsel << 9) | qgs; };
            DsaPre S;
            int t = blockIdx.x;
            if (t < 2048) dsa_prefetch(p, dsa_map(t), S);
            for (; t < 2048; t += G) dsa_task(p, dsa_map(t), lds, S, (t + G < 2048) ? dsa_map(t + G) : -1);
            __syncthreads();
        }
        xcd_barrier(bar);
        for (int t = blockIdx.x; t < 256; t += G) mlstm_scan(p, t, lds);
        xcd_barrier(bar);
        {   PbPre S;
            int t = blockIdx.x;
            if (t < 1024) pb_prefetch(p, t, S);
            for (; t < 1024; t += G) mlstm_passB(p, t, lds, S, (t + G < 1024) ? t + G : -1);
            __syncthreads();
        }
    PHASE_END
    PHASE_BEGIN(PH_GEMM_OUT)
        {   pg8::StaticOrder S; S.init(NTOK, 1024, G, blockIdx.x);
            EpiOut E; E.x = p.x; E.ada = (const float*)(p.ws + OFF_ADA); E.out = p.out;
            pg8::gemm_phase(lds, pg8::Gemm{(const bf16_t*)(p.ws + OFF_ACT), (const bf16_t*)(p.ws + OFF_WOUT), NTOK, 1024, 1024}, S, E); }
    PHASE_END
    PHASE_BEGIN(PH_H2) norm_mod_rows(p.out, p.norm2_g, (const float*)(p.ws + OFF_ADA), 3072, 4096, (bf16_t*)(p.ws + OFF_ACT)); PHASE_END
    PHASE_BEGIN(PH_GEMM_Q)
        {   pg8::StaticOrder S; S.init(NTOK, 1024, G, blockIdx.x);
            EpiQry E; E.O = (bf16_t*)(p.ws + OFF_QRY);
            pg8::gemm_phase(lds, pg8::Gemm{(const bf16_t*)(p.ws + OFF_ACT), (const bf16_t*)(p.ws + OFF_WPQ), NTOK, 1024, 1024}, S, E); }
    PHASE_END
    PHASE_BEGIN(PH_ROUTE)
        if (G * 64 == NTOK) { peer_route(p, 2 * (int)blockIdx.x, lds); peer_route(p, 2 * (int)blockIdx.x + 1, lds); }
        else for (int t = blockIdx.x; t < 512; t += G) peer_route(p, t, lds);
    PHASE_END
    if (((PHMASK >> PH_EXPERT) & 1) && ph_lo <= PH_EXPERT && PH_EXPERT < ph_hi) {
        const Params& p = kparams(); const int G = gridDim.x;
        const bool local = (G * 64 == NTOK) && (ph_lo < PH_EXPERT);
        if (local) {
            asm volatile("s_waitcnt vmcnt(0)" ::: "memory");
            __syncthreads();
            if (threadIdx.x == 0) { __builtin_amdgcn_fence(__ATOMIC_ACQUIRE, "agent"); asm volatile("s_waitcnt vmcnt(0)" ::: "memory"); }
            __syncthreads();
        } else if (ph_lo != PH_EXPERT) xcd_barrier(bar);
        peer_experts(p, true, lds, local);
    }
}

extern "C" void kernel_launch(void* const* d_in, const int* in_sizes, int n_in, void* d_out, int out_size, void* d_ws, size_t ws_size, hipStream_t stream) {
    static int grid = 0;
    if (grid == 0) {
        int dev = 0, cus = 0, per_cu = 0;
        if (hipGetDevice(&dev) != hipSuccess || hipDeviceGetAttribute(&cus, hipDeviceAttributeMultiprocessorCount, dev) != hipSuccess) { fprintf(stderr, "kernel_launch: device query failed\n"); grid = -1; return; }
        if (hipFuncSetAttribute((const void*)hymba_fwd, hipFuncAttributeMaxDynamicSharedMemorySize, LDS_BYTES) != hipSuccess) { fprintf(stderr, "kernel_launch: hipFuncSetAttribute failed\n"); grid = -1; return; }
        if (hipOccupancyMaxActiveBlocksPerMultiprocessor(&per_cu, (const void*)hymba_fwd, NTHREADS, LDS_BYTES) != hipSuccess || per_cu < 1) { fprintf(stderr, "kernel_launch: occupancy query says %d blocks/CU\n", per_cu); }
        (void)hipGetLastError();
        grid = cus;
        if (ws_size < WS_END || n_in != 17) { fprintf(stderr, "kernel_launch: unexpected sizes (ws %zu, n_in %d)\n", ws_size, n_in); grid = -1; return; }
    }
    if (grid < 0) return;
    (void)hipMemsetAsync((char*)d_ws + OFF_CTL, 0, CTL_BYTES, stream);
    Params p{};
    p.x = (const float*)d_in[0]; p.c = (const float*)d_in[1]; p.w_ada = (const float*)d_in[2]; p.b_ada = (const float*)d_in[3]; p.norm1_g = (const float*)d_in[4];
    p.w_in = (const float*)d_in[5]; p.b_in = (const float*)d_in[6]; p.conv_qk = (const float*)d_in[7]; p.out_norm_m = (const float*)d_in[8]; p.out_norm_a = (const float*)d_in[9];
    p.w_out = (const float*)d_in[10]; p.norm2_g = (const float*)d_in[11]; p.w_peer_q = (const float*)d_in[12]; p.sub_keys = (const float*)d_in[13]; p.peer_u = (const float*)d_in[14];
    p.peer_v = (const float*)d_in[15]; p.final_g = (const float*)d_in[16];
    p.out = (float*)d_out; p.ws = (unsigned char*)d_ws; p.ph_lo = 0; p.ph_hi = PH_COUNT;
    void* args[] = {&p};
    hipError_t e = hipLaunchCooperativeKernel((const void*)hymba_fwd, dim3(grid), dim3(NTHREADS), args, LDS_BYTES, stream);
    if (e != hipSuccess) fprintf(stderr, "kernel_launch: cooperative launch failed: %s (grid %d)\n", hipGetErrorString(e), grid);
}
```
